# Optimizing an MI355X kernel written in HIP

```python
import jax
import jax.numpy as jnp
from jax import lax
import numpy as np

D_MODEL = 1024
BATCH = 8
SEQ = 2048
DEPTH = 2

GRID_W = 64
CTX_LEN = 256
CHUNK = 128
Q_BLOCK = 128
EPS = 1e-6
N_MOD = 6

SGU_HEADS = 4
SGU_HEAD_DIM = 64
SGU_WIDTH = SGU_HEADS * SGU_HEAD_DIM

SSD_HEADS = 6
SSD_HEAD_DIM = 64
SSD_WIDTH = SSD_HEADS * SSD_HEAD_DIM
SSD_GROUPS = 2
SSD_HPG = SSD_HEADS // SSD_GROUPS
SSD_STATE = 128
SSD_CONV = 5
SSD_BC = SSD_GROUPS * SSD_STATE
SSD_CONV_CH = SSD_WIDTH + 2 * SSD_BC

MLA_HEADS = 6
MLA_NOPE = 64
MLA_ROPE = 32
MLA_V = 64
MLA_WIDTH = MLA_HEADS * MLA_V
Q_LORA = 384
KV_LORA = 256
ROPE_THETA = 10000.0
MLA_SCALE = (MLA_NOPE + MLA_ROPE) ** -0.5

MIX_WIDTH = SGU_WIDTH + SSD_WIDTH + MLA_WIDTH
IN_SGU = 2 * SGU_WIDTH
IN_SSD = SSD_WIDTH + SSD_CONV_CH + 2 * SSD_HEADS
IN_MLA = Q_LORA + KV_LORA + MLA_ROPE
IN_WIDTH = IN_SGU + IN_SSD + IN_MLA

D_FF = 2816
N_EXPERTS = 8
TOP_K = 2
D_FF_EXPERT = 1408

kernel_name = "hybrid_sgu_ssd_mla_moe_dit"


def rmsnorm(x, g):
    xf = x.astype(jnp.float32)
    y = xf * lax.rsqrt(jnp.mean(xf * xf, axis=-1, keepdims=True) + EPS)
    return y.astype(x.dtype) * g


def layernorm(x, g, b):
    xf = x.astype(jnp.float32)
    mu = jnp.mean(xf, axis=-1, keepdims=True)
    xc = xf - mu
    y = xc * lax.rsqrt(jnp.mean(xc * xc, axis=-1, keepdims=True) + EPS)
    return y.astype(x.dtype) * g + b


def modulate(x, g, shift, scale):
    return rmsnorm(x, g) * (1 + scale) + shift


def axial_rope_tables(n_tokens):
    grid_rows = n_tokens // GRID_W
    row = jnp.repeat(jnp.arange(grid_rows, dtype=jnp.float32), GRID_W)
    col = jnp.tile(jnp.arange(GRID_W, dtype=jnp.float32), grid_rows)
    n_freq = MLA_ROPE // 4
    inv_freq = ROPE_THETA ** (-jnp.arange(n_freq, dtype=jnp.float32) / n_freq)
    ang = jnp.stack([row[:, None] * inv_freq, col[:, None] * inv_freq], axis=1)
    return jnp.cos(ang), jnp.sin(ang)


def apply_axial_rope(t, cos, sin):
    shp = t.shape
    t = t.reshape(shp[:-1] + (2, 2, MLA_ROPE // 4))
    t1, t2 = t[..., 0, :], t[..., 1, :]
    cos = cos.astype(t.dtype)
    sin = sin.astype(t.dtype)
    out = jnp.stack([t1 * cos - t2 * sin, t1 * sin + t2 * cos], axis=-2)
    return out.reshape(shp)


def sgu_mixer(p, w_s, b_s, g_n, beta_n):
    bsz, n, _ = p.shape
    u, v = jnp.split(jax.nn.gelu(p), 2, axis=-1)
    v = layernorm(v, g_n, beta_n).reshape(bsz, n // CHUNK, CHUNK, SGU_HEADS, SGU_HEAD_DIM)
    mixed = jnp.einsum('hts,bcshd->bcthd', w_s, v) + b_s.T[:, :, None]
    return u * mixed.reshape(bsz, n, SGU_WIDTH)


def depthwise_conv(x, w, b):
    pad = SSD_CONV // 2
    y = lax.conv_general_dilated(x, w[:, None, :], window_strides=(1,), padding=[(pad, pad)],
                                 dimension_numbers=('NWC', 'WIO', 'NWC'), feature_group_count=x.shape[-1])
    return y + b


def ssd_streams(p, conv_w, conv_b, dt_bias):
    bsz, n, _ = p.shape
    z = p[..., :SSD_WIDTH]
    xbc = jax.nn.silu(depthwise_conv(p[..., SSD_WIDTH:SSD_WIDTH + SSD_CONV_CH], conv_w, conv_b))
    dt = jax.nn.softplus(p[..., SSD_WIDTH + SSD_CONV_CH:] + dt_bias.reshape(-1))
    xs = xbc[..., :SSD_WIDTH].reshape(bsz, n, SSD_GROUPS, SSD_HPG, SSD_HEAD_DIM)
    bm = xbc[..., SSD_WIDTH:SSD_WIDTH + SSD_BC].reshape(bsz, n, SSD_GROUPS, SSD_STATE)
    cm = xbc[..., SSD_WIDTH + SSD_BC:].reshape(bsz, n, SSD_GROUPS, SSD_STATE)
    dt = dt.reshape(bsz, n, 2, SSD_GROUPS, SSD_HPG)
    return z, xs, bm, cm, dt


def ssd_final_state(x, dt, a, bm):
    acs = jnp.cumsum(dt.astype(jnp.float32) * a, axis=1)
    w = jnp.exp(acs[:, -1:] - acs).astype(x.dtype) * dt
    return jnp.einsum('blgn,blgj,blgjp->bgjpn', bm, w, x)


def ssd_chunked(x, dt, a, bm, cm, h0):
    bsz, n, g, j, p = x.shape
    nc = n // CHUNK
    xc = x.reshape(bsz, nc, CHUNK, g, j, p)
    dtc = dt.reshape(bsz, nc, CHUNK, g, j)
    bc = bm.reshape(bsz, nc, CHUNK, g, SSD_STATE)
    cc = cm.reshape(bsz, nc, CHUNK, g, SSD_STATE)
    acs = jnp.cumsum(dtc.astype(jnp.float32) * a, axis=2)
    xdt = xc * dtc[..., None]
    seg = acs[:, :, :, None] - acs[:, :, None, :]
    lower = jnp.tril(jnp.ones((CHUNK, CHUNK), dtype=bool))[:, :, None, None]
    decay = jnp.exp(jnp.where(lower, seg, -jnp.inf)).astype(x.dtype)
    cb = jnp.einsum('bclgn,bcsgn->bclsg', cc, bc)
    y_diag = jnp.einsum('bclsgj,bcsgjp->bclgjp', cb[..., None] * decay, xdt)
    to_end = jnp.exp(acs[:, :, -1:] - acs).astype(x.dtype)
    states = jnp.einsum('bcsgn,bcsgj,bcsgjp->bcgjpn', bc, to_end, xdt)
    chunk_decay = jnp.exp(acs[:, :, -1]).astype(x.dtype)

    def carry_step(h, inp):
        dec, st = inp
        return dec[..., None, None] * h + st, h

    _, h_in = lax.scan(carry_step, h0, (jnp.moveaxis(chunk_decay, 1, 0), jnp.moveaxis(states, 1, 0)))
    h_in = jnp.moveaxis(h_in, 0, 1)
    y_off = jnp.einsum('bclgn,bcgjpn,bclgj->bclgjp', cc, h_in, jnp.exp(acs).astype(x.dtype))
    return (y_diag + y_off).reshape(bsz, n, g, j, p)


def ssd_mixer(p, pc, conv_w, conv_b, dt_bias, a_log, d_skip, g_ssd, need_ctx):
    z, xs, bm, cm, dt = ssd_streams(p, conv_w, conv_b, dt_bias)
    zc, xsc, bmc, cmc, dtc = ssd_streams(pc, conv_w, conv_b, dt_bias)
    a = -jnp.exp(a_log.astype(jnp.float32)).reshape(2, SSD_GROUPS, SSD_HPG)
    skip = d_skip.reshape(SSD_GROUPS, SSD_HPG, 1)
    bsz, n = xs.shape[:2]
    y = skip * xs
    yc = skip * xsc
    for direction in range(2):
        order = (lambda t: t) if direction == 0 else (lambda t: jnp.flip(t, axis=1))
        h_ctx = ssd_final_state(order(xsc), order(dtc[:, :, direction]), a[direction], order(bmc))
        y = y + order(ssd_chunked(order(xs), order(dt[:, :, direction]), a[direction],
                                  order(bm), order(cm), h_ctx))
        if need_ctx:
            yc = yc + order(ssd_chunked(order(xsc), order(dtc[:, :, direction]), a[direction],
                                        order(bmc), order(cmc), jnp.zeros_like(h_ctx)))
    out = rmsnorm(y.reshape(bsz, n, SSD_WIDTH) * jax.nn.silu(z), g_ssd)
    if not need_ctx:
        return out, None
    outc = rmsnorm(yc.reshape(bsz, pc.shape[1], SSD_WIDTH) * jax.nn.silu(zc), g_ssd)
    return out, outc


def mla_queries(p, g_q, w_uq):
    bsz, n, _ = p.shape
    q = (rmsnorm(p[..., :Q_LORA], g_q) @ w_uq).reshape(bsz, n, MLA_HEADS, MLA_NOPE + MLA_ROPE)
    return q[..., :MLA_NOPE], q[..., MLA_NOPE:]


def mla_keys_values(p, g_kv, w_ukv):
    bsz, n, _ = p.shape
    kv = (rmsnorm(p[..., Q_LORA:Q_LORA + KV_LORA], g_kv) @ w_ukv).reshape(bsz, n, MLA_HEADS, MLA_NOPE + MLA_V)
    k_rope = p[..., Q_LORA + KV_LORA:]
    return kv[..., :MLA_NOPE], k_rope, kv[..., MLA_NOPE:]


def mla_attend(qn, qr, kn, kr, v):
    s = jnp.einsum('bqhd,bkhd->bhqk', qn, kn) + jnp.einsum('bqhr,bkr->bhqk', qr, kr)
    prob = jax.nn.softmax(s.astype(jnp.float32) * MLA_SCALE, axis=-1).astype(v.dtype)
    return jnp.einsum('bhqk,bkhd->bqhd', prob, v)


def mla_mixer(p, pc, g_q, w_uq, g_kv, w_ukv, cos, sin, need_ctx):
    bsz, n, _ = p.shape
    qn, qr = mla_queries(p, g_q, w_uq)
    qr = apply_axial_rope(qr, cos[:, None], sin[:, None])
    kn, kr, v = mla_keys_values(p, g_kv, w_ukv)
    kr = apply_axial_rope(kr, cos, sin)
    knc, krc, vc = mla_keys_values(pc, g_kv, w_ukv)
    kn_all = jnp.concatenate([knc, kn], axis=1)
    kr_all = jnp.concatenate([krc, kr], axis=1)
    v_all = jnp.concatenate([vc, v], axis=1)
    n_blk = n // Q_BLOCK

    def to_blocks(t):
        return jnp.moveaxis(t.reshape((bsz, n_blk, Q_BLOCK) + t.shape[2:]), 1, 0)

    o = lax.map(lambda qb: mla_attend(qb[0], qb[1], kn_all, kr_all, v_all), (to_blocks(qn), to_blocks(qr)))
    o = jnp.moveaxis(o, 0, 1).reshape(bsz, n, MLA_WIDTH)
    if not need_ctx:
        return o, None
    qnc, qrc = mla_queries(pc, g_q, w_uq)
    oc = mla_attend(qnc, qrc, knc, krc, vc).reshape(bsz, pc.shape[1], MLA_WIDTH)
    return o, oc


def swiglu(h, wg, wu, wd):
    return (jax.nn.silu(h @ wg) * (h @ wu)) @ wd


def moe_ffn(h, w_router, wg, wu, wd):
    logits = (h @ w_router).astype(jnp.float32)
    top_logit, top_idx = lax.top_k(logits, TOP_K)
    top_w = jax.nn.softmax(top_logit, axis=-1).astype(h.dtype)
    out = jnp.zeros_like(h)
    for e in range(N_EXPERTS):
        gate_e = jnp.sum(jnp.where(top_idx == e, top_w, 0), axis=-1, keepdims=True)
        out = out + gate_e * swiglu(h, wg[e], wu[e], wd[e])
    return out


def setup_inputs(seed: int = 0) -> dict:
    key = jax.random.key(seed)
    ks = iter(jax.random.split(key, 40))
    L = DEPTH
    n_dense = (DEPTH + 1) // 2
    n_moe = DEPTH // 2

    def nrm(shape, scale):
        return jax.random.normal(next(ks), shape, jnp.float32) * scale

    def gain(shape):
        return 1.0 + nrm(shape, 0.02)

    x = nrm((BATCH, SEQ, D_MODEL), 1.0)
    c = nrm((BATCH, D_MODEL), 1.0)
    ctx = nrm((BATCH, CTX_LEN, D_MODEL), 1.0)
    c_ctx = nrm((D_MODEL,), 1.0)
    w_mod = nrm((L, D_MODEL, N_MOD * D_MODEL), 0.5 * D_MODEL ** -0.5)
    b_mod = nrm((L, N_MOD * D_MODEL), 0.02)
    g_mix = gain((L, D_MODEL))
    w_in = nrm((L, D_MODEL, IN_WIDTH), D_MODEL ** -0.5)
    w_sgu = nrm((L, SGU_HEADS, CHUNK, CHUNK), CHUNK ** -0.5)
    b_sgu = nrm((L, SGU_HEADS, CHUNK), 0.02)
    g_sgu = gain((L, SGU_WIDTH))
    beta_sgu = nrm((L, SGU_WIDTH), 0.02)
    conv_w = nrm((L, SSD_CONV, SSD_CONV_CH), SSD_CONV ** -0.5)
    conv_b = nrm((L, SSD_CONV_CH), 0.02)
    dt0 = jnp.exp(jax.random.uniform(next(ks), (L, 2, SSD_HEADS), jnp.float32, np.log(1e-3), np.log(1e-1)))
    dt_bias = dt0 + jnp.log(-jnp.expm1(-dt0))
    a_log = jnp.log(jax.random.uniform(next(ks), (L, 2, SSD_HEADS), jnp.float32, 1.0, 16.0))
    d_skip = gain((L, SSD_HEADS))
    g_ssd = gain((L, SSD_WIDTH))
    g_q = gain((L, Q_LORA))
    w_uq = nrm((L, Q_LORA, MLA_HEADS * (MLA_NOPE + MLA_ROPE)), Q_LORA ** -0.5)
    g_kv = gain((L, KV_LORA))
    w_ukv = nrm((L, KV_LORA, MLA_HEADS * (MLA_NOPE + MLA_V)), KV_LORA ** -0.5)
    w_out = nrm((L, MIX_WIDTH, D_MODEL), MIX_WIDTH ** -0.5)
    g_ffn = gain((L, D_MODEL))
    w_gate = nrm((n_dense, D_MODEL, D_FF), D_MODEL ** -0.5)
    w_up = nrm((n_dense, D_MODEL, D_FF), D_MODEL ** -0.5)
    w_down = nrm((n_dense, D_FF, D_MODEL), D_FF ** -0.5)
    w_router = nrm((n_moe, D_MODEL, N_EXPERTS), D_MODEL ** -0.5)
    w_gate_e = nrm((n_moe, N_EXPERTS, D_MODEL, D_FF_EXPERT), D_MODEL ** -0.5)
    w_up_e = nrm((n_moe, N_EXPERTS, D_MODEL, D_FF_EXPERT), D_MODEL ** -0.5)
    w_down_e = nrm((n_moe, N_EXPERTS, D_FF_EXPERT, D_MODEL), D_FF_EXPERT ** -0.5)
    g_final = gain((D_MODEL,))
    return {"x": x, "c": c, "ctx": ctx, "c_ctx": c_ctx, "w_mod": w_mod, "b_mod": b_mod, "g_mix": g_mix,
            "w_in": w_in, "w_sgu": w_sgu, "b_sgu": b_sgu, "g_sgu": g_sgu, "beta_sgu": beta_sgu,
            "conv_w": conv_w, "conv_b": conv_b, "dt_bias": dt_bias, "a_log": a_log, "d_skip": d_skip,
            "g_ssd": g_ssd, "g_q": g_q, "w_uq": w_uq, "g_kv": g_kv, "w_ukv": w_ukv, "w_out": w_out,
            "g_ffn": g_ffn, "w_gate": w_gate, "w_up": w_up, "w_down": w_down, "w_router": w_router,
            "w_gate_e": w_gate_e, "w_up_e": w_up_e, "w_down_e": w_down_e, "g_final": g_final}


def reference(x, c, ctx, c_ctx, w_mod, b_mod, g_mix, w_in, w_sgu, b_sgu, g_sgu, beta_sgu, conv_w, conv_b,
              dt_bias, a_log, d_skip, g_ssd, g_q, w_uq, g_kv, w_ukv, w_out, g_ffn, w_gate, w_up, w_down,
              w_router, w_gate_e, w_up_e, w_down_e, g_final):
    bsz, n, d = x.shape
    cos, sin = axial_rope_tables(n)
    cond = jax.nn.silu(c)
    cond_ctx = jax.nn.silu(c_ctx)
    xc = ctx
    for layer in range(DEPTH):
        need_ctx = layer < DEPTH - 1
        mod = (cond @ w_mod[layer] + b_mod[layer]).reshape(bsz, 1, N_MOD, d)
        modc = (cond_ctx @ w_mod[layer] + b_mod[layer]).reshape(N_MOD, d)
        h = modulate(x, g_mix[layer], mod[:, :, 0], mod[:, :, 1])
        hc = modulate(xc, g_mix[layer], modc[0], modc[1])
        p = h @ w_in[layer]
        pc = hc @ w_in[layer]
        s0, s1 = IN_SGU, IN_SGU + IN_SSD
        o_sgu = sgu_mixer(p[..., :s0], w_sgu[layer], b_sgu[layer], g_sgu[layer], beta_sgu[layer])
        o_ssd, oc_ssd = ssd_mixer(p[..., s0:s1], pc[..., s0:s1], conv_w[layer], conv_b[layer], dt_bias[layer],
                                  a_log[layer], d_skip[layer], g_ssd[layer], need_ctx)
        o_mla, oc_mla = mla_mixer(p[..., s1:], pc[..., s1:], g_q[layer], w_uq[layer], g_kv[layer],
                                  w_ukv[layer], cos, sin, need_ctx)
        x = x + mod[:, :, 2] * (jnp.concatenate([o_sgu, o_ssd, o_mla], axis=-1) @ w_out[layer])
        if need_ctx:
            oc_sgu = sgu_mixer(pc[..., :s0], w_sgu[layer], b_sgu[layer], g_sgu[layer], beta_sgu[layer])
            xc = xc + modc[2] * (jnp.concatenate([oc_sgu, oc_ssd, oc_mla], axis=-1) @ w_out[layer])
        if layer % 2 == 0:
            i = layer // 2
            ffn = lambda t: swiglu(t, w_gate[i], w_up[i], w_down[i])
        else:
            i = layer // 2
            ffn = lambda t: moe_ffn(t, w_router[i], w_gate_e[i], w_up_e[i], w_down_e[i])
        x = x + mod[:, :, 5] * ffn(modulate(x, g_ffn[layer], mod[:, :, 3], mod[:, :, 4]))
        if need_ctx:
            xc = xc + modc[5] * ffn(modulate(xc, g_ffn[layer], modc[3], modc[4]))
    return rmsnorm(x, g_final)
```

```cpp
#include <hip/hip_runtime.h>
#include <cstdio>
#include <cstdint>

#define LAS __attribute__((address_space(3)))
#define GAS __attribute__((address_space(1)))
typedef unsigned short bf16_t;
typedef short bf16x8 __attribute__((ext_vector_type(8)));
typedef float f32x4 __attribute__((ext_vector_type(4)));
typedef float f32x16 __attribute__((ext_vector_type(16)));
typedef float f32x2 __attribute__((ext_vector_type(2)));
typedef unsigned u32x4 __attribute__((ext_vector_type(4)));
typedef unsigned u32x2 __attribute__((ext_vector_type(2)));
typedef __bf16 bf16x2_t __attribute__((ext_vector_type(2)));

constexpr int BATCH = 8, SEQ = 2048, DM = 1024, CTXL = 256, DEPTH = 2;
constexpr int NLAT = BATCH * SEQ, NCTX = BATCH * CTXL, MT = NLAT + NCTX;
constexpr int INW = 2476, INP = 2560;
constexpr int PC_U = 0, PC_V = 256, PC_Z = 512, PC_X = 896, PC_B = 1280, PC_C = 1536, PC_CQ = 1792, PC_CKV = 2176, PC_KR = 2432, PC_DT = 2464;
constexpr int DFF = 2816, NEXP = 8, DFE = 1408;
constexpr int QW = 576, QWP = 768, KVW = 768;
constexpr float EPS = 1e-6f;
constexpr float QSCALE = 0.10206207261596577f * 1.4426950408889634f;
constexpr int NPOS = 18;

constexpr size_t MiB = 1u << 20;
constexpr size_t WS_CTL = 0, CTL_BYTES = 64 * 1024;
constexpr size_t WS_MOD = 1 * MiB;
constexpr size_t WS_ACS = 2 * MiB;
constexpr size_t WS_MISC = 3 * MiB;
constexpr size_t WS_LIST = 4 * MiB;
constexpr size_t WS_WSGU = 5 * MiB;
constexpr size_t WS_WIN = 6 * MiB;
constexpr size_t WS_WUQ = 16 * MiB;
constexpr size_t WS_WUKV = 18 * MiB;
constexpr size_t WS_WOUT = 19 * MiB;
constexpr size_t WS_WGU = 23 * MiB;
constexpr size_t WS_WD = 34 * MiB;
constexpr size_t WS_XC = 40 * MiB;
constexpr size_t WS_H = 48 * MiB;
constexpr size_t WS_Q = 48 * MiB;
constexpr size_t WS_KR = 70 * MiB;
constexpr size_t WS_P = 84 * MiB;
constexpr size_t WS_CAT = 174 * MiB;
constexpr size_t WS_KV = 210 * MiB;
constexpr size_t WS_CC = 237 * MiB;
constexpr size_t WS_YP = 246 * MiB;
constexpr size_t WS_ST = 273 * MiB;
constexpr size_t WS_ACT = 84 * MiB;
constexpr size_t WS_MOEW_GU = 84 * MiB;
constexpr size_t WS_MOEW_D = 128 * MiB;
constexpr size_t WS_MACT = 150 * MiB;
constexpr size_t WS_Y = 244 * MiB;
constexpr size_t WS_SSQP = 300 * MiB;
constexpr size_t WS_VT = 302 * MiB;
constexpr size_t WS_SLAB = 200 * MiB;
constexpr size_t WS_END = 316 * MiB;
constexpr size_t MISC_SSQ = 0, MISC_DEC = 256 * 1024, MISC_ROPE = 320 * 1024, MISC_TOPW = 384 * 1024;
constexpr int CW_CNT = 64;
constexpr int CW_BAR = 4096;

__device__ __forceinline__ unsigned cvtpk(float lo, float hi) { f32x2 v = {lo, hi}; bf16x2_t b = __builtin_convertvector(v, bf16x2_t); return __builtin_bit_cast(unsigned, b); }
__device__ __forceinline__ float bflo(unsigned u) { return __uint_as_float(u << 16); }
__device__ __forceinline__ float bfhi(unsigned u) { return __uint_as_float(u & 0xffff0000u); }
__device__ __forceinline__ float bf1(bf16_t h) { return __uint_as_float((unsigned)h << 16); }
__device__ __forceinline__ bf16_t f2bf(float f) { return (bf16_t)(cvtpk(f, 0.f) & 0xffffu); }
__device__ __forceinline__ float wave_sum(float v) {
#pragma unroll
    for (int o = 1; o < 64; o <<= 1) v += __shfl_xor(v, o);
    return v;
}
__device__ __forceinline__ float silu_f(float x) { return x * __builtin_amdgcn_rcpf(1.f + __expf(-x)); }
__device__ __forceinline__ float gelu_tanh(float x) { const float u = 0.7978845608028654f * (x + 0.044715f * x * x * x); const float t = 1.f - 2.f * __builtin_amdgcn_rcpf(1.f + __expf(2.f * u)); return 0.5f * x * (1.f + t); }
__device__ __forceinline__ float softplus_f(float x) { return x > 20.f ? x : log1pf(__expf(x)); }
#define LDS_WAIT() asm volatile("s_waitcnt lgkmcnt(0)" ::: "memory")
#define LDS_BARRIER() asm volatile("s_waitcnt lgkmcnt(0)\n\ts_barrier" ::: "memory")
#define MFMA16(a, b, c) __builtin_amdgcn_mfma_f32_16x16x32_bf16((a), (b), (c), 0, 0, 0)
#define MFMA32(a, b, c) __builtin_amdgcn_mfma_f32_32x32x16_bf16((a), (b), (c), 0, 0, 0)

namespace pg8 {
constexpr int BM = 256, BK = 64, HALF = 128, HTB = HALF * BK * 2, STAGE_BYTES = 8 * HTB, NXCD = 8, WGM = 8;
__host__ __device__ __forceinline__ int lds_byte(int r, int c) { const int st = (r >> 4) * 2 + (c >> 5), rr = r & 15, cc = c & 31, ob = rr * 64 + cc * 2; return st * 1024 + (ob ^ (((ob >> 9) & 1) << 5)); }
__host__ __device__ __forceinline__ void stage_rc(int b, int& R, int& C) { const int st = b / 1024, sb = b % 1024, swz = sb ^ (((sb >> 9) & 1) << 5); R = (st >> 1) * 16 + swz / 64; C = (st & 1) * 32 + (swz % 64) / 2; }
__host__ __device__ __forceinline__ int perm32(int rho) { const int n = rho >> 4, i = rho & 15; return 8 * (i >> 2) + 4 * n + (i & 3); }

struct Unit { int pm, pn, e, kt0, nkt; };
struct Gemm { const bf16_t* A; const bf16_t* Bt; int lda; int K; size_t bstride_e; };

struct StaticOrder {
    int nM, nN, nwg, G, c;
    __device__ void init(int M, int N, int G_, int c_) { nM = M / BM; nN = N / BM; nwg = nM * nN; G = G_; c = c_; }
    __device__ bool next(int i, Unit& u) const {
        const long L = (long)i * G + c; if (L >= nwg) return false;
        int wgid = (int)L; { const int q = nwg / NXCD, r = nwg % NXCD, xcd = wgid % NXCD, off = wgid / NXCD; wgid = (xcd < r ? xcd * (q + 1) : r * (q + 1) + (xcd - r) * q) + off; }
        const int nig = WGM * nN, gid = wgid / nig, fm = gid * WGM, gsz = (nM - fm) < WGM ? (nM - fm) : WGM;
        u.pm = fm + ((wgid % nig) % gsz); u.pn = (wgid % nig) / gsz; u.e = 0; return true;
    }
    __device__ __forceinline__ int arow(const Unit& u, int r) const { return u.pm * BM + r; }
};

template <class Epi, class Sched, bool ALIGN_EPI, bool GATHER, bool KSPLIT = false>
__device__ __forceinline__ void gemm_phase(LAS unsigned char* lds, const int tid, const Gemm g, const Sched& S, const Epi& E) {
    const int wid = __builtin_amdgcn_readfirstlane(tid >> 6), lane = tid & 63, wr = wid >> 2, wc = wid & 3, fr = lane & 15, fq = lane >> 4;
    const int K = g.K; int nt = K / BK;
    int Rr[2], Cc[2]; unsigned voffA[2], voffB[2];
#pragma unroll
    for (int i = 0; i < 2; ++i) { int R, C; stage_rc(tid * 16 + i * 8192, R, C); Rr[i] = R; Cc[i] = C; const int Rb = Epi::PERM ? ((R & ~31) + perm32(R & 31)) : R;
        voffA[i] = (unsigned)(R * g.lda + C) * 2u; voffB[i] = (unsigned)(Rb * K + C) * 2u; }
    const size_t kstep = (size_t)(BK * 2);
    const size_t hstepB = (size_t)HALF * K * 2, tstepB = 2 * hstepB;
    const size_t hstepA = (size_t)HALF * g.lda * 2, tstepA = 2 * hstepA;
    const unsigned ldsw = (unsigned)wid * 1024u;
    const int aoff = lds_byte(wr * 64 + fr, fq * 8), boff = lds_byte(wc * 32 + fr, fq * 8);
    const char* const Abase = (const char*)g.A;
#define PG8_SA(b, h) (((b) * 2 + (h)) * HTB)
#define PG8_SB(b, h) ((4 + (b) * 2 + (h)) * HTB)
#define PG8_GL(gp, off) __builtin_amdgcn_global_load_lds((const unsigned*)(gp), (LAS unsigned*)(lds + (off)), 16, 0, 0)
#define PG8_STAGE_B(bufoff, gbase) do { PG8_GL((const char*)(gbase) + voffB[0], (bufoff) + ldsw); PG8_GL((const char*)(gbase) + voffB[1], (bufoff) + ldsw + 8192); } while (0)
#define PG8_STAGE_A_CUR(bufoff, kt, h) do { if constexpr (GATHER) { const char* _p = Abase + (size_t)(kt) * kstep; PG8_GL(_p + ((h) ? c10 : c00), (bufoff) + ldsw); PG8_GL(_p + ((h) ? c11 : c01), (bufoff) + ldsw + 8192); } \
        else { const char* _p = cA + (size_t)(kt) * kstep + (h) * hstepA; PG8_GL(_p + voffA[0], (bufoff) + ldsw); PG8_GL(_p + voffA[1], (bufoff) + ldsw + 8192); } } while (0)
#define PG8_STAGE_A_SEL(bufoff, kt, h) do { if constexpr (GATHER) { const char* _p = Abase + (size_t)(kt) * kstep; PG8_GL(_p + ((h) ? x10 : x00), (bufoff) + ldsw); PG8_GL(_p + ((h) ? x11 : x01), (bufoff) + ldsw + 8192); } \
        else { const char* _p = xA + (size_t)(kt) * kstep + (h) * hstepA; PG8_GL(_p + voffA[0], (bufoff) + ldsw); PG8_GL(_p + voffA[1], (bufoff) + ldsw + 8192); } } while (0)
#define PG8_LDA(dst, b, h) do { _Pragma("unroll") for (int m = 0; m < 4; ++m) _Pragma("unroll") for (int k = 0; k < 2; ++k) dst[m][k] = *(const LAS bf16x8*)(lds + PG8_SA(b, h) + aoff + m * 2048 + k * 1024); } while (0)
#define PG8_LDB(dst, b, h) do { _Pragma("unroll") for (int n = 0; n < 2; ++n) _Pragma("unroll") for (int k = 0; k < 2; ++k) dst[n][k] = *(const LAS bf16x8*)(lds + PG8_SB(b, h) + boff + n * 2048 + k * 1024); } while (0)
#define PG8_MMA(ai, bj, At, Bt) do { __builtin_amdgcn_s_setprio(1); _Pragma("unroll") for (int m = 0; m < 4; ++m) _Pragma("unroll") for (int n = 0; n < 2; ++n) _Pragma("unroll") for (int k = 0; k < 2; ++k) \
        acc[ai][bj][m][n] = __builtin_amdgcn_mfma_f32_16x16x32_bf16(Bt[n][k], At[m][k], acc[ai][bj][m][n], 0, 0, 0); __builtin_amdgcn_s_setprio(0); } while (0)
#define PG8_WAIT_V(n) asm volatile("s_waitcnt vmcnt(" #n ")" ::: "memory")
#define PG8_WAIT_L(n) asm volatile("s_waitcnt lgkmcnt(" #n ")" ::: "memory")
#define PG8_BAR __builtin_amdgcn_s_barrier()
#define PG8_SCHED __builtin_amdgcn_sched_barrier(0)
#define PG8_AOFFS(u, o00, o01, o10, o11) do { if constexpr (GATHER) { \
        o00 = (unsigned)(((size_t)S.arow(u, Rr[0]) * g.lda + Cc[0]) * 2); o01 = (unsigned)(((size_t)S.arow(u, Rr[1]) * g.lda + Cc[1]) * 2); \
        o10 = (unsigned)(((size_t)S.arow(u, HALF + Rr[0]) * g.lda + Cc[0]) * 2); o11 = (unsigned)(((size_t)S.arow(u, HALF + Rr[1]) * g.lda + Cc[1]) * 2); } } while (0)
    Unit cur, nxt; int ui = 0;
    if (!S.next(0, cur)) return;
    f32x4 acc[2][2][4][2];
#pragma unroll
    for (int a = 0; a < 2; ++a)
#pragma unroll
        for (int b = 0; b < 2; ++b)
#pragma unroll
            for (int m = 0; m < 4; ++m)
#pragma unroll
                for (int n = 0; n < 2; ++n) acc[a][b][m][n] = (f32x4){0.f, 0.f, 0.f, 0.f};
    bf16x8 At[4][2], B0[2][2], B1[2][2];
    unsigned c00 = 0, c01 = 0, c10 = 0, c11 = 0, n00 = 0, n01 = 0, n10 = 0, n11 = 0;
    PG8_AOFFS(cur, c00, c01, c10, c11);
    const char* cA = Abase + (size_t)cur.pm * tstepA;
    const char* cB = (const char*)g.Bt + ((size_t)cur.e * g.bstride_e) * 2 + (size_t)cur.pn * tstepB;
    if constexpr (KSPLIT) { cA += (size_t)cur.kt0 * kstep; cB += (size_t)cur.kt0 * kstep; nt = cur.nkt; }
    PG8_STAGE_B(PG8_SB(0, 0), cB); PG8_STAGE_B(PG8_SB(0, 1), cB + hstepB); PG8_STAGE_A_CUR(PG8_SA(0, 0), 0, 0); PG8_STAGE_A_CUR(PG8_SA(0, 1), 0, 1);
    if (wr == 1) PG8_BAR;
    PG8_WAIT_V(2); PG8_BAR;
    PG8_STAGE_B(PG8_SB(1, 0), cB + kstep); PG8_STAGE_A_CUR(PG8_SA(1, 0), 1, 0); PG8_STAGE_B(PG8_SB(1, 1), cB + hstepB + kstep);
    PG8_WAIT_V(6); PG8_BAR;
    for (;;) {
        const bool has_next = S.next(ui + 1, nxt);
        const char* nB = cB; const char* nA = cA;
        if (has_next) { PG8_AOFFS(nxt, n00, n01, n10, n11); nA = Abase + (size_t)nxt.pm * tstepA; nB = (const char*)g.Bt + ((size_t)nxt.e * g.bstride_e) * 2 + (size_t)nxt.pn * tstepB;
            if constexpr (KSPLIT) { nA += (size_t)nxt.kt0 * kstep; nB += (size_t)nxt.kt0 * kstep; } }
        else { n00 = c00; n01 = c01; n10 = c10; n11 = c11; }
#pragma unroll 1
        for (int t = 0; t < nt; t += 2) {
            const bool last = (t == nt - 2);
            const int kt2 = last ? 0 : t + 2, kt3 = kt2 + 1;
            const unsigned x00 = last ? n00 : c00, x01 = last ? n01 : c01, x10 = last ? n10 : c10, x11 = last ? n11 : c11;
            const char* xA = last ? nA : cA;
            const char* b2 = last ? nB : cB + (size_t)(t + 2) * kstep; const char* b3 = b2 + kstep;
            (void)x00; (void)x01; (void)x10; (void)x11; (void)xA;
            PG8_LDB(B0, 0, 0); PG8_LDB(B1, 0, 1); PG8_SCHED; PG8_LDA(At, 0, 0); PG8_STAGE_A_CUR(PG8_SA(1, 1), t + 1, 1);
            PG8_WAIT_V(8); PG8_WAIT_L(0); PG8_BAR; PG8_MMA(0, 0, At, B0); PG8_MMA(0, 1, At, B1); PG8_BAR; PG8_SCHED;
            PG8_LDA(At, 0, 1); PG8_STAGE_B(PG8_SB(0, 0), b2); PG8_STAGE_B(PG8_SB(0, 1), b2 + hstepB); PG8_STAGE_A_SEL(PG8_SA(0, 0), kt2, 0);
            PG8_WAIT_V(8); PG8_WAIT_L(0); PG8_BAR; PG8_MMA(1, 0, At, B0); PG8_MMA(1, 1, At, B1); PG8_BAR; PG8_SCHED;
            PG8_LDB(B0, 1, 0); PG8_LDB(B1, 1, 1); PG8_SCHED; PG8_LDA(At, 1, 0); PG8_STAGE_A_SEL(PG8_SA(0, 1), kt2, 1);
            PG8_WAIT_V(8); PG8_WAIT_L(0); PG8_BAR; PG8_MMA(0, 0, At, B0); PG8_MMA(0, 1, At, B1); PG8_BAR; PG8_SCHED;
            PG8_LDA(At, 1, 1); PG8_STAGE_B(PG8_SB(1, 0), b3); PG8_STAGE_B(PG8_SB(1, 1), b3 + hstepB); PG8_STAGE_A_SEL(PG8_SA(1, 0), kt3, 0);
            PG8_WAIT_V(8); PG8_WAIT_L(0); PG8_BAR; PG8_MMA(1, 0, At, B0); PG8_MMA(1, 1, At, B1); PG8_BAR; PG8_SCHED;
        }
        if constexpr (ALIGN_EPI) { if (wr == 0) PG8_BAR; }
        E(acc, cur, wr, wc, fr, fq);
        if (!has_next) break;
#pragma unroll
        for (int a = 0; a < 2; ++a)
#pragma unroll
            for (int b = 0; b < 2; ++b)
#pragma unroll
                for (int m = 0; m < 4; ++m)
#pragma unroll
                    for (int n = 0; n < 2; ++n) acc[a][b][m][n] = (f32x4){0.f, 0.f, 0.f, 0.f};
        cur = nxt; cA = nA; cB = nB; c00 = n00; c01 = n01; c10 = n10; c11 = n11; ++ui;
        if constexpr (KSPLIT) nt = cur.nkt;
        if constexpr (ALIGN_EPI) { if (wr == 1) PG8_BAR; }
    }
    PG8_WAIT_V(0);
    if constexpr (!ALIGN_EPI) { if (wr == 0) PG8_BAR; }
    PG8_BAR;
#undef PG8_SA
#undef PG8_SB
#undef PG8_GL
#undef PG8_STAGE_A_CUR
#undef PG8_STAGE_A_SEL
#undef PG8_STAGE_B
#undef PG8_LDA
#undef PG8_LDB
#undef PG8_MMA
#undef PG8_WAIT_V
#undef PG8_WAIT_L
#undef PG8_BAR
#undef PG8_SCHED
#undef PG8_AOFFS
}
}
namespace pg8 {
struct EpiInProj {
    static constexpr bool PERM = true;
    bf16_t* O; float* ssq; bool dry;
    __device__ __forceinline__ void operator()(const f32x4 (&acc)[2][2][4][2], const Unit& u, int wr, int wc, int fr, int fq) const {
        if (dry) return;
        const int row0 = u.pm * BM + wr * 64 + fr, col0 = u.pn * BM + wc * 32 + 8 * fq;
#pragma unroll
        for (int ai = 0; ai < 2; ++ai)
#pragma unroll
            for (int m = 0; m < 4; ++m) { const int row = row0 + ai * HALF + m * 16; bf16_t* rowp = O + (size_t)row * INP + col0;
                float sq = 0.f, sk = 0.f;
#pragma unroll
                for (int bj = 0; bj < 2; ++bj) { const f32x4 v0 = acc[ai][bj][m][0], v1 = acc[ai][bj][m][1];
                    u32x4 w; w.x = cvtpk(v0[0], v0[1]); w.y = cvtpk(v0[2], v0[3]); w.z = cvtpk(v1[0], v1[1]); w.w = cvtpk(v1[2], v1[3]);
                    *(u32x4*)(rowp + bj * HALF) = w;
                    const int hidx = 2 * u.pn + bj;
                    const float s = (v0[0] * v0[0] + v0[1] * v0[1]) + (v0[2] * v0[2] + v0[3] * v0[3]) + (v1[0] * v1[0] + v1[1] * v1[1]) + (v1[2] * v1[2] + v1[3] * v1[3]);
                    if (hidx >= 14 && hidx <= 16) sq += s;
                    if (hidx >= 17 && hidx <= 18) sk += s; }
                if (u.pn >= 7 && u.pn <= 9) {
                    sq += __shfl_xor(sq, 16); sq += __shfl_xor(sq, 32); sk += __shfl_xor(sk, 16); sk += __shfl_xor(sk, 32);
                    if (fq == 0) { float* sp = ssq + (size_t)row * 16;
                        if (u.pn == 7) sp[wc] = sq; if (u.pn == 8) { sp[4 + wc] = sq; sp[8 + wc] = sk; } if (u.pn == 9) sp[12 + wc] = sk; } } }
    }
};
struct EpiScaleBf16 {
    static constexpr bool PERM = true;
    bf16_t* O; int ldc, ncols; const float* ssq; int idx; float invn, mul;
    __device__ __forceinline__ void operator()(const f32x4 (&acc)[2][2][4][2], const Unit& u, int wr, int wc, int fr, int fq) const {
        const int row0 = u.pm * BM + wr * 64 + fr, col0 = u.pn * BM + wc * 32 + 8 * fq;
#pragma unroll
        for (int ai = 0; ai < 2; ++ai) {
            float scv[4];
#pragma unroll
            for (int m = 0; m < 4; ++m) { const int row = row0 + ai * HALF + m * 16;
                const f32x4 pa = *(const f32x4*)(ssq + (size_t)row * 16 + 8 * idx), pb = *(const f32x4*)(ssq + (size_t)row * 16 + 8 * idx + 4);
                scv[m] = rsqrtf((((pa[0] + pa[1]) + (pa[2] + pa[3])) + ((pb[0] + pb[1]) + (pb[2] + pb[3]))) * invn + EPS) * mul; }
            asm volatile("" ::: "memory");
#pragma unroll
            for (int m = 0; m < 4; ++m) { const int row = row0 + ai * HALF + m * 16; bf16_t* rowp = O + (size_t)row * ldc + col0;
                const float sc = scv[m];
#pragma unroll
                for (int bj = 0; bj < 2; ++bj) if (col0 + bj * HALF < ncols) { const f32x4 v0 = acc[ai][bj][m][0] * sc, v1 = acc[ai][bj][m][1] * sc;
                    u32x4 w; w.x = cvtpk(v0[0], v0[1]); w.y = cvtpk(v0[2], v0[3]); w.z = cvtpk(v1[0], v1[1]); w.w = cvtpk(v1[2], v1[3]);
                    *(u32x4*)(rowp + bj * HALF) = w; } } }
    }
};
struct EpiResid {
    static constexpr bool PERM = false;
    const float* oldL; const float* oldC; float* newL; float* newC; const float* mod; int gi; bool dry; float* slab;
    __device__ __forceinline__ void operator()(const f32x4 (&acc)[2][2][4][2], const Unit& u, int wr, int wc, int fr, int fq) const {
        if (dry) return;
        if (slab && u.e > 0) {
            float* sp = slab + ((size_t)(u.e - 1) * NCTX + (u.pm * BM - NLAT) + wr * 64 + fr) * DM + u.pn * BM + wc * 32 + 4 * fq;
#pragma unroll
            for (int ai = 0; ai < 2; ++ai)
#pragma unroll
                for (int m = 0; m < 4; ++m)
#pragma unroll
                    for (int bj = 0; bj < 2; ++bj)
#pragma unroll
                        for (int n = 0; n < 2; ++n) *(f32x4*)(sp + (size_t)(ai * HALF + m * 16) * DM + bj * HALF + n * 16) = acc[ai][bj][m][n];
            return; }
        const int rbase = u.pm * BM; const bool isc = rbase >= NLAT; const int b = isc ? 8 : (rbase >> 11);
        const float* xo = isc ? oldC - (size_t)NLAT * DM : oldL; float* xn = isc ? newC - (size_t)NLAT * DM : newL;
        const int row0 = rbase + wr * 64 + fr, col0 = u.pn * BM + wc * 32 + 4 * fq;
        const float* gp = mod + (size_t)b * 6144 + gi * DM + col0;
        f32x4 gv[2][2];
#pragma unroll
        for (int bj = 0; bj < 2; ++bj)
#pragma unroll
            for (int n = 0; n < 2; ++n) gv[bj][n] = *(const f32x4*)(gp + bj * HALF + n * 16);
#pragma unroll
        for (int am = 0; am < 4; ++am) { const int ai = am >> 1, m0 = (am & 1) * 2;
            f32x4 xv[2][2][2];
#pragma unroll
            for (int mm = 0; mm < 2; ++mm) { const size_t off = (size_t)(row0 + ai * HALF + (m0 + mm) * 16) * DM + col0;
#pragma unroll
                for (int bj = 0; bj < 2; ++bj)
#pragma unroll
                    for (int n = 0; n < 2; ++n) xv[mm][bj][n] = *(const f32x4*)(xo + off + bj * HALF + n * 16); }
            asm volatile("" ::: "memory");
#pragma unroll
            for (int mm = 0; mm < 2; ++mm) { const size_t off = (size_t)(row0 + ai * HALF + (m0 + mm) * 16) * DM + col0;
#pragma unroll
                for (int bj = 0; bj < 2; ++bj)
#pragma unroll
                    for (int n = 0; n < 2; ++n) *(f32x4*)(xn + off + bj * HALF + n * 16) = xv[mm][bj][n] + gv[bj][n] * acc[ai][bj][m0 + mm][n]; }
            asm volatile("" ::: "memory"); }
    }
};
struct EpiSwiglu {
    static constexpr bool PERM = true;
    bf16_t* O; int ldc;
    __device__ __forceinline__ void operator()(const f32x4 (&acc)[2][2][4][2], const Unit& u, int wr, int wc, int fr, int fq) const {
        const int row0 = u.pm * BM + wr * 64 + fr, col0 = u.pn * HALF + wc * 32 + 8 * fq;
#pragma unroll
        for (int ai = 0; ai < 2; ++ai)
#pragma unroll
            for (int m = 0; m < 4; ++m) { bf16_t* rowp = O + (size_t)(row0 + ai * HALF + m * 16) * ldc + col0;
                float r[8];
#pragma unroll
                for (int n = 0; n < 2; ++n)
#pragma unroll
                    for (int j = 0; j < 4; ++j) { const float gt = acc[ai][0][m][n][j], up = acc[ai][1][m][n][j]; r[4 * n + j] = silu_f(gt) * up; }
                u32x4 w; w.x = cvtpk(r[0], r[1]); w.y = cvtpk(r[2], r[3]); w.z = cvtpk(r[4], r[5]); w.w = cvtpk(r[6], r[7]);
                *(u32x4*)rowp = w; }
    }
};
struct DownSplitOrder {
    StaticOrder so; int G, c;
    __device__ void init(int G_, int c_) { so.init(NLAT, DM, G_, c_); G = G_; c = c_; }
    __device__ bool next(int i, Unit& u) const {
        if (so.next(i, u)) { u.kt0 = 0; u.nkt = DFF / BK; return true; }
        const int rounds = (so.nwg + G - 1) / G; const int j = (i - rounds) * G + c; if (i < rounds || j >= 128) return false;
        const int tile = j >> 2, part = j & 3; u.pm = NLAT / BM + (tile >> 2); u.pn = tile & 3; u.e = 1 + part;
        u.kt0 = part == 0 ? 0 : part == 1 ? 12 : part == 2 ? 24 : 34; u.nkt = part < 2 ? 12 : 10; return true;
    }
    __device__ __forceinline__ int arow(const Unit& u, int r) const { return u.pm * BM + r; }
};
struct MoeOrder {
    int c0, c1, c2, c3, c4, c5, c6, c7, t1, t2, t3, t4, t5, t6, t7, t8; int npn, G, c; const int* list; bool gather;
    __device__ void init(const unsigned* cw, int npn_, int G_, int c_, const int* list_, bool gather_) {
        #define RFL_(x) __builtin_amdgcn_readfirstlane((int)(x))
        c0 = RFL_(cw[0]); c1 = RFL_(cw[64]); c2 = RFL_(cw[128]); c3 = RFL_(cw[192]); c4 = RFL_(cw[256]); c5 = RFL_(cw[320]); c6 = RFL_(cw[384]); c7 = RFL_(cw[448]);
#undef RFL_
        t1 = (c0 + 255) >> 8; t2 = t1 + ((c1 + 255) >> 8); t3 = t2 + ((c2 + 255) >> 8); t4 = t3 + ((c3 + 255) >> 8); t5 = t4 + ((c4 + 255) >> 8); t6 = t5 + ((c5 + 255) >> 8); t7 = t6 + ((c6 + 255) >> 8); t8 = t7 + ((c7 + 255) >> 8);
        npn = npn_; G = G_; c = c_; list = list_; gather = gather_;
    }
    __device__ bool next(int i, Unit& u) const {
        const int L = i * G + c, nwg = t8 * npn; if (L >= nwg) return false;
        int wgid = L; { const int q = nwg / NXCD, r = nwg % NXCD, xcd = wgid % NXCD, off = wgid / NXCD; wgid = (xcd < r ? xcd * (q + 1) : r * (q + 1) + (xcd - r) * q) + off; }
        const int nig = WGM * npn, gid = wgid / nig, fm = gid * WGM, gsz = (t8 - fm) < WGM ? (t8 - fm) : WGM;
        const int ti = fm + ((wgid % nig) % gsz); u.pn = (wgid % nig) / gsz; u.pm = ti;
        u.e = (ti >= t1) + (ti >= t2) + (ti >= t3) + (ti >= t4) + (ti >= t5) + (ti >= t6) + (ti >= t7); return true;
    }
    __device__ __forceinline__ int ecnt(int e) const { return e == 0 ? c0 : e == 1 ? c1 : e == 2 ? c2 : e == 3 ? c3 : e == 4 ? c4 : e == 5 ? c5 : e == 6 ? c6 : c7; }
    __device__ __forceinline__ int etb(int e) const { return e == 0 ? 0 : e == 1 ? t1 : e == 2 ? t2 : e == 3 ? t3 : e == 4 ? t4 : e == 5 ? t5 : e == 6 ? t6 : t7; }
    __device__ __forceinline__ int arow(const Unit& u, int r) const {
        if (!gather) return u.pm * BM + r;
        const int pos = (u.pm - etb(u.e)) * BM + r;
        const int n_e = ecnt(u.e); const int v = list[u.e * NLAT + (pos < n_e ? pos : 0)] >> 1; return pos < n_e ? v : 0;
    }
};
struct EpiMoeDown {
    static constexpr bool PERM = true;
    bf16_t* Y; const int* list; const float* topw; MoeOrder mo;
    __device__ __forceinline__ void operator()(const f32x4 (&acc)[2][2][4][2], const Unit& u, int wr, int wc, int fr, int fq) const {
        const int pos0 = (u.pm - mo.etb(u.e)) * BM + wr * 64 + fr, n_e = mo.ecnt(u.e), col0 = u.pn * BM + wc * 32 + 8 * fq;
        int tkv[8]; float wgv[8];
#pragma unroll
        for (int i = 0; i < 8; ++i) { const int pos = pos0 + (i >> 2) * HALF + (i & 3) * 16; tkv[i] = list[u.e * NLAT + (pos < n_e ? pos : 0)]; }
#pragma unroll
        for (int i = 0; i < 8; ++i) wgv[i] = topw[tkv[i]];
#pragma unroll
        for (int ai = 0; ai < 2; ++ai)
#pragma unroll
            for (int m = 0; m < 4; ++m) { const int pos = pos0 + ai * HALF + m * 16;
                if (pos < n_e) { const int tk = tkv[ai * 4 + m]; const float wgt = wgv[ai * 4 + m]; bf16_t* rowp = Y + (size_t)tk * DM + col0;
#pragma unroll
                    for (int bj = 0; bj < 2; ++bj) { const f32x4 v0 = acc[ai][bj][m][0] * wgt, v1 = acc[ai][bj][m][1] * wgt;
                        u32x4 w; w.x = cvtpk(v0[0], v0[1]); w.y = cvtpk(v0[2], v0[3]); w.z = cvtpk(v1[0], v1[1]); w.w = cvtpk(v1[2], v1[3]);
                        *(u32x4*)(rowp + bj * HALF) = w; } } }
    }
};
}
constexpr int NWAVES = 8, NTHR = 512;
constexpr int RING_BYTES = 147456;
constexpr int LDSCTL_OFF = RING_BYTES, MISC_OFF = LDSCTL_OFF + 320;
constexpr int LDS_BYTES = RING_BYTES + 1024;
typedef GAS unsigned gu32;
#define RLX_AGENT __ATOMIC_RELAXED, __HIP_MEMORY_SCOPE_AGENT

#define XB_TMO      128
#define XB_XCNT(j)  (256  + 64 * (j))
#define XB_XSUB(j)  (1280 + 64 * (j))
#define XB_XGEN(j)  (2304 + 64 * (j))
#define XB_TOP      3328
#define XB_TOPGEN   3392
#define XCD_BAR_WORDS 3456
#define XB_SPIN_CAP (1u << 18)
__device__ __forceinline__ unsigned xb_ld(unsigned* p)              { return __hip_atomic_load(p, __ATOMIC_RELAXED, __HIP_MEMORY_SCOPE_AGENT); }
__device__ __forceinline__ unsigned xb_add(unsigned* p, unsigned v) { return __hip_atomic_fetch_add(p, v, __ATOMIC_RELAXED, __HIP_MEMORY_SCOPE_AGENT); }
__device__ __forceinline__ unsigned xb_xcc_id() { return (unsigned)__builtin_amdgcn_s_getreg((3 << 11) | 20) & 0xFu; }
#define XB_SPIN(cond, bar) do { unsigned _sp = 0; while (cond) { __builtin_amdgcn_s_sleep(1); \
    if ((++_sp & 255u) == 0u) { if (xb_ld(&(bar)[XB_TMO])) break; if (_sp > XB_SPIN_CAP) { atomicAdd(&(bar)[XB_TMO], 1u); break; } } } } while (0)
struct XcdBarrier { unsigned* bar; unsigned x; volatile LAS unsigned* st; };
__device__ __forceinline__ XcdBarrier xcd_barrier_post(unsigned* bar, volatile LAS unsigned* st, bool leader) {
    XcdBarrier b; b.bar = bar; b.x = xb_xcc_id(); b.st = st;
    if (leader) (void)xb_add(&bar[XB_XCNT(b.x)], 1u);
    return b;
}
__device__ __forceinline__ void xcd_barrier_complete(unsigned* bar, unsigned x, unsigned& nloc, unsigned& nx) {
    const unsigned G = gridDim.x * gridDim.y * gridDim.z;
    unsigned sum, cnt, mine, sp = 0u;
    for (;;) {
        sum = 0u; cnt = 0u; mine = 0u;
#pragma unroll
        for (unsigned j = 0; j < 16; ++j) { const unsigned c = xb_ld(&bar[XB_XCNT(j)]); sum += c; cnt += (c > 0u) ? 1u : 0u; mine = (j == x) ? c : mine; }
        if (sum == G) break;
        __builtin_amdgcn_s_sleep(1);
        if ((++sp & 255u) == 0u) { if (xb_ld(&bar[XB_TMO])) break; if (sp > XB_SPIN_CAP) { atomicAdd(&bar[XB_TMO], 1u); break; } }
    }
    nloc = mine > 0u ? mine : 1u; nx = cnt > 0u ? cnt : 1u;
}
__device__ __forceinline__ void xcd_barrier(const XcdBarrier& b, bool leader) {
    asm volatile("s_waitcnt vmcnt(0)" ::: "memory");
    __syncthreads();
    if (leader) {
        unsigned* bar = b.bar;
        __builtin_amdgcn_s_waitcnt(0);
        unsigned nloc = b.st[0], nx = b.st[1];
        if (nloc == 0u) { xcd_barrier_complete(bar, b.x, nloc, nx); b.st[0] = nloc; b.st[1] = nx; }
        const unsigned old = xb_add(&bar[XB_XSUB(b.x)], 1u);
        const unsigned gen = old / nloc;
        if (old + 1u == (gen + 1u) * nloc) {
            __builtin_amdgcn_fence(__ATOMIC_RELEASE, "agent");
            asm volatile("s_waitcnt vmcnt(0)" ::: "memory");
            const unsigned og = xb_add(&bar[XB_TOP], 1u);
            const unsigned tg = og / nx;
            if (og + 1u == (tg + 1u) * nx) xb_add(&bar[XB_TOPGEN], 1u);
            else XB_SPIN(xb_ld(&bar[XB_TOPGEN]) == tg, bar);
            __builtin_amdgcn_fence(__ATOMIC_ACQUIRE, "agent");
            xb_add(&bar[XB_XGEN(b.x)], 1u);
            asm volatile("s_waitcnt vmcnt(0)" ::: "memory");
        } else {
            XB_SPIN(xb_ld(&bar[XB_XGEN(b.x)]) == gen, bar);
            __builtin_amdgcn_fence(__ATOMIC_ACQUIRE, "agent");
            asm volatile("s_waitcnt vmcnt(0)" ::: "memory");
        }
    }
    __syncthreads();
}

struct Frame {
    unsigned char* sm;
    LAS unsigned char* lds;
    int tid, lane, wave, G, vcu;
    const float *x, *c, *ctx, *c_ctx, *w_mod, *b_mod, *g_mix, *w_in, *w_sgu, *b_sgu, *g_sgu, *beta_sgu, *conv_w, *conv_b, *dt_bias, *a_log, *d_skip, *g_ssd, *g_q, *w_uq, *g_kv, *w_ukv,
                *w_out, *g_ffn, *w_gate, *w_up, *w_down, *w_router, *w_gate_e, *w_up_e, *w_down_e, *g_final;
    float* out; unsigned char* ws;
};
#define WSP(T, off) ((T*)(F.ws + (off)))

__device__ __forceinline__ int rowmap(int mode, int n) {
    if (mode == 1) { if (n < 1792) return n; if (n < 1804) return n + 672; return n - 12; }
    if (mode == 2) return ((n >> 7) << 8) + (n & 127);
    if (mode == 3) return ((n >> 7) << 8) + 128 + (n & 127);
    return n;
}
__device__ __forceinline__ void transpose_item(const float* W, int K, int N, bf16_t* WT, const float* ks, int mode, LAS float* scr, int item, int lane) {
    const int nblk = (N + 31) / 32, kb = item / nblk, nb = item % nblk, k0 = 64 * kb, n0 = 32 * nb;
    const int nn = n0 + (lane & 31); const bool nok = nn < N;
#pragma unroll 16
    for (int i = 0; i < 32; ++i) { const int kk = 2 * i + (lane >> 5); float v = W[(size_t)(k0 + kk) * N + (nok ? nn : N - 1)]; v = nok ? v : 0.f; if (ks) v *= ks[k0 + kk]; scr[kk * 33 + (lane & 31)] = v; }
    LDS_WAIT(); asm volatile("" ::: "memory");
    const int cch = lane & 7;
#pragma unroll
    for (int j = 0; j < 4; ++j) { const int n = (lane >> 3) + 8 * j; const LAS float* s = scr + (8 * cch) * 33 + n;
        u32x4 o; o.x = cvtpk(s[0 * 33], s[1 * 33]); o.y = cvtpk(s[2 * 33], s[3 * 33]); o.z = cvtpk(s[4 * 33], s[5 * 33]); o.w = cvtpk(s[6 * 33], s[7 * 33]);
        if (n0 + n < N) *(u32x4*)(WT + (size_t)rowmap(mode, n0 + n) * K + k0 + 8 * cch) = o; }
    LDS_WAIT(); asm volatile("" ::: "memory");
}
__device__ __forceinline__ void transpose_item64(const float* W, int K, int N, bf16_t* WT, const float* ks, int mode, LAS float* scr, int item, int lane) {
    const int nblk = (N + 63) / 64, kb = item / nblk, nb = item % nblk, k0 = 64 * kb, n0 = 64 * nb;
    const int lr = lane >> 4, lc = (lane & 15) * 4; const bool nok = n0 + lc < N; const int ncol = nok ? n0 + lc : N - 4;
#pragma unroll
    for (int i = 0; i < 16; ++i) { const int kk = 4 * i + lr; f32x4 v = *(const f32x4*)(W + (size_t)(k0 + kk) * N + ncol); if (ks) v = v * ks[k0 + kk];
        scr[kk * 65 + lc] = v[0]; scr[kk * 65 + lc + 1] = v[1]; scr[kk * 65 + lc + 2] = v[2]; scr[kk * 65 + lc + 3] = v[3]; }
    LDS_WAIT(); asm volatile("" ::: "memory");
    const int cch = lane & 7;
#pragma unroll
    for (int j = 0; j < 8; ++j) { const int n = (lane >> 3) + 8 * j; const LAS float* s = scr + (8 * cch) * 65 + n;
        u32x4 o; o.x = cvtpk(s[0 * 65], s[1 * 65]); o.y = cvtpk(s[2 * 65], s[3 * 65]); o.z = cvtpk(s[4 * 65], s[5 * 65]); o.w = cvtpk(s[6 * 65], s[7 * 65]);
        if (n0 + n < N) *(u32x4*)(WT + (size_t)rowmap(mode, n0 + n) * K + k0 + 8 * cch) = o; }
    LDS_WAIT(); asm volatile("" ::: "memory");
}
__device__ __forceinline__ void zero_fill16(Frame& F, void* p, size_t bytes) {
    const size_t n = bytes / 16; const u32x4 z = {0u, 0u, 0u, 0u};
    for (size_t i = (size_t)F.vcu * NTHR + F.tid; i < n; i += (size_t)F.G * NTHR) ((u32x4*)p)[i] = z;
}
__device__ __forceinline__ void mod_gemv(Frame& F, int l, int wi, int nw) {
    LAS float* cond = (LAS float*)F.lds;
    LAS float* red = (LAS float*)(F.lds + 36864);
    __syncthreads();
    for (int i = F.tid; i < 9 * DM; i += NTHR) { const float v = i < 8 * DM ? F.c[i] : F.c_ctx[i - 8 * DM]; cond[i] = silu_f(v); }
    __syncthreads();
    for (int ch = wi; ch < 192; ch += nw) {
        const int cl = F.lane & 31, kh = F.lane >> 5, col = ch * 32 + cl, kg = F.wave;
        const float* wp = F.w_mod + (size_t)l * DM * 6144 + (size_t)(kg * 128 + kh) * 6144 + col;
        float a[9];
#pragma unroll
        for (int r = 0; r < 9; ++r) a[r] = 0.f;
#pragma unroll 8
        for (int k4 = 0; k4 < 16; ++k4) { const float w0 = wp[(size_t)(8 * k4) * 6144], w1 = wp[(size_t)(8 * k4 + 2) * 6144], w2 = wp[(size_t)(8 * k4 + 4) * 6144], w3 = wp[(size_t)(8 * k4 + 6) * 6144];
#pragma unroll
            for (int r = 0; r < 9; ++r) { const LAS float* cp = cond + r * DM + kg * 128 + 8 * k4 + kh; a[r] += (cp[0] * w0 + cp[2] * w1) + (cp[4] * w2 + cp[6] * w3); } }
#pragma unroll
        for (int r = 0; r < 9; ++r) { a[r] += __shfl_xor(a[r], 32); if (kh == 0) red[(kg * 9 + r) * 32 + cl] = a[r]; }
        __syncthreads();
        for (int idx = F.tid; idx < 9 * 32; idx += NTHR) { const int r = idx >> 5, cc = idx & 31; float s = 0.f;
#pragma unroll
            for (int g = 0; g < 8; ++g) s += red[(g * 9 + r) * 32 + cc];
            WSP(float, WS_MOD)[((size_t)l * 9 + r) * 6144 + ch * 32 + cc] = s + F.b_mod[l * 6144 + ch * 32 + cc]; }
        __syncthreads();
    }
}
__device__ __forceinline__ void convert_set(Frame& F, int set, int wi, int nw) {
    __syncthreads();
    LAS float* scr = (LAS float*)(F.lds + F.wave * 16640);
    const int gw = wi * NWAVES + F.wave, NGW = nw * NWAVES;
    constexpr int I_IN = 16 * 39, I_UQ = 6 * 9, I_UKV = 4 * 12, I_OUT = 16 * 16, I_G = 16 * 44, I_D = 44 * 16;
    if (set == 0 || set == 3) { const int l = set == 0 ? 0 : 1; const int n = I_IN + I_UQ + I_UKV + (l == 1 ? I_OUT : 0);
        for (int it = gw; it < n; it += NGW) { int r = it;
            if (r < I_IN) { transpose_item64(F.w_in + (size_t)l * DM * INW, DM, INW, WSP(bf16_t, WS_WIN) + (size_t)l * INP * DM, nullptr, 1, scr, r, F.lane); continue; } r -= I_IN;
            if (r < I_UQ) { transpose_item64(F.w_uq + (size_t)l * 384 * QW, 384, QW, WSP(bf16_t, WS_WUQ) + (size_t)l * QWP * 384, F.g_q + l * 384, 0, scr, r, F.lane); continue; } r -= I_UQ;
            if (r < I_UKV) { transpose_item64(F.w_ukv + (size_t)l * 256 * KVW, 256, KVW, WSP(bf16_t, WS_WUKV) + (size_t)l * KVW * 256, F.g_kv + l * 256, 0, scr, r, F.lane); continue; } r -= I_UKV;
            transpose_item64(F.w_out + (size_t)l * DM * DM, DM, DM, WSP(bf16_t, WS_WOUT) + (size_t)l * DM * DM, nullptr, 0, scr, r, F.lane); }
        const u32x4 z = {0u, 0u, 0u, 0u};
        { u32x4* p0 = (u32x4*)(WSP(bf16_t, WS_WIN) + ((size_t)l * INP + INW) * DM); const size_t n0 = (size_t)(INP - INW) * DM * 2 / 16; for (size_t i = (size_t)wi * NTHR + F.tid; i < n0; i += (size_t)nw * NTHR) p0[i] = z;
          u32x4* p1 = (u32x4*)(WSP(bf16_t, WS_WUQ) + ((size_t)l * QWP + QW) * 384); const size_t n1 = (size_t)(QWP - QW) * 384 * 2 / 16; for (size_t i = (size_t)wi * NTHR + F.tid; i < n1; i += (size_t)nw * NTHR) p1[i] = z; }
    } else if (set == 1) {
        for (int it = gw; it < I_OUT; it += NGW) transpose_item64(F.w_out, DM, DM, WSP(bf16_t, WS_WOUT), nullptr, 0, scr, it, F.lane);
    } else {
        for (int it = gw; it < 2 * I_G + I_D; it += NGW) { int r = it;
            if (r < I_G) { transpose_item64(F.w_gate, DM, DFF, WSP(bf16_t, WS_WGU), nullptr, 2, scr, r, F.lane); continue; } r -= I_G;
            if (r < I_G) { transpose_item64(F.w_up, DM, DFF, WSP(bf16_t, WS_WGU), nullptr, 3, scr, r, F.lane); continue; } r -= I_G;
            transpose_item64(F.w_down, DFF, DM, WSP(bf16_t, WS_WD), nullptr, 0, scr, r, F.lane); }
    }
    __syncthreads();
}
__device__ __forceinline__ void p_prologue(Frame& F) {
    mod_gemv(F, 0, F.vcu, F.G);
    for (int set_ = 0; set_ < 2; ++set_) convert_set(F, set_, F.vcu, F.G);
    if (F.vcu == 0) { for (int i = F.tid; i < 64 * 8; i += NTHR) { const int pos = i >> 3, f = i & 7; const float inv = powf(10000.f, -(float)f / 8.f); const float ang = (float)pos * inv;
            WSP(f32x2, WS_MISC + MISC_ROPE)[i] = (f32x2){cosf(ang), sinf(ang)}; } }
    for (int i = F.vcu * NTHR + F.tid; i < 2 * 4 * 128 * 128 / 2; i += F.G * NTHR) { const f32x2 v = ((const f32x2*)F.w_sgu)[i]; WSP(unsigned, WS_WSGU)[i] = cvtpk(v.x, v.y); }
}
__device__ __forceinline__ bool tail_worker(int nwg, int G, int c, int& wi, int& nw) {
    const int rounds = (nwg + G - 1) / G, first = nwg - (rounds - 1) * G;
    if (first >= G) { wi = c; nw = G; return true; }
    if (c < first) return false;
    wi = c - first; nw = G - first; return true;
}
__device__ __forceinline__ void p_moe_weights(Frame& F) {
    __syncthreads();
    LAS float* scr = (LAS float*)(F.lds + F.wave * 16640);
    const int gw = F.vcu * NWAVES + F.wave, NGW = F.G * NWAVES;
    constexpr int I_G = 16 * 22, I_D = 22 * 16, PER_E = 2 * I_G + I_D;
    for (int it = gw; it < 8 * PER_E; it += NGW) {
        const int e = it / PER_E; int r = it - e * PER_E;
        bf16_t* gu = WSP(bf16_t, WS_MOEW_GU) + (size_t)e * 2 * DFE * DM;
        if (r < I_G) { transpose_item64(F.w_gate_e + (size_t)e * DM * DFE, DM, DFE, gu, nullptr, 2, scr, r, F.lane); continue; } r -= I_G;
        if (r < I_G) { transpose_item64(F.w_up_e + (size_t)e * DM * DFE, DM, DFE, gu, nullptr, 3, scr, r, F.lane); continue; } r -= I_G;
        transpose_item64(F.w_down_e + (size_t)e * DFE * DM, DFE, DM, WSP(bf16_t, WS_MOEW_D) + (size_t)e * DM * DFE, nullptr, 0, scr, r, F.lane);
    }
    __syncthreads();
}

template <bool ROUTE>
__device__ __forceinline__ void p_norm(Frame& F, int l, int which, int nrows, const float* srcL, const float* srcC, const float* slab = nullptr, const float* slabgate = nullptr) {
    const float* mod = WSP(float, WS_MOD) + (size_t)l * 9 * 6144;
    const float* g = (which == 0 ? F.g_mix : F.g_ffn) + l * DM;
    bf16_t* H = WSP(bf16_t, WS_H);
    LAS int* lcnt = (LAS int*)(F.lds + 32768);
    LAS int* rec = (LAS int*)(F.lds + 32768 + 64);
    int nrec = 0;
    if (ROUTE) { LAS float* wr = (LAS float*)F.lds; for (int i = F.tid; i < DM * 8; i += NTHR) wr[i] = F.w_router[i]; if (F.tid < 16) lcnt[F.tid] = 0; __syncthreads(); }
    const int gw = F.vcu * NWAVES + F.wave, NGW = F.G * NWAVES;
    for (int row = gw; row < nrows; row += NGW) {
        const bool isc = row >= NLAT; const int b = isc ? 8 : (row >> 11);
        const float* xr = isc ? srcC + (size_t)(row - NLAT) * DM : srcL + (size_t)row * DM;
        f32x4 v[4]; float s = 0.f;
#pragma unroll
        for (int j = 0; j < 4; ++j) v[j] = *(const f32x4*)(xr + 256 * j + 4 * F.lane);
        if (slab && isc) {
#pragma unroll
            for (int j = 0; j < 4; ++j) { const size_t o_ = (size_t)(row - NLAT) * DM + 256 * j + 4 * F.lane; const f32x4 gt = *(const f32x4*)(slabgate + 256 * j + 4 * F.lane);
                const f32x4 p0 = *(const f32x4*)(slab + o_), p1 = *(const f32x4*)(slab + (size_t)NCTX * DM + o_), p2 = *(const f32x4*)(slab + (size_t)2 * NCTX * DM + o_), p3 = *(const f32x4*)(slab + (size_t)3 * NCTX * DM + o_);
                v[j] = v[j] + gt * ((p0 + p1) + (p2 + p3)); } }
#pragma unroll
        for (int j = 0; j < 4; ++j) s += (v[j].x * v[j].x + v[j].y * v[j].y) + (v[j].z * v[j].z + v[j].w * v[j].w);
        const float rstd = rsqrtf(wave_sum(s) * (1.f / DM) + EPS);
        const float* sh = mod + (size_t)b * 6144 + (which * 3) * DM; const float* sc = sh + DM;
        float lg[8];
        if (ROUTE) {
#pragma unroll
            for (int e = 0; e < 8; ++e) lg[e] = 0.f; }
#pragma unroll
        for (int j = 0; j < 4; ++j) { const int k = 256 * j + 4 * F.lane;
            const f32x4 gg = *(const f32x4*)(g + k), s1 = *(const f32x4*)(sc + k), s0 = *(const f32x4*)(sh + k);
            f32x4 h = (v[j] * rstd) * gg * (s1 + 1.f) + s0;
            u32x2 w; w.x = cvtpk(h.x, h.y); w.y = cvtpk(h.z, h.w);
            *(u32x2*)(H + (size_t)row * DM + k) = w;
            if (ROUTE) { const LAS float* wr = (const LAS float*)F.lds + k * 8;
#pragma unroll
                for (int i = 0; i < 4; ++i) { const f32x4 w0 = *(const LAS f32x4*)(wr + 8 * i), w1 = *(const LAS f32x4*)(wr + 8 * i + 4); const float hv = h[i];
                    lg[0] += hv * w0.x; lg[1] += hv * w0.y; lg[2] += hv * w0.z; lg[3] += hv * w0.w; lg[4] += hv * w1.x; lg[5] += hv * w1.y; lg[6] += hv * w1.z; lg[7] += hv * w1.w; }
                asm volatile("" ::: "memory"); }
        }
        if (ROUTE) {
#pragma unroll
            for (int e = 0; e < 8; ++e) lg[e] = wave_sum(lg[e]);
            int i0 = 0; float m0 = lg[0];
#pragma unroll
            for (int e = 1; e < 8; ++e) if (lg[e] > m0) { m0 = lg[e]; i0 = e; }
            int i1 = -1; float m1 = -3.0e38f;
#pragma unroll
            for (int e = 0; e < 8; ++e) if (e != i0 && lg[e] > m1) { m1 = lg[e]; i1 = e; }
            const float w1 = 1.f / (1.f + __expf(m0 - m1)), w0 = 1.f - w1;
            if (F.lane == 0) { float* tw = WSP(float, WS_MISC + MISC_TOPW);
                const int p0 = __hip_atomic_fetch_add(lcnt + i0, 1, __ATOMIC_RELAXED, __HIP_MEMORY_SCOPE_WORKGROUP), p1 = __hip_atomic_fetch_add(lcnt + i1, 1, __ATOMIC_RELAXED, __HIP_MEMORY_SCOPE_WORKGROUP);
                LAS int* r = rec + (F.wave * 16 + nrec) * 4; r[0] = row; r[1] = i0 | (i1 << 8); r[2] = p0; r[3] = p1; tw[row * 2] = w0; tw[row * 2 + 1] = w1; }
            ++nrec;
        }
    }
    if (ROUTE) {
        __syncthreads();
        if (F.tid < 8) lcnt[8 + F.tid] = (int)atomicAdd(WSP(unsigned, WS_CTL) + CW_CNT + 64 * F.tid, (unsigned)lcnt[F.tid]);
        __syncthreads();
        int* list = WSP(int, WS_LIST);
        if (F.lane < nrec) { const LAS int* r = rec + (F.wave * 16 + F.lane) * 4; const int row = r[0], i0 = r[1] & 255, i1 = r[1] >> 8;
            list[i0 * NLAT + lcnt[8 + i0] + r[2]] = row * 2; list[i1 * NLAT + lcnt[8 + i1] + r[3]] = row * 2 + 1; }
        __syncthreads();
    }
}
__device__ __forceinline__ void p_final(Frame& F) {
    const float* mod = WSP(float, WS_MOD) + (size_t)1 * 9 * 6144; const bf16_t* Y = WSP(bf16_t, WS_Y);
    const int gw = F.vcu * NWAVES + F.wave, NGW = F.G * NWAVES;
    for (int row = gw; row < NLAT; row += NGW) {
        const int b = row >> 11; float* xr = F.out + (size_t)row * DM; const float* gt = mod + (size_t)b * 6144 + 5 * DM;
        f32x4 v[4]; float s = 0.f;
#pragma unroll
        for (int j = 0; j < 4; ++j) { const int k = 256 * j + 4 * F.lane; const f32x4 xv = *(const f32x4*)(xr + k), gv = *(const f32x4*)(gt + k);
            const u32x2 a = *(const u32x2*)(Y + (size_t)(2 * row) * DM + k), c = *(const u32x2*)(Y + (size_t)(2 * row + 1) * DM + k);
            f32x4 y; y.x = bflo(a.x) + bflo(c.x); y.y = bfhi(a.x) + bfhi(c.x); y.z = bflo(a.y) + bflo(c.y); y.w = bfhi(a.y) + bfhi(c.y);
            v[j] = xv + gv * y; s += (v[j].x * v[j].x + v[j].y * v[j].y) + (v[j].z * v[j].z + v[j].w * v[j].w); }
        const float rstd = rsqrtf(wave_sum(s) * (1.f / DM) + EPS);
#pragma unroll
        for (int j = 0; j < 4; ++j) { const int k = 256 * j + 4 * F.lane; *(f32x4*)(xr + k) = (v[j] * rstd) * *(const f32x4*)(F.g_final + k); }
    }
}
constexpr int LP = 272;
__device__ __forceinline__ void chunk_rows(int u, int& row0, bool& isc) {
    if (u < 128) { row0 = (u >> 4) * SEQ + (u & 15) * 128; isc = false; } else { const int uu = u - 128; row0 = NLAT + (uu >> 1) * CTXL + (uu & 1) * 128; isc = true; }
}
__device__ __forceinline__ void krope_unit(Frame& F, int u) {
    int row0; bool isc; chunk_rows(u, row0, isc);
    const bf16_t* P = WSP(bf16_t, WS_P);
    if (F.tid < 128) {
        const int row = row0 + F.tid; const u32x4* src = (const u32x4*)(P + (size_t)row * INP + PC_KR);
        u32x4 q[4];
#pragma unroll
        for (int i = 0; i < 4; ++i) q[i] = src[i];
        if (!isc) {
            const int tok = row & (SEQ - 1); const f32x2* rt = WSP(f32x2, WS_MISC + MISC_ROPE);
            float v[32];
#pragma unroll
            for (int i = 0; i < 4; ++i) { v[8 * i] = bflo(q[i].x); v[8 * i + 1] = bfhi(q[i].x); v[8 * i + 2] = bflo(q[i].y); v[8 * i + 3] = bfhi(q[i].y); v[8 * i + 4] = bflo(q[i].z); v[8 * i + 5] = bfhi(q[i].z); v[8 * i + 6] = bflo(q[i].w); v[8 * i + 7] = bfhi(q[i].w); }
#pragma unroll
            for (int ax = 0; ax < 2; ++ax) { const int pos = ax == 0 ? (tok >> 6) : (tok & 63);
#pragma unroll
                for (int f = 0; f < 8; ++f) { const f32x2 cs = rt[pos * 8 + f]; const float t1 = v[16 * ax + f], t2 = v[16 * ax + 8 + f];
                    v[16 * ax + f] = t1 * cs.x - t2 * cs.y; v[16 * ax + 8 + f] = t1 * cs.y + t2 * cs.x; } }
#pragma unroll
            for (int i = 0; i < 4; ++i) { q[i].x = cvtpk(v[8 * i], v[8 * i + 1]); q[i].y = cvtpk(v[8 * i + 2], v[8 * i + 3]); q[i].z = cvtpk(v[8 * i + 4], v[8 * i + 5]); q[i].w = cvtpk(v[8 * i + 6], v[8 * i + 7]); }
        }
        u32x4* dst = (u32x4*)(WSP(bf16_t, WS_KR) + (size_t)row * 32);
#pragma unroll
        for (int i = 0; i < 4; ++i) dst[i] = q[i];
    }
}
__device__ __forceinline__ void sgu_unit(Frame& F, int l, int u) {
    int row0; bool isc; chunk_rows(u, row0, isc);
    const bf16_t* P = WSP(bf16_t, WS_P); bf16_t* CAT = WSP(bf16_t, WS_CAT);
    LAS unsigned char* VT = F.lds;
    LAS unsigned char* WB = F.lds + 256 * LP;
    const int w = F.wave, lane = F.lane;
    {
        const f32x4 gs = *(const f32x4*)(F.g_sgu + l * 256 + 4 * lane), bs = *(const f32x4*)(F.beta_sgu + l * 256 + 4 * lane);
#pragma unroll
        for (int grp = 0; grp < 2; ++grp) {
            const int s0 = 16 * w + 8 * grp;
            float v[8][4];
#pragma unroll
            for (int tt = 0; tt < 8; ++tt) { const u32x2 r = *(const u32x2*)(P + (size_t)(row0 + s0 + tt) * INP + PC_V + 4 * lane);
                v[tt][0] = gelu_tanh(bflo(r.x)); v[tt][1] = gelu_tanh(bfhi(r.x)); v[tt][2] = gelu_tanh(bflo(r.y)); v[tt][3] = gelu_tanh(bfhi(r.y)); }
#pragma unroll
            for (int tt = 0; tt < 8; ++tt) {
                const float mu = wave_sum((v[tt][0] + v[tt][1]) + (v[tt][2] + v[tt][3])) * (1.f / 256.f);
                float d0 = v[tt][0] - mu, d1 = v[tt][1] - mu, d2 = v[tt][2] - mu, d3 = v[tt][3] - mu;
                const float rstd = rsqrtf(wave_sum((d0 * d0 + d1 * d1) + (d2 * d2 + d3 * d3)) * (1.f / 256.f) + EPS);
                v[tt][0] = d0 * rstd * gs.x + bs.x; v[tt][1] = d1 * rstd * gs.y + bs.y; v[tt][2] = d2 * rstd * gs.z + bs.z; v[tt][3] = d3 * rstd * gs.w + bs.w; }
#pragma unroll
            for (int i = 0; i < 4; ++i) { u32x4 o; o.x = cvtpk(v[0][i], v[1][i]); o.y = cvtpk(v[2][i], v[3][i]); o.z = cvtpk(v[4][i], v[5][i]); o.w = cvtpk(v[6][i], v[7][i]);
                *(LAS u32x4*)(VT + (4 * lane + i) * LP + s0 * 2) = o; }
        }
    }
    const bf16_t* Wg = WSP(bf16_t, WS_WSGU) + (size_t)l * 4 * 128 * 128;
#define SGU_STAGE_W(h, buf) do { _Pragma("unroll") for (int _i = 0; _i < 4; ++_i) { const int q_ = F.tid + NTHR * _i, r_ = q_ >> 4, c_ = q_ & 15; \
        *(LAS u32x4*)(WB + (buf) * 128 * LP + r_ * LP + c_ * 16) = *(const u32x4*)(Wg + (size_t)(h) * 16384 + r_ * 128 + c_ * 8); } } while (0)
    SGU_STAGE_W(0, 0);
    u32x2 upre[4][4];
    { const int t_ = 16 * w + (lane & 15), row_ = row0 + t_;
#pragma unroll
        for (int h = 0; h < 4; ++h)
#pragma unroll
            for (int dt = 0; dt < 4; ++dt) upre[h][dt] = *(const u32x2*)(P + (size_t)row_ * INP + PC_U + h * 64 + dt * 16 + 4 * (lane >> 4)); }
    __syncthreads();
    f32x4 acc[4][4];
#pragma unroll
    for (int h = 0; h < 4; ++h)
#pragma unroll
        for (int dt = 0; dt < 4; ++dt) acc[h][dt] = (f32x4){0.f, 0.f, 0.f, 0.f};
    const int fr = lane & 15, fq = lane >> 4;
#pragma unroll
    for (int h = 0; h < 4; ++h) {
        if (h + 1 < 4) SGU_STAGE_W(h + 1, (h + 1) & 1);
        const LAS unsigned char* Wh = WB + (h & 1) * 128 * LP;
#pragma unroll
        for (int ks = 0; ks < 4; ++ks) {
            const bf16x8 bw = *(const LAS bf16x8*)(Wh + (16 * w + fr) * LP + (32 * ks + 8 * fq) * 2);
#pragma unroll
            for (int dt = 0; dt < 4; ++dt) { const bf16x8 av = *(const LAS bf16x8*)(VT + (h * 64 + dt * 16 + fr) * LP + (32 * ks + 8 * fq) * 2);
                acc[h][dt] = MFMA16(av, bw, acc[h][dt]); }
        }
        __syncthreads();
    }
#undef SGU_STAGE_W
    { const int t = 16 * w + fr, row = row0 + t;
#pragma unroll
        for (int h = 0; h < 4; ++h) { const float bsv = F.b_sgu[(l * 4 + h) * 128 + t];
#pragma unroll
            for (int dt = 0; dt < 4; ++dt) { const int c = h * 64 + dt * 16 + 4 * fq; const u32x2 r = upre[h][dt];
                const float o0 = gelu_tanh(bflo(r.x)) * (acc[h][dt][0] + bsv), o1 = gelu_tanh(bfhi(r.x)) * (acc[h][dt][1] + bsv), o2 = gelu_tanh(bflo(r.y)) * (acc[h][dt][2] + bsv), o3 = gelu_tanh(bfhi(r.y)) * (acc[h][dt][3] + bsv);
                u32x2 o; o.x = cvtpk(o0, o1); o.y = cvtpk(o2, o3); *(u32x2*)(CAT + (size_t)row * DM + c) = o; } } }
    __syncthreads();
}

__device__ __forceinline__ void ssd_local_unit(Frame& F, int l, int u) {
    int b, c, g, row0, seq0, seqlen; bool isc;
    if (u < 256) { b = u >> 5; c = (u >> 1) & 15; g = u & 1; row0 = b * SEQ + c * 128; seq0 = b * SEQ; seqlen = SEQ; isc = false; }
    else { const int uu = u - 256; b = uu >> 2; c = (uu >> 1) & 1; g = uu & 1; row0 = NLAT + b * CTXL + c * 128; seq0 = NLAT + b * CTXL; seqlen = CTXL; isc = true; }
    const bf16_t* P = WSP(bf16_t, WS_P);
    LAS unsigned char* R1 = F.lds;
    LAS unsigned char* R2 = F.lds + 128 * LP;
    LAS unsigned char* XT = F.lds + 256 * LP;
    LAS float* dtv = (LAS float*)(F.lds + 448 * LP);
    LAS float* acsv = dtv + 768;
    LAS float* wv = acsv + 768;
    const int w = F.wave, lane = F.lane, tid = F.tid, fr = lane & 15, fq = lane >> 4;
    const float* cw = F.conv_w + (size_t)l * 5 * 896; const float* cb = F.conv_b + l * 896;
    LAS float* wlb = (LAS float*)(F.lds + 448 * LP + 9216);
    if (tid < 56) { const int chx0 = tid < 24 ? g * 192 + 8 * tid : (tid < 40 ? 384 + g * 128 + 8 * (tid - 24) : 640 + g * 128 + 8 * (tid - 40));
#pragma unroll
        for (int k = 0; k < 5; ++k) { *(LAS f32x4*)(wlb + tid * 48 + 8 * k) = *(const f32x4*)(cw + k * 896 + chx0); *(LAS f32x4*)(wlb + tid * 48 + 8 * k + 4) = *(const f32x4*)(cw + k * 896 + chx0 + 4); }
        *(LAS f32x4*)(wlb + tid * 48 + 40) = *(const f32x4*)(cb + chx0); *(LAS f32x4*)(wlb + tid * 48 + 44) = *(const f32x4*)(cb + chx0 + 4); }
    __syncthreads();
    if (tid < 448) {
        const int cg = tid % 56, seg = tid / 56;
        int pcol, role, lch;
        if (cg < 24) { role = 0; lch = 8 * cg; pcol = PC_X + g * 192 + lch; }
        else if (cg < 40) { role = 1; lch = 8 * (cg - 24); pcol = PC_B + g * 128 + lch; }
        else { role = 2; lch = 8 * (cg - 40); pcol = PC_C + g * 128 + lch; }
        const LAS float* wl = wlb + cg * 48;
#pragma unroll 1
        for (int hb = 0; hb < 2; ++hb) {
            const int t0 = 16 * seg + 8 * hb;
            u32x4 rows[12];
#pragma unroll
            for (int i = 0; i < 12; ++i) { const int grow = row0 + t0 - 2 + i;
                if (i >= 2 && i < 10) rows[i] = *(const u32x4*)(P + (size_t)grow * INP + pcol);
                else { const bool ok = grow >= seq0 && grow < seq0 + seqlen; const int gcl = i < 2 ? (grow < seq0 ? seq0 : grow) : (grow >= seq0 + seqlen ? seq0 + seqlen - 1 : grow);
                    const u32x4 v_ = *(const u32x4*)(P + (size_t)gcl * INP + pcol); rows[i] = ok ? v_ : (u32x4){0u, 0u, 0u, 0u}; } }
            unsigned pk[8][4];
#pragma unroll
            for (int o2 = 0; o2 < 4; ++o2) {
                float y[2][8];
#pragma unroll
                for (int e = 0; e < 2; ++e) { const int o = 2 * o2 + e; f32x4 ya = *(const LAS f32x4*)(wl + 40), yb = *(const LAS f32x4*)(wl + 44);
#pragma unroll
                    for (int k = 0; k < 5; ++k) { const u32x4 r = rows[o + k]; const f32x4 xa = {bflo(r.x), bfhi(r.x), bflo(r.y), bfhi(r.y)}, xb = {bflo(r.z), bfhi(r.z), bflo(r.w), bfhi(r.w)};
                        ya += *(const LAS f32x4*)(wl + 8 * k) * xa; yb += *(const LAS f32x4*)(wl + 8 * k + 4) * xb; }
#pragma unroll
                    for (int c8 = 0; c8 < 4; ++c8) { y[e][c8] = silu_f(ya[c8]); y[e][4 + c8] = silu_f(yb[c8]); }
                    if (role != 0) { u32x4 st; st.x = cvtpk(y[e][0], y[e][1]); st.y = cvtpk(y[e][2], y[e][3]); st.z = cvtpk(y[e][4], y[e][5]); st.w = cvtpk(y[e][6], y[e][7]);
                        *(u32x4*)((role == 1 ? R2 : R1) + (t0 + o) * LP + lch * 2) = st;
                        if (role == 2) *(u32x4*)(WSP(bf16_t, WS_CC) + (size_t)(row0 + t0 + o) * 256 + g * 128 + lch) = st; }
                }
#pragma unroll
                for (int c8 = 0; c8 < 8; ++c8) pk[c8][o2] = cvtpk(y[0][c8], y[1][c8]);
            }
            if (role == 0) {
#pragma unroll
                for (int c8 = 0; c8 < 8; ++c8) *(LAS u32x4*)(XT + (lch + c8) * LP + t0 * 2) = (u32x4){pk[c8][0], pk[c8][1], pk[c8][2], pk[c8][3]}; }
        }
    }
    else {
        bf16_t draw[6][2];
#pragma unroll
        for (int q = 0; q < 6; ++q) { const int d = q / 3, h = g * 3 + q % 3; const int e0 = 2 * lane, t0 = d == 0 ? e0 : 127 - e0, t1 = d == 0 ? e0 + 1 : 126 - e0;
            draw[q][0] = P[(size_t)(row0 + t0) * INP + PC_DT + d * 6 + h]; draw[q][1] = P[(size_t)(row0 + t1) * INP + PC_DT + d * 6 + h]; }
        asm volatile("" ::: "memory");
#pragma unroll
        for (int q = 0; q < 6; ++q) { const int d = q / 3, j = q % 3, h = g * 3 + j;
            const float a = -__expf(F.a_log[l * 12 + d * 6 + h]), bias = F.dt_bias[l * 12 + d * 6 + h];
            const int e0 = 2 * lane, e1 = 2 * lane + 1, t0 = d == 0 ? e0 : 127 - e0, t1 = d == 0 ? e1 : 127 - e1;
            const float dt0 = softplus_f(bf1(draw[q][0]) + bias), dt1 = softplus_f(bf1(draw[q][1]) + bias);
            const float x0 = dt0 * a, x1 = dt1 * a; float s = x0 + x1;
#pragma unroll
            for (int off = 1; off < 64; off <<= 1) { const float t = __shfl_up(s, off); if (lane >= off) s += t; }
            const float a1v = s, a0v = s - x1, tot = __shfl(s, 63);
            dtv[q * 128 + t0] = dt0; dtv[q * 128 + t1] = dt1; acsv[q * 128 + t0] = a0v; acsv[q * 128 + t1] = a1v;
            wv[q * 128 + t0] = __expf(tot - a0v) * dt0; wv[q * 128 + t1] = __expf(tot - a1v) * dt1;
            float* ACS = WSP(float, WS_ACS); ACS[(size_t)(row0 + t0) * 12 + d * 6 + h] = a0v; ACS[(size_t)(row0 + t1) * 12 + d * 6 + h] = a1v;
            if (lane == 0) { const int pos = isc ? (d == 0 ? c : 1 - c) : (d == 0 ? 2 + c : 17 - c); WSP(float, WS_MISC + MISC_DEC)[((b * 2 + d) * NPOS + pos) * 6 + h] = __expf(tot); }
        }
    }
    __syncthreads();
    f32x4 G[8];
#pragma unroll
    for (int t = 0; t < 8; ++t) G[t] = (f32x4){0.f, 0.f, 0.f, 0.f};
#pragma unroll
    for (int ks = 0; ks < 4; ++ks) { const bf16x8 cf = *(const LAS bf16x8*)(R1 + (16 * w + fr) * LP + (32 * ks + 8 * fq) * 2);
#pragma unroll
        for (int t = 0; t < 8; ++t) { const bf16x8 bfm = *(const LAS bf16x8*)(R2 + (16 * t + fr) * LP + (32 * ks + 8 * fq) * 2); G[t] = MFMA16(bfm, cf, G[t]); } }
    __syncthreads();
    if (tid < 256) { const int sb = tid >> 4, nb = tid & 15; u32x4 r[8];
#pragma unroll
        for (int i = 0; i < 8; ++i) r[i] = *(const LAS u32x4*)(R2 + (8 * sb + i) * LP + nb * 16);
#pragma unroll
        for (int j = 0; j < 8; ++j) { u32x4 o;
            if ((j & 1) == 0) { o.x = (r[0][j >> 1] & 0xffffu) | (r[1][j >> 1] << 16); o.y = (r[2][j >> 1] & 0xffffu) | (r[3][j >> 1] << 16); o.z = (r[4][j >> 1] & 0xffffu) | (r[5][j >> 1] << 16); o.w = (r[6][j >> 1] & 0xffffu) | (r[7][j >> 1] << 16); }
            else { o.x = (r[0][j >> 1] >> 16) | (r[1][j >> 1] & 0xffff0000u); o.y = (r[2][j >> 1] >> 16) | (r[3][j >> 1] & 0xffff0000u); o.z = (r[4][j >> 1] >> 16) | (r[5][j >> 1] & 0xffff0000u); o.w = (r[6][j >> 1] >> 16) | (r[7][j >> 1] & 0xffff0000u); }
            *(LAS u32x4*)(R1 + (8 * nb + j) * LP + sb * 16) = o; } }
    __syncthreads();
    LAS unsigned char* Mw = R2 + w * 16 * LP;
    bf16_t* ST = WSP(bf16_t, WS_ST); float* YP = WSP(float, WS_YP);
    const bool needy = !(isc && l == DEPTH - 1);
    const int lrow = 16 * w + fr;
#pragma unroll 1
    for (int j = 0; j < 3; ++j) {
        const int h = g * 3 + j;
        f32x4 ay[4];
#pragma unroll
        for (int pt = 0; pt < 4; ++pt) ay[pt] = (f32x4){0.f, 0.f, 0.f, 0.f};
#pragma unroll 1
        for (int d = 0; d < 2; ++d) {
            const int q = d * 3 + j; const float al = acsv[q * 128 + lrow];
            if (needy) {
#pragma unroll
            for (int t = 0; t < 8; ++t) { const int s4 = 16 * t + 4 * fq; u32x2 o = {0u, 0u};
                if (d == 0 ? (t <= w) : (t >= w)) {
                    const f32x4 as = *(const LAS f32x4*)(acsv + q * 128 + s4), ds = *(const LAS f32x4*)(dtv + q * 128 + s4);
                    float mv[4];
#pragma unroll
                    for (int r = 0; r < 4; ++r) { const int s = s4 + r; const bool ok = (t != w) || (d == 0 ? (s <= lrow) : (s >= lrow)); mv[r] = ok ? G[t][r] * __expf(al - as[r]) * ds[r] : 0.f; }
                    o.x = cvtpk(mv[0], mv[1]); o.y = cvtpk(mv[2], mv[3]); }
                *(LAS u32x2*)(Mw + fr * LP + s4 * 2) = o; }
            LDS_WAIT();
#pragma unroll
            for (int ks = 0; ks < 4; ++ks) if (d == 0 ? (2 * ks <= w) : (2 * ks + 1 >= w)) { const bf16x8 mf = *(const LAS bf16x8*)(Mw + fr * LP + (32 * ks + 8 * fq) * 2);
#pragma unroll
                for (int pt = 0; pt < 4; ++pt) { const bf16x8 xf = *(const LAS bf16x8*)(XT + (j * 64 + 16 * pt + fr) * LP + (32 * ks + 8 * fq) * 2); ay[pt] = MFMA16(xf, mf, ay[pt]); } }
            }
            f32x4 as4[4];
#pragma unroll
            for (int pt = 0; pt < 4; ++pt) as4[pt] = (f32x4){0.f, 0.f, 0.f, 0.f};
#pragma unroll
            for (int ks = 0; ks < 4; ++ks) { const u32x4 raw = *(const LAS u32x4*)(R1 + (16 * w + fr) * LP + (32 * ks + 8 * fq) * 2);
                const f32x4 wa = *(const LAS f32x4*)(wv + q * 128 + 32 * ks + 8 * fq), wb = *(const LAS f32x4*)(wv + q * 128 + 32 * ks + 8 * fq + 4);
                u32x4 sc; sc.x = cvtpk(bflo(raw.x) * wa.x, bfhi(raw.x) * wa.y); sc.y = cvtpk(bflo(raw.y) * wa.z, bfhi(raw.y) * wa.w); sc.z = cvtpk(bflo(raw.z) * wb.x, bfhi(raw.z) * wb.y); sc.w = cvtpk(bflo(raw.w) * wb.z, bfhi(raw.w) * wb.w);
                const bf16x8 bsf = __builtin_bit_cast(bf16x8, sc);
#pragma unroll
                for (int pt = 0; pt < 4; ++pt) { const bf16x8 xf = *(const LAS bf16x8*)(XT + (j * 64 + 16 * pt + fr) * LP + (32 * ks + 8 * fq) * 2); as4[pt] = MFMA16(bsf, xf, as4[pt]); } }
            { const int pos = isc ? (d == 0 ? c : 1 - c) : (d == 0 ? 2 + c : 17 - c); bf16_t* sp = ST + ((size_t)((b * 2 + d) * NPOS + pos) * 6 + h) * 8192;
#pragma unroll
                for (int pt = 0; pt < 4; ++pt) { u32x2 o; o.x = cvtpk(as4[pt][0], as4[pt][1]); o.y = cvtpk(as4[pt][2], as4[pt][3]); *(u32x2*)(sp + (16 * pt + fr) * 128 + 16 * w + 4 * fq) = o; } }
        }
        if (needy) { const float skip = F.d_skip[l * 6 + h];
#pragma unroll
            for (int pt = 0; pt < 4; ++pt) { f32x4 o;
#pragma unroll
                for (int r = 0; r < 4; ++r) o[r] = ay[pt][r] + skip * bf1(*(const LAS bf16_t*)(XT + (j * 64 + 16 * pt + 4 * fq + r) * LP + lrow * 2));
                *(f32x4*)(YP + (size_t)(row0 + lrow) * 384 + h * 64 + 16 * pt + 4 * fq) = o; } }
    }
    __syncthreads();
}

__device__ __forceinline__ void ssd_scan(Frame& F) {
    bf16_t* ST = WSP(bf16_t, WS_ST); const float* DEC = WSP(float, WS_MISC + MISC_DEC);
    for (int gt = F.vcu * NTHR + F.tid; gt < 96 * 1024; gt += F.G * NTHR) {
        const int combo = gt >> 10, e8 = gt & 1023, bd = combo / 6, h = combo - bd * 6;
        u32x4 st[17]; float dec[17];
#pragma unroll
        for (int q = 0; q < 17; ++q) { const size_t sidx = (size_t)(bd * NPOS + q) * 6 + h; st[q] = *(const u32x4*)(ST + sidx * 8192 + e8 * 8); dec[q] = DEC[sidx]; }
        float hv[8];
#pragma unroll
        for (int i = 0; i < 8; ++i) hv[i] = 0.f;
#pragma unroll
        for (int q = 0; q < 17; ++q) { const size_t sidx = (size_t)(bd * NPOS + q) * 6 + h; const float dq = dec[q];
            hv[0] = dq * hv[0] + bflo(st[q].x); hv[1] = dq * hv[1] + bfhi(st[q].x); hv[2] = dq * hv[2] + bflo(st[q].y); hv[3] = dq * hv[3] + bfhi(st[q].y);
            hv[4] = dq * hv[4] + bflo(st[q].z); hv[5] = dq * hv[5] + bfhi(st[q].z); hv[6] = dq * hv[6] + bflo(st[q].w); hv[7] = dq * hv[7] + bfhi(st[q].w);
            u32x4 o; o.x = cvtpk(hv[0], hv[1]); o.y = cvtpk(hv[2], hv[3]); o.z = cvtpk(hv[4], hv[5]); o.w = cvtpk(hv[6], hv[7]);
            *(u32x4*)(ST + sidx * 8192 + e8 * 8) = o; }
    }
}

__device__ __forceinline__ void ssd_final_unit(Frame& F, int l, int u) {
    int row0; bool isc; chunk_rows(u, row0, isc);
    const int b = isc ? ((u - 128) >> 1) : (u >> 4), c = isc ? ((u - 128) & 1) : (u & 15);
    constexpr int CPITCH = 528;
    LAS unsigned char* Cs = F.lds;
    LAS unsigned char* Hs = F.lds + 128 * CPITCH;
    const int w = F.wave, lane = F.lane, tid = F.tid, fr = lane & 15, fq = lane >> 4;
    const bf16_t* CC = WSP(bf16_t, WS_CC); const bf16_t* ST = WSP(bf16_t, WS_ST); const float* ACS = WSP(float, WS_ACS);
#pragma unroll
    for (int i = 0; i < 8; ++i) { const int q = tid + NTHR * i, r = q >> 5, cc = q & 31; *(LAS u32x4*)(Cs + r * CPITCH + cc * 16) = *(const u32x4*)(CC + (size_t)(row0 + r) * 256 + cc * 8); }
    const int lrow = 16 * w + fr, row = row0 + lrow;
    const int hp = tid >> 3, hn0 = (tid & 7) * 16;
    const float* YP = WSP(float, WS_YP); const bf16_t* P = WSP(bf16_t, WS_P); bf16_t* CAT = WSP(bf16_t, WS_CAT);
    float ss = 0.f;
    const f32x4 ac0 = *(const f32x4*)(ACS + (size_t)row * 12), ac1 = *(const f32x4*)(ACS + (size_t)row * 12 + 4), ac2 = *(const f32x4*)(ACS + (size_t)row * 12 + 8);
    const float acv[12] = {ac0[0], ac0[1], ac0[2], ac0[3], ac1[0], ac1[1], ac1[2], ac1[3], ac2[0], ac2[1], ac2[2], ac2[3]};
    u32x4 hpre[2][2][2]; f32x4 ypre[2][4]; u32x2 zpre[2][4];
#define SSDF_LOAD(hh, S_) do { \
        _Pragma("unroll") for (int d = 0; d < 2; ++d) { const int pos = isc ? (d == 0 ? c : 1 - c) : (d == 0 ? 2 + c : 17 - c); hpre[S_][d][0] = (u32x4){0u, 0u, 0u, 0u}; hpre[S_][d][1] = hpre[S_][d][0]; \
            if (pos > 0) { const size_t sidx = (size_t)((b * 2 + d) * NPOS + pos - 1) * 6 + (hh); hpre[S_][d][0] = *(const u32x4*)(ST + sidx * 8192 + hp * 128 + hn0); hpre[S_][d][1] = *(const u32x4*)(ST + sidx * 8192 + hp * 128 + hn0 + 8); } } \
        _Pragma("unroll") for (int pt = 0; pt < 4; ++pt) { const int cidx = (hh) * 64 + 16 * pt + 4 * fq; ypre[S_][pt] = *(const f32x4*)(YP + (size_t)row * 384 + cidx); zpre[S_][pt] = *(const u32x2*)(P + (size_t)row * INP + PC_Z + cidx); } } while (0)
    SSDF_LOAD(0, 1);
#pragma unroll 1
    for (int h = 0; h < 6; ++h) {
        const int g = h / 3; constexpr int S = 0;
#pragma unroll
        for (int d = 0; d < 2; ++d) { hpre[0][d][0] = hpre[1][d][0]; hpre[0][d][1] = hpre[1][d][1]; }
#pragma unroll
        for (int pt = 0; pt < 4; ++pt) { ypre[0][pt] = ypre[1][pt]; zpre[0][pt] = zpre[1][pt]; }
        if (h + 1 < 6) SSDF_LOAD(h + 1, 1);
        LAS unsigned char* Hset = Hs + (h & 1) * 2 * 64 * LP;
#pragma unroll
        for (int d = 0; d < 2; ++d) { LAS unsigned char* Hb = Hset + d * 64 * LP;
            *(LAS u32x4*)(Hb + hp * LP + hn0 * 2) = hpre[S][d][0]; *(LAS u32x4*)(Hb + hp * LP + hn0 * 2 + 16) = hpre[S][d][1]; }
        LDS_BARRIER();
        f32x4 yh[4];
#pragma unroll
        for (int pt = 0; pt < 4; ++pt) yh[pt] = (f32x4){0.f, 0.f, 0.f, 0.f};
#pragma unroll
        for (int d = 0; d < 2; ++d) {
            const LAS unsigned char* Hb = Hset + d * 64 * LP;
            f32x4 tm[4];
#pragma unroll
            for (int pt = 0; pt < 4; ++pt) tm[pt] = (f32x4){0.f, 0.f, 0.f, 0.f};
#pragma unroll
            for (int ks = 0; ks < 4; ++ks) { const bf16x8 cf = *(const LAS bf16x8*)(Cs + lrow * CPITCH + (g * 128 + 32 * ks + 8 * fq) * 2);
#pragma unroll
                for (int pt = 0; pt < 4; ++pt) { const bf16x8 hf = *(const LAS bf16x8*)(Hb + (16 * pt + fr) * LP + (32 * ks + 8 * fq) * 2); tm[pt] = MFMA16(hf, cf, tm[pt]); } }
            const float e = __expf(d == 0 ? (h == 0 ? acv[0] : h == 1 ? acv[1] : h == 2 ? acv[2] : h == 3 ? acv[3] : h == 4 ? acv[4] : acv[5]) : (h == 0 ? acv[6] : h == 1 ? acv[7] : h == 2 ? acv[8] : h == 3 ? acv[9] : h == 4 ? acv[10] : acv[11]));
#pragma unroll
            for (int pt = 0; pt < 4; ++pt) yh[pt] += tm[pt] * e;
        }
#pragma unroll
        for (int pt = 0; pt < 4; ++pt) { const int cidx = h * 64 + 16 * pt + 4 * fq; const u32x2 z = zpre[S][pt];
            f32x4 v = yh[pt] + ypre[S][pt]; v[0] *= silu_f(bflo(z.x)); v[1] *= silu_f(bfhi(z.x)); v[2] *= silu_f(bflo(z.y)); v[3] *= silu_f(bfhi(z.y));
            u32x2 o; o.x = cvtpk(v[0], v[1]); o.y = cvtpk(v[2], v[3]); *(u32x2*)(CAT + (size_t)row * DM + 256 + cidx) = o; ss += (v[0] * v[0] + v[1] * v[1]) + (v[2] * v[2] + v[3] * v[3]); }
    }
#undef SSDF_LOAD
    ss += __shfl_xor(ss, 16); ss += __shfl_xor(ss, 32);
    const float rstd = rsqrtf(ss * (1.f / 384.f) + EPS);
    u32x2 st[6][4];
#pragma unroll
    for (int h = 0; h < 6; ++h)
#pragma unroll
        for (int pt = 0; pt < 4; ++pt) st[h][pt] = *(const u32x2*)(CAT + (size_t)row * DM + 256 + h * 64 + 16 * pt + 4 * fq);
    asm volatile("" ::: "memory");
#pragma unroll
    for (int h = 0; h < 6; ++h)
#pragma unroll
        for (int pt = 0; pt < 4; ++pt) { const int cidx = h * 64 + 16 * pt + 4 * fq; const f32x4 gg = *(const f32x4*)(F.g_ssd + l * 384 + cidx); const u32x2 t = st[h][pt]; f32x4 v = {bflo(t.x), bfhi(t.x), bflo(t.y), bfhi(t.y)}; v = v * rstd * gg;
            u32x2 o; o.x = cvtpk(v[0], v[1]); o.y = cvtpk(v[2], v[3]); *(u32x2*)(CAT + (size_t)row * DM + 256 + cidx) = o; }
    __syncthreads();
}

__device__ __forceinline__ void build_vt_item(Frame& F, int gt, int h) {
    const bf16_t* KV = WSP(bf16_t, WS_KV); bf16_t* VT = WSP(bf16_t, WS_VT);
    const int t7 = F.tid & 127, kq = t7 & 15, ch = t7 >> 4; u32x4 v[4];
#pragma unroll
    for (int r = 0; r < 4; ++r) v[r] = *(const u32x4*)(KV + (size_t)(gt * 64 + 4 * kq + r) * KVW + h * 128 + 64 + ch * 8);
    bf16_t* dst = VT + ((size_t)gt * 6 + h) * 4096 + 4 * kq;
#pragma unroll
    for (int j = 0; j < 4; ++j) { const unsigned a0 = v[0][j], a1 = v[1][j], a2 = v[2][j], a3 = v[3][j];
        u32x2 lo, hi; lo.x = (a0 & 0xffffu) | (a1 << 16); lo.y = (a2 & 0xffffu) | (a3 << 16); hi.x = (a0 >> 16) | (a1 & 0xffff0000u); hi.y = (a2 >> 16) | (a3 & 0xffff0000u);
        *(u32x2*)(dst + (8 * ch + 2 * j) * 64) = lo; *(u32x2*)(dst + (8 * ch + 2 * j + 1) * 64) = hi; }
}
template <class Sched> __device__ __forceinline__ void build_vt_own(Frame& F, const Sched& S) {
    asm volatile("s_waitcnt vmcnt(0)" ::: "memory"); __syncthreads();
    pg8::Unit u; const int sub = F.tid >> 7;
    for (int i = 0; S.next(i, u); ++i) {
#pragma unroll
        for (int k = 0; k < 2; ++k) { const int item = sub + 4 * k;
            build_vt_item(F, u.pm * 4 + (item & 3), u.pn * 2 + (item >> 2)); }
    }
}

__device__ __forceinline__ void attn_unit(Frame& F, int u) {
    int b, h, q0, nt; bool isc;
    if (u < 768) { b = u / 96; const int rem = u % 96; h = rem >> 4; q0 = b * SEQ + (rem & 15) * 128; nt = 36; isc = false; }
    else { const int uu = u - 768; b = uu / 12; const int rem = uu % 12; h = rem >> 1; q0 = NLAT + b * CTXL + (rem & 1) * 128; nt = 4; isc = true; }
    constexpr int KP = 208, VP = 136, TILEB = 64 * KP + 64 * VP;
    const bf16_t* Q = WSP(bf16_t, WS_Q); const bf16_t* KV = WSP(bf16_t, WS_KV); const bf16_t* KR = WSP(bf16_t, WS_KR); const bf16_t* VTg = WSP(bf16_t, WS_VT); bf16_t* CAT = WSP(bf16_t, WS_CAT);
    const int w = F.wave, lane = F.lane, tid = F.tid, qs = w & 3, par = w >> 2, r32 = lane & 31, hf = lane >> 5;
    bf16x8 qf[6];
    { const int qrow = q0 + 32 * qs + r32; const bf16_t* qp = Q + (size_t)qrow * QW + h * 96 + 8 * hf;
#pragma unroll
        for (int ks = 0; ks < 6; ++ks) qf[ks] = *(const bf16x8*)(qp + 16 * ks);
        if (!isc) { const int tok = qrow & (SEQ - 1); const f32x2* rt = WSP(f32x2, WS_MISC + MISC_ROPE);
#pragma unroll
            for (int ax = 0; ax < 2; ++ax) { const int pos = ax == 0 ? (tok >> 6) : (tok & 63); u32x4 own = __builtin_bit_cast(u32x4, qf[4 + ax]); u32x4 oth;
                oth.x = __shfl_xor(own.x, 32); oth.y = __shfl_xor(own.y, 32); oth.z = __shfl_xor(own.z, 32); oth.w = __shfl_xor(own.w, 32);
                float a[8], o[8], r[8];
                a[0] = bflo(own.x); a[1] = bfhi(own.x); a[2] = bflo(own.y); a[3] = bfhi(own.y); a[4] = bflo(own.z); a[5] = bfhi(own.z); a[6] = bflo(own.w); a[7] = bfhi(own.w);
                o[0] = bflo(oth.x); o[1] = bfhi(oth.x); o[2] = bflo(oth.y); o[3] = bfhi(oth.y); o[4] = bflo(oth.z); o[5] = bfhi(oth.z); o[6] = bflo(oth.w); o[7] = bfhi(oth.w);
#pragma unroll
                for (int f = 0; f < 8; ++f) { const f32x2 cs = rt[pos * 8 + f]; r[f] = hf == 0 ? (a[f] * cs.x - o[f] * cs.y) : (o[f] * cs.y + a[f] * cs.x); }
                u32x4 res; res.x = cvtpk(r[0], r[1]); res.y = cvtpk(r[2], r[3]); res.z = cvtpk(r[4], r[5]); res.w = cvtpk(r[6], r[7]); qf[4 + ax] = __builtin_bit_cast(bf16x8, res); } }
    }
    u32x4 knA[2], krA, vregA[2], knB[2], krB, vregB[2];
    const unsigned voffK = (unsigned)((tid >> 3) * KVW + (tid & 7) * 8) * 2u, voffR = (unsigned)tid * 16u, voffV = (unsigned)tid * 16u;
    const unsigned ldsK = (unsigned)((tid >> 3) * KP + (tid & 7) * 16), ldsR = (unsigned)((tid >> 8) * TILEB + ((tid >> 2) & 63) * KP + (8 + (tid & 3)) * 16), ldsV = (unsigned)(64 * KP + (tid >> 3) * VP + (tid & 7) * 16);
#define ATT_R(tp) ((isc || (tp) < 2) ? (NLAT + b * CTXL + (tp) * 128) : (b * SEQ + ((tp) - 2) * 128))
#define ATT_LOAD(kn, kr, vreg, tp) do { const int R_ = __builtin_amdgcn_readfirstlane(ATT_R(tp)); \
        const unsigned char* kb_ = (const unsigned char*)(KV + (size_t)R_ * KVW + h * 128); \
        kn[0] = *(const u32x4*)(kb_ + voffK); kn[1] = *(const u32x4*)(kb_ + 64 * KVW * 2 + voffK); \
        kr = *(const u32x4*)((const unsigned char*)(KR + (size_t)R_ * 32) + voffR); \
        const unsigned char* vb_ = (const unsigned char*)(VTg + ((size_t)(R_ >> 6) * 6 + h) * 4096); \
        vreg[0] = *(const u32x4*)(vb_ + voffV); vreg[1] = *(const u32x4*)(vb_ + 6 * 4096 * 2 + voffV); } while (0)
#define ATT_WRITE(kn, kr, vreg, buf) do { LAS unsigned char* base_ = F.lds + (buf) * 2 * TILEB; \
        *(LAS u32x4*)(base_ + ldsK) = kn[0]; *(LAS u32x4*)(base_ + TILEB + ldsK) = kn[1]; *(LAS u32x4*)(base_ + ldsR) = kr; \
        _Pragma("unroll") for (int i = 0; i < 2; ++i) { LAS unsigned char* vt = base_ + i * TILEB + ldsV; \
            *(LAS u32x2*)vt = (u32x2){vreg[i].x, vreg[i].y}; *(LAS u32x2*)(vt + 8) = (u32x2){vreg[i].z, vreg[i].w}; } } while (0)
    const int np = nt / 2;
    ATT_LOAD(knA, krA, vregA, 0); ATT_WRITE(knA, krA, vregA, 0);
    __syncthreads();
    ATT_LOAD(knB, krB, vregB, 1);
    f32x16 o0, o1;
#pragma unroll
    for (int r = 0; r < 16; ++r) { o0[r] = 0.f; o1[r] = 0.f; }
    float mrun = 0.f, lrun = 0.f;
    const unsigned kfo = (unsigned)(r32 * KP + 16 * hf), vfo = (unsigned)(64 * KP + r32 * VP + 8 * hf);
#define ATT_STEP(tp) do { \
        const LAS unsigned char* Kt = F.lds + ((((tp)) & 1) * 2 + par) * TILEB; \
        bf16x8 ka[6], kb[6]; \
        _Pragma("unroll") \
        for (int ks = 0; ks < 6; ++ks) ka[ks] = *(const LAS bf16x8*)(Kt + kfo + 32 * ks); \
        _Pragma("unroll") \
        for (int ks = 0; ks < 6; ++ks) kb[ks] = *(const LAS bf16x8*)(Kt + kfo + 32 * KP + 32 * ks); \
        f32x16 p0, p1; \
        _Pragma("unroll") \
        for (int r = 0; r < 16; ++r) { p0[r] = -mrun; p1[r] = -mrun; } \
        __builtin_amdgcn_sched_barrier(0); \
        _Pragma("unroll") \
        for (int ks = 0; ks < 6; ++ks) { p0 = MFMA32(ka[ks], qf[ks], p0); p1 = MFMA32(kb[ks], qf[ks], p1); } \
        u32x2 va[4][2], vc[4][2]; \
        _Pragma("unroll") \
        for (int s2 = 0; s2 < 4; ++s2) { \
            va[s2][0] = *(const LAS u32x2*)(Kt + vfo + 32 * s2); va[s2][1] = *(const LAS u32x2*)(Kt + vfo + 32 * s2 + 16); \
            vc[s2][0] = *(const LAS u32x2*)(Kt + vfo + 32 * VP + 32 * s2); vc[s2][1] = *(const LAS u32x2*)(Kt + vfo + 32 * VP + 32 * s2 + 16); } \
        __builtin_amdgcn_sched_barrier(0); \
        float mx = p0[0]; \
        _Pragma("unroll") \
        for (int r = 1; r < 16; ++r) mx = fmaxf(mx, p0[r]); \
        _Pragma("unroll") \
        for (int r = 0; r < 16; ++r) mx = fmaxf(mx, p1[r]); \
        mx = fmaxf(mx, __shfl_xor(mx, 32)); \
        if ((tp) == 0 || __any(mx > 8.f)) { const float dl = (tp) == 0 ? mx : fmaxf(mx, 0.f), alpha = __builtin_amdgcn_exp2f(-dl); lrun *= alpha; mrun += dl; \
        _Pragma("unroll") \
            for (int r = 0; r < 16; ++r) { o0[r] *= alpha; o1[r] *= alpha; p0[r] -= dl; p1[r] -= dl; } } \
        _Pragma("unroll") \
        for (int r = 0; r < 16; ++r) { p0[r] = __builtin_amdgcn_exp2f(p0[r]); p1[r] = __builtin_amdgcn_exp2f(p1[r]); } \
        float sa = p0[0], sb = p0[1], sc = p1[0], sd = p1[1]; \
        _Pragma("unroll") \
        for (int r = 2; r < 16; r += 2) { sa += p0[r]; sb += p0[r + 1]; sc += p1[r]; sd += p1[r + 1]; } \
        lrun += (sa + sb) + (sc + sd); \
        bf16x8 pf[4]; \
        _Pragma("unroll") \
        for (int s2 = 0; s2 < 4; ++s2) { u32x4 t; \
            if (s2 < 2) { t.x = cvtpk(p0[8 * s2], p0[8 * s2 + 1]); t.y = cvtpk(p0[8 * s2 + 2], p0[8 * s2 + 3]); t.z = cvtpk(p0[8 * s2 + 4], p0[8 * s2 + 5]); t.w = cvtpk(p0[8 * s2 + 6], p0[8 * s2 + 7]); } \
            else { const int s = s2 - 2; t.x = cvtpk(p1[8 * s], p1[8 * s + 1]); t.y = cvtpk(p1[8 * s + 2], p1[8 * s + 3]); t.z = cvtpk(p1[8 * s + 4], p1[8 * s + 5]); t.w = cvtpk(p1[8 * s + 6], p1[8 * s + 7]); } \
            pf[s2] = __builtin_bit_cast(bf16x8, t); } \
        _Pragma("unroll") \
        for (int s2 = 0; s2 < 4; ++s2) { \
            const u32x4 va4 = {va[s2][0].x, va[s2][0].y, va[s2][1].x, va[s2][1].y}, vc4 = {vc[s2][0].x, vc[s2][0].y, vc[s2][1].x, vc[s2][1].y}; \
            o0 = MFMA32(__builtin_bit_cast(bf16x8, va4), pf[s2], o0); o1 = MFMA32(__builtin_bit_cast(bf16x8, vc4), pf[s2], o1); } \
    } while (0)
    for (int tp = 0; tp < np; tp += 2) {
        ATT_LOAD(knA, krA, vregA, min(tp + 2, np - 1));
        ATT_STEP(tp);
        if (tp + 1 < np) ATT_WRITE(knB, krB, vregB, 1);
        LDS_BARRIER();
        if (tp + 1 < np) {
            ATT_LOAD(knB, krB, vregB, min(tp + 3, np - 1));
            ATT_STEP(tp + 1);
            if (tp + 2 < np) ATT_WRITE(knA, krA, vregA, 0);
            LDS_BARRIER();
        }
    }
#undef ATT_STEP
#undef ATT_R
#undef ATT_LOAD
#undef ATT_WRITE
    lrun += __shfl_xor(lrun, 32);
    LAS float* mg = (LAS float*)(F.lds + 4 * TILEB);
    if (par == 1) { LAS float* d = mg + ((qs * 64 + lane) * 36);
#pragma unroll
        for (int r = 0; r < 16; r += 4) { *(LAS f32x4*)(d + r) = (f32x4){o0[r], o0[r + 1], o0[r + 2], o0[r + 3]}; *(LAS f32x4*)(d + 16 + r) = (f32x4){o1[r], o1[r + 1], o1[r + 2], o1[r + 3]}; }
        d[32] = mrun; d[33] = lrun; }
    __syncthreads();
    if (par == 0) { const LAS float* d = mg + ((qs * 64 + lane) * 36);
        const float m2 = d[32], l2 = d[33], mm = fmaxf(mrun, m2), a1 = __builtin_amdgcn_exp2f(mrun - mm), a2 = __builtin_amdgcn_exp2f(m2 - mm), inv = 1.f / (lrun * a1 + l2 * a2);
        const int qrow = q0 + 32 * qs + r32; bf16_t* op = CAT + (size_t)qrow * DM + 640 + h * 64;
#pragma unroll
        for (int g4 = 0; g4 < 4; ++g4) { const f32x4 e0 = *(const LAS f32x4*)(d + 4 * g4), e1 = *(const LAS f32x4*)(d + 16 + 4 * g4);
            float r0[4], r1[4];
#pragma unroll
            for (int r = 0; r < 4; ++r) { r0[r] = (o0[4 * g4 + r] * a1 + e0[r] * a2) * inv; r1[r] = (o1[4 * g4 + r] * a1 + e1[r] * a2) * inv; }
            u32x2 w0, w1; w0.x = cvtpk(r0[0], r0[1]); w0.y = cvtpk(r0[2], r0[3]); w1.x = cvtpk(r1[0], r1[1]); w1.y = cvtpk(r1[2], r1[3]);
            *(u32x2*)(op + 8 * g4 + 4 * hf) = w0; *(u32x2*)(op + 32 + 8 * g4 + 4 * hf) = w1; } }
    __syncthreads();
}
#ifndef MK_PER_PHASE
#define MK_PER_PHASE 0
#endif
constexpr int N_PHASES = 20;
struct Args { const float* in[32]; float* out; unsigned char* ws; int ph_lo, ph_hi; };
typedef __attribute__((address_space(4))) const Args CArgs;
#define GPF(k) ((const float*)(GAS const float*)ap_->in[k])

__global__ void __launch_bounds__(NTHR, 2) fwd_megakernel(Args args) {
    extern __shared__ __attribute__((aligned(16))) unsigned char lds_raw[];
    Frame F;
    F.sm = lds_raw; F.lds = (LAS unsigned char*)lds_raw;
    F.G = gridDim.x; { const int bx = blockIdx.x; F.vcu = (F.G % 8 == 0) ? (bx % 8) * (F.G / 8) + bx / 8 : bx; }
#define PHASE_BEGIN() do { int t_ = threadIdx.x; asm volatile("" : "+v"(t_)); t_ &= 511; F.tid = t_; F.lane = t_ & 63; F.wave = __builtin_amdgcn_readfirstlane(t_ >> 6); \
    CArgs* ap_ = (CArgs*)__builtin_amdgcn_kernarg_segment_ptr(); asm volatile("" : "+s"(ap_)); \
    F.x = GPF(0); F.c = GPF(1); F.ctx = GPF(2); F.c_ctx = GPF(3); F.w_mod = GPF(4); F.b_mod = GPF(5); F.g_mix = GPF(6); F.w_in = GPF(7); \
    F.w_sgu = GPF(8); F.b_sgu = GPF(9); F.g_sgu = GPF(10); F.beta_sgu = GPF(11); F.conv_w = GPF(12); F.conv_b = GPF(13); F.dt_bias = GPF(14); F.a_log = GPF(15); \
    F.d_skip = GPF(16); F.g_ssd = GPF(17); F.g_q = GPF(18); F.w_uq = GPF(19); F.g_kv = GPF(20); F.w_ukv = GPF(21); F.w_out = GPF(22); F.g_ffn = GPF(23); \
    F.w_gate = GPF(24); F.w_up = GPF(25); F.w_down = GPF(26); F.w_router = GPF(27); F.w_gate_e = GPF(28); F.w_up_e = GPF(29); F.w_down_e = GPF(30); F.g_final = GPF(31); \
    F.out = (float*)(GAS float*)ap_->out; F.ws = (unsigned char*)(GAS unsigned char*)ap_->ws; } while (0)
    PHASE_BEGIN();
    volatile LAS unsigned* MISC = (volatile LAS unsigned*)(F.lds + MISC_OFF);
    for (int u = F.tid; u < (LDS_BYTES - LDSCTL_OFF) / 4; u += NTHR) ((LAS unsigned*)(F.lds + LDSCTL_OFF))[u] = 0u;
    __syncthreads();
    XcdBarrier bar = xcd_barrier_post(WSP(unsigned, WS_CTL) + CW_BAR, MISC + 8, threadIdx.x == 0);
    { long pc0_; int clen_; asm volatile("mk_code_beg:\n\ts_getpc_b64 %0\n\ts_mov_b32 %1, mk_code_end - mk_code_beg" : "=s"(pc0_), "=s"(clen_));
      if (threadIdx.x == 0) { volatile LAS unsigned* cw = (volatile LAS unsigned*)(F.lds + LDSCTL_OFF + 960); cw[0] = (unsigned)pc0_; cw[1] = (unsigned)((unsigned long)pc0_ >> 32); cw[2] = (unsigned)clen_; }
      const int ln_ = ((int)blockIdx.x >> 3) * NTHR + (int)threadIdx.x; if (ln_ * 128 < clen_) (void)*(volatile const unsigned*)((const char*)pc0_ + (size_t)ln_ * 128); }
#ifndef WARM_AT
#define WARM_AT(k) 0
#endif
#define CODE_WARM() do { const volatile LAS unsigned* cw_ = (const volatile LAS unsigned*)(F.lds + LDSCTL_OFF + 960); const int ln_ = ((int)blockIdx.x >> 3) * NTHR + (int)threadIdx.x; \
    if (ln_ * 128 < (int)cw_[2]) { const char* cb_ = (const char*)(((unsigned long)cw_[1] << 32) | (unsigned long)cw_[0]); (void)*(volatile const unsigned*)(cb_ + (size_t)ln_ * 128); } } while (0)
#if MK_PER_PHASE
    const int lo = args.ph_lo, hi = args.ph_hi;
#else
    constexpr int lo = 0, hi = N_PHASES;
#endif
#ifndef PH_MASK
#define PH_MASK 0xFFFFFFFFu
#endif
#define PE(b) ((PH_MASK >> (b)) & 1u)
#ifndef REP_MASK
#define REP_MASK 0u
#endif
#ifndef SSD_DRY_LIMIT
#define SSD_DRY_LIMIT 0
#endif
#define NREP(b) (1 + (int)((REP_MASK >> (b)) & 1u))
#define IN(k) (lo <= (k) && (k) < hi)
#define SEAM(k) do { if (IN(k) && IN((k) + 1)) { if (WARM_AT(k)) CODE_WARM(); for (int rep_ = 0; rep_ < NREP(20); ++rep_) xcd_barrier(bar, threadIdx.x == 0); } } while (0)
#define XC WSP(float, WS_XC)
#define SSQ WSP(float, WS_SSQP)
#define ctl WSP(unsigned, WS_CTL)

    if (IN(0) && PE(0)) { for (int rep = 0; rep < NREP(0); ++rep) { PHASE_BEGIN(); p_prologue(F); } }
    SEAM(0);
#pragma unroll 1
    for (int l = 0; l < DEPTH; ++l) {
        const int pb = 1 + 9 * l;
#define modl (WSP(float, WS_MOD) + (size_t)l * 9 * 6144)
#define srcL (l == 0 ? F.x : (const float*)F.out)
#define srcC (l == 0 ? F.ctx : (const float*)XC)
        if (IN(pb + 0) && PE(1)) for (int rep = 0; rep < NREP(1); ++rep) { PHASE_BEGIN(); p_norm<false>(F, l, 0, MT, srcL, srcC, l == 1 ? WSP(float, WS_SLAB) : nullptr, WSP(float, WS_MOD) + (size_t)8 * 6144 + 5 * DM); }
        SEAM(pb + 0);
        if (IN(pb + 1) && PE(2)) for (int rep = 0; rep < NREP(2); ++rep) {
            PHASE_BEGIN();
            pg8::Gemm g{WSP(bf16_t, WS_H), WSP(bf16_t, WS_WIN) + (size_t)l * INP * DM, DM, DM, 0};
            pg8::StaticOrder S; S.init(MT, INP, F.G, (int)blockIdx.x);
            pg8::EpiInProj E{WSP(bf16_t, WS_P), SSQ, rep < NREP(2) - 1};
            pg8::gemm_phase<pg8::EpiInProj, pg8::StaticOrder, true, false>(F.lds, F.tid, g, S, E);
        }
        SEAM(pb + 1);
        if (IN(pb + 2)) {
            if (PE(3)) for (int rep = 0; rep < NREP(3); ++rep) { PHASE_BEGIN(); pg8::Gemm g{WSP(bf16_t, WS_P) + PC_CQ, WSP(bf16_t, WS_WUQ) + (size_t)l * QWP * 384, INP, 384, 0};
              pg8::StaticOrder S; S.init(l == 0 ? MT : NLAT, QWP, F.G, (int)blockIdx.x);
              pg8::EpiScaleBf16 E{WSP(bf16_t, WS_Q), QW, QW, SSQ, 0, 1.f / 384.f, QSCALE};
              pg8::gemm_phase<pg8::EpiScaleBf16, pg8::StaticOrder, true, false>(F.lds, F.tid, g, S, E); }
            if (PE(4)) for (int rep = 0; rep < NREP(4); ++rep) { PHASE_BEGIN(); pg8::Gemm g{WSP(bf16_t, WS_P) + PC_CKV, WSP(bf16_t, WS_WUKV) + (size_t)l * KVW * 256, INP, 256, 0};
              pg8::StaticOrder S; S.init(MT, KVW, F.G, (int)((blockIdx.x + 128u) % (unsigned)F.G));
              pg8::EpiScaleBf16 E{WSP(bf16_t, WS_KV), KVW, KVW, SSQ, 1, 1.f / 256.f, 1.f};
              pg8::gemm_phase<pg8::EpiScaleBf16, pg8::StaticOrder, true, false>(F.lds, F.tid, g, S, E);
              build_vt_own(F, S); }
            if (PE(5)) for (int rep = 0; rep < NREP(5); ++rep) { PHASE_BEGIN();
                for (int k = 0; k < 2; ++k) {
                    const int bx_ = (int)blockIdx.x; int u;
                    if (F.G == 256) u = k == 0 ? F.vcu : ((bx_ >= 88 && bx_ < 120) ? 256 + bx_ - 88 : -1); else u = F.vcu + k * F.G;
                    if (u >= 0 && u < 288) ssd_local_unit(F, l, u); } }
            if (PE(6)) { PHASE_BEGIN(); for (int u = F.vcu; u < 144; u += F.G) krope_unit(F, u); }
            if (PE(6) && !(l == 1 && F.G == 256)) for (int rep = 0; rep < NREP(6); ++rep) { PHASE_BEGIN();
                const int bx_ = (int)blockIdx.x;
                if (F.G == 256) { const int u = bx_ >= 120 ? bx_ - 120 : (bx_ < 8 ? 136 + bx_ : -1); if (u >= 0 && u < 144) sgu_unit(F, l, u); }
                else { for (int u = F.G - 1 - F.vcu; u < 144; u += F.G) sgu_unit(F, l, u); } }
        }
        SEAM(pb + 2);
        if (IN(pb + 3)) {
            if (PE(5)) { PHASE_BEGIN(); ssd_scan(F); }
        }
        SEAM(pb + 3);
        if (IN(pb + 4)) {
            const int nat = l == 0 ? 864 : 768, nsf = l == 0 ? 144 : 128;
            if (PE(7)) for (int rep = 0; rep < NREP(7); ++rep) { PHASE_BEGIN(); for (int u = F.vcu; u < nat; u += F.G) attn_unit(F, u); }
            if (PE(8)) for (int rep = 0; rep < NREP(8); ++rep) { PHASE_BEGIN(); for (int u = F.G - 1 - F.vcu; u < nsf; u += F.G) ssd_final_unit(F, l, u); }
            if (PE(6) && l == 1 && F.G == 256) { PHASE_BEGIN();
                if (F.vcu < 128) sgu_unit(F, l, F.vcu); }
        }
        SEAM(pb + 4);
        if (IN(pb + 5) && PE(9)) {
          for (int rep = 0; rep < NREP(9); ++rep) {
            PHASE_BEGIN();
            pg8::Gemm g{WSP(bf16_t, WS_CAT), WSP(bf16_t, WS_WOUT) + (size_t)l * DM * DM, DM, DM, 0};
            pg8::StaticOrder S; S.init(l == 0 ? MT : NLAT, DM, F.G, (int)blockIdx.x);
            pg8::EpiResid E{srcL, srcC, F.out, XC, modl, 2, rep < NREP(9) - 1, nullptr};
            pg8::gemm_phase<pg8::EpiResid, pg8::StaticOrder, true, false>(F.lds, F.tid, g, S, E);
            if (l == 0 && rep == NREP(9) - 1) { PHASE_BEGIN(); int wi_, nw_; if (tail_worker(MT / 256 * (DM / 256), F.G, (int)blockIdx.x, wi_, nw_)) { for (int set_ = 2; set_ < 4; ++set_) convert_set(F, set_, wi_, nw_); mod_gemv(F, 1, wi_, nw_); } }
          }
            if (l == 1 && PE(10)) for (int rep = 0; rep < NREP(10); ++rep) { PHASE_BEGIN(); p_moe_weights(F); }
        }
        SEAM(pb + 5);
        if (IN(pb + 6) && PE(11)) { PHASE_BEGIN(); if (l == 0) { for (int rep = 0; rep < NREP(11); ++rep) p_norm<false>(F, l, 1, MT, F.out, XC); } else p_norm<true>(F, l, 1, NLAT, F.out, XC); }
        SEAM(pb + 6);
        if (IN(pb + 7)) {
            if (l == 0 && PE(12)) for (int rep = 0; rep < NREP(12); ++rep) {
                PHASE_BEGIN();
                pg8::Gemm g{WSP(bf16_t, WS_H), WSP(bf16_t, WS_WGU), DM, DM, 0};
                pg8::StaticOrder S; S.init(MT, 2 * DFF, F.G, (int)blockIdx.x);
                pg8::EpiSwiglu E{WSP(bf16_t, WS_ACT), DFF};
                pg8::gemm_phase<pg8::EpiSwiglu, pg8::StaticOrder, true, false>(F.lds, F.tid, g, S, E);
            } else if (l == 1 && PE(13)) for (int rep = 0; rep < NREP(13); ++rep) {
                PHASE_BEGIN();
                pg8::Gemm g{WSP(bf16_t, WS_H), WSP(bf16_t, WS_MOEW_GU), DM, DM, (size_t)2 * DFE * DM};
                pg8::MoeOrder S; S.init(ctl + CW_CNT, 11, F.G, (int)blockIdx.x, WSP(int, WS_LIST), true);
                pg8::EpiSwiglu E{WSP(bf16_t, WS_MACT), DFE};
                pg8::gemm_phase<pg8::EpiSwiglu, pg8::MoeOrder, true, true>(F.lds, F.tid, g, S, E);
            }
        }
        SEAM(pb + 7);
        if (IN(pb + 8)) {
            if (l == 0 && PE(14)) for (int rep = 0; rep < NREP(14); ++rep) {
                PHASE_BEGIN();
                pg8::Gemm g{WSP(bf16_t, WS_ACT), WSP(bf16_t, WS_WD), DFF, DFF, 0};
                pg8::DownSplitOrder S; S.init(F.G, (int)blockIdx.x);
                pg8::EpiResid E{F.out, XC, F.out, XC, modl, 5, rep < NREP(14) - 1, WSP(float, WS_SLAB)};
                pg8::gemm_phase<pg8::EpiResid, pg8::DownSplitOrder, true, false, true>(F.lds, F.tid, g, S, E);
            } else if (l == 1 && PE(15)) for (int rep = 0; rep < NREP(15); ++rep) {
                PHASE_BEGIN();
                pg8::Gemm g{WSP(bf16_t, WS_MACT), WSP(bf16_t, WS_MOEW_D), DFE, DFE, (size_t)DM * DFE};
                pg8::MoeOrder S; S.init(ctl + CW_CNT, 4, F.G, (int)blockIdx.x, WSP(int, WS_LIST), false);
                pg8::EpiMoeDown E{WSP(bf16_t, WS_Y), WSP(int, WS_LIST), WSP(float, WS_MISC + MISC_TOPW), S};
                pg8::gemm_phase<pg8::EpiMoeDown, pg8::MoeOrder, true, false>(F.lds, F.tid, g, S, E);
            }
        }
        SEAM(pb + 8);
    }
    if (IN(19) && PE(16)) { PHASE_BEGIN(); p_final(F); }
#undef IN
#undef SEAM
#undef XC
#undef SSQ
#undef ctl
#undef modl
#undef srcL
#undef srcC
#undef PHASE_BEGIN
    asm volatile("mk_code_end:");
}

extern "C" void kernel_launch(void* const* d_in, const int* in_sizes, int n_in, void* d_out, int out_size, void* d_ws, size_t ws_size, hipStream_t stream) {
    static int grid = 0;
    if (grid == 0) {
        if (n_in != 32 || out_size != NLAT * DM || ws_size < WS_END) { fprintf(stderr, "kernel_launch: unexpected shapes (n_in %d, out %d, ws %zu); nothing launched\n", n_in, out_size, ws_size); grid = -1; return; }
        int dev = 0, cus = 0, per_cu = 0;
        if (hipGetDevice(&dev) != hipSuccess || hipDeviceGetAttribute(&cus, hipDeviceAttributeMultiprocessorCount, dev) != hipSuccess) { grid = -1; return; }
        if (hipFuncSetAttribute((const void*)fwd_megakernel, hipFuncAttributeMaxDynamicSharedMemorySize, LDS_BYTES) != hipSuccess) { fprintf(stderr, "kernel_launch: hipFuncSetAttribute failed\n"); grid = -1; return; }
        if (hipOccupancyMaxActiveBlocksPerMultiprocessor(&per_cu, (const void*)fwd_megakernel, NTHR, LDS_BYTES) != hipSuccess || per_cu < 1) { fprintf(stderr, "kernel_launch: occupancy query says %d blocks/CU\n", per_cu); (void)hipGetLastError(); grid = -1; return; }
        grid = cus;
    }
    if (grid < 0) return;
    (void)hipMemsetAsync((char*)d_ws + WS_CTL, 0, CTL_BYTES, stream);
    Args a{};
    for (int i = 0; i < 32; ++i) a.in[i] = (const float*)d_in[i];
    a.out = (float*)d_out; a.ws = (unsigned char*)d_ws;
#if MK_PER_PHASE
    for (int k = 0; k < N_PHASES; ++k) { a.ph_lo = k; a.ph_hi = k + 1; hipLaunchKernelGGL(fwd_megakernel, dim3(grid), dim3(NTHR), LDS_BYTES, stream, a); }
#else
    a.ph_lo = 0; a.ph_hi = N_PHASES;
    void* kargs[] = {&a};
    hipError_t e = hipLaunchCooperativeKernel((const void*)fwd_megakernel, dim3(grid), dim3(NTHR), kargs, LDS_BYTES, stream);
    if (e != hipSuccess) fprintf(stderr, "kernel_launch: cooperative launch failed: %s (grid %d)\n", hipGetErrorString(e), grid);
#endif
}
```

```cpp
#include <hip/hip_runtime.h>
#include <cstdio>
#include <cstdint>

#define LAS __attribute__((address_space(3)))
#define GAS __attribute__((address_space(1)))
typedef unsigned short bf16_t;
typedef short bf16x8 __attribute__((ext_vector_type(8)));
typedef float f32x4 __attribute__((ext_vector_type(4)));
typedef float f32x16 __attribute__((ext_vector_type(16)));
typedef float f32x2 __attribute__((ext_vector_type(2)));
typedef unsigned u32x4 __attribute__((ext_vector_type(4)));
typedef unsigned u32x2 __attribute__((ext_vector_type(2)));
typedef __bf16 bf16x2_t __attribute__((ext_vector_type(2)));

constexpr int BATCH = 8, SEQ = 2048, DM = 1024, CTXL = 256, DEPTH = 2;
constexpr int NLAT = BATCH * SEQ, NCTX = BATCH * CTXL, MT = NLAT + NCTX;
constexpr int INW = 2476, INP = 2560;
constexpr int PC_U = 0, PC_V = 256, PC_Z = 512, PC_X = 896, PC_B = 1280, PC_C = 1536, PC_CQ = 1792, PC_CKV = 2176, PC_KR = 2432, PC_DT = 2464;
constexpr int DFF = 2816, NEXP = 8, DFE = 1408;
constexpr int QW = 576, QWP = 768, KVW = 768;
constexpr float EPS = 1e-6f;
constexpr float QSCALE = 0.10206207261596577f * 1.4426950408889634f;
constexpr int NPOS = 18;

constexpr size_t MiB = 1u << 20;
constexpr size_t WS_CTL = 0, CTL_BYTES = 64 * 1024;
constexpr size_t WS_MOD = 1 * MiB;
constexpr size_t WS_ACS = 2 * MiB;
constexpr size_t WS_MISC = 3 * MiB;
constexpr size_t WS_LIST = 4 * MiB;
constexpr size_t WS_WSGU = 5 * MiB;
constexpr size_t WS_WIN = 6 * MiB;
constexpr size_t WS_WUQ = 16 * MiB;
constexpr size_t WS_WUKV = 18 * MiB;
constexpr size_t WS_WOUT = 19 * MiB;
constexpr size_t WS_WGU = 23 * MiB;
constexpr size_t WS_WD = 34 * MiB;
constexpr size_t WS_XC = 40 * MiB;
constexpr size_t WS_H = 48 * MiB;
constexpr size_t WS_Q = 48 * MiB;
constexpr size_t WS_KR = 70 * MiB;
constexpr size_t WS_P = 84 * MiB;
constexpr size_t WS_CAT = 174 * MiB;
constexpr size_t WS_KV = 210 * MiB;
constexpr size_t WS_CC = 237 * MiB;
constexpr size_t WS_YP = 246 * MiB;
constexpr size_t WS_ST = 273 * MiB;
constexpr size_t WS_ACT = 84 * MiB;
constexpr size_t WS_MOEW_GU = 84 * MiB;
constexpr size_t WS_MOEW_D = 128 * MiB;
constexpr size_t WS_MACT = 150 * MiB;
constexpr size_t WS_Y = 244 * MiB;
constexpr size_t WS_SSQP = 300 * MiB;
constexpr size_t WS_VT = 302 * MiB;
constexpr size_t WS_SLAB = 200 * MiB;
constexpr size_t WS_END = 316 * MiB;
constexpr size_t MISC_SSQ = 0, MISC_DEC = 256 * 1024, MISC_ROPE = 320 * 1024, MISC_TOPW = 384 * 1024;
constexpr int CW_CNT = 64;
constexpr int CW_BAR = 4096;

__device__ __forceinline__ unsigned cvtpk(float lo, float hi) { f32x2 v = {lo, hi}; bf16x2_t b = __builtin_convertvector(v, bf16x2_t); return __builtin_bit_cast(unsigned, b); }
__device__ __forceinline__ float bflo(unsigned u) { return __uint_as_float(u << 16); }
__device__ __forceinline__ float bfhi(unsigned u) { return __uint_as_float(u & 0xffff0000u); }
__device__ __forceinline__ float bf1(bf16_t h) { return __uint_as_float((unsigned)h << 16); }
__device__ __forceinline__ bf16_t f2bf(float f) { return (bf16_t)(cvtpk(f, 0.f) & 0xffffu); }
__device__ __forceinline__ float wave_sum(float v) {
#pragma unroll
    for (int o = 1; o < 64; o <<= 1) v += __shfl_xor(v, o);
    return v;
}
__device__ __forceinline__ float silu_f(float x) { return x * __builtin_amdgcn_rcpf(1.f + __expf(-x)); }
__device__ __forceinline__ float gelu_tanh(float x) { const float u = 0.7978845608028654f * (x + 0.044715f * x * x * x); const float t = 1.f - 2.f * __builtin_amdgcn_rcpf(1.f + __expf(2.f * u)); return 0.5f * x * (1.f + t); }
__device__ __forceinline__ float softplus_f(float x) { return x > 20.f ? x : log1pf(__expf(x)); }
#define LDS_WAIT() asm volatile("s_waitcnt lgkmcnt(0)" ::: "memory")
#define LDS_BARRIER() asm volatile("s_waitcnt lgkmcnt(0)\n\ts_barrier" ::: "memory")
#define MFMA16(a, b, c) __builtin_amdgcn_mfma_f32_16x16x32_bf16((a), (b), (c), 0, 0, 0)
#define MFMA32(a, b, c) __builtin_amdgcn_mfma_f32_32x32x16_bf16((a), (b), (c), 0, 0, 0)

namespace pg8 {
constexpr int BM = 256, BK = 64, HALF = 128, HTB = HALF * BK * 2, STAGE_BYTES = 8 * HTB, NXCD = 8, WGM = 8;
__host__ __device__ __forceinline__ int lds_byte(int r, int c) { const int st = (r >> 4) * 2 + (c >> 5), rr = r & 15, cc = c & 31, ob = rr * 64 + cc * 2; return st * 1024 + (ob ^ (((ob >> 9) & 1) << 5)); }
__host__ __device__ __forceinline__ void stage_rc(int b, int& R, int& C) { const int st = b / 1024, sb = b % 1024, swz = sb ^ (((sb >> 9) & 1) << 5); R = (st >> 1) * 16 + swz / 64; C = (st & 1) * 32 + (swz % 64) / 2; }
__host__ __device__ __forceinline__ int perm32(int rho) { const int n = rho >> 4, i = rho & 15; return 8 * (i >> 2) + 4 * n + (i & 3); }

struct Unit { int pm, pn, e, kt0, nkt; };
struct Gemm { const bf16_t* A; const bf16_t* Bt; int lda; int K; size_t bstride_e; };

struct StaticOrder {
    int nM, nN, nwg, G, c;
    __device__ void init(int M, int N, int G_, int c_) { nM = M / BM; nN = N / BM; nwg = nM * nN; G = G_; c = c_; }
    __device__ bool next(int i, Unit& u) const {
        const long L = (long)i * G + c; if (L >= nwg) return false;
        int wgid = (int)L; { const int q = nwg / NXCD, r = nwg % NXCD, xcd = wgid % NXCD, off = wgid / NXCD; wgid = (xcd < r ? xcd * (q + 1) : r * (q + 1) + (xcd - r) * q) + off; }
        const int nig = WGM * nN, gid = wgid / nig, fm = gid * WGM, gsz = (nM - fm) < WGM ? (nM - fm) : WGM;
        u.pm = fm + ((wgid % nig) % gsz); u.pn = (wgid % nig) / gsz; u.e = 0; return true;
    }
    __device__ __forceinline__ int arow(const Unit& u, int r) const { return u.pm * BM + r; }
};

template <class Epi, class Sched, bool ALIGN_EPI, bool GATHER, bool KSPLIT = false>
__device__ __forceinline__ void gemm_phase(LAS unsigned char* lds, const int tid, const Gemm g, const Sched& S, const Epi& E) {
    const int wid = __builtin_amdgcn_readfirstlane(tid >> 6), lane = tid & 63, wr = wid >> 2, wc = wid & 3, fr = lane & 15, fq = lane >> 4;
    const int K = g.K; int nt = K / BK;
    int Rr[2], Cc[2]; unsigned voffA[2], voffB[2];
#pragma unroll
    for (int i = 0; i < 2; ++i) { int R, C; stage_rc(tid * 16 + i * 8192, R, C); Rr[i] = R; Cc[i] = C; const int Rb = Epi::PERM ? ((R & ~31) + perm32(R & 31)) : R;
        voffA[i] = (unsigned)(R * g.lda + C) * 2u; voffB[i] = (unsigned)(Rb * K + C) * 2u; }
    const size_t kstep = (size_t)(BK * 2);
    const size_t hstepB = (size_t)HALF * K * 2, tstepB = 2 * hstepB;
    const size_t hstepA = (size_t)HALF * g.lda * 2, tstepA = 2 * hstepA;
    const unsigned ldsw = (unsigned)wid * 1024u;
    const int aoff = lds_byte(wr * 64 + fr, fq * 8), boff = lds_byte(wc * 32 + fr, fq * 8);
    const char* const Abase = (const char*)g.A;
#define PG8_SA(b, h) (((b) * 2 + (h)) * HTB)
#define PG8_SB(b, h) ((4 + (b) * 2 + (h)) * HTB)
#define PG8_GL(gp, off) __builtin_amdgcn_global_load_lds((const unsigned*)(gp), (LAS unsigned*)(lds + (off)), 16, 0, 0)
#define PG8_STAGE_B(bufoff, gbase) do { PG8_GL((const char*)(gbase) + voffB[0], (bufoff) + ldsw); PG8_GL((const char*)(gbase) + voffB[1], (bufoff) + ldsw + 8192); } while (0)
#define PG8_STAGE_A_CUR(bufoff, kt, h) do { if constexpr (GATHER) { const char* _p = Abase + (size_t)(kt) * kstep; PG8_GL(_p + ((h) ? c10 : c00), (bufoff) + ldsw); PG8_GL(_p + ((h) ? c11 : c01), (bufoff) + ldsw + 8192); } \
        else { const char* _p = cA + (size_t)(kt) * kstep + (h) * hstepA; PG8_GL(_p + voffA[0], (bufoff) + ldsw); PG8_GL(_p + voffA[1], (bufoff) + ldsw + 8192); } } while (0)
#define PG8_STAGE_A_SEL(bufoff, kt, h) do { if constexpr (GATHER) { const char* _p = Abase + (size_t)(kt) * kstep; PG8_GL(_p + ((h) ? x10 : x00), (bufoff) + ldsw); PG8_GL(_p + ((h) ? x11 : x01), (bufoff) + ldsw + 8192); } \
        else { const char* _p = xA + (size_t)(kt) * kstep + (h) * hstepA; PG8_GL(_p + voffA[0], (bufoff) + ldsw); PG8_GL(_p + voffA[1], (bufoff) + ldsw + 8192); } } while (0)
#define PG8_LDA(dst, b, h) do { _Pragma("unroll") for (int m = 0; m < 4; ++m) _Pragma("unroll") for (int k = 0; k < 2; ++k) dst[m][k] = *(const LAS bf16x8*)(lds + PG8_SA(b, h) + aoff + m * 2048 + k * 1024); } while (0)
#define PG8_LDB(dst, b, h) do { _Pragma("unroll") for (int n = 0; n < 2; ++n) _Pragma("unroll") for (int k = 0; k < 2; ++k) dst[n][k] = *(const LAS bf16x8*)(lds + PG8_SB(b, h) + boff + n * 2048 + k * 1024); } while (0)
#define PG8_MMA(ai, bj, At, Bt) do { __builtin_amdgcn_s_setprio(1); _Pragma("unroll") for (int m = 0; m < 4; ++m) _Pragma("unroll") for (int n = 0; n < 2; ++n) _Pragma("unroll") for (int k = 0; k < 2; ++k) \
        acc[ai][bj][m][n] = __builtin_amdgcn_mfma_f32_16x16x32_bf16(Bt[n][k], At[m][k], acc[ai][bj][m][n], 0, 0, 0); __builtin_amdgcn_s_setprio(0); } while (0)
#define PG8_WAIT_V(n) asm volatile("s_waitcnt vmcnt(" #n ")" ::: "memory")
#define PG8_WAIT_L(n) asm volatile("s_waitcnt lgkmcnt(" #n ")" ::: "memory")
#define PG8_BAR __builtin_amdgcn_s_barrier()
#define PG8_SCHED __builtin_amdgcn_sched_barrier(0)
#define PG8_AOFFS(u, o00, o01, o10, o11) do { if constexpr (GATHER) { \
        o00 = (unsigned)(((size_t)S.arow(u, Rr[0]) * g.lda + Cc[0]) * 2); o01 = (unsigned)(((size_t)S.arow(u, Rr[1]) * g.lda + Cc[1]) * 2); \
        o10 = (unsigned)(((size_t)S.arow(u, HALF + Rr[0]) * g.lda + Cc[0]) * 2); o11 = (unsigned)(((size_t)S.arow(u, HALF + Rr[1]) * g.lda + Cc[1]) * 2); } } while (0)
    Unit cur, nxt; int ui = 0;
    if (!S.next(0, cur)) return;
    f32x4 acc[2][2][4][2];
#pragma unroll
    for (int a = 0; a < 2; ++a)
#pragma unroll
        for (int b = 0; b < 2; ++b)
#pragma unroll
            for (int m = 0; m < 4; ++m)
#pragma unroll
                for (int n = 0; n < 2; ++n) acc[a][b][m][n] = (f32x4){0.f, 0.f, 0.f, 0.f};
    bf16x8 At[4][2], B0[2][2], B1[2][2];
    unsigned c00 = 0, c01 = 0, c10 = 0, c11 = 0, n00 = 0, n01 = 0, n10 = 0, n11 = 0;
    PG8_AOFFS(cur, c00, c01, c10, c11);
    const char* cA = Abase + (size_t)cur.pm * tstepA;
    const char* cB = (const char*)g.Bt + ((size_t)cur.e * g.bstride_e) * 2 + (size_t)cur.pn * tstepB;
    if constexpr (KSPLIT) { cA += (size_t)cur.kt0 * kstep; cB += (size_t)cur.kt0 * kstep; nt = cur.nkt; }
    PG8_STAGE_B(PG8_SB(0, 0), cB); PG8_STAGE_B(PG8_SB(0, 1), cB + hstepB); PG8_STAGE_A_CUR(PG8_SA(0, 0), 0, 0); PG8_STAGE_A_CUR(PG8_SA(0, 1), 0, 1);
    if (wr == 1) PG8_BAR;
    PG8_WAIT_V(2); PG8_BAR;
    PG8_STAGE_B(PG8_SB(1, 0), cB + kstep); PG8_STAGE_A_CUR(PG8_SA(1, 0), 1, 0); PG8_STAGE_B(PG8_SB(1, 1), cB + hstepB + kstep);
    PG8_WAIT_V(6); PG8_BAR;
    for (;;) {
        const bool has_next = S.next(ui + 1, nxt);
        const char* nB = cB; const char* nA = cA;
        if (has_next) { PG8_AOFFS(nxt, n00, n01, n10, n11); nA = Abase + (size_t)nxt.pm * tstepA; nB = (const char*)g.Bt + ((size_t)nxt.e * g.bstride_e) * 2 + (size_t)nxt.pn * tstepB;
            if constexpr (KSPLIT) { nA += (size_t)nxt.kt0 * kstep; nB += (size_t)nxt.kt0 * kstep; } }
        else { n00 = c00; n01 = c01; n10 = c10; n11 = c11; }
#pragma unroll 1
        for (int t = 0; t < nt; t += 2) {
            const bool last = (t == nt - 2);
            const int kt2 = last ? 0 : t + 2, kt3 = kt2 + 1;
            const unsigned x00 = last ? n00 : c00, x01 = last ? n01 : c01, x10 = last ? n10 : c10, x11 = last ? n11 : c11;
            const char* xA = last ? nA : cA;
            const char* b2 = last ? nB : cB + (size_t)(t + 2) * kstep; const char* b3 = b2 + kstep;
            (void)x00; (void)x01; (void)x10; (void)x11; (void)xA;
            PG8_LDB(B0, 0, 0); PG8_LDB(B1, 0, 1); PG8_SCHED; PG8_LDA(At, 0, 0); PG8_STAGE_A_CUR(PG8_SA(1, 1), t + 1, 1);
            PG8_WAIT_V(8); PG8_WAIT_L(0); PG8_BAR; PG8_MMA(0, 0, At, B0); PG8_MMA(0, 1, At, B1); PG8_BAR; PG8_SCHED;
            PG8_LDA(At, 0, 1); PG8_STAGE_B(PG8_SB(0, 0), b2); PG8_STAGE_B(PG8_SB(0, 1), b2 + hstepB); PG8_STAGE_A_SEL(PG8_SA(0, 0), kt2, 0);
            PG8_WAIT_V(8); PG8_WAIT_L(0); PG8_BAR; PG8_MMA(1, 0, At, B0); PG8_MMA(1, 1, At, B1); PG8_BAR; PG8_SCHED;
            PG8_LDB(B0, 1, 0); PG8_LDB(B1, 1, 1); PG8_SCHED; PG8_LDA(At, 1, 0); PG8_STAGE_A_SEL(PG8_SA(0, 1), kt2, 1);
            PG8_WAIT_V(8); PG8_WAIT_L(0); PG8_BAR; PG8_MMA(0, 0, At, B0); PG8_MMA(0, 1, At, B1); PG8_BAR; PG8_SCHED;
            PG8_LDA(At, 1, 1); PG8_STAGE_B(PG8_SB(1, 0), b3); PG8_STAGE_B(PG8_SB(1, 1), b3 + hstepB); PG8_STAGE_A_SEL(PG8_SA(1, 0), kt3, 0);
            PG8_WAIT_V(8); PG8_WAIT_L(0); PG8_BAR; PG8_MMA(1, 0, At, B0); PG8_MMA(1, 1, At, B1); PG8_BAR; PG8_SCHED;
        }
        if constexpr (ALIGN_EPI) { if (wr == 0) PG8_BAR; }
        E(acc, cur, wr, wc, fr, fq);
        if (!has_next) break;
#pragma unroll
        for (int a = 0; a < 2; ++a)
#pragma unroll
            for (int b = 0; b < 2; ++b)
#pragma unroll
                for (int m = 0; m < 4; ++m)
#pragma unroll
                    for (int n = 0; n < 2; ++n) acc[a][b][m][n] = (f32x4){0.f, 0.f, 0.f, 0.f};
        cur = nxt; cA = nA; cB = nB; c00 = n00; c01 = n01; c10 = n10; c11 = n11; ++ui;
        if constexpr (KSPLIT) nt = cur.nkt;
        if constexpr (ALIGN_EPI) { if (wr == 1) PG8_BAR; }
    }
    PG8_WAIT_V(0);
    if constexpr (!ALIGN_EPI) { if (wr == 0) PG8_BAR; }
    PG8_BAR;
#undef PG8_SA
#undef PG8_SB
#undef PG8_GL
#undef PG8_STAGE_A_CUR
#undef PG8_STAGE_A_SEL
#undef PG8_STAGE_B
#undef PG8_LDA
#undef PG8_LDB
#undef PG8_MMA
#undef PG8_WAIT_V
#undef PG8_WAIT_L
#undef PG8_BAR
#undef PG8_SCHED
#undef PG8_AOFFS
}
}
namespace pg8 {
struct EpiInProj {
    static constexpr bool PERM = true;
    bf16_t* O; float* ssq; bool dry;
    __device__ __forceinline__ void operator()(const f32x4 (&acc)[2][2][4][2], const Unit& u, int wr, int wc, int fr, int fq) const {
        if (dry) return;
        const int row0 = u.pm * BM + wr * 64 + fr, col0 = u.pn * BM + wc * 32 + 8 * fq;
#pragma unroll
        for (int ai = 0; ai < 2; ++ai)
#pragma unroll
            for (int m = 0; m < 4; ++m) { const int row = row0 + ai * HALF + m * 16; bf16_t* rowp = O + (size_t)row * INP + col0;
                float sq = 0.f, sk = 0.f;
#pragma unroll
                for (int bj = 0; bj < 2; ++bj) { const f32x4 v0 = acc[ai][bj][m][0], v1 = acc[ai][bj][m][1];
                    u32x4 w; w.x = cvtpk(v0[0], v0[1]); w.y = cvtpk(v0[2], v0[3]); w.z = cvtpk(v1[0], v1[1]); w.w = cvtpk(v1[2], v1[3]);
                    *(u32x4*)(rowp + bj * HALF) = w;
                    const int hidx = 2 * u.pn + bj;
                    const float s = (v0[0] * v0[0] + v0[1] * v0[1]) + (v0[2] * v0[2] + v0[3] * v0[3]) + (v1[0] * v1[0] + v1[1] * v1[1]) + (v1[2] * v1[2] + v1[3] * v1[3]);
                    if (hidx >= 14 && hidx <= 16) sq += s;
                    if (hidx >= 17 && hidx <= 18) sk += s; }
                if (u.pn >= 7 && u.pn <= 9) {
                    sq += __shfl_xor(sq, 16); sq += __shfl_xor(sq, 32); sk += __shfl_xor(sk, 16); sk += __shfl_xor(sk, 32);
                    if (fq == 0) { float* sp = ssq + (size_t)row * 16;
                        if (u.pn == 7) sp[wc] = sq; if (u.pn == 8) { sp[4 + wc] = sq; sp[8 + wc] = sk; } if (u.pn == 9) sp[12 + wc] = sk; } } }
    }
};
struct EpiScaleBf16 {
    static constexpr bool PERM = true;
    bf16_t* O; int ldc, ncols; const float* ssq; int idx; float invn, mul;
    __device__ __forceinline__ void operator()(const f32x4 (&acc)[2][2][4][2], const Unit& u, int wr, int wc, int fr, int fq) const {
        const int row0 = u.pm * BM + wr * 64 + fr, col0 = u.pn * BM + wc * 32 + 8 * fq;
#pragma unroll
        for (int ai = 0; ai < 2; ++ai) {
            float scv[4];
#pragma unroll
            for (int m = 0; m < 4; ++m) { const int row = row0 + ai * HALF + m * 16;
                const f32x4 pa = *(const f32x4*)(ssq + (size_t)row * 16 + 8 * idx), pb = *(const f32x4*)(ssq + (size_t)row * 16 + 8 * idx + 4);
                scv[m] = rsqrtf((((pa[0] + pa[1]) + (pa[2] + pa[3])) + ((pb[0] + pb[1]) + (pb[2] + pb[3]))) * invn + EPS) * mul; }
            asm volatile("" ::: "memory");
#pragma unroll
            for (int m = 0; m < 4; ++m) { const int row = row0 + ai * HALF + m * 16; bf16_t* rowp = O + (size_t)row * ldc + col0;
                const float sc = scv[m];
#pragma unroll
                for (int bj = 0; bj < 2; ++bj) if (col0 + bj * HALF < ncols) { const f32x4 v0 = acc[ai][bj][m][0] * sc, v1 = acc[ai][bj][m][1] * sc;
                    u32x4 w; w.x = cvtpk(v0[0], v0[1]); w.y = cvtpk(v0[2], v0[3]); w.z = cvtpk(v1[0], v1[1]); w.w = cvtpk(v1[2], v1[3]);
                    *(u32x4*)(rowp + bj * HALF) = w; } } }
    }
};
struct EpiResid {
    static constexpr bool PERM = false;
    const float* oldL; const float* oldC; float* newL; float* newC; const float* mod; int gi; bool dry; float* slab;
    __device__ __forceinline__ void operator()(const f32x4 (&acc)[2][2][4][2], const Unit& u, int wr, int wc, int fr, int fq) const {
        if (dry) return;
        if (slab && u.e > 0) {
            float* sp = slab + ((size_t)(u.e - 1) * NCTX + (u.pm * BM - NLAT) + wr * 64 + fr) * DM + u.pn * BM + wc * 32 + 4 * fq;
#pragma unroll
            for (int ai = 0; ai < 2; ++ai)
#pragma unroll
                for (int m = 0; m < 4; ++m)
#pragma unroll
                    for (int bj = 0; bj < 2; ++bj)
#pragma unroll
                        for (int n = 0; n < 2; ++n) *(f32x4*)(sp + (size_t)(ai * HALF + m * 16) * DM + bj * HALF + n * 16) = acc[ai][bj][m][n];
            return; }
        const int rbase = u.pm * BM; const bool isc = rbase >= NLAT; const int b = isc ? 8 : (rbase >> 11);
        const float* xo = isc ? oldC - (size_t)NLAT * DM : oldL; float* xn = isc ? newC - (size_t)NLAT * DM : newL;
        const int row0 = rbase + wr * 64 + fr, col0 = u.pn * BM + wc * 32 + 4 * fq;
        const float* gp = mod + (size_t)b * 6144 + gi * DM + col0;
        f32x4 gv[2][2];
#pragma unroll
        for (int bj = 0; bj < 2; ++bj)
#pragma unroll
            for (int n = 0; n < 2; ++n) gv[bj][n] = *(const f32x4*)(gp + bj * HALF + n * 16);
#pragma unroll
        for (int am = 0; am < 4; ++am) { const int ai = am >> 1, m0 = (am & 1) * 2;
            f32x4 xv[2][2][2];
#pragma unroll
            for (int mm = 0; mm < 2; ++mm) { const size_t off = (size_t)(row0 + ai * HALF + (m0 + mm) * 16) * DM + col0;
#pragma unroll
                for (int bj = 0; bj < 2; ++bj)
#pragma unroll
                    for (int n = 0; n < 2; ++n) xv[mm][bj][n] = *(const f32x4*)(xo + off + bj * HALF + n * 16); }
            asm volatile("" ::: "memory");
#pragma unroll
            for (int mm = 0; mm < 2; ++mm) { const size_t off = (size_t)(row0 + ai * HALF + (m0 + mm) * 16) * DM + col0;
#pragma unroll
                for (int bj = 0; bj < 2; ++bj)
#pragma unroll
                    for (int n = 0; n < 2; ++n) *(f32x4*)(xn + off + bj * HALF + n * 16) = xv[mm][bj][n] + gv[bj][n] * acc[ai][bj][m0 + mm][n]; }
            asm volatile("" ::: "memory"); }
    }
};
struct EpiSwiglu {
    static constexpr bool PERM = true;
    bf16_t* O; int ldc;
    __device__ __forceinline__ void operator()(const f32x4 (&acc)[2][2][4][2], const Unit& u, int wr, int wc, int fr, int fq) const {
        const int row0 = u.pm * BM + wr * 64 + fr, col0 = u.pn * HALF + wc * 32 + 8 * fq;
#pragma unroll
        for (int ai = 0; ai < 2; ++ai)
#pragma unroll
            for (int m = 0; m < 4; ++m) { bf16_t* rowp = O + (size_t)(row0 + ai * HALF + m * 16) * ldc + col0;
                float r[8];
#pragma unroll
                for (int n = 0; n < 2; ++n)
#pragma unroll
                    for (int j = 0; j < 4; ++j) { const float gt = acc[ai][0][m][n][j], up = acc[ai][1][m][n][j]; r[4 * n + j] = silu_f(gt) * up; }
                u32x4 w; w.x = cvtpk(r[0], r[1]); w.y = cvtpk(r[2], r[3]); w.z = cvtpk(r[4], r[5]); w.w = cvtpk(r[6], r[7]);
                *(u32x4*)rowp = w; }
    }
};
struct DownSplitOrder {
    StaticOrder so; int G, c;
    __device__ void init(int G_, int c_) { so.init(NLAT, DM, G_, c_); G = G_; c = c_; }
    __device__ bool next(int i, Unit& u) const {
        if (so.next(i, u)) { u.kt0 = 0; u.nkt = DFF / BK; return true; }
        const int rounds = (so.nwg + G - 1) / G; const int j = (i - rounds) * G + c; if (i < rounds || j >= 128) return false;
        const int tile = j >> 2, part = j & 3; u.pm = NLAT / BM + (tile >> 2); u.pn = tile & 3; u.e = 1 + part;
        u.kt0 = part == 0 ? 0 : part == 1 ? 12 : part == 2 ? 24 : 34; u.nkt = part < 2 ? 12 : 10; return true;
    }
    __device__ __forceinline__ int arow(const Unit& u, int r) const { return u.pm * BM + r; }
};
struct MoeOrder {
    int c0, c1, c2, c3, c4, c5, c6, c7, t1, t2, t3, t4, t5, t6, t7, t8; int npn, G, c; const int* list; bool gather;
    __device__ void init(const unsigned* cw, int npn_, int G_, int c_, const int* list_, bool gather_) {
        #define RFL_(x) __builtin_amdgcn_readfirstlane((int)(x))
        c0 = RFL_(cw[0]); c1 = RFL_(cw[64]); c2 = RFL_(cw[128]); c3 = RFL_(cw[192]); c4 = RFL_(cw[256]); c5 = RFL_(cw[320]); c6 = RFL_(cw[384]); c7 = RFL_(cw[448]);
#undef RFL_
        t1 = (c0 + 255) >> 8; t2 = t1 + ((c1 + 255) >> 8); t3 = t2 + ((c2 + 255) >> 8); t4 = t3 + ((c3 + 255) >> 8); t5 = t4 + ((c4 + 255) >> 8); t6 = t5 + ((c5 + 255) >> 8); t7 = t6 + ((c6 + 255) >> 8); t8 = t7 + ((c7 + 255) >> 8);
        npn = npn_; G = G_; c = c_; list = list_; gather = gather_;
    }
    __device__ bool next(int i, Unit& u) const {
        const int L = i * G + c, nwg = t8 * npn; if (L >= nwg) return false;
        int wgid = L; { const int q = nwg / NXCD, r = nwg % NXCD, xcd = wgid % NXCD, off = wgid / NXCD; wgid = (xcd < r ? xcd * (q + 1) : r * (q + 1) + (xcd - r) * q) + off; }
        const int nig = WGM * npn, gid = wgid / nig, fm = gid * WGM, gsz = (t8 - fm) < WGM ? (t8 - fm) : WGM;
        const int ti = fm + ((wgid % nig) % gsz); u.pn = (wgid % nig) / gsz; u.pm = ti;
        u.e = (ti >= t1) + (ti >= t2) + (ti >= t3) + (ti >= t4) + (ti >= t5) + (ti >= t6) + (ti >= t7); return true;
    }
    __device__ __forceinline__ int ecnt(int e) const { return e == 0 ? c0 : e == 1 ? c1 : e == 2 ? c2 : e == 3 ? c3 : e == 4 ? c4 : e == 5 ? c5 : e == 6 ? c6 : c7; }
    __device__ __forceinline__ int etb(int e) const { return e == 0 ? 0 : e == 1 ? t1 : e == 2 ? t2 : e == 3 ? t3 : e == 4 ? t4 : e == 5 ? t5 : e == 6 ? t6 : t7; }
    __device__ __forceinline__ int arow(const Unit& u, int r) const {
        if (!gather) return u.pm * BM + r;
        const int pos = (u.pm - etb(u.e)) * BM + r;
        const int n_e = ecnt(u.e); const int v = list[u.e * NLAT + (pos < n_e ? pos : 0)] >> 1; return pos < n_e ? v : 0;
    }
};
struct EpiMoeDown {
    static constexpr bool PERM = true;
    bf16_t* Y; const int* list; const float* topw; MoeOrder mo;
    __device__ __forceinline__ void operator()(const f32x4 (&acc)[2][2][4][2], const Unit& u, int wr, int wc, int fr, int fq) const {
        const int pos0 = (u.pm - mo.etb(u.e)) * BM + wr * 64 + fr, n_e = mo.ecnt(u.e), col0 = u.pn * BM + wc * 32 + 8 * fq;
        int tkv[8]; float wgv[8];
#pragma unroll
        for (int i = 0; i < 8; ++i) { const int pos = pos0 + (i >> 2) * HALF + (i & 3) * 16; tkv[i] = list[u.e * NLAT + (pos < n_e ? pos : 0)]; }
#pragma unroll
        for (int i = 0; i < 8; ++i) wgv[i] = topw[tkv[i]];
#pragma unroll
        for (int ai = 0; ai < 2; ++ai)
#pragma unroll
            for (int m = 0; m < 4; ++m) { const int pos = pos0 + ai * HALF + m * 16;
                if (pos < n_e) { const int tk = tkv[ai * 4 + m]; const float wgt = wgv[ai * 4 + m]; bf16_t* rowp = Y + (size_t)tk * DM + col0;
#pragma unroll
                    for (int bj = 0; bj < 2; ++bj) { const f32x4 v0 = acc[ai][bj][m][0] * wgt, v1 = acc[ai][bj][m][1] * wgt;
                        u32x4 w; w.x = cvtpk(v0[0], v0[1]); w.y = cvtpk(v0[2], v0[3]); w.z = cvtpk(v1[0], v1[1]); w.w = cvtpk(v1[2], v1[3]);
                        *(u32x4*)(rowp + bj * HALF) = w; } } }
    }
};
}
constexpr int NWAVES = 8, NTHR = 512;
constexpr int RING_BYTES = 147456;
constexpr int LDSCTL_OFF = RING_BYTES, MISC_OFF = LDSCTL_OFF + 320;
constexpr int LDS_BYTES = RING_BYTES + 1024;
typedef GAS unsigned gu32;
#define RLX_AGENT __ATOMIC_RELAXED, __HIP_MEMORY_SCOPE_AGENT

#define XB_TMO      128
#define XB_XCNT(j)  (256  + 64 * (j))
#define XB_XSUB(j)  (1280 + 64 * (j))
#define XB_XGEN(j)  (2304 + 64 * (j))
#define XB_TOP      3328
#define XB_TOPGEN   3392
#define XCD_BAR_WORDS 3456
#define XB_SPIN_CAP (1u << 18)
__device__ __forceinline__ unsigned xb_ld(unsigned* p)              { return __hip_atomic_load(p, __ATOMIC_RELAXED, __HIP_MEMORY_SCOPE_AGENT); }
__device__ __forceinline__ unsigned xb_add(unsigned* p, unsigned v) { return __hip_atomic_fetch_add(p, v, __ATOMIC_RELAXED, __HIP_MEMORY_SCOPE_AGENT); }
__device__ __forceinline__ unsigned xb_xcc_id() { return (unsigned)__builtin_amdgcn_s_getreg((3 << 11) | 20) & 0xFu; }
#define XB_SPIN(cond, bar) do { unsigned _sp = 0; while (cond) { __builtin_amdgcn_s_sleep(1); \
    if ((++_sp & 255u) == 0u) { if (xb_ld(&(bar)[XB_TMO])) break; if (_sp > XB_SPIN_CAP) { atomicAdd(&(bar)[XB_TMO], 1u); break; } } } } while (0)
struct XcdBarrier { unsigned* bar; unsigned x; volatile LAS unsigned* st; };
__device__ __forceinline__ XcdBarrier xcd_barrier_post(unsigned* bar, volatile LAS unsigned* st, bool leader) {
    XcdBarrier b; b.bar = bar; b.x = xb_xcc_id(); b.st = st;
    if (leader) (void)xb_add(&bar[XB_XCNT(b.x)], 1u);
    return b;
}
__device__ __forceinline__ void xcd_barrier_complete(unsigned* bar, unsigned x, unsigned& nloc, unsigned& nx) {
    const unsigned G = gridDim.x * gridDim.y * gridDim.z;
    unsigned sum, cnt, mine, sp = 0u;
    for (;;) {
        sum = 0u; cnt = 0u; mine = 0u;
#pragma unroll
        for (unsigned j = 0; j < 16; ++j) { const unsigned c = xb_ld(&bar[XB_XCNT(j)]); sum += c; cnt += (c > 0u) ? 1u : 0u; mine = (j == x) ? c : mine; }
        if (sum == G) break;
        __builtin_amdgcn_s_sleep(1);
        if ((++sp & 255u) == 0u) { if (xb_ld(&bar[XB_TMO])) break; if (sp > XB_SPIN_CAP) { atomicAdd(&bar[XB_TMO], 1u); break; } }
    }
    nloc = mine > 0u ? mine : 1u; nx = cnt > 0u ? cnt : 1u;
}
__device__ __forceinline__ void xcd_barrier(const XcdBarrier& b, bool leader) {
    asm volatile("s_waitcnt vmcnt(0)" ::: "memory");
    __syncthreads();
    if (leader) {
        unsigned* bar = b.bar;
        __builtin_amdgcn_s_waitcnt(0);
        unsigned nloc = b.st[0], nx = b.st[1];
        if (nloc == 0u) { xcd_barrier_complete(bar, b.x, nloc, nx); b.st[0] = nloc; b.st[1] = nx; }
        const unsigned old = xb_add(&bar[XB_XSUB(b.x)], 1u);
        const unsigned gen = old / nloc;
        if (old + 1u == (gen + 1u) * nloc) {
            __builtin_amdgcn_fence(__ATOMIC_RELEASE, "agent");
            asm volatile("s_waitcnt vmcnt(0)" ::: "memory");
            const unsigned og = xb_add(&bar[XB_TOP], 1u);
            const unsigned tg = og / nx;
            if (og + 1u == (tg + 1u) * nx) xb_add(&bar[XB_TOPGEN], 1u);
            else XB_SPIN(xb_ld(&bar[XB_TOPGEN]) == tg, bar);
            __builtin_amdgcn_fence(__ATOMIC_ACQUIRE, "agent");
            xb_add(&bar[XB_XGEN(b.x)], 1u);
            asm volatile("s_waitcnt vmcnt(0)" ::: "memory");
        } else {
            XB_SPIN(xb_ld(&bar[XB_XGEN(b.x)]) == gen, bar);
            __builtin_amdgcn_fence(__ATOMIC_ACQUIRE, "agent");
            asm volatile("s_waitcnt vmcnt(0)" ::: "memory");
        }
    }
    __syncthreads();
}

struct Frame {
    unsigned char* sm;
    LAS unsigned char* lds;
    int tid, lane, wave, G, vcu;
    const float *x, *c, *ctx, *c_ctx, *w_mod, *b_mod, *g_mix, *w_in, *w_sgu, *b_sgu, *g_sgu, *beta_sgu, *conv_w, *conv_b, *dt_bias, *a_log, *d_skip, *g_ssd, *g_q, *w_uq, *g_kv, *w_ukv,
                *w_out, *g_ffn, *w_gate, *w_up, *w_down, *w_router, *w_gate_e, *w_up_e, *w_down_e, *g_final;
    float* out; unsigned char* ws;
};
#define WSP(T, off) ((T*)(F.ws + (off)))

__device__ __forceinline__ int rowmap(int mode, int n) {
    if (mode == 1) { if (n < 1792) return n; if (n < 1804) return n + 672; return n - 12; }
    if (mode == 2) return ((n >> 7) << 8) + (n & 127);
    if (mode == 3) return ((n >> 7) << 8) + 128 + (n & 127);
    return n;
}
__device__ __forceinline__ void transpose_item(const float* W, int K, int N, bf16_t* WT, const float* ks, int mode, LAS float* scr, int item, int lane) {
    const int nblk = (N + 31) / 32, kb = item / nblk, nb = item % nblk, k0 = 64 * kb, n0 = 32 * nb;
    const int nn = n0 + (lane & 31); const bool nok = nn < N;
#pragma unroll 16
    for (int i = 0; i < 32; ++i) { const int kk = 2 * i + (lane >> 5); float v = W[(size_t)(k0 + kk) * N + (nok ? nn : N - 1)]; v = nok ? v : 0.f; if (ks) v *= ks[k0 + kk]; scr[kk * 33 + (lane & 31)] = v; }
    LDS_WAIT(); asm volatile("" ::: "memory");
    const int cch = lane & 7;
#pragma unroll
    for (int j = 0; j < 4; ++j) { const int n = (lane >> 3) + 8 * j; const LAS float* s = scr + (8 * cch) * 33 + n;
        u32x4 o; o.x = cvtpk(s[0 * 33], s[1 * 33]); o.y = cvtpk(s[2 * 33], s[3 * 33]); o.z = cvtpk(s[4 * 33], s[5 * 33]); o.w = cvtpk(s[6 * 33], s[7 * 33]);
        if (n0 + n < N) *(u32x4*)(WT + (size_t)rowmap(mode, n0 + n) * K + k0 + 8 * cch) = o; }
    LDS_WAIT(); asm volatile("" ::: "memory");
}
__device__ __forceinline__ void transpose_item64(const float* W, int K, int N, bf16_t* WT, const float* ks, int mode, LAS float* scr, int item, int lane) {
    const int nblk = (N + 63) / 64, kb = item / nblk, nb = item % nblk, k0 = 64 * kb, n0 = 64 * nb;
    const int lr = lane >> 4, lc = (lane & 15) * 4; const bool nok = n0 + lc < N; const int ncol = nok ? n0 + lc : N - 4;
#pragma unroll
    for (int i = 0; i < 16; ++i) { const int kk = 4 * i + lr; f32x4 v = *(const f32x4*)(W + (size_t)(k0 + kk) * N + ncol); if (ks) v = v * ks[k0 + kk];
        scr[kk * 65 + lc] = v[0]; scr[kk * 65 + lc + 1] = v[1]; scr[kk * 65 + lc + 2] = v[2]; scr[kk * 65 + lc + 3] = v[3]; }
    LDS_WAIT(); asm volatile("" ::: "memory");
    const int cch = lane & 7;
#pragma unroll
    for (int j = 0; j < 8; ++j) { const int n = (lane >> 3) + 8 * j; const LAS float* s = scr + (8 * cch) * 65 + n;
        u32x4 o; o.x = cvtpk(s[0 * 65], s[1 * 65]); o.y = cvtpk(s[2 * 65], s[3 * 65]); o.z = cvtpk(s[4 * 65], s[5 * 65]); o.w = cvtpk(s[6 * 65], s[7 * 65]);
        if (n0 + n < N) *(u32x4*)(WT + (size_t)rowmap(mode, n0 + n) * K + k0 + 8 * cch) = o; }
    LDS_WAIT(); asm volatile("" ::: "memory");
}
__device__ __forceinline__ void zero_fill16(Frame& F, void* p, size_t bytes) {
    const size_t n = bytes / 16; const u32x4 z = {0u, 0u, 0u, 0u};
    for (size_t i = (size_t)F.vcu * NTHR + F.tid; i < n; i += (size_t)F.G * NTHR) ((u32x4*)p)[i] = z;
}
__device__ __forceinline__ void mod_gemv(Frame& F, int l, int wi, int nw) {
    LAS float* cond = (LAS float*)F.lds;
    LAS float* red = (LAS float*)(F.lds + 36864);
    __syncthreads();
    for (int i = F.tid; i < 9 * DM; i += NTHR) { const float v = i < 8 * DM ? F.c[i] : F.c_ctx[i - 8 * DM]; cond[i] = silu_f(v); }
    __syncthreads();
    for (int ch = wi; ch < 192; ch += nw) {
        const int cl = F.lane & 31, kh = F.lane >> 5, col = ch * 32 + cl, kg = F.wave;
        const float* wp = F.w_mod + (size_t)l * DM * 6144 + (size_t)(kg * 128 + kh) * 6144 + col;
        float a[9];
#pragma unroll
        for (int r = 0; r < 9; ++r) a[r] = 0.f;
#pragma unroll 8
        for (int k4 = 0; k4 < 16; ++k4) { const float w0 = wp[(size_t)(8 * k4) * 6144], w1 = wp[(size_t)(8 * k4 + 2) * 6144], w2 = wp[(size_t)(8 * k4 + 4) * 6144], w3 = wp[(size_t)(8 * k4 + 6) * 6144];
#pragma unroll
            for (int r = 0; r < 9; ++r) { const LAS float* cp = cond + r * DM + kg * 128 + 8 * k4 + kh; a[r] += (cp[0] * w0 + cp[2] * w1) + (cp[4] * w2 + cp[6] * w3); } }
#pragma unroll
        for (int r = 0; r < 9; ++r) { a[r] += __shfl_xor(a[r], 32); if (kh == 0) red[(kg * 9 + r) * 32 + cl] = a[r]; }
        __syncthreads();
        for (int idx = F.tid; idx < 9 * 32; idx += NTHR) { const int r = idx >> 5, cc = idx & 31; float s = 0.f;
#pragma unroll
            for (int g = 0; g < 8; ++g) s += red[(g * 9 + r) * 32 + cc];
            WSP(float, WS_MOD)[((size_t)l * 9 + r) * 6144 + ch * 32 + cc] = s + F.b_mod[l * 6144 + ch * 32 + cc]; }
        __syncthreads();
    }
}
__device__ __forceinline__ void convert_set(Frame& F, int set, int wi, int nw) {
    __syncthreads();
    LAS float* scr = (LAS float*)(F.lds + F.wave * 16640);
    const int gw = wi * NWAVES + F.wave, NGW = nw * NWAVES;
    constexpr int I_IN = 16 * 39, I_UQ = 6 * 9, I_UKV = 4 * 12, I_OUT = 16 * 16, I_G = 16 * 44, I_D = 44 * 16;
    if (set == 0 || set == 3) { const int l = set == 0 ? 0 : 1; const int n = I_IN + I_UQ + I_UKV + (l == 1 ? I_OUT : 0);
        for (int it = gw; it < n; it += NGW) { int r = it;
            if (r < I_IN) { transpose_item64(F.w_in + (size_t)l * DM * INW, DM, INW, WSP(bf16_t, WS_WIN) + (size_t)l * INP * DM, nullptr, 1, scr, r, F.lane); continue; } r -= I_IN;
            if (r < I_UQ) { transpose_item64(F.w_uq + (size_t)l * 384 * QW, 384, QW, WSP(bf16_t, WS_WUQ) + (size_t)l * QWP * 384, F.g_q + l * 384, 0, scr, r, F.lane); continue; } r -= I_UQ;
            if (r < I_UKV) { transpose_item64(F.w_ukv + (size_t)l * 256 * KVW, 256, KVW, WSP(bf16_t, WS_WUKV) + (size_t)l * KVW * 256, F.g_kv + l * 256, 0, scr, r, F.lane); continue; } r -= I_UKV;
            transpose_item64(F.w_out + (size_t)l * DM * DM, DM, DM, WSP(bf16_t, WS_WOUT) + (size_t)l * DM * DM, nullptr, 0, scr, r, F.lane); }
        const u32x4 z = {0u, 0u, 0u, 0u};
        { u32x4* p0 = (u32x4*)(WSP(bf16_t, WS_WIN) + ((size_t)l * INP + INW) * DM); const size_t n0 = (size_t)(INP - INW) * DM * 2 / 16; for (size_t i = (size_t)wi * NTHR + F.tid; i < n0; i += (size_t)nw * NTHR) p0[i] = z;
          u32x4* p1 = (u32x4*)(WSP(bf16_t, WS_WUQ) + ((size_t)l * QWP + QW) * 384); const size_t n1 = (size_t)(QWP - QW) * 384 * 2 / 16; for (size_t i = (size_t)wi * NTHR + F.tid; i < n1; i += (size_t)nw * NTHR) p1[i] = z; }
    } else if (set == 1) {
        for (int it = gw; it < I_OUT; it += NGW) transpose_item64(F.w_out, DM, DM, WSP(bf16_t, WS_WOUT), nullptr, 0, scr, it, F.lane);
    } else {
        for (int it = gw; it < 2 * I_G + I_D; it += NGW) { int r = it;
            if (r < I_G) { transpose_item64(F.w_gate, DM, DFF, WSP(bf16_t, WS_WGU), nullptr, 2, scr, r, F.lane); continue; } r -= I_G;
            if (r < I_G) { transpose_item64(F.w_up, DM, DFF, WSP(bf16_t, WS_WGU), nullptr, 3, scr, r, F.lane); continue; } r -= I_G;
            transpose_item64(F.w_down, DFF, DM, WSP(bf16_t, WS_WD), nullptr, 0, scr, r, F.lane); }
    }
    __syncthreads();
}
__device__ __forceinline__ void p_prologue(Frame& F) {
    mod_gemv(F, 0, F.vcu, F.G);
    for (int set_ = 0; set_ < 2; ++set_) convert_set(F, set_, F.vcu, F.G);
    if (F.vcu == 0) { for (int i = F.tid; i < 64 * 8; i += NTHR) { const int pos = i >> 3, f = i & 7; const float inv = powf(10000.f, -(float)f / 8.f); const float ang = (float)pos * inv;
            WSP(f32x2, WS_MISC + MISC_ROPE)[i] = (f32x2){cosf(ang), sinf(ang)}; } }
    for (int i = F.vcu * NTHR + F.tid; i < 2 * 4 * 128 * 128 / 2; i += F.G * NTHR) { const f32x2 v = ((const f32x2*)F.w_sgu)[i]; WSP(unsigned, WS_WSGU)[i] = cvtpk(v.x, v.y); }
}
__device__ __forceinline__ bool tail_worker(int nwg, int G, int c, int& wi, int& nw) {
    const int rounds = (nwg + G - 1) / G, first = nwg - (rounds - 1) * G;
    if (first >= G) { wi = c; nw = G; return true; }
    if (c < first) return false;
    wi = c - first; nw = G - first; return true;
}
__device__ __forceinline__ void p_moe_weights(Frame& F) {
    __syncthreads();
    LAS float* scr = (LAS float*)(F.lds + F.wave * 16640);
    const int gw = F.vcu * NWAVES + F.wave, NGW = F.G * NWAVES;
    constexpr int I_G = 16 * 22, I_D = 22 * 16, PER_E = 2 * I_G + I_D;
    for (int it = gw; it < 8 * PER_E; it += NGW) {
        const int e = it / PER_E; int r = it - e * PER_E;
        bf16_t* gu = WSP(bf16_t, WS_MOEW_GU) + (size_t)e * 2 * DFE * DM;
        if (r < I_G) { transpose_item64(F.w_gate_e + (size_t)e * DM * DFE, DM, DFE, gu, nullptr, 2, scr, r, F.lane); continue; } r -= I_G;
        if (r < I_G) { transpose_item64(F.w_up_e + (size_t)e * DM * DFE, DM, DFE, gu, nullptr, 3, scr, r, F.lane); continue; } r -= I_G;
        transpose_item64(F.w_down_e + (size_t)e * DFE * DM, DFE, DM, WSP(bf16_t, WS_MOEW_D) + (size_t)e * DM * DFE, nullptr, 0, scr, r, F.lane);
    }
    __syncthreads();
}

template <bool ROUTE>
__device__ __forceinline__ void p_norm(Frame& F, int l, int which, int nrows, const float* srcL, const float* srcC, const float* slab = nullptr, const float* slabgate = nullptr) {
    const float* mod = WSP(float, WS_MOD) + (size_t)l * 9 * 6144;
    const float* g = (which == 0 ? F.g_mix : F.g_ffn) + l * DM;
    bf16_t* H = WSP(bf16_t, WS_H);
    LAS int* lcnt = (LAS int*)(F.lds + 32768);
    LAS int* rec = (LAS int*)(F.lds + 32768 + 64);
    int nrec = 0;
    if (ROUTE) { LAS float* wr = (LAS float*)F.lds; for (int i = F.tid; i < DM * 8; i += NTHR) wr[i] = F.w_router[i]; if (F.tid < 16) lcnt[F.tid] = 0; __syncthreads(); }
    const int gw = F.vcu * NWAVES + F.wave, NGW = F.G * NWAVES;
    for (int row = gw; row < nrows; row += NGW) {
        const bool isc = row >= NLAT; const int b = isc ? 8 : (row >> 11);
        const float* xr = isc ? srcC + (size_t)(row - NLAT) * DM : srcL + (size_t)row * DM;
        f32x4 v[4]; float s = 0.f;
#pragma unroll
        for (int j = 0; j < 4; ++j) v[j] = *(const f32x4*)(xr + 256 * j + 4 * F.lane);
        if (slab && isc) {
#pragma unroll
            for (int j = 0; j < 4; ++j) { const size_t o_ = (size_t)(row - NLAT) * DM + 256 * j + 4 * F.lane; const f32x4 gt = *(const f32x4*)(slabgate + 256 * j + 4 * F.lane);
                const f32x4 p0 = *(const f32x4*)(slab + o_), p1 = *(const f32x4*)(slab + (size_t)NCTX * DM + o_), p2 = *(const f32x4*)(slab + (size_t)2 * NCTX * DM + o_), p3 = *(const f32x4*)(slab + (size_t)3 * NCTX * DM + o_);
                v[j] = v[j] + gt * ((p0 + p1) + (p2 + p3)); } }
#pragma unroll
        for (int j = 0; j < 4; ++j) s += (v[j].x * v[j].x + v[j].y * v[j].y) + (v[j].z * v[j].z + v[j].w * v[j].w);
        const float rstd = rsqrtf(wave_sum(s) * (1.f / DM) + EPS);
        const float* sh = mod + (size_t)b * 6144 + (which * 3) * DM; const float* sc = sh + DM;
        float lg[8];
        if (ROUTE) {
#pragma unroll
            for (int e = 0; e < 8; ++e) lg[e] = 0.f; }
#pragma unroll
        for (int j = 0; j < 4; ++j) { const int k = 256 * j + 4 * F.lane;
            const f32x4 gg = *(const f32x4*)(g + k), s1 = *(const f32x4*)(sc + k), s0 = *(const f32x4*)(sh + k);
            f32x4 h = (v[j] * rstd) * gg * (s1 + 1.f) + s0;
            u32x2 w; w.x = cvtpk(h.x, h.y); w.y = cvtpk(h.z, h.w);
            *(u32x2*)(H + (size_t)row * DM + k) = w;
            if (ROUTE) { const LAS float* wr = (const LAS float*)F.lds + k * 8;
#pragma unroll
                for (int i = 0; i < 4; ++i) { const f32x4 w0 = *(const LAS f32x4*)(wr + 8 * i), w1 = *(const LAS f32x4*)(wr + 8 * i + 4); const float hv = h[i];
                    lg[0] += hv * w0.x; lg[1] += hv * w0.y; lg[2] += hv * w0.z; lg[3] += hv * w0.w; lg[4] += hv * w1.x; lg[5] += hv * w1.y; lg[6] += hv * w1.z; lg[7] += hv * w1.w; }
                asm volatile("" ::: "memory"); }
        }
        if (ROUTE) {
#pragma unroll
            for (int e = 0; e < 8; ++e) lg[e] = wave_sum(lg[e]);
            int i0 = 0; float m0 = lg[0];
#pragma unroll
            for (int e = 1; e < 8; ++e) if (lg[e] > m0) { m0 = lg[e]; i0 = e; }
            int i1 = -1; float m1 = -3.0e38f;
#pragma unroll
            for (int e = 0; e < 8; ++e) if (e != i0 && lg[e] > m1) { m1 = lg[e]; i1 = e; }
            const float w1 = 1.f / (1.f + __expf(m0 - m1)), w0 = 1.f - w1;
            if (F.lane == 0) { float* tw = WSP(float, WS_MISC + MISC_TOPW);
                const int p0 = __hip_atomic_fetch_add(lcnt + i0, 1, __ATOMIC_RELAXED, __HIP_MEMORY_SCOPE_WORKGROUP), p1 = __hip_atomic_fetch_add(lcnt + i1, 1, __ATOMIC_RELAXED, __HIP_MEMORY_SCOPE_WORKGROUP);
                LAS int* r = rec + (F.wave * 16 + nrec) * 4; r[0] = row; r[1] = i0 | (i1 << 8); r[2] = p0; r[3] = p1; tw[row * 2] = w0; tw[row * 2 + 1] = w1; }
            ++nrec;
        }
    }
    if (ROUTE) {
        __syncthreads();
        if (F.tid < 8) lcnt[8 + F.tid] = (int)atomicAdd(WSP(unsigned, WS_CTL) + CW_CNT + 64 * F.tid, (unsigned)lcnt[F.tid]);
        __syncthreads();
        int* list = WSP(int, WS_LIST);
        if (F.lane < nrec) { const LAS int* r = rec + (F.wave * 16 + F.lane) * 4; const int row = r[0], i0 = r[1] & 255, i1 = r[1] >> 8;
            list[i0 * NLAT + lcnt[8 + i0] + r[2]] = row * 2; list[i1 * NLAT + lcnt[8 + i1] + r[3]] = row * 2 + 1; }
        __syncthreads();
    }
}
__device__ __forceinline__ void p_final(Frame& F) {
    const float* mod = WSP(float, WS_MOD) + (size_t)1 * 9 * 6144; const bf16_t* Y = WSP(bf16_t, WS_Y);
    const int gw = F.vcu * NWAVES + F.wave, NGW = F.G * NWAVES;
    for (int row = gw; row < NLAT; row += NGW) {
        const int b = row >> 11; float* xr = F.out + (size_t)row * DM; const float* gt = mod + (size_t)b * 6144 + 5 * DM;
        f32x4 v[4]; float s = 0.f;
#pragma unroll
        for (int j = 0; j < 4; ++j) { const int k = 256 * j + 4 * F.lane; const f32x4 xv = *(const f32x4*)(xr + k), gv = *(const f32x4*)(gt + k);
            const u32x2 a = *(const u32x2*)(Y + (size_t)(2 * row) * DM + k), c = *(const u32x2*)(Y + (size_t)(2 * row + 1) * DM + k);
            f32x4 y; y.x = bflo(a.x) + bflo(c.x); y.y = bfhi(a.x) + bfhi(c.x); y.z = bflo(a.y) + bflo(c.y); y.w = bfhi(a.y) + bfhi(c.y);
            v[j] = xv + gv * y; s += (v[j].x * v[j].x + v[j].y * v[j].y) + (v[j].z * v[j].z + v[j].w * v[j].w); }
        const float rstd = rsqrtf(wave_sum(s) * (1.f / DM) + EPS);
#pragma unroll
        for (int j = 0; j < 4; ++j) { const int k = 256 * j + 4 * F.lane; *(f32x4*)(xr + k) = (v[j] * rstd) * *(const f32x4*)(F.g_final + k); }
    }
}
constexpr int LP = 272;
__device__ __forceinline__ void chunk_rows(int u, int& row0, bool& isc) {
    if (u < 128) { row0 = (u >> 4) * SEQ + (u & 15) * 128; isc = false; } else { const int uu = u - 128; row0 = NLAT + (uu >> 1) * CTXL + (uu & 1) * 128; isc = true; }
}
__device__ __forceinline__ void krope_unit(Frame& F, int u) {
    int row0; bool isc; chunk_rows(u, row0, isc);
    const bf16_t* P = WSP(bf16_t, WS_P);
    if (F.tid < 128) {
        const int row = row0 + F.tid; const u32x4* src = (const u32x4*)(P + (size_t)row * INP + PC_KR);
        u32x4 q[4];
#pragma unroll
        for (int i = 0; i < 4; ++i) q[i] = src[i];
        if (!isc) {
            const int tok = row & (SEQ - 1); const f32x2* rt = WSP(f32x2, WS_MISC + MISC_ROPE);
            float v[32];
#pragma unroll
            for (int i = 0; i < 4; ++i) { v[8 * i] = bflo(q[i].x); v[8 * i + 1] = bfhi(q[i].x); v[8 * i + 2] = bflo(q[i].y); v[8 * i + 3] = bfhi(q[i].y); v[8 * i + 4] = bflo(q[i].z); v[8 * i + 5] = bfhi(q[i].z); v[8 * i + 6] = bflo(q[i].w); v[8 * i + 7] = bfhi(q[i].w); }
#pragma unroll
            for (int ax = 0; ax < 2; ++ax) { const int pos = ax == 0 ? (tok >> 6) : (tok & 63);
#pragma unroll
                for (int f = 0; f < 8; ++f) { const f32x2 cs = rt[pos * 8 + f]; const float t1 = v[16 * ax + f], t2 = v[16 * ax + 8 + f];
                    v[16 * ax + f] = t1 * cs.x - t2 * cs.y; v[16 * ax + 8 + f] = t1 * cs.y + t2 * cs.x; } }
#pragma unroll
            for (int i = 0; i < 4; ++i) { q[i].x = cvtpk(v[8 * i], v[8 * i + 1]); q[i].y = cvtpk(v[8 * i + 2], v[8 * i + 3]); q[i].z = cvtpk(v[8 * i + 4], v[8 * i + 5]); q[i].w = cvtpk(v[8 * i + 6], v[8 * i + 7]); }
        }
        u32x4* dst = (u32x4*)(WSP(bf16_t, WS_KR) + (size_t)row * 32);
#pragma unroll
        for (int i = 0; i < 4; ++i) dst[i] = q[i];
    }
}
__device__ __forceinline__ void sgu_unit(Frame& F, int l, int u) {
    int row0; bool isc; chunk_rows(u, row0, isc);
    const bf16_t* P = WSP(bf16_t, WS_P); bf16_t* CAT = WSP(bf16_t, WS_CAT);
    LAS unsigned char* VT = F.lds;
    LAS unsigned char* WB = F.lds + 256 * LP;
    const int w = F.wave, lane = F.lane;
    {
        const f32x4 gs = *(const f32x4*)(F.g_sgu + l * 256 + 4 * lane), bs = *(const f32x4*)(F.beta_sgu + l * 256 + 4 * lane);
#pragma unroll
        for (int grp = 0; grp < 2; ++grp) {
            const int s0 = 16 * w + 8 * grp;
            float v[8][4];
#pragma unroll
            for (int tt = 0; tt < 8; ++tt) { const u32x2 r = *(const u32x2*)(P + (size_t)(row0 + s0 + tt) * INP + PC_V + 4 * lane);
                v[tt][0] = gelu_tanh(bflo(r.x)); v[tt][1] = gelu_tanh(bfhi(r.x)); v[tt][2] = gelu_tanh(bflo(r.y)); v[tt][3] = gelu_tanh(bfhi(r.y)); }
#pragma unroll
            for (int tt = 0; tt < 8; ++tt) {
                const float mu = wave_sum((v[tt][0] + v[tt][1]) + (v[tt][2] + v[tt][3])) * (1.f / 256.f);
                float d0 = v[tt][0] - mu, d1 = v[tt][1] - mu, d2 = v[tt][2] - mu, d3 = v[tt][3] - mu;
                const float rstd = rsqrtf(wave_sum((d0 * d0 + d1 * d1) + (d2 * d2 + d3 * d3)) * (1.f / 256.f) + EPS);
                v[tt][0] = d0 * rstd * gs.x + bs.x; v[tt][1] = d1 * rstd * gs.y + bs.y; v[tt][2] = d2 * rstd * gs.z + bs.z; v[tt][3] = d3 * rstd * gs.w + bs.w; }
#pragma unroll
            for (int i = 0; i < 4; ++i) { u32x4 o; o.x = cvtpk(v[0][i], v[1][i]); o.y = cvtpk(v[2][i], v[3][i]); o.z = cvtpk(v[4][i], v[5][i]); o.w = cvtpk(v[6][i], v[7][i]);
                *(LAS u32x4*)(VT + (4 * lane + i) * LP + s0 * 2) = o; }
        }
    }
    const bf16_t* Wg = WSP(bf16_t, WS_WSGU) + (size_t)l * 4 * 128 * 128;
#define SGU_STAGE_W(h, buf) do { _Pragma("unroll") for (int _i = 0; _i < 4; ++_i) { const int q_ = F.tid + NTHR * _i, r_ = q_ >> 4, c_ = q_ & 15; \
        *(LAS u32x4*)(WB + (buf) * 128 * LP + r_ * LP + c_ * 16) = *(const u32x4*)(Wg + (size_t)(h) * 16384 + r_ * 128 + c_ * 8); } } while (0)
    SGU_STAGE_W(0, 0);
    u32x2 upre[4][4];
    { const int t_ = 16 * w + (lane & 15), row_ = row0 + t_;
#pragma unroll
        for (int h = 0; h < 4; ++h)
#pragma unroll
            for (int dt = 0; dt < 4; ++dt) upre[h][dt] = *(const u32x2*)(P + (size_t)row_ * INP + PC_U + h * 64 + dt * 16 + 4 * (lane >> 4)); }
    __syncthreads();
    f32x4 acc[4][4];
#pragma unroll
    for (int h = 0; h < 4; ++h)
#pragma unroll
        for (int dt = 0; dt < 4; ++dt) acc[h][dt] = (f32x4){0.f, 0.f, 0.f, 0.f};
    const int fr = lane & 15, fq = lane >> 4;
#pragma unroll
    for (int h = 0; h < 4; ++h) {
        if (h + 1 < 4) SGU_STAGE_W(h + 1, (h + 1) & 1);
        const LAS unsigned char* Wh = WB + (h & 1) * 128 * LP;
#pragma unroll
        for (int ks = 0; ks < 4; ++ks) {
            const bf16x8 bw = *(const LAS bf16x8*)(Wh + (16 * w + fr) * LP + (32 * ks + 8 * fq) * 2);
#pragma unroll
            for (int dt = 0; dt < 4; ++dt) { const bf16x8 av = *(const LAS bf16x8*)(VT + (h * 64 + dt * 16 + fr) * LP + (32 * ks + 8 * fq) * 2);
                acc[h][dt] = MFMA16(av, bw, acc[h][dt]); }
        }
        __syncthreads();
    }
#undef SGU_STAGE_W
    { const int t = 16 * w + fr, row = row0 + t;
#pragma unroll
        for (int h = 0; h < 4; ++h) { const float bsv = F.b_sgu[(l * 4 + h) * 128 + t];
#pragma unroll
            for (int dt = 0; dt < 4; ++dt) { const int c = h * 64 + dt * 16 + 4 * fq; const u32x2 r = upre[h][dt];
                const float o0 = gelu_tanh(bflo(r.x)) * (acc[h][dt][0] + bsv), o1 = gelu_tanh(bfhi(r.x)) * (acc[h][dt][1] + bsv), o2 = gelu_tanh(bflo(r.y)) * (acc[h][dt][2] + bsv), o3 = gelu_tanh(bfhi(r.y)) * (acc[h][dt][3] + bsv);
                u32x2 o; o.x = cvtpk(o0, o1); o.y = cvtpk(o2, o3); *(u32x2*)(CAT + (size_t)row * DM + c) = o; } } }
    __syncthreads();
}

__device__ __forceinline__ void ssd_local_unit(Frame& F, int l, int u) {
    int b, c, g, row0, seq0, seqlen; bool isc;
    if (u < 256) { b = u >> 5; c = (u >> 1) & 15; g = u & 1; row0 = b * SEQ + c * 128; seq0 = b * SEQ; seqlen = SEQ; isc = false; }
    else { const int uu = u - 256; b = uu >> 2; c = (uu >> 1) & 1; g = uu & 1; row0 = NLAT + b * CTXL + c * 128; seq0 = NLAT + b * CTXL; seqlen = CTXL; isc = true; }
    const bf16_t* P = WSP(bf16_t, WS_P);
    LAS unsigned char* R1 = F.lds;
    LAS unsigned char* R2 = F.lds + 128 * LP;
    LAS unsigned char* XT = F.lds + 256 * LP;
    LAS float* dtv = (LAS float*)(F.lds + 448 * LP);
    LAS float* acsv = dtv + 768;
    LAS float* wv = acsv + 768;
    const int w = F.wave, lane = F.lane, tid = F.tid, fr = lane & 15, fq = lane >> 4;
    const float* cw = F.conv_w + (size_t)l * 5 * 896; const float* cb = F.conv_b + l * 896;
    LAS float* wlb = (LAS float*)(F.lds + 448 * LP + 9216);
    if (tid < 56) { const int chx0 = tid < 24 ? g * 192 + 8 * tid : (tid < 40 ? 384 + g * 128 + 8 * (tid - 24) : 640 + g * 128 + 8 * (tid - 40));
#pragma unroll
        for (int k = 0; k < 5; ++k) { *(LAS f32x4*)(wlb + tid * 48 + 8 * k) = *(const f32x4*)(cw + k * 896 + chx0); *(LAS f32x4*)(wlb + tid * 48 + 8 * k + 4) = *(const f32x4*)(cw + k * 896 + chx0 + 4); }
        *(LAS f32x4*)(wlb + tid * 48 + 40) = *(const f32x4*)(cb + chx0); *(LAS f32x4*)(wlb + tid * 48 + 44) = *(const f32x4*)(cb + chx0 + 4); }
    __syncthreads();
    if (tid < 448) {
        const int cg = tid % 56, seg = tid / 56;
        int pcol, role, lch;
        if (cg < 24) { role = 0; lch = 8 * cg; pcol = PC_X + g * 192 + lch; }
        else if (cg < 40) { role = 1; lch = 8 * (cg - 24); pcol = PC_B + g * 128 + lch; }
        else { role = 2; lch = 8 * (cg - 40); pcol = PC_C + g * 128 + lch; }
        const LAS float* wl = wlb + cg * 48;
#pragma unroll 1
        for (int hb = 0; hb < 2; ++hb) {
            const int t0 = 16 * seg + 8 * hb;
            u32x4 rows[12];
#pragma unroll
            for (int i = 0; i < 12; ++i) { const int grow = row0 + t0 - 2 + i;
                if (i >= 2 && i < 10) rows[i] = *(const u32x4*)(P + (size_t)grow * INP + pcol);
                else { const bool ok = grow >= seq0 && grow < seq0 + seqlen; const int gcl = i < 2 ? (grow < seq0 ? seq0 : grow) : (grow >= seq0 + seqlen ? seq0 + seqlen - 1 : grow);
                    const u32x4 v_ = *(const u32x4*)(P + (size_t)gcl * INP + pcol); rows[i] = ok ? v_ : (u32x4){0u, 0u, 0u, 0u}; } }
            unsigned pk[8][4];
#pragma unroll
            for (int o2 = 0; o2 < 4; ++o2) {
                float y[2][8];
#pragma unroll
                for (int e = 0; e < 2; ++e) { const int o = 2 * o2 + e; f32x4 ya = *(const LAS f32x4*)(wl + 40), yb = *(const LAS f32x4*)(wl + 44);
#pragma unroll
                    for (int k = 0; k < 5; ++k) { const u32x4 r = rows[o + k]; const f32x4 xa = {bflo(r.x), bfhi(r.x), bflo(r.y), bfhi(r.y)}, xb = {bflo(r.z), bfhi(r.z), bflo(r.w), bfhi(r.w)};
                        ya += *(const LAS f32x4*)(wl + 8 * k) * xa; yb += *(const LAS f32x4*)(wl + 8 * k + 4) * xb; }
#pragma unroll
                    for (int c8 = 0; c8 < 4; ++c8) { y[e][c8] = silu_f(ya[c8]); y[e][4 + c8] = silu_f(yb[c8]); }
                    if (role != 0) { u32x4 st; st.x = cvtpk(y[e][0], y[e][1]); st.y = cvtpk(y[e][2], y[e][3]); st.z = cvtpk(y[e][4], y[e][5]); st.w = cvtpk(y[e][6], y[e][7]);
                        *(u32x4*)((role == 1 ? R2 : R1) + (t0 + o) * LP + lch * 2) = st;
                        if (role == 2) *(u32x4*)(WSP(bf16_t, WS_CC) + (size_t)(row0 + t0 + o) * 256 + g * 128 + lch) = st; }
                }
#pragma unroll
                for (int c8 = 0; c8 < 8; ++c8) pk[c8][o2] = cvtpk(y[0][c8], y[1][c8]);
            }
            if (role == 0) {
#pragma unroll
                for (int c8 = 0; c8 < 8; ++c8) *(LAS u32x4*)(XT + (lch + c8) * LP + t0 * 2) = (u32x4){pk[c8][0], pk[c8][1], pk[c8][2], pk[c8][3]}; }
        }
    }
    else {
        bf16_t draw[6][2];
#pragma unroll
        for (int q = 0; q < 6; ++q) { const int d = q / 3, h = g * 3 + q % 3; const int e0 = 2 * lane, t0 = d == 0 ? e0 : 127 - e0, t1 = d == 0 ? e0 + 1 : 126 - e0;
            draw[q][0] = P[(size_t)(row0 + t0) * INP + PC_DT + d * 6 + h]; draw[q][1] = P[(size_t)(row0 + t1) * INP + PC_DT + d * 6 + h]; }
        asm volatile("" ::: "memory");
#pragma unroll
        for (int q = 0; q < 6; ++q) { const int d = q / 3, j = q % 3, h = g * 3 + j;
            const float a = -__expf(F.a_log[l * 12 + d * 6 + h]), bias = F.dt_bias[l * 12 + d * 6 + h];
            const int e0 = 2 * lane, e1 = 2 * lane + 1, t0 = d == 0 ? e0 : 127 - e0, t1 = d == 0 ? e1 : 127 - e1;
            const float dt0 = softplus_f(bf1(draw[q][0]) + bias), dt1 = softplus_f(bf1(draw[q][1]) + bias);
            const float x0 = dt0 * a, x1 = dt1 * a; float s = x0 + x1;
#pragma unroll
            for (int off = 1; off < 64; off <<= 1) { const float t = __shfl_up(s, off); if (lane >= off) s += t; }
            const float a1v = s, a0v = s - x1, tot = __shfl(s, 63);
            dtv[q * 128 + t0] = dt0; dtv[q * 128 + t1] = dt1; acsv[q * 128 + t0] = a0v; acsv[q * 128 + t1] = a1v;
            wv[q * 128 + t0] = __expf(tot - a0v) * dt0; wv[q * 128 + t1] = __expf(tot - a1v) * dt1;
            float* ACS = WSP(float, WS_ACS); ACS[(size_t)(row0 + t0) * 12 + d * 6 + h] = a0v; ACS[(size_t)(row0 + t1) * 12 + d * 6 + h] = a1v;
            if (lane == 0) { const int pos = isc ? (d == 0 ? c : 1 - c) : (d == 0 ? 2 + c : 17 - c); WSP(float, WS_MISC + MISC_DEC)[((b * 2 + d) * NPOS + pos) * 6 + h] = __expf(tot); }
        }
    }
    __syncthreads();
    f32x4 G[8];
#pragma unroll
    for (int t = 0; t < 8; ++t) G[t] = (f32x4){0.f, 0.f, 0.f, 0.f};
#pragma unroll
    for (int ks = 0; ks < 4; ++ks) { const bf16x8 cf = *(const LAS bf16x8*)(R1 + (16 * w + fr) * LP + (32 * ks + 8 * fq) * 2);
#pragma unroll
        for (int t = 0; t < 8; ++t) { const bf16x8 bfm = *(const LAS bf16x8*)(R2 + (16 * t + fr) * LP + (32 * ks + 8 * fq) * 2); G[t] = MFMA16(bfm, cf, G[t]); } }
    __syncthreads();
    if (tid < 256) { const int sb = tid >> 4, nb = tid & 15; u32x4 r[8];
#pragma unroll
        for (int i = 0; i < 8; ++i) r[i] = *(const LAS u32x4*)(R2 + (8 * sb + i) * LP + nb * 16);
#pragma unroll
        for (int j = 0; j < 8; ++j) { u32x4 o;
            if ((j & 1) == 0) { o.x = (r[0][j >> 1] & 0xffffu) | (r[1][j >> 1] << 16); o.y = (r[2][j >> 1] & 0xffffu) | (r[3][j >> 1] << 16); o.z = (r[4][j >> 1] & 0xffffu) | (r[5][j >> 1] << 16); o.w = (r[6][j >> 1] & 0xffffu) | (r[7][j >> 1] << 16); }
            else { o.x = (r[0][j >> 1] >> 16) | (r[1][j >> 1] & 0xffff0000u); o.y = (r[2][j >> 1] >> 16) | (r[3][j >> 1] & 0xffff0000u); o.z = (r[4][j >> 1] >> 16) | (r[5][j >> 1] & 0xffff0000u); o.w = (r[6][j >> 1] >> 16) | (r[7][j >> 1] & 0xffff0000u); }
            *(LAS u32x4*)(R1 + (8 * nb + j) * LP + sb * 16) = o; } }
    __syncthreads();
    LAS unsigned char* Mw = R2 + w * 16 * LP;
    bf16_t* ST = WSP(bf16_t, WS_ST); float* YP = WSP(float, WS_YP);
    const bool needy = !(isc && l == DEPTH - 1);
    const int lrow = 16 * w + fr;
#pragma unroll 1
    for (int j = 0; j < 3; ++j) {
        const int h = g * 3 + j;
        f32x4 ay[4];
#pragma unroll
        for (int pt = 0; pt < 4; ++pt) ay[pt] = (f32x4){0.f, 0.f, 0.f, 0.f};
#pragma unroll 1
        for (int d = 0; d < 2; ++d) {
            const int q = d * 3 + j; const float al = acsv[q * 128 + lrow];
            if (needy) {
#pragma unroll
            for (int t = 0; t < 8; ++t) { const int s4 = 16 * t + 4 * fq; u32x2 o = {0u, 0u};
                if (d == 0 ? (t <= w) : (t >= w)) {
                    const f32x4 as = *(const LAS f32x4*)(acsv + q * 128 + s4), ds = *(const LAS f32x4*)(dtv + q * 128 + s4);
                    float mv[4];
#pragma unroll
                    for (int r = 0; r < 4; ++r) { const int s = s4 + r; const bool ok = (t != w) || (d == 0 ? (s <= lrow) : (s >= lrow)); mv[r] = ok ? G[t][r] * __expf(al - as[r]) * ds[r] : 0.f; }
                    o.x = cvtpk(mv[0], mv[1]); o.y = cvtpk(mv[2], mv[3]); }
                *(LAS u32x2*)(Mw + fr * LP + s4 * 2) = o; }
            LDS_WAIT();
#pragma unroll
            for (int ks = 0; ks < 4; ++ks) if (d == 0 ? (2 * ks <= w) : (2 * ks + 1 >= w)) { const bf16x8 mf = *(const LAS bf16x8*)(Mw + fr * LP + (32 * ks + 8 * fq) * 2);
#pragma unroll
                for (int pt = 0; pt < 4; ++pt) { const bf16x8 xf = *(const LAS bf16x8*)(XT + (j * 64 + 16 * pt + fr) * LP + (32 * ks + 8 * fq) * 2); ay[pt] = MFMA16(xf, mf, ay[pt]); } }
            }
            f32x4 as4[4];
#pragma unroll
            for (int pt = 0; pt < 4; ++pt) as4[pt] = (f32x4){0.f, 0.f, 0.f, 0.f};
#pragma unroll
            for (int ks = 0; ks < 4; ++ks) { const u32x4 raw = *(const LAS u32x4*)(R1 + (16 * w + fr) * LP + (32 * ks + 8 * fq) * 2);
                const f32x4 wa = *(const LAS f32x4*)(wv + q * 128 + 32 * ks + 8 * fq), wb = *(const LAS f32x4*)(wv + q * 128 + 32 * ks + 8 * fq + 4);
                u32x4 sc; sc.x = cvtpk(bflo(raw.x) * wa.x, bfhi(raw.x) * wa.y); sc.y = cvtpk(bflo(raw.y) * wa.z, bfhi(raw.y) * wa.w); sc.z = cvtpk(bflo(raw.z) * wb.x, bfhi(raw.z) * wb.y); sc.w = cvtpk(bflo(raw.w) * wb.z, bfhi(raw.w) * wb.w);
                const bf16x8 bsf = __builtin_bit_cast(bf16x8, sc);
#pragma unroll
                for (int pt = 0; pt < 4; ++pt) { const bf16x8 xf = *(const LAS bf16x8*)(XT + (j * 64 + 16 * pt + fr) * LP + (32 * ks + 8 * fq) * 2); as4[pt] = MFMA16(bsf, xf, as4[pt]); } }
            { const int pos = isc ? (d == 0 ? c : 1 - c) : (d == 0 ? 2 + c : 17 - c); bf16_t* sp = ST + ((size_t)((b * 2 + d) * NPOS + pos) * 6 + h) * 8192;
#pragma unroll
                for (int pt = 0; pt < 4; ++pt) { u32x2 o; o.x = cvtpk(as4[pt][0], as4[pt][1]); o.y = cvtpk(as4[pt][2], as4[pt][3]); *(u32x2*)(sp + (16 * pt + fr) * 128 + 16 * w + 4 * fq) = o; } }
        }
        if (needy) { const float skip = F.d_skip[l * 6 + h];
#pragma unroll
            for (int pt = 0; pt < 4; ++pt) { f32x4 o;
#pragma unroll
                for (int r = 0; r < 4; ++r) o[r] = ay[pt][r] + skip * bf1(*(const LAS bf16_t*)(XT + (j * 64 + 16 * pt + 4 * fq + r) * LP + lrow * 2));
                *(f32x4*)(YP + (size_t)(row0 + lrow) * 384 + h * 64 + 16 * pt + 4 * fq) = o; } }
    }
    __syncthreads();
}

__device__ __forceinline__ void ssd_scan(Frame& F) {
    bf16_t* ST = WSP(bf16_t, WS_ST); const float* DEC = WSP(float, WS_MISC + MISC_DEC);
    for (int gt = F.vcu * NTHR + F.tid; gt < 96 * 1024; gt += F.G * NTHR) {
        const int combo = gt >> 10, e8 = gt & 1023, bd = combo / 6, h = combo - bd * 6;
        u32x4 st[17]; float dec[17];
#pragma unroll
        for (int q = 0; q < 17; ++q) { const size_t sidx = (size_t)(bd * NPOS + q) * 6 + h; st[q] = *(const u32x4*)(ST + sidx * 8192 + e8 * 8); dec[q] = DEC[sidx]; }
        float hv[8];
#pragma unroll
        for (int i = 0; i < 8; ++i) hv[i] = 0.f;
#pragma unroll
        for (int q = 0; q < 17; ++q) { const size_t sidx = (size_t)(bd * NPOS + q) * 6 + h; const float dq = dec[q];
            hv[0] = dq * hv[0] + bflo(st[q].x); hv[1] = dq * hv[1] + bfhi(st[q].x); hv[2] = dq * hv[2] + bflo(st[q].y); hv[3] = dq * hv[3] + bfhi(st[q].y);
            hv[4] = dq * hv[4] + bflo(st[q].z); hv[5] = dq * hv[5] + bfhi(st[q].z); hv[6] = dq * hv[6] + bflo(st[q].w); hv[7] = dq * hv[7] + bfhi(st[q].w);
            u32x4 o; o.x = cvtpk(hv[0], hv[1]); o.y = cvtpk(hv[2], hv[3]); o.z = cvtpk(hv[4], hv[5]); o.w = cvtpk(hv[6], hv[7]);
            *(u32x4*)(ST + sidx * 8192 + e8 * 8) = o; }
    }
}

__device__ __forceinline__ void ssd_final_unit(Frame& F, int l, int u) {
    int row0; bool isc; chunk_rows(u, row0, isc);
    const int b = isc ? ((u - 128) >> 1) : (u >> 4), c = isc ? ((u - 128) & 1) : (u & 15);
    constexpr int CPITCH = 528;
    LAS unsigned char* Cs = F.lds;
    LAS unsigned char* Hs = F.lds + 128 * CPITCH;
    const int w = F.wave, lane = F.lane, tid = F.tid, fr = lane & 15, fq = lane >> 4;
    const bf16_t* CC = WSP(bf16_t, WS_CC); const bf16_t* ST = WSP(bf16_t, WS_ST); const float* ACS = WSP(float, WS_ACS);
#pragma unroll
    for (int i = 0; i < 8; ++i) { const int q = tid + NTHR * i, r = q >> 5, cc = q & 31; *(LAS u32x4*)(Cs + r * CPITCH + cc * 16) = *(const u32x4*)(CC + (size_t)(row0 + r) * 256 + cc * 8); }
    const int lrow = 16 * w + fr, row = row0 + lrow;
    const int hp = tid >> 3, hn0 = (tid & 7) * 16;
    const float* YP = WSP(float, WS_YP); const bf16_t* P = WSP(bf16_t, WS_P); bf16_t* CAT = WSP(bf16_t, WS_CAT);
    float ss = 0.f;
    const f32x4 ac0 = *(const f32x4*)(ACS + (size_t)row * 12), ac1 = *(const f32x4*)(ACS + (size_t)row * 12 + 4), ac2 = *(const f32x4*)(ACS + (size_t)row * 12 + 8);
    const float acv[12] = {ac0[0], ac0[1], ac0[2], ac0[3], ac1[0], ac1[1], ac1[2], ac1[3], ac2[0], ac2[1], ac2[2], ac2[3]};
    u32x4 hpre[2][2][2]; f32x4 ypre[2][4]; u32x2 zpre[2][4];
#define SSDF_LOAD(hh, S_) do { \
        _Pragma("unroll") for (int d = 0; d < 2; ++d) { const int pos = isc ? (d == 0 ? c : 1 - c) : (d == 0 ? 2 + c : 17 - c); hpre[S_][d][0] = (u32x4){0u, 0u, 0u, 0u}; hpre[S_][d][1] = hpre[S_][d][0]; \
            if (pos > 0) { const size_t sidx = (size_t)((b * 2 + d) * NPOS + pos - 1) * 6 + (hh); hpre[S_][d][0] = *(const u32x4*)(ST + sidx * 8192 + hp * 128 + hn0); hpre[S_][d][1] = *(const u32x4*)(ST + sidx * 8192 + hp * 128 + hn0 + 8); } } \
        _Pragma("unroll") for (int pt = 0; pt < 4; ++pt) { const int cidx = (hh) * 64 + 16 * pt + 4 * fq; ypre[S_][pt] = *(const f32x4*)(YP + (size_t)row * 384 + cidx); zpre[S_][pt] = *(const u32x2*)(P + (size_t)row * INP + PC_Z + cidx); } } while (0)
    SSDF_LOAD(0, 1);
#pragma unroll 1
    for (int h = 0; h < 6; ++h) {
        const int g = h / 3; constexpr int S = 0;
#pragma unroll
        for (int d = 0; d < 2; ++d) { hpre[0][d][0] = hpre[1][d][0]; hpre[0][d][1] = hpre[1][d][1]; }
#pragma unroll
        for (int pt = 0; pt < 4; ++pt) { ypre[0][pt] = ypre[1][pt]; zpre[0][pt] = zpre[1][pt]; }
        if (h + 1 < 6) SSDF_LOAD(h + 1, 1);
        LAS unsigned char* Hset = Hs + (h & 1) * 2 * 64 * LP;
#pragma unroll
        for (int d = 0; d < 2; ++d) { LAS unsigned char* Hb = Hset + d * 64 * LP;
            *(LAS u32x4*)(Hb + hp * LP + hn0 * 2) = hpre[S][d][0]; *(LAS u32x4*)(Hb + hp * LP + hn0 * 2 + 16) = hpre[S][d][1]; }
        LDS_BARRIER();
        f32x4 yh[4];
#pragma unroll
        for (int pt = 0; pt < 4; ++pt) yh[pt] = (f32x4){0.f, 0.f, 0.f, 0.f};
#pragma unroll
        for (int d = 0; d < 2; ++d) {
            const LAS unsigned char* Hb = Hset + d * 64 * LP;
            f32x4 tm[4];
#pragma unroll
            for (int pt = 0; pt < 4; ++pt) tm[pt] = (f32x4){0.f, 0.f, 0.f, 0.f};
#pragma unroll
            for (int ks = 0; ks < 4; ++ks) { const bf16x8 cf = *(const LAS bf16x8*)(Cs + lrow * CPITCH + (g * 128 + 32 * ks + 8 * fq) * 2);
#pragma unroll
                for (int pt = 0; pt < 4; ++pt) { const bf16x8 hf = *(const LAS bf16x8*)(Hb + (16 * pt + fr) * LP + (32 * ks + 8 * fq) * 2); tm[pt] = MFMA16(hf, cf, tm[pt]); } }
            const float e = __expf(d == 0 ? (h == 0 ? acv[0] : h == 1 ? acv[1] : h == 2 ? acv[2] : h == 3 ? acv[3] : h == 4 ? acv[4] : acv[5]) : (h == 0 ? acv[6] : h == 1 ? acv[7] : h == 2 ? acv[8] : h == 3 ? acv[9] : h == 4 ? acv[10] : acv[11]));
#pragma unroll
            for (int pt = 0; pt < 4; ++pt) yh[pt] += tm[pt] * e;
        }
#pragma unroll
        for (int pt = 0; pt < 4; ++pt) { const int cidx = h * 64 + 16 * pt + 4 * fq; const u32x2 z = zpre[S][pt];
            f32x4 v = yh[pt] + ypre[S][pt]; v[0] *= silu_f(bflo(z.x)); v[1] *= silu_f(bfhi(z.x)); v[2] *= silu_f(bflo(z.y)); v[3] *= silu_f(bfhi(z.y));
            u32x2 o; o.x = cvtpk(v[0], v[1]); o.y = cvtpk(v[2], v[3]); *(u32x2*)(CAT + (size_t)row * DM + 256 + cidx) = o; ss += (v[0] * v[0] + v[1] * v[1]) + (v[2] * v[2] + v[3] * v[3]); }
    }
#undef SSDF_LOAD
    ss += __shfl_xor(ss, 16); ss += __shfl_xor(ss, 32);
    const float rstd = rsqrtf(ss * (1.f / 384.f) + EPS);
    u32x2 st[6][4];
#pragma unroll
    for (int h = 0; h < 6; ++h)
#pragma unroll
        for (int pt = 0; pt < 4; ++pt) st[h][pt] = *(const u32x2*)(CAT + (size_t)row * DM + 256 + h * 64 + 16 * pt + 4 * fq);
    asm volatile("" ::: "memory");
#pragma unroll
    for (int h = 0; h < 6; ++h)
#pragma unroll
        for (int pt = 0; pt < 4; ++pt) { const int cidx = h * 64 + 16 * pt + 4 * fq; const f32x4 gg = *(const f32x4*)(F.g_ssd + l * 384 + cidx); const u32x2 t = st[h][pt]; f32x4 v = {bflo(t.x), bfhi(t.x), bflo(t.y), bfhi(t.y)}; v = v * rstd * gg;
            u32x2 o; o.x = cvtpk(v[0], v[1]); o.y = cvtpk(v[2], v[3]); *(u32x2*)(CAT + (size_t)row * DM + 256 + cidx) = o; }
    __syncthreads();
}

__device__ __forceinline__ void build_vt_item(Frame& F, int gt, int h) {
    const bf16_t* KV = WSP(bf16_t, WS_KV); bf16_t* VT = WSP(bf16_t, WS_VT);
    const int t7 = F.tid & 127, kq = t7 & 15, ch = t7 >> 4; u32x4 v[4];
#pragma unroll
    for (int r = 0; r < 4; ++r) v[r] = *(const u32x4*)(KV + (size_t)(gt * 64 + 4 * kq + r) * KVW + h * 128 + 64 + ch * 8);
    bf16_t* dst = VT + ((size_t)gt * 6 + h) * 4096 + 4 * kq;
#pragma unroll
    for (int j = 0; j < 4; ++j) { const unsigned a0 = v[0][j], a1 = v[1][j], a2 = v[2][j], a3 = v[3][j];
        u32x2 lo, hi; lo.x = (a0 & 0xffffu) | (a1 << 16); lo.y = (a2 & 0xffffu) | (a3 << 16); hi.x = (a0 >> 16) | (a1 & 0xffff0000u); hi.y = (a2 >> 16) | (a3 & 0xffff0000u);
        *(u32x2*)(dst + (8 * ch + 2 * j) * 64) = lo; *(u32x2*)(dst + (8 * ch + 2 * j + 1) * 64) = hi; }
}
template <class Sched> __device__ __forceinline__ void build_vt_own(Frame& F, const Sched& S) {
    asm volatile("s_waitcnt vmcnt(0)" ::: "memory"); __syncthreads();
    pg8::Unit u; const int sub = F.tid >> 7;
    for (int i = 0; S.next(i, u); ++i) {
#pragma unroll
        for (int k = 0; k < 2; ++k) { const int item = sub + 4 * k;
            build_vt_item(F, u.pm * 4 + (item & 3), u.pn * 2 + (item >> 2)); }
    }
}

__device__ __forceinline__ void attn_unit(Frame& F, int u) {
    int b, h, q0, nt; bool isc;
    if (u < 768) { b = u / 96; const int rem = u % 96; h = rem >> 4; q0 = b * SEQ + (rem & 15) * 128; nt = 36; isc = false; }
    else { const int uu = u - 768; b = uu / 12; const int rem = uu % 12; h = rem >> 1; q0 = NLAT + b * CTXL + (rem & 1) * 128; nt = 4; isc = true; }
    constexpr int KP = 208, VP = 136, TILEB = 64 * KP + 64 * VP;
    const bf16_t* Q = WSP(bf16_t, WS_Q); const bf16_t* KV = WSP(bf16_t, WS_KV); const bf16_t* KR = WSP(bf16_t, WS_KR); const bf16_t* VTg = WSP(bf16_t, WS_VT); bf16_t* CAT = WSP(bf16_t, WS_CAT);
    const int w = F.wave, lane = F.lane, tid = F.tid, qs = w & 3, par = w >> 2, r32 = lane & 31, hf = lane >> 5;
    bf16x8 qf[6];
    { const int qrow = q0 + 32 * qs + r32; const bf16_t* qp = Q + (size_t)qrow * QW + h * 96 + 8 * hf;
#pragma unroll
        for (int ks = 0; ks < 6; ++ks) qf[ks] = *(const bf16x8*)(qp + 16 * ks);
        if (!isc) { const int tok = qrow & (SEQ - 1); const f32x2* rt = WSP(f32x2, WS_MISC + MISC_ROPE);
#pragma unroll
            for (int ax = 0; ax < 2; ++ax) { const int pos = ax == 0 ? (tok >> 6) : (tok & 63); u32x4 own = __builtin_bit_cast(u32x4, qf[4 + ax]); u32x4 oth;
                oth.x = __shfl_xor(own.x, 32); oth.y = __shfl_xor(own.y, 32); oth.z = __shfl_xor(own.z, 32); oth.w = __shfl_xor(own.w, 32);
                float a[8], o[8], r[8];
                a[0] = bflo(own.x); a[1] = bfhi(own.x); a[2] = bflo(own.y); a[3] = bfhi(own.y); a[4] = bflo(own.z); a[5] = bfhi(own.z); a[6] = bflo(own.w); a[7] = bfhi(own.w);
                o[0] = bflo(oth.x); o[1] = bfhi(oth.x); o[2] = bflo(oth.y); o[3] = bfhi(oth.y); o[4] = bflo(oth.z); o[5] = bfhi(oth.z); o[6] = bflo(oth.w); o[7] = bfhi(oth.w);
#pragma unroll
                for (int f = 0; f < 8; ++f) { const f32x2 cs = rt[pos * 8 + f]; r[f] = hf == 0 ? (a[f] * cs.x - o[f] * cs.y) : (o[f] * cs.y + a[f] * cs.x); }
                u32x4 res; res.x = cvtpk(r[0], r[1]); res.y = cvtpk(r[2], r[3]); res.z = cvtpk(r[4], r[5]); res.w = cvtpk(r[6], r[7]); qf[4 + ax] = __builtin_bit_cast(bf16x8, res); } }
    }
    u32x4 knA[2], krA, vregA[2], knB[2], krB, vregB[2];
    const unsigned voffK = (unsigned)((tid >> 3) * KVW + (tid & 7) * 8) * 2u, voffR = (unsigned)tid * 16u, voffV = (unsigned)tid * 16u;
    const unsigned ldsK = (unsigned)((tid >> 3) * KP + (tid & 7) * 16), ldsR = (unsigned)((tid >> 8) * TILEB + ((tid >> 2) & 63) * KP + (8 + (tid & 3)) * 16), ldsV = (unsigned)(64 * KP + (tid >> 3) * VP + (tid & 7) * 16);
#define ATT_R(tp) ((isc || (tp) < 2) ? (NLAT + b * CTXL + (tp) * 128) : (b * SEQ + ((tp) - 2) * 128))
#define ATT_LOAD(kn, kr, vreg, tp) do { const int R_ = __builtin_amdgcn_readfirstlane(ATT_R(tp)); \
        const unsigned char* kb_ = (const unsigned char*)(KV + (size_t)R_ * KVW + h * 128); \
        kn[0] = *(const u32x4*)(kb_ + voffK); kn[1] = *(const u32x4*)(kb_ + 64 * KVW * 2 + voffK); \
        kr = *(const u32x4*)((const unsigned char*)(KR + (size_t)R_ * 32) + voffR); \
        const unsigned char* vb_ = (const unsigned char*)(VTg + ((size_t)(R_ >> 6) * 6 + h) * 4096); \
        vreg[0] = *(const u32x4*)(vb_ + voffV); vreg[1] = *(const u32x4*)(vb_ + 6 * 4096 * 2 + voffV); } while (0)
#define ATT_WRITE(kn, kr, vreg, buf) do { LAS unsigned char* base_ = F.lds + (buf) * 2 * TILEB; \
        *(LAS u32x4*)(base_ + ldsK) = kn[0]; *(LAS u32x4*)(base_ + TILEB + ldsK) = kn[1]; *(LAS u32x4*)(base_ + ldsR) = kr; \
        _Pragma("unroll") for (int i = 0; i < 2; ++i) { LAS unsigned char* vt = base_ + i * TILEB + ldsV; \
            *(LAS u32x2*)vt = (u32x2){vreg[i].x, vreg[i].y}; *(LAS u32x2*)(vt + 8) = (u32x2){vreg[i].z, vreg[i].w}; } } while (0)
    const int np = nt / 2;
    ATT_LOAD(knA, krA, vregA, 0); ATT_WRITE(knA, krA, vregA, 0);
    __syncthreads();
    ATT_LOAD(knB, krB, vregB, 1);
    f32x16 o0, o1;
#pragma unroll
    for (int r = 0; r < 16; ++r) { o0[r] = 0.f; o1[r] = 0.f; }
    float mrun = 0.f, lrun = 0.f;
    const unsigned kfo = (unsigned)(r32 * KP + 16 * hf), vfo = (unsigned)(64 * KP + r32 * VP + 8 * hf);
#define ATT_STEP(tp) do { \
        const LAS unsigned char* Kt = F.lds + ((((tp)) & 1) * 2 + par) * TILEB; \
        bf16x8 ka[6], kb[6]; \
        _Pragma("unroll") \
        for (int ks = 0; ks < 6; ++ks) ka[ks] = *(const LAS bf16x8*)(Kt + kfo + 32 * ks); \
        _Pragma("unroll") \
        for (int ks = 0; ks < 6; ++ks) kb[ks] = *(const LAS bf16x8*)(Kt + kfo + 32 * KP + 32 * ks); \
        f32x16 p0, p1; \
        _Pragma("unroll") \
        for (int r = 0; r < 16; ++r) { p0[r] = -mrun; p1[r] = -mrun; } \
        __builtin_amdgcn_sched_barrier(0); \
        _Pragma("unroll") \
        for (int ks = 0; ks < 6; ++ks) { p0 = MFMA32(ka[ks], qf[ks], p0); p1 = MFMA32(kb[ks], qf[ks], p1); } \
        u32x2 va[4][2], vc[4][2]; \
        _Pragma("unroll") \
        for (int s2 = 0; s2 < 4; ++s2) { \
            va[s2][0] = *(const LAS u32x2*)(Kt + vfo + 32 * s2); va[s2][1] = *(const LAS u32x2*)(Kt + vfo + 32 * s2 + 16); \
            vc[s2][0] = *(const LAS u32x2*)(Kt + vfo + 32 * VP + 32 * s2); vc[s2][1] = *(const LAS u32x2*)(Kt + vfo + 32 * VP + 32 * s2 + 16); } \
        __builtin_amdgcn_sched_barrier(0); \
        float mx = p0[0]; \
        _Pragma("unroll") \
        for (int r = 1; r < 16; ++r) mx = fmaxf(mx, p0[r]); \
        _Pragma("unroll") \
        for (int r = 0; r < 16; ++r) mx = fmaxf(mx, p1[r]); \
        mx = fmaxf(mx, __shfl_xor(mx, 32)); \
        if ((tp) == 0 || __any(mx > 8.f)) { const float dl = (tp) == 0 ? mx : fmaxf(mx, 0.f), alpha = __builtin_amdgcn_exp2f(-dl); lrun *= alpha; mrun += dl; \
        _Pragma("unroll") \
            for (int r = 0; r < 16; ++r) { o0[r] *= alpha; o1[r] *= alpha; p0[r] -= dl; p1[r] -= dl; } } \
        _Pragma("unroll") \
        for (int r = 0; r < 16; ++r) { p0[r] = __builtin_amdgcn_exp2f(p0[r]); p1[r] = __builtin_amdgcn_exp2f(p1[r]); } \
        float sa = p0[0], sb = p0[1], sc = p1[0], sd = p1[1]; \
        _Pragma("unroll") \
        for (int r = 2; r < 16; r += 2) { sa += p0[r]; sb += p0[r + 1]; sc += p1[r]; sd += p1[r + 1]; } \
        lrun += (sa + sb) + (sc + sd); \
        bf16x8 pf[4]; \
        _Pragma("unroll") \
        for (int s2 = 0; s2 < 4; ++s2) { u32x4 t; \
            if (s2 < 2) { t.x = cvtpk(p0[8 * s2], p0[8 * s2 + 1]); t.y = cvtpk(p0[8 * s2 + 2], p0[8 * s2 + 3]); t.z = cvtpk(p0[8 * s2 + 4], p0[8 * s2 + 5]); t.w = cvtpk(p0[8 * s2 + 6], p0[8 * s2 + 7]); } \
            else { const int s = s2 - 2; t.x = cvtpk(p1[8 * s], p1[8 * s + 1]); t.y = cvtpk(p1[8 * s + 2], p1[8 * s + 3]); t.z = cvtpk(p1[8 * s + 4], p1[8 * s + 5]); t.w = cvtpk(p1[8 * s + 6], p1[8 * s + 7]); } \
            pf[s2] = __builtin_bit_cast(bf16x8, t); } \
        _Pragma("unroll") \
        for (int s2 = 0; s2 < 4; ++s2) { \
            const u32x4 va4 = {va[s2][0].x, va[s2][0].y, va[s2][1].x, va[s2][1].y}, vc4 = {vc[s2][0].x, vc[s2][0].y, vc[s2][1].x, vc[s2][1].y}; \
            o0 = MFMA32(__builtin_bit_cast(bf16x8, va4), pf[s2], o0); o1 = MFMA32(__builtin_bit_cast(bf16x8, vc4), pf[s2], o1); } \
    } while (0)
    for (int tp = 0; tp < np; tp += 2) {
        ATT_LOAD(knA, krA, vregA, min(tp + 2, np - 1));
        ATT_STEP(tp);
        if (tp + 1 < np) ATT_WRITE(knB, krB, vregB, 1);
        LDS_BARRIER();
        if (tp + 1 < np) {
            ATT_LOAD(knB, krB, vregB, min(tp + 3, np - 1));
            ATT_STEP(tp + 1);
            if (tp + 2 < np) ATT_WRITE(knA, krA, vregA, 0);
            LDS_BARRIER();
        }
    }
#undef ATT_STEP
#undef ATT_R
#undef ATT_LOAD
#undef ATT_WRITE
    lrun += __shfl_xor(lrun, 32);
    LAS float* mg = (LAS float*)(F.lds + 4 * TILEB);
    if (par == 1) { LAS float* d = mg + ((qs * 64 + lane) * 36);
#pragma unroll
        for (int r = 0; r < 16; r += 4) { *(LAS f32x4*)(d + r) = (f32x4){o0[r], o0[r + 1], o0[r + 2], o0[r + 3]}; *(LAS f32x4*)(d + 16 + r) = (f32x4){o1[r], o1[r + 1], o1[r + 2], o1[r + 3]}; }
        d[32] = mrun; d[33] = lrun; }
    __syncthreads();
    if (par == 0) { const LAS float* d = mg + ((qs * 64 + lane) * 36);
        const float m2 = d[32], l2 = d[33], mm = fmaxf(mrun, m2), a1 = __builtin_amdgcn_exp2f(mrun - mm), a2 = __builtin_amdgcn_exp2f(m2 - mm), inv = 1.f / (lrun * a1 + l2 * a2);
        const int qrow = q0 + 32 * qs + r32; bf16_t* op = CAT + (size_t)qrow * DM + 640 + h * 64;
#pragma unroll
        for (int g4 = 0; g4 < 4; ++g4) { const f32x4 e0 = *(const LAS f32x4*)(d + 4 * g4), e1 = *(const LAS f32x4*)(d + 16 + 4 * g4);
            float r0[4], r1[4];
#pragma unroll
            for (int r = 0; r < 4; ++r) { r0[r] = (o0[4 * g4 + r] * a1 + e0[r] * a2) * inv; r1[r] = (o1[4 * g4 + r] * a1 + e1[r] * a2) * inv; }
            u32x2 w0, w1; w0.x = cvtpk(r0[0], r0[1]); w0.y = cvtpk(r0[2], r0[3]); w1.x = cvtpk(r1[0], r1[1]); w1.y = cvtpk(r1[2], r1[3]);
            *(u32x2*)(op + 8 * g4 + 4 * hf) = w0; *(u32x2*)(op + 32 + 8 * g4 + 4 * hf) = w1; } }
    __syncthreads();
}
#ifndef MK_PER_PHASE
#define MK_PER_PHASE 0
#endif
constexpr int N_PHASES = 20;
struct Args { const float* in[32]; float* out; unsigned char* ws; int ph_lo, ph_hi; };
typedef __attribute__((address_space(4))) const Args CArgs;
#define GPF(k) ((const float*)(GAS const float*)ap_->in[k])

__global__ void __launch_bounds__(NTHR, 2) fwd_megakernel(Args args) {
    extern __shared__ __attribute__((aligned(16))) unsigned char lds_raw[];
    Frame F;
    F.sm = lds_raw; F.lds = (LAS unsigned char*)lds_raw;
    F.G = gridDim.x; { const int bx = blockIdx.x; F.vcu = (F.G % 8 == 0) ? (bx % 8) * (F.G / 8) + bx / 8 : bx; }
#define PHASE_BEGIN() do { int t_ = threadIdx.x; asm volatile("" : "+v"(t_)); t_ &= 511; F.tid = t_; F.lane = t_ & 63; F.wave = __builtin_amdgcn_readfirstlane(t_ >> 6); \
    CArgs* ap_ = (CArgs*)__builtin_amdgcn_kernarg_segment_ptr(); asm volatile("" : "+s"(ap_)); \
    F.x = GPF(0); F.c = GPF(1); F.ctx = GPF(2); F.c_ctx = GPF(3); F.w_mod = GPF(4); F.b_mod = GPF(5); F.g_mix = GPF(6); F.w_in = GPF(7); \
    F.w_sgu = GPF(8); F.b_sgu = GPF(9); F.g_sgu = GPF(10); F.beta_sgu = GPF(11); F.conv_w = GPF(12); F.conv_b = GPF(13); F.dt_bias = GPF(14); F.a_log = GPF(15); \
    F.d_skip = GPF(16); F.g_ssd = GPF(17); F.g_q = GPF(18); F.w_uq = GPF(19); F.g_kv = GPF(20); F.w_ukv = GPF(21); F.w_out = GPF(22); F.g_ffn = GPF(23); \
    F.w_gate = GPF(24); F.w_up = GPF(25); F.w_down = GPF(26); F.w_router = GPF(27); F.w_gate_e = GPF(28); F.w_up_e = GPF(29); F.w_down_e = GPF(30); F.g_final = GPF(31); \
    F.out = (float*)(GAS float*)ap_->out; F.ws = (unsigned char*)(GAS unsigned char*)ap_->ws; } while (0)
    PHASE_BEGIN();
    volatile LAS unsigned* MISC = (volatile LAS unsigned*)(F.lds + MISC_OFF);
    for (int u = F.tid; u < (LDS_BYTES - LDSCTL_OFF) / 4; u += NTHR) ((LAS unsigned*)(F.lds + LDSCTL_OFF))[u] = 0u;
    __syncthreads();
    XcdBarrier bar = xcd_barrier_post(WSP(unsigned, WS_CTL) + CW_BAR, MISC + 8, threadIdx.x == 0);
    { long pc0_; int clen_; asm volatile("mk_code_beg:\n\ts_getpc_b64 %0\n\ts_mov_b32 %1, mk_code_end - mk_code_beg" : "=s"(pc0_), "=s"(clen_));
      if (threadIdx.x == 0) { volatile LAS unsigned* cw = (volatile LAS unsigned*)(F.lds + LDSCTL_OFF + 960); cw[0] = (unsigned)pc0_; cw[1] = (unsigned)((unsigned long)pc0_ >> 32); cw[2] = (unsigned)clen_; }
      const int ln_ = ((int)blockIdx.x >> 3) * NTHR + (int)threadIdx.x; if (ln_ * 128 < clen_) (void)*(volatile const unsigned*)((const char*)pc0_ + (size_t)ln_ * 128); }
#ifndef WARM_AT
#define WARM_AT(k) 0
#endif
#define CODE_WARM() do { const volatile LAS unsigned* cw_ = (const volatile LAS unsigned*)(F.lds + LDSCTL_OFF + 960); const int ln_ = ((int)blockIdx.x >> 3) * NTHR + (int)threadIdx.x; \
    if (ln_ * 128 < (int)cw_[2]) { const char* cb_ = (const char*)(((unsigned long)cw_[1] << 32) | (unsigned long)cw_[0]); (void)*(volatile const unsigned*)(cb_ + (size_t)ln_ * 128); } } while (0)
#if MK_PER_PHASE
    const int lo = args.ph_lo, hi = args.ph_hi;
#else
    constexpr int lo = 0, hi = N_PHASES;
#endif
#ifndef PH_MASK
#define PH_MASK 0xFFFFFFFFu
#endif
#define PE(b) ((PH_MASK >> (b)) & 1u)
#ifndef REP_MASK
#define REP_MASK 0u
#endif
#ifndef SSD_DRY_LIMIT
#define SSD_DRY_LIMIT 0
#endif
#define NREP(b) (1 + (int)((REP_MASK >> (b)) & 1u))
#define IN(k) (lo <= (k) && (k) < hi)
#define SEAM(k) do { if (IN(k) && IN((k) + 1)) { if (WARM_AT(k)) CODE_WARM(); for (int rep_ = 0; rep_ < NREP(20); ++rep_) xcd_barrier(bar, threadIdx.x == 0); } } while (0)
#define XC WSP(float, WS_XC)
#define SSQ WSP(float, WS_SSQP)
#define ctl WSP(unsigned, WS_CTL)

    if (IN(0) && PE(0)) { for (int rep = 0; rep < NREP(0); ++rep) { PHASE_BEGIN(); p_prologue(F); } }
    SEAM(0);
#pragma unroll 1
    for (int l = 0; l < DEPTH; ++l) {
        const int pb = 1 + 9 * l;
#define modl (WSP(float, WS_MOD) + (size_t)l * 9 * 6144)
#define srcL (l == 0 ? F.x : (const float*)F.out)
#define srcC (l == 0 ? F.ctx : (const float*)XC)
        if (IN(pb + 0) && PE(1)) for (int rep = 0; rep < NREP(1); ++rep) { PHASE_BEGIN(); p_norm<false>(F, l, 0, MT, srcL, srcC, l == 1 ? WSP(float, WS_SLAB) : nullptr, WSP(float, WS_MOD) + (size_t)8 * 6144 + 5 * DM); }
        SEAM(pb + 0);
        if (IN(pb + 1) && PE(2)) for (int rep = 0; rep < NREP(2); ++rep) {
            PHASE_BEGIN();
            pg8::Gemm g{WSP(bf16_t, WS_H), WSP(bf16_t, WS_WIN) + (size_t)l * INP * DM, DM, DM, 0};
            pg8::StaticOrder S; S.init(MT, INP, F.G, (int)blockIdx.x);
            pg8::EpiInProj E{WSP(bf16_t, WS_P), SSQ, rep < NREP(2) - 1};
            pg8::gemm_phase<pg8::EpiInProj, pg8::StaticOrder, true, false>(F.lds, F.tid, g, S, E);
        }
        SEAM(pb + 1);
        if (IN(pb + 2)) {
            if (PE(3)) for (int rep = 0; rep < NREP(3); ++rep) { PHASE_BEGIN(); pg8::Gemm g{WSP(bf16_t, WS_P) + PC_CQ, WSP(bf16_t, WS_WUQ) + (size_t)l * QWP * 384, INP, 384, 0};
              pg8::StaticOrder S; S.init(l == 0 ? MT : NLAT, QWP, F.G, l == 0 ? (int)blockIdx.x : (int)((blockIdx.x + 136u) % (unsigned)F.G));
              pg8::EpiScaleBf16 E{WSP(bf16_t, WS_Q), QW, QW, SSQ, 0, 1.f / 384.f, QSCALE};
              pg8::gemm_phase<pg8::EpiScaleBf16, pg8::StaticOrder, true, false>(F.lds, F.tid, g, S, E); }
            if (PE(4)) for (int rep = 0; rep < NREP(4); ++rep) { PHASE_BEGIN(); pg8::Gemm g{WSP(bf16_t, WS_P) + PC_CKV, WSP(bf16_t, WS_WUKV) + (size_t)l * KVW * 256, INP, 256, 0};
              pg8::StaticOrder S; S.init(MT, KVW, F.G, (int)((blockIdx.x + 128u) % (unsigned)F.G));
              pg8::EpiScaleBf16 E{WSP(bf16_t, WS_KV), KVW, KVW, SSQ, 1, 1.f / 256.f, 1.f};
              pg8::gemm_phase<pg8::EpiScaleBf16, pg8::StaticOrder, true, false>(F.lds, F.tid, g, S, E);
              build_vt_own(F, S); }
            if (PE(5)) for (int rep = 0; rep < NREP(5); ++rep) { PHASE_BEGIN();
                for (int k = 0; k < 2; ++k) {
                    const int bx_ = (int)blockIdx.x; int u;
                    if (F.G == 256) u = k == 0 ? F.vcu : ((bx_ >= 88 && bx_ < 120) ? 256 + bx_ - 88 : -1); else u = F.vcu + k * F.G;
                    if (u >= 0 && u < 288) ssd_local_unit(F, l, u); } }
            if (PE(6)) { PHASE_BEGIN(); for (int u = F.vcu; u < 144; u += F.G) krope_unit(F, u); }
            if (PE(6) && !(l == 1 && F.G == 256)) for (int rep = 0; rep < NREP(6); ++rep) { PHASE_BEGIN();
                const int bx_ = (int)blockIdx.x;
                if (F.G == 256) { const int u = bx_ >= 120 ? bx_ - 120 : (bx_ < 8 ? 136 + bx_ : -1); if (u >= 0 && u < 144) sgu_unit(F, l, u); }
                else { for (int u = F.G - 1 - F.vcu; u < 144; u += F.G) sgu_unit(F, l, u); } }
        }
        SEAM(pb + 2);
        if (IN(pb + 3)) {
            if (PE(5)) { PHASE_BEGIN(); ssd_scan(F); }
        }
        SEAM(pb + 3);
        if (IN(pb + 4)) {
            const int nat = l == 0 ? 864 : 768, nsf = l == 0 ? 144 : 128;
            if (PE(7)) for (int rep = 0; rep < NREP(7); ++rep) { PHASE_BEGIN(); for (int u = F.vcu; u < nat; u += F.G) attn_unit(F, u); }
            if (PE(8)) for (int rep = 0; rep < NREP(8); ++rep) { PHASE_BEGIN(); for (int u = F.G - 1 - F.vcu; u < nsf; u += F.G) ssd_final_unit(F, l, u); }
            if (PE(6) && l == 1 && F.G == 256) { PHASE_BEGIN();
                if (F.vcu < 128) sgu_unit(F, l, F.vcu); }
        }
        SEAM(pb + 4);
        if (IN(pb + 5) && PE(9)) {
          for (int rep = 0; rep < NREP(9); ++rep) {
            PHASE_BEGIN();
            pg8::Gemm g{WSP(bf16_t, WS_CAT), WSP(bf16_t, WS_WOUT) + (size_t)l * DM * DM, DM, DM, 0};
            pg8::StaticOrder S; S.init(l == 0 ? MT : NLAT, DM, F.G, (int)blockIdx.x);
            pg8::EpiResid E{srcL, srcC, F.out, XC, modl, 2, rep < NREP(9) - 1, nullptr};
            pg8::gemm_phase<pg8::EpiResid, pg8::StaticOrder, true, false>(F.lds, F.tid, g, S, E);
            if (l == 0 && rep == NREP(9) - 1) { PHASE_BEGIN(); int wi_, nw_; if (tail_worker(MT / 256 * (DM / 256), F.G, (int)blockIdx.x, wi_, nw_)) { for (int set_ = 2; set_ < 4; ++set_) convert_set(F, set_, wi_, nw_); mod_gemv(F, 1, wi_, nw_); } }
          }
            if (l == 1 && PE(10)) for (int rep = 0; rep < NREP(10); ++rep) { PHASE_BEGIN(); p_moe_weights(F); }
        }
        SEAM(pb + 5);
        if (IN(pb + 6) && PE(11)) { PHASE_BEGIN(); if (l == 0) { for (int rep = 0; rep < NREP(11); ++rep) p_norm<false>(F, l, 1, MT, F.out, XC); } else p_norm<true>(F, l, 1, NLAT, F.out, XC); }
        SEAM(pb + 6);
        if (IN(pb + 7)) {
            if (l == 0 && PE(12)) for (int rep = 0; rep < NREP(12); ++rep) {
                PHASE_BEGIN();
                pg8::Gemm g{WSP(bf16_t, WS_H), WSP(bf16_t, WS_WGU), DM, DM, 0};
                pg8::StaticOrder S; S.init(MT, 2 * DFF, F.G, (int)blockIdx.x);
                pg8::EpiSwiglu E{WSP(bf16_t, WS_ACT), DFF};
                pg8::gemm_phase<pg8::EpiSwiglu, pg8::StaticOrder, true, false>(F.lds, F.tid, g, S, E);
            } else if (l == 1 && PE(13)) for (int rep = 0; rep < NREP(13); ++rep) {
                PHASE_BEGIN();
                pg8::Gemm g{WSP(bf16_t, WS_H), WSP(bf16_t, WS_MOEW_GU), DM, DM, (size_t)2 * DFE * DM};
                pg8::MoeOrder S; S.init(ctl + CW_CNT, 11, F.G, (int)blockIdx.x, WSP(int, WS_LIST), true);
                pg8::EpiSwiglu E{WSP(bf16_t, WS_MACT), DFE};
                pg8::gemm_phase<pg8::EpiSwiglu, pg8::MoeOrder, true, true>(F.lds, F.tid, g, S, E);
            }
        }
        SEAM(pb + 7);
        if (IN(pb + 8)) {
            if (l == 0 && PE(14)) for (int rep = 0; rep < NREP(14); ++rep) {
                PHASE_BEGIN();
                pg8::Gemm g{WSP(bf16_t, WS_ACT), WSP(bf16_t, WS_WD), DFF, DFF, 0};
                pg8::DownSplitOrder S; S.init(F.G, (int)blockIdx.x);
                pg8::EpiResid E{F.out, XC, F.out, XC, modl, 5, rep < NREP(14) - 1, WSP(float, WS_SLAB)};
                pg8::gemm_phase<pg8::EpiResid, pg8::DownSplitOrder, true, false, true>(F.lds, F.tid, g, S, E);
            } else if (l == 1 && PE(15)) for (int rep = 0; rep < NREP(15); ++rep) {
                PHASE_BEGIN();
                pg8::Gemm g{WSP(bf16_t, WS_MACT), WSP(bf16_t, WS_MOEW_D), DFE, DFE, (size_t)DM * DFE};
                pg8::MoeOrder S; S.init(ctl + CW_CNT, 4, F.G, (int)blockIdx.x, WSP(int, WS_LIST), false);
                pg8::EpiMoeDown E{WSP(bf16_t, WS_Y), WSP(int, WS_LIST), WSP(float, WS_MISC + MISC_TOPW), S};
                pg8::gemm_phase<pg8::EpiMoeDown, pg8::MoeOrder, true, false>(F.lds, F.tid, g, S, E);
            }
        }
        SEAM(pb + 8);
    }
    if (IN(19) && PE(16)) { PHASE_BEGIN(); p_final(F); }
#undef IN
#undef SEAM
#undef XC
#undef SSQ
#undef ctl
#undef modl
#undef srcL
#undef srcC
#undef PHASE_BEGIN
    asm volatile("mk_code_end:");
}

extern "C" void kernel_launch(void* const* d_in, const int* in_sizes, int n_in, void* d_out, int out_size, void* d_ws, size_t ws_size, hipStream_t stream) {
    static int grid = 0;
    if (grid == 0) {
        if (n_in != 32 || out_size != NLAT * DM || ws_size < WS_END) { fprintf(stderr, "kernel_launch: unexpected shapes (n_in %d, out %d, ws %zu); nothing launched\n", n_in, out_size, ws_size); grid = -1; return; }
        int dev = 0, cus = 0, per_cu = 0;
        if (hipGetDevice(&dev) != hipSuccess || hipDeviceGetAttribute(&cus, hipDeviceAttributeMultiprocessorCount, dev) != hipSuccess) { grid = -1; return; }
        if (hipFuncSetAttribute((const void*)fwd_megakernel, hipFuncAttributeMaxDynamicSharedMemorySize, LDS_BYTES) != hipSuccess) { fprintf(stderr, "kernel_launch: hipFuncSetAttribute failed\n"); grid = -1; return; }
        if (hipOccupancyMaxActiveBlocksPerMultiprocessor(&per_cu, (const void*)fwd_megakernel, NTHR, LDS_BYTES) != hipSuccess || per_cu < 1) { fprintf(stderr, "kernel_launch: occupancy query says %d blocks/CU\n", per_cu); (void)hipGetLastError(); grid = -1; return; }
        grid = cus;
    }
    if (grid < 0) return;
    (void)hipMemsetAsync((char*)d_ws + WS_CTL, 0, CTL_BYTES, stream);
    Args a{};
    for (int i = 0; i < 32; ++i) a.in[i] = (const float*)d_in[i];
    a.out = (float*)d_out; a.ws = (unsigned char*)d_ws;
#if MK_PER_PHASE
    for (int k = 0; k < N_PHASES; ++k) { a.ph_lo = k; a.ph_hi = k + 1; hipLaunchKernelGGL(fwd_megakernel, dim3(grid), dim3(NTHR), LDS_BYTES, stream, a); }
#else
    a.ph_lo = 0; a.ph_hi = N_PHASES;
    void* kargs[] = {&a};
    hipError_t e = hipLaunchCooperativeKernel((const void*)fwd_megakernel, dim3(grid), dim3(NTHR), kargs, LDS_BYTES, stream);
    if (e != hipSuccess) fprintf(stderr, "kernel_launch: cooperative launch failed: %s (grid %d)\n", hipGetErrorString(e), grid);
#endif
}
```

```cpp
#include <hip/hip_runtime.h>
#include <cstdio>
#include <cstdint>

#define LAS __attribute__((address_space(3)))
#define GAS __attribute__((address_space(1)))
typedef unsigned short bf16_t;
typedef short bf16x8 __attribute__((ext_vector_type(8)));
typedef float f32x4 __attribute__((ext_vector_type(4)));
typedef float f32x16 __attribute__((ext_vector_type(16)));
typedef float f32x2 __attribute__((ext_vector_type(2)));
typedef unsigned u32x4 __attribute__((ext_vector_type(4)));
typedef unsigned u32x2 __attribute__((ext_vector_type(2)));
typedef __bf16 bf16x2_t __attribute__((ext_vector_type(2)));

constexpr int BATCH = 8, SEQ = 2048, DM = 1024, CTXL = 256, DEPTH = 2;
constexpr int NLAT = BATCH * SEQ, NCTX = BATCH * CTXL, MT = NLAT + NCTX;
constexpr int INW = 2476, INP = 2560;
constexpr int PC_U = 0, PC_V = 256, PC_Z = 512, PC_X = 896, PC_B = 1280, PC_C = 1536, PC_CQ = 1792, PC_CKV = 2176, PC_KR = 2432, PC_DT = 2464;
constexpr int DFF = 2816, NEXP = 8, DFE = 1408;
constexpr int QW = 576, QWP = 768, KVW = 768;
constexpr float EPS = 1e-6f;
constexpr float QSCALE = 0.10206207261596577f * 1.4426950408889634f;
constexpr int NPOS = 18;

constexpr size_t MiB = 1u << 20;
constexpr size_t WS_CTL = 0, CTL_BYTES = 64 * 1024;
constexpr size_t WS_MOD = 1 * MiB;
constexpr size_t WS_ACS = 2 * MiB;
constexpr size_t WS_MISC = 3 * MiB;
constexpr size_t WS_LIST = 4 * MiB;
constexpr size_t WS_WSGU = 5 * MiB;
constexpr size_t WS_WIN = 6 * MiB;
constexpr size_t WS_WUQ = 16 * MiB;
constexpr size_t WS_WUKV = 18 * MiB;
constexpr size_t WS_WOUT = 19 * MiB;
constexpr size_t WS_WGU = 23 * MiB;
constexpr size_t WS_WD = 34 * MiB;
constexpr size_t WS_XC = 40 * MiB;
constexpr size_t WS_H = 48 * MiB;
constexpr size_t WS_Q = 48 * MiB;
constexpr size_t WS_KR = 70 * MiB;
constexpr size_t WS_P = 84 * MiB;
constexpr size_t WS_CAT = 174 * MiB;
constexpr size_t WS_KV = 210 * MiB;
constexpr size_t WS_CC = 237 * MiB;
constexpr size_t WS_YP = 246 * MiB;
constexpr size_t WS_ST = 273 * MiB;
constexpr size_t WS_ACT = 84 * MiB;
constexpr size_t WS_MOEW_GU = 84 * MiB;
constexpr size_t WS_MOEW_D = 128 * MiB;
constexpr size_t WS_MACT = 150 * MiB;
constexpr size_t WS_Y = 244 * MiB;
constexpr size_t WS_SSQP = 300 * MiB;
constexpr size_t WS_VT = 302 * MiB;
constexpr size_t WS_SLAB = 200 * MiB;
constexpr size_t WS_END = 316 * MiB;
constexpr size_t MISC_SSQ = 0, MISC_DEC = 256 * 1024, MISC_ROPE = 320 * 1024, MISC_TOPW = 384 * 1024;
constexpr int CW_CNT = 64;
constexpr int CW_BAR = 4096;

__device__ __forceinline__ unsigned cvtpk(float lo, float hi) { f32x2 v = {lo, hi}; bf16x2_t b = __builtin_convertvector(v, bf16x2_t); return __builtin_bit_cast(unsigned, b); }
__device__ __forceinline__ float bflo(unsigned u) { return __uint_as_float(u << 16); }
__device__ __forceinline__ float bfhi(unsigned u) { return __uint_as_float(u & 0xffff0000u); }
__device__ __forceinline__ float bf1(bf16_t h) { return __uint_as_float((unsigned)h << 16); }
__device__ __forceinline__ bf16_t f2bf(float f) { return (bf16_t)(cvtpk(f, 0.f) & 0xffffu); }
__device__ __forceinline__ float wave_sum(float v) {
#pragma unroll
    for (int o = 1; o < 64; o <<= 1) v += __shfl_xor(v, o);
    return v;
}
__device__ __forceinline__ float silu_f(float x) { return x * __builtin_amdgcn_rcpf(1.f + __expf(-x)); }
__device__ __forceinline__ float gelu_tanh(float x) { const float u = 0.7978845608028654f * (x + 0.044715f * x * x * x); const float t = 1.f - 2.f * __builtin_amdgcn_rcpf(1.f + __expf(2.f * u)); return 0.5f * x * (1.f + t); }
__device__ __forceinline__ float softplus_f(float x) { return x > 20.f ? x : log1pf(__expf(x)); }
#define LDS_WAIT() asm volatile("s_waitcnt lgkmcnt(0)" ::: "memory")
#define LDS_BARRIER() asm volatile("s_waitcnt lgkmcnt(0)\n\ts_barrier" ::: "memory")
#define MFMA16(a, b, c) __builtin_amdgcn_mfma_f32_16x16x32_bf16((a), (b), (c), 0, 0, 0)
#define MFMA32(a, b, c) __builtin_amdgcn_mfma_f32_32x32x16_bf16((a), (b), (c), 0, 0, 0)

namespace pg8 {
constexpr int BM = 256, BK = 64, HALF = 128, HTB = HALF * BK * 2, STAGE_BYTES = 8 * HTB, NXCD = 8, WGM = 8;
__host__ __device__ __forceinline__ int lds_byte(int r, int c) { const int st = (r >> 4) * 2 + (c >> 5), rr = r & 15, cc = c & 31, ob = rr * 64 + cc * 2; return st * 1024 + (ob ^ (((ob >> 9) & 1) << 5)); }
__host__ __device__ __forceinline__ void stage_rc(int b, int& R, int& C) { const int st = b / 1024, sb = b % 1024, swz = sb ^ (((sb >> 9) & 1) << 5); R = (st >> 1) * 16 + swz / 64; C = (st & 1) * 32 + (swz % 64) / 2; }
__host__ __device__ __forceinline__ int perm32(int rho) { const int n = rho >> 4, i = rho & 15; return 8 * (i >> 2) + 4 * n + (i & 3); }

struct Unit { int pm, pn, e, kt0, nkt; };
struct Gemm { const bf16_t* A; const bf16_t* Bt; int lda; int K; size_t bstride_e; };

struct StaticOrder {
    int nM, nN, nwg, G, c;
    __device__ void init(int M, int N, int G_, int c_) { nM = M / BM; nN = N / BM; nwg = nM * nN; G = G_; c = c_; }
    __device__ bool next(int i, Unit& u) const {
        const long L = (long)i * G + c; if (L >= nwg) return false;
        int wgid = (int)L; { const int q = nwg / NXCD, r = nwg % NXCD, xcd = wgid % NXCD, off = wgid / NXCD; wgid = (xcd < r ? xcd * (q + 1) : r * (q + 1) + (xcd - r) * q) + off; }
        const int nig = WGM * nN, gid = wgid / nig, fm = gid * WGM, gsz = (nM - fm) < WGM ? (nM - fm) : WGM;
        u.pm = fm + ((wgid % nig) % gsz); u.pn = (wgid % nig) / gsz; u.e = 0; return true;
    }
    __device__ __forceinline__ int arow(const Unit& u, int r) const { return u.pm * BM + r; }
};

template <class Epi, class Sched, bool ALIGN_EPI, bool GATHER, bool KSPLIT = false>
__device__ __forceinline__ void gemm_phase(LAS unsigned char* lds, const int tid, const Gemm g, const Sched& S, const Epi& E) {
    const int wid = __builtin_amdgcn_readfirstlane(tid >> 6), lane = tid & 63, wr = wid >> 2, wc = wid & 3, fr = lane & 15, fq = lane >> 4;
    const int K = g.K; int nt = K / BK;
    int Rr[2], Cc[2]; unsigned voffA[2], voffB[2];
#pragma unroll
    for (int i = 0; i < 2; ++i) { int R, C; stage_rc(tid * 16 + i * 8192, R, C); Rr[i] = R; Cc[i] = C; const int Rb = Epi::PERM ? ((R & ~31) + perm32(R & 31)) : R;
        voffA[i] = (unsigned)(R * g.lda + C) * 2u; voffB[i] = (unsigned)(Rb * K + C) * 2u; }
    const size_t kstep = (size_t)(BK * 2);
    const size_t hstepB = (size_t)HALF * K * 2, tstepB = 2 * hstepB;
    const size_t hstepA = (size_t)HALF * g.lda * 2, tstepA = 2 * hstepA;
    const unsigned ldsw = (unsigned)wid * 1024u;
    const int aoff = lds_byte(wr * 64 + fr, fq * 8), boff = lds_byte(wc * 32 + fr, fq * 8);
    const char* const Abase = (const char*)g.A;
#define PG8_SA(b, h) (((b) * 2 + (h)) * HTB)
#define PG8_SB(b, h) ((4 + (b) * 2 + (h)) * HTB)
#define PG8_GL(gp, off) __builtin_amdgcn_global_load_lds((const unsigned*)(gp), (LAS unsigned*)(lds + (off)), 16, 0, 0)
#define PG8_STAGE_B(bufoff, gbase) do { PG8_GL((const char*)(gbase) + voffB[0], (bufoff) + ldsw); PG8_GL((const char*)(gbase) + voffB[1], (bufoff) + ldsw + 8192); } while (0)
#define PG8_STAGE_A_CUR(bufoff, kt, h) do { if constexpr (GATHER) { const char* _p = Abase + (size_t)(kt) * kstep; PG8_GL(_p + ((h) ? c10 : c00), (bufoff) + ldsw); PG8_GL(_p + ((h) ? c11 : c01), (bufoff) + ldsw + 8192); } \
        else { const char* _p = cA + (size_t)(kt) * kstep + (h) * hstepA; PG8_GL(_p + voffA[0], (bufoff) + ldsw); PG8_GL(_p + voffA[1], (bufoff) + ldsw + 8192); } } while (0)
#define PG8_STAGE_A_SEL(bufoff, kt, h) do { if constexpr (GATHER) { const char* _p = Abase + (size_t)(kt) * kstep; PG8_GL(_p + ((h) ? x10 : x00), (bufoff) + ldsw); PG8_GL(_p + ((h) ? x11 : x01), (bufoff) + ldsw + 8192); } \
        else { const char* _p = xA + (size_t)(kt) * kstep + (h) * hstepA; PG8_GL(_p + voffA[0], (bufoff) + ldsw); PG8_GL(_p + voffA[1], (bufoff) + ldsw + 8192); } } while (0)
#define PG8_LDA(dst, b, h) do { _Pragma("unroll") for (int m = 0; m < 4; ++m) _Pragma("unroll") for (int k = 0; k < 2; ++k) dst[m][k] = *(const LAS bf16x8*)(lds + PG8_SA(b, h) + aoff + m * 2048 + k * 1024); } while (0)
#define PG8_LDB(dst, b, h) do { _Pragma("unroll") for (int n = 0; n < 2; ++n) _Pragma("unroll") for (int k = 0; k < 2; ++k) dst[n][k] = *(const LAS bf16x8*)(lds + PG8_SB(b, h) + boff + n * 2048 + k * 1024); } while (0)
#define PG8_MMA(ai, bj, At, Bt) do { __builtin_amdgcn_s_setprio(1); _Pragma("unroll") for (int m = 0; m < 4; ++m) _Pragma("unroll") for (int n = 0; n < 2; ++n) _Pragma("unroll") for (int k = 0; k < 2; ++k) \
        acc[ai][bj][m][n] = __builtin_amdgcn_mfma_f32_16x16x32_bf16(Bt[n][k], At[m][k], acc[ai][bj][m][n], 0, 0, 0); __builtin_amdgcn_s_setprio(0); } while (0)
#define PG8_WAIT_V(n) asm volatile("s_waitcnt vmcnt(" #n ")" ::: "memory")
#define PG8_WAIT_L(n) asm volatile("s_waitcnt lgkmcnt(" #n ")" ::: "memory")
#define PG8_BAR __builtin_amdgcn_s_barrier()
#define PG8_SCHED __builtin_amdgcn_sched_barrier(0)
#define PG8_AOFFS(u, o00, o01, o10, o11) do { if constexpr (GATHER) { \
        o00 = (unsigned)(((size_t)S.arow(u, Rr[0]) * g.lda + Cc[0]) * 2); o01 = (unsigned)(((size_t)S.arow(u, Rr[1]) * g.lda + Cc[1]) * 2); \
        o10 = (unsigned)(((size_t)S.arow(u, HALF + Rr[0]) * g.lda + Cc[0]) * 2); o11 = (unsigned)(((size_t)S.arow(u, HALF + Rr[1]) * g.lda + Cc[1]) * 2); } } while (0)
    Unit cur, nxt; int ui = 0;
    if (!S.next(0, cur)) return;
    f32x4 acc[2][2][4][2];
#pragma unroll
    for (int a = 0; a < 2; ++a)
#pragma unroll
        for (int b = 0; b < 2; ++b)
#pragma unroll
            for (int m = 0; m < 4; ++m)
#pragma unroll
                for (int n = 0; n < 2; ++n) acc[a][b][m][n] = (f32x4){0.f, 0.f, 0.f, 0.f};
    bf16x8 At[4][2], B0[2][2], B1[2][2];
    unsigned c00 = 0, c01 = 0, c10 = 0, c11 = 0, n00 = 0, n01 = 0, n10 = 0, n11 = 0;
    PG8_AOFFS(cur, c00, c01, c10, c11);
    const char* cA = Abase + (size_t)cur.pm * tstepA;
    const char* cB = (const char*)g.Bt + ((size_t)cur.e * g.bstride_e) * 2 + (size_t)cur.pn * tstepB;
    if constexpr (KSPLIT) { cA += (size_t)cur.kt0 * kstep; cB += (size_t)cur.kt0 * kstep; nt = cur.nkt; }
    PG8_STAGE_B(PG8_SB(0, 0), cB); PG8_STAGE_B(PG8_SB(0, 1), cB + hstepB); PG8_STAGE_A_CUR(PG8_SA(0, 0), 0, 0); PG8_STAGE_A_CUR(PG8_SA(0, 1), 0, 1);
    if (wr == 1) PG8_BAR;
    PG8_WAIT_V(2); PG8_BAR;
    PG8_STAGE_B(PG8_SB(1, 0), cB + kstep); PG8_STAGE_A_CUR(PG8_SA(1, 0), 1, 0); PG8_STAGE_B(PG8_SB(1, 1), cB + hstepB + kstep);
    PG8_WAIT_V(6); PG8_BAR;
    for (;;) {
        const bool has_next = S.next(ui + 1, nxt);
        const char* nB = cB; const char* nA = cA;
        if (has_next) { PG8_AOFFS(nxt, n00, n01, n10, n11); nA = Abase + (size_t)nxt.pm * tstepA; nB = (const char*)g.Bt + ((size_t)nxt.e * g.bstride_e) * 2 + (size_t)nxt.pn * tstepB;
            if constexpr (KSPLIT) { nA += (size_t)nxt.kt0 * kstep; nB += (size_t)nxt.kt0 * kstep; } }
        else { n00 = c00; n01 = c01; n10 = c10; n11 = c11; }
#pragma unroll 1
        for (int t = 0; t < nt; t += 2) {
            const bool last = (t == nt - 2);
            const int kt2 = last ? 0 : t + 2, kt3 = kt2 + 1;
            const unsigned x00 = last ? n00 : c00, x01 = last ? n01 : c01, x10 = last ? n10 : c10, x11 = last ? n11 : c11;
            const char* xA = last ? nA : cA;
            const char* b2 = last ? nB : cB + (size_t)(t + 2) * kstep; const char* b3 = b2 + kstep;
            (void)x00; (void)x01; (void)x10; (void)x11; (void)xA;
            PG8_LDB(B0, 0, 0); PG8_LDB(B1, 0, 1); PG8_SCHED; PG8_LDA(At, 0, 0); PG8_STAGE_A_CUR(PG8_SA(1, 1), t + 1, 1);
            PG8_WAIT_V(8); PG8_WAIT_L(0); PG8_BAR; PG8_MMA(0, 0, At, B0); PG8_MMA(0, 1, At, B1); PG8_BAR; PG8_SCHED;
            PG8_LDA(At, 0, 1); PG8_STAGE_B(PG8_SB(0, 0), b2); PG8_STAGE_B(PG8_SB(0, 1), b2 + hstepB); PG8_STAGE_A_SEL(PG8_SA(0, 0), kt2, 0);
            PG8_WAIT_V(8); PG8_WAIT_L(0); PG8_BAR; PG8_MMA(1, 0, At, B0); PG8_MMA(1, 1, At, B1); PG8_BAR; PG8_SCHED;
            PG8_LDB(B0, 1, 0); PG8_LDB(B1, 1, 1); PG8_SCHED; PG8_LDA(At, 1, 0); PG8_STAGE_A_SEL(PG8_SA(0, 1), kt2, 1);
            PG8_WAIT_V(8); PG8_WAIT_L(0); PG8_BAR; PG8_MMA(0, 0, At, B0); PG8_MMA(0, 1, At, B1); PG8_BAR; PG8_SCHED;
            PG8_LDA(At, 1, 1); PG8_STAGE_B(PG8_SB(1, 0), b3); PG8_STAGE_B(PG8_SB(1, 1), b3 + hstepB); PG8_STAGE_A_SEL(PG8_SA(1, 0), kt3, 0);
            PG8_WAIT_V(8); PG8_WAIT_L(0); PG8_BAR; PG8_MMA(1, 0, At, B0); PG8_MMA(1, 1, At, B1); PG8_BAR; PG8_SCHED;
        }
        if constexpr (ALIGN_EPI) { if (wr == 0) PG8_BAR; }
        E(acc, cur, wr, wc, fr, fq);
        if (!has_next) break;
#pragma unroll
        for (int a = 0; a < 2; ++a)
#pragma unroll
            for (int b = 0; b < 2; ++b)
#pragma unroll
                for (int m = 0; m < 4; ++m)
#pragma unroll
                    for (int n = 0; n < 2; ++n) acc[a][b][m][n] = (f32x4){0.f, 0.f, 0.f, 0.f};
        cur = nxt; cA = nA; cB = nB; c00 = n00; c01 = n01; c10 = n10; c11 = n11; ++ui;
        if constexpr (KSPLIT) nt = cur.nkt;
        if constexpr (ALIGN_EPI) { if (wr == 1) PG8_BAR; }
    }
    PG8_WAIT_V(0);
    if constexpr (!ALIGN_EPI) { if (wr == 0) PG8_BAR; }
    PG8_BAR;
#undef PG8_SA
#undef PG8_SB
#undef PG8_GL
#undef PG8_STAGE_A_CUR
#undef PG8_STAGE_A_SEL
#undef PG8_STAGE_B
#undef PG8_LDA
#undef PG8_LDB
#undef PG8_MMA
#undef PG8_WAIT_V
#undef PG8_WAIT_L
#undef PG8_BAR
#undef PG8_SCHED
#undef PG8_AOFFS
}
}
namespace pg8 {
struct EpiInProj {
    static constexpr bool PERM = true;
    bf16_t* O; float* ssq; bool dry;
    __device__ __forceinline__ void operator()(const f32x4 (&acc)[2][2][4][2], const Unit& u, int wr, int wc, int fr, int fq) const {
        if (dry) return;
        const int row0 = u.pm * BM + wr * 64 + fr, col0 = u.pn * BM + wc * 32 + 8 * fq;
#pragma unroll
        for (int ai = 0; ai < 2; ++ai)
#pragma unroll
            for (int m = 0; m < 4; ++m) { const int row = row0 + ai * HALF + m * 16; bf16_t* rowp = O + (size_t)row * INP + col0;
                float sq = 0.f, sk = 0.f;
#pragma unroll
                for (int bj = 0; bj < 2; ++bj) { const f32x4 v0 = acc[ai][bj][m][0], v1 = acc[ai][bj][m][1];
                    u32x4 w; w.x = cvtpk(v0[0], v0[1]); w.y = cvtpk(v0[2], v0[3]); w.z = cvtpk(v1[0], v1[1]); w.w = cvtpk(v1[2], v1[3]);
                    *(u32x4*)(rowp + bj * HALF) = w;
                    const int hidx = 2 * u.pn + bj;
                    const float s = (v0[0] * v0[0] + v0[1] * v0[1]) + (v0[2] * v0[2] + v0[3] * v0[3]) + (v1[0] * v1[0] + v1[1] * v1[1]) + (v1[2] * v1[2] + v1[3] * v1[3]);
                    if (hidx >= 14 && hidx <= 16) sq += s;
                    if (hidx >= 17 && hidx <= 18) sk += s; }
                if (u.pn >= 7 && u.pn <= 9) {
                    sq += __shfl_xor(sq, 16); sq += __shfl_xor(sq, 32); sk += __shfl_xor(sk, 16); sk += __shfl_xor(sk, 32);
                    if (fq == 0) { float* sp = ssq + (size_t)row * 16;
                        if (u.pn == 7) sp[wc] = sq; if (u.pn == 8) { sp[4 + wc] = sq; sp[8 + wc] = sk; } if (u.pn == 9) sp[12 + wc] = sk; } } }
    }
};
struct EpiScaleBf16 {
    static constexpr bool PERM = true;
    bf16_t* O; int ldc, ncols; const float* ssq; int idx; float invn, mul;
    __device__ __forceinline__ void operator()(const f32x4 (&acc)[2][2][4][2], const Unit& u, int wr, int wc, int fr, int fq) const {
        const int row0 = u.pm * BM + wr * 64 + fr, col0 = u.pn * BM + wc * 32 + 8 * fq;
#pragma unroll
        for (int ai = 0; ai < 2; ++ai) {
            float scv[4];
#pragma unroll
            for (int m = 0; m < 4; ++m) { const int row = row0 + ai * HALF + m * 16;
                const f32x4 pa = *(const f32x4*)(ssq + (size_t)row * 16 + 8 * idx), pb = *(const f32x4*)(ssq + (size_t)row * 16 + 8 * idx + 4);
                scv[m] = rsqrtf((((pa[0] + pa[1]) + (pa[2] + pa[3])) + ((pb[0] + pb[1]) + (pb[2] + pb[3]))) * invn + EPS) * mul; }
            asm volatile("" ::: "memory");
#pragma unroll
            for (int m = 0; m < 4; ++m) { const int row = row0 + ai * HALF + m * 16; bf16_t* rowp = O + (size_t)row * ldc + col0;
                const float sc = scv[m];
#pragma unroll
                for (int bj = 0; bj < 2; ++bj) if (col0 + bj * HALF < ncols) { const f32x4 v0 = acc[ai][bj][m][0] * sc, v1 = acc[ai][bj][m][1] * sc;
                    u32x4 w; w.x = cvtpk(v0[0], v0[1]); w.y = cvtpk(v0[2], v0[3]); w.z = cvtpk(v1[0], v1[1]); w.w = cvtpk(v1[2], v1[3]);
                    *(u32x4*)(rowp + bj * HALF) = w; } } }
    }
};
struct EpiResid {
    static constexpr bool PERM = false;
    const float* oldL; const float* oldC; float* newL; float* newC; const float* mod; int gi; bool dry; float* slab;
    __device__ __forceinline__ void operator()(const f32x4 (&acc)[2][2][4][2], const Unit& u, int wr, int wc, int fr, int fq) const {
        if (dry) return;
        if (slab && u.e > 0) {
            float* sp = slab + ((size_t)(u.e - 1) * NCTX + (u.pm * BM - NLAT) + wr * 64 + fr) * DM + u.pn * BM + wc * 32 + 4 * fq;
#pragma unroll
            for (int ai = 0; ai < 2; ++ai)
#pragma unroll
                for (int m = 0; m < 4; ++m)
#pragma unroll
                    for (int bj = 0; bj < 2; ++bj)
#pragma unroll
                        for (int n = 0; n < 2; ++n) *(f32x4*)(sp + (size_t)(ai * HALF + m * 16) * DM + bj * HALF + n * 16) = acc[ai][bj][m][n];
            return; }
        const int rbase = u.pm * BM; const bool isc = rbase >= NLAT; const int b = isc ? 8 : (rbase >> 11);
        const float* xo = isc ? oldC - (size_t)NLAT * DM : oldL; float* xn = isc ? newC - (size_t)NLAT * DM : newL;
        const int row0 = rbase + wr * 64 + fr, col0 = u.pn * BM + wc * 32 + 4 * fq;
        const float* gp = mod + (size_t)b * 6144 + gi * DM + col0;
        f32x4 gv[2][2];
#pragma unroll
        for (int bj = 0; bj < 2; ++bj)
#pragma unroll
            for (int n = 0; n < 2; ++n) gv[bj][n] = *(const f32x4*)(gp + bj * HALF + n * 16);
#pragma unroll
        for (int am = 0; am < 4; ++am) { const int ai = am >> 1, m0 = (am & 1) * 2;
            f32x4 xv[2][2][2];
#pragma unroll
            for (int mm = 0; mm < 2; ++mm) { const size_t off = (size_t)(row0 + ai * HALF + (m0 + mm) * 16) * DM + col0;
#pragma unroll
                for (int bj = 0; bj < 2; ++bj)
#pragma unroll
                    for (int n = 0; n < 2; ++n) xv[mm][bj][n] = *(const f32x4*)(xo + off + bj * HALF + n * 16); }
            asm volatile("" ::: "memory");
#pragma unroll
            for (int mm = 0; mm < 2; ++mm) { const size_t off = (size_t)(row0 + ai * HALF + (m0 + mm) * 16) * DM + col0;
#pragma unroll
                for (int bj = 0; bj < 2; ++bj)
#pragma unroll
                    for (int n = 0; n < 2; ++n) *(f32x4*)(xn + off + bj * HALF + n * 16) = xv[mm][bj][n] + gv[bj][n] * acc[ai][bj][m0 + mm][n]; }
            asm volatile("" ::: "memory"); }
    }
};
struct EpiSwiglu {
    static constexpr bool PERM = true;
    bf16_t* O; int ldc;
    __device__ __forceinline__ void operator()(const f32x4 (&acc)[2][2][4][2], const Unit& u, int wr, int wc, int fr, int fq) const {
        const int row0 = u.pm * BM + wr * 64 + fr, col0 = u.pn * HALF + wc * 32 + 8 * fq;
#pragma unroll
        for (int ai = 0; ai < 2; ++ai)
#pragma unroll
            for (int m = 0; m < 4; ++m) { bf16_t* rowp = O + (size_t)(row0 + ai * HALF + m * 16) * ldc + col0;
                float r[8];
#pragma unroll
                for (int n = 0; n < 2; ++n)
#pragma unroll
                    for (int j = 0; j < 4; ++j) { const float gt = acc[ai][0][m][n][j], up = acc[ai][1][m][n][j]; r[4 * n + j] = silu_f(gt) * up; }
                u32x4 w; w.x = cvtpk(r[0], r[1]); w.y = cvtpk(r[2], r[3]); w.z = cvtpk(r[4], r[5]); w.w = cvtpk(r[6], r[7]);
                *(u32x4*)rowp = w; }
    }
};
struct DownSplitOrder {
    StaticOrder so; int G, c;
    __device__ void init(int G_, int c_) { so.init(NLAT, DM, G_, c_); G = G_; c = c_; }
    __device__ bool next(int i, Unit& u) const {
        if (so.next(i, u)) { u.kt0 = 0; u.nkt = DFF / BK; return true; }
        const int rounds = (so.nwg + G - 1) / G; const int j = (i - rounds) * G + c; if (i < rounds || j >= 128) return false;
        const int tile = j >> 2, part = j & 3; u.pm = NLAT / BM + (tile >> 2); u.pn = tile & 3; u.e = 1 + part;
        u.kt0 = part == 0 ? 0 : part == 1 ? 12 : part == 2 ? 24 : 34; u.nkt = part < 2 ? 12 : 10; return true;
    }
    __device__ __forceinline__ int arow(const Unit& u, int r) const { return u.pm * BM + r; }
};
struct MoeOrder {
    int c0, c1, c2, c3, c4, c5, c6, c7, t1, t2, t3, t4, t5, t6, t7, t8; int npn, G, c; const int* list; bool gather;
    __device__ void init(const unsigned* cw, int npn_, int G_, int c_, const int* list_, bool gather_) {
        #define RFL_(x) __builtin_amdgcn_readfirstlane((int)(x))
        c0 = RFL_(cw[0]); c1 = RFL_(cw[64]); c2 = RFL_(cw[128]); c3 = RFL_(cw[192]); c4 = RFL_(cw[256]); c5 = RFL_(cw[320]); c6 = RFL_(cw[384]); c7 = RFL_(cw[448]);
#undef RFL_
        t1 = (c0 + 255) >> 8; t2 = t1 + ((c1 + 255) >> 8); t3 = t2 + ((c2 + 255) >> 8); t4 = t3 + ((c3 + 255) >> 8); t5 = t4 + ((c4 + 255) >> 8); t6 = t5 + ((c5 + 255) >> 8); t7 = t6 + ((c6 + 255) >> 8); t8 = t7 + ((c7 + 255) >> 8);
        npn = npn_; G = G_; c = c_; list = list_; gather = gather_;
    }
    __device__ bool next(int i, Unit& u) const {
        const int L = i * G + c, nwg = t8 * npn; if (L >= nwg) return false;
        int wgid = L; { const int q = nwg / NXCD, r = nwg % NXCD, xcd = wgid % NXCD, off = wgid / NXCD; wgid = (xcd < r ? xcd * (q + 1) : r * (q + 1) + (xcd - r) * q) + off; }
        const int nig = WGM * npn, gid = wgid / nig, fm = gid * WGM, gsz = (t8 - fm) < WGM ? (t8 - fm) : WGM;
        const int ti = fm + ((wgid % nig) % gsz); u.pn = (wgid % nig) / gsz; u.pm = ti;
        u.e = (ti >= t1) + (ti >= t2) + (ti >= t3) + (ti >= t4) + (ti >= t5) + (ti >= t6) + (ti >= t7); return true;
    }
    __device__ __forceinline__ int ecnt(int e) const { return e == 0 ? c0 : e == 1 ? c1 : e == 2 ? c2 : e == 3 ? c3 : e == 4 ? c4 : e == 5 ? c5 : e == 6 ? c6 : c7; }
    __device__ __forceinline__ int etb(int e) const { return e == 0 ? 0 : e == 1 ? t1 : e == 2 ? t2 : e == 3 ? t3 : e == 4 ? t4 : e == 5 ? t5 : e == 6 ? t6 : t7; }
    __device__ __forceinline__ int arow(const Unit& u, int r) const {
        if (!gather) return u.pm * BM + r;
        const int pos = (u.pm - etb(u.e)) * BM + r;
        const int n_e = ecnt(u.e); const int v = list[u.e * NLAT + (pos < n_e ? pos : 0)] >> 1; return pos < n_e ? v : 0;
    }
};
struct EpiMoeDown {
    static constexpr bool PERM = true;
    bf16_t* Y; const int* list; const float* topw; MoeOrder mo;
    __device__ __forceinline__ void operator()(const f32x4 (&acc)[2][2][4][2], const Unit& u, int wr, int wc, int fr, int fq) const {
        const int pos0 = (u.pm - mo.etb(u.e)) * BM + wr * 64 + fr, n_e = mo.ecnt(u.e), col0 = u.pn * BM + wc * 32 + 8 * fq;
        int tkv[8]; float wgv[8];
#pragma unroll
        for (int i = 0; i < 8; ++i) { const int pos = pos0 + (i >> 2) * HALF + (i & 3) * 16; tkv[i] = list[u.e * NLAT + (pos < n_e ? pos : 0)]; }
#pragma unroll
        for (int i = 0; i < 8; ++i) wgv[i] = topw[tkv[i]];
#pragma unroll
        for (int ai = 0; ai < 2; ++ai)
#pragma unroll
            for (int m = 0; m < 4; ++m) { const int pos = pos0 + ai * HALF + m * 16;
                if (pos < n_e) { const int tk = tkv[ai * 4 + m]; const float wgt = wgv[ai * 4 + m]; bf16_t* rowp = Y + (size_t)tk * DM + col0;
#pragma unroll
                    for (int bj = 0; bj < 2; ++bj) { const f32x4 v0 = acc[ai][bj][m][0] * wgt, v1 = acc[ai][bj][m][1] * wgt;
                        u32x4 w; w.x = cvtpk(v0[0], v0[1]); w.y = cvtpk(v0[2], v0[3]); w.z = cvtpk(v1[0], v1[1]); w.w = cvtpk(v1[2], v1[3]);
                        *(u32x4*)(rowp + bj * HALF) = w; } } }
    }
};
}
constexpr int NWAVES = 8, NTHR = 512;
constexpr int RING_BYTES = 147456;
constexpr int LDSCTL_OFF = RING_BYTES, MISC_OFF = LDSCTL_OFF + 320;
constexpr int LDS_BYTES = RING_BYTES + 1024;
typedef GAS unsigned gu32;
#define RLX_AGENT __ATOMIC_RELAXED, __HIP_MEMORY_SCOPE_AGENT

#define XB_TMO      128
#define XB_XCNT(j)  (256  + 64 * (j))
#define XB_XSUB(j)  (1280 + 64 * (j))
#define XB_XGEN(j)  (2304 + 64 * (j))
#define XB_TOP      3328
#define XB_TOPGEN   3392
#define XCD_BAR_WORDS 3456
#define XB_SPIN_CAP (1u << 18)
__device__ __forceinline__ unsigned xb_ld(unsigned* p)              { return __hip_atomic_load(p, __ATOMIC_RELAXED, __HIP_MEMORY_SCOPE_AGENT); }
__device__ __forceinline__ unsigned xb_add(unsigned* p, unsigned v) { return __hip_atomic_fetch_add(p, v, __ATOMIC_RELAXED, __HIP_MEMORY_SCOPE_AGENT); }
__device__ __forceinline__ unsigned xb_xcc_id() { return (unsigned)__builtin_amdgcn_s_getreg((3 << 11) | 20) & 0xFu; }
#define XB_SPIN(cond, bar) do { unsigned _sp = 0; while (cond) { __builtin_amdgcn_s_sleep(1); \
    if ((++_sp & 255u) == 0u) { if (xb_ld(&(bar)[XB_TMO])) break; if (_sp > XB_SPIN_CAP) { atomicAdd(&(bar)[XB_TMO], 1u); break; } } } } while (0)
struct XcdBarrier { unsigned* bar; unsigned x; volatile LAS unsigned* st; };
__device__ __forceinline__ XcdBarrier xcd_barrier_post(unsigned* bar, volatile LAS unsigned* st, bool leader) {
    XcdBarrier b; b.bar = bar; b.x = xb_xcc_id(); b.st = st;
    if (leader) (void)xb_add(&bar[XB_XCNT(b.x)], 1u);
    return b;
}
__device__ __forceinline__ void xcd_barrier_complete(unsigned* bar, unsigned x, unsigned& nloc, unsigned& nx) {
    const unsigned G = gridDim.x * gridDim.y * gridDim.z;
    unsigned sum, cnt, mine, sp = 0u;
    for (;;) {
        sum = 0u; cnt = 0u; mine = 0u;
#pragma unroll
        for (unsigned j = 0; j < 16; ++j) { const unsigned c = xb_ld(&bar[XB_XCNT(j)]); sum += c; cnt += (c > 0u) ? 1u : 0u; mine = (j == x) ? c : mine; }
        if (sum == G) break;
        __builtin_amdgcn_s_sleep(1);
        if ((++sp & 255u) == 0u) { if (xb_ld(&bar[XB_TMO])) break; if (sp > XB_SPIN_CAP) { atomicAdd(&bar[XB_TMO], 1u); break; } }
    }
    nloc = mine > 0u ? mine : 1u; nx = cnt > 0u ? cnt : 1u;
}
__device__ __forceinline__ void xcd_barrier(const XcdBarrier& b, bool leader) {
    asm volatile("s_waitcnt vmcnt(0)" ::: "memory");
    __syncthreads();
    if (leader) {
        unsigned* bar = b.bar;
        __builtin_amdgcn_s_waitcnt(0);
        unsigned nloc = b.st[0], nx = b.st[1];
        if (nloc == 0u) { xcd_barrier_complete(bar, b.x, nloc, nx); b.st[0] = nloc; b.st[1] = nx; }
        const unsigned old = xb_add(&bar[XB_XSUB(b.x)], 1u);
        const unsigned gen = old / nloc;
        if (old + 1u == (gen + 1u) * nloc) {
            __builtin_amdgcn_fence(__ATOMIC_RELEASE, "agent");
            asm volatile("s_waitcnt vmcnt(0)" ::: "memory");
            const unsigned og = xb_add(&bar[XB_TOP], 1u);
            const unsigned tg = og / nx;
            if (og + 1u == (tg + 1u) * nx) xb_add(&bar[XB_TOPGEN], 1u);
            else XB_SPIN(xb_ld(&bar[XB_TOPGEN]) == tg, bar);
            __builtin_amdgcn_fence(__ATOMIC_ACQUIRE, "agent");
            xb_add(&bar[XB_XGEN(b.x)], 1u);
            asm volatile("s_waitcnt vmcnt(0)" ::: "memory");
        } else {
            XB_SPIN(xb_ld(&bar[XB_XGEN(b.x)]) == gen, bar);
            __builtin_amdgcn_fence(__ATOMIC_ACQUIRE, "agent");
            asm volatile("s_waitcnt vmcnt(0)" ::: "memory");
        }
    }
    __syncthreads();
}

struct Frame {
    unsigned char* sm;
    LAS unsigned char* lds;
    int tid, lane, wave, G, vcu;
    const float *x, *c, *ctx, *c_ctx, *w_mod, *b_mod, *g_mix, *w_in, *w_sgu, *b_sgu, *g_sgu, *beta_sgu, *conv_w, *conv_b, *dt_bias, *a_log, *d_skip, *g_ssd, *g_q, *w_uq, *g_kv, *w_ukv,
                *w_out, *g_ffn, *w_gate, *w_up, *w_down, *w_router, *w_gate_e, *w_up_e, *w_down_e, *g_final;
    float* out; unsigned char* ws;
};
#define WSP(T, off) ((T*)(F.ws + (off)))

__device__ __forceinline__ int rowmap(int mode, int n) {
    if (mode == 1) { if (n < 1792) return n; if (n < 1804) return n + 672; return n - 12; }
    if (mode == 2) return ((n >> 7) << 8) + (n & 127);
    if (mode == 3) return ((n >> 7) << 8) + 128 + (n & 127);
    return n;
}
__device__ __forceinline__ void transpose_item(const float* W, int K, int N, bf16_t* WT, const float* ks, int mode, LAS float* scr, int item, int lane) {
    const int nblk = (N + 31) / 32, kb = item / nblk, nb = item % nblk, k0 = 64 * kb, n0 = 32 * nb;
    const int nn = n0 + (lane & 31); const bool nok = nn < N;
#pragma unroll 16
    for (int i = 0; i < 32; ++i) { const int kk = 2 * i + (lane >> 5); float v = W[(size_t)(k0 + kk) * N + (nok ? nn : N - 1)]; v = nok ? v : 0.f; if (ks) v *= ks[k0 + kk]; scr[kk * 33 + (lane & 31)] = v; }
    LDS_WAIT(); asm volatile("" ::: "memory");
    const int cch = lane & 7;
#pragma unroll
    for (int j = 0; j < 4; ++j) { const int n = (lane >> 3) + 8 * j; const LAS float* s = scr + (8 * cch) * 33 + n;
        u32x4 o; o.x = cvtpk(s[0 * 33], s[1 * 33]); o.y = cvtpk(s[2 * 33], s[3 * 33]); o.z = cvtpk(s[4 * 33], s[5 * 33]); o.w = cvtpk(s[6 * 33], s[7 * 33]);
        if (n0 + n < N) *(u32x4*)(WT + (size_t)rowmap(mode, n0 + n) * K + k0 + 8 * cch) = o; }
    LDS_WAIT(); asm volatile("" ::: "memory");
}
__device__ __forceinline__ void transpose_item64(const float* W, int K, int N, bf16_t* WT, const float* ks, int mode, LAS float* scr, int item, int lane) {
    const int nblk = (N + 63) / 64, kb = item / nblk, nb = item % nblk, k0 = 64 * kb, n0 = 64 * nb;
    const int lr = lane >> 4, lc = (lane & 15) * 4; const bool nok = n0 + lc < N; const int ncol = nok ? n0 + lc : N - 4;
#pragma unroll
    for (int i = 0; i < 16; ++i) { const int kk = 4 * i + lr; f32x4 v = *(const f32x4*)(W + (size_t)(k0 + kk) * N + ncol); if (ks) v = v * ks[k0 + kk];
        scr[kk * 65 + lc] = v[0]; scr[kk * 65 + lc + 1] = v[1]; scr[kk * 65 + lc + 2] = v[2]; scr[kk * 65 + lc + 3] = v[3]; }
    LDS_WAIT(); asm volatile("" ::: "memory");
    const int cch = lane & 7;
#pragma unroll
    for (int j = 0; j < 8; ++j) { const int n = (lane >> 3) + 8 * j; const LAS float* s = scr + (8 * cch) * 65 + n;
        u32x4 o; o.x = cvtpk(s[0 * 65], s[1 * 65]); o.y = cvtpk(s[2 * 65], s[3 * 65]); o.z = cvtpk(s[4 * 65], s[5 * 65]); o.w = cvtpk(s[6 * 65], s[7 * 65]);
        if (n0 + n < N) *(u32x4*)(WT + (size_t)rowmap(mode, n0 + n) * K + k0 + 8 * cch) = o; }
    LDS_WAIT(); asm volatile("" ::: "memory");
}
__device__ __forceinline__ void zero_fill16(Frame& F, void* p, size_t bytes) {
    const size_t n = bytes / 16; const u32x4 z = {0u, 0u, 0u, 0u};
    for (size_t i = (size_t)F.vcu * NTHR + F.tid; i < n; i += (size_t)F.G * NTHR) ((u32x4*)p)[i] = z;
}
__device__ __forceinline__ void mod_gemv(Frame& F, int l, int wi, int nw) {
    LAS float* cond = (LAS float*)F.lds;
    LAS float* red = (LAS float*)(F.lds + 36864);
    __syncthreads();
    for (int i = F.tid; i < 9 * DM; i += NTHR) { const float v = i < 8 * DM ? F.c[i] : F.c_ctx[i - 8 * DM]; cond[i] = silu_f(v); }
    __syncthreads();
    for (int ch = wi; ch < 192; ch += nw) {
        const int cl = F.lane & 31, kh = F.lane >> 5, col = ch * 32 + cl, kg = F.wave;
        const float* wp = F.w_mod + (size_t)l * DM * 6144 + (size_t)(kg * 128 + kh) * 6144 + col;
        float a[9];
#pragma unroll
        for (int r = 0; r < 9; ++r) a[r] = 0.f;
#pragma unroll 8
        for (int k4 = 0; k4 < 16; ++k4) { const float w0 = wp[(size_t)(8 * k4) * 6144], w1 = wp[(size_t)(8 * k4 + 2) * 6144], w2 = wp[(size_t)(8 * k4 + 4) * 6144], w3 = wp[(size_t)(8 * k4 + 6) * 6144];
#pragma unroll
            for (int r = 0; r < 9; ++r) { const LAS float* cp = cond + r * DM + kg * 128 + 8 * k4 + kh; a[r] += (cp[0] * w0 + cp[2] * w1) + (cp[4] * w2 + cp[6] * w3); } }
#pragma unroll
        for (int r = 0; r < 9; ++r) { a[r] += __shfl_xor(a[r], 32); if (kh == 0) red[(kg * 9 + r) * 32 + cl] = a[r]; }
        __syncthreads();
        for (int idx = F.tid; idx < 9 * 32; idx += NTHR) { const int r = idx >> 5, cc = idx & 31; float s = 0.f;
#pragma unroll
            for (int g = 0; g < 8; ++g) s += red[(g * 9 + r) * 32 + cc];
            WSP(float, WS_MOD)[((size_t)l * 9 + r) * 6144 + ch * 32 + cc] = s + F.b_mod[l * 6144 + ch * 32 + cc]; }
        __syncthreads();
    }
}
__device__ __forceinline__ void convert_set(Frame& F, int set, int wi, int nw) {
    __syncthreads();
    LAS float* scr = (LAS float*)(F.lds + F.wave * 16640);
    const int gw = wi * NWAVES + F.wave, NGW = nw * NWAVES;
    constexpr int I_IN = 16 * 39, I_UQ = 6 * 9, I_UKV = 4 * 12, I_OUT = 16 * 16, I_G = 16 * 44, I_D = 44 * 16;
    if (set == 0 || set == 3) { const int l = set == 0 ? 0 : 1; const int n = I_IN + I_UQ + I_UKV + (l == 1 ? I_OUT : 0);
        for (int it = gw; it < n; it += NGW) { int r = it;
            if (r < I_IN) { transpose_item64(F.w_in + (size_t)l * DM * INW, DM, INW, WSP(bf16_t, WS_WIN) + (size_t)l * INP * DM, nullptr, 1, scr, r, F.lane); continue; } r -= I_IN;
            if (r < I_UQ) { transpose_item64(F.w_uq + (size_t)l * 384 * QW, 384, QW, WSP(bf16_t, WS_WUQ) + (size_t)l * QWP * 384, F.g_q + l * 384, 0, scr, r, F.lane); continue; } r -= I_UQ;
            if (r < I_UKV) { transpose_item64(F.w_ukv + (size_t)l * 256 * KVW, 256, KVW, WSP(bf16_t, WS_WUKV) + (size_t)l * KVW * 256, F.g_kv + l * 256, 0, scr, r, F.lane); continue; } r -= I_UKV;
            transpose_item64(F.w_out + (size_t)l * DM * DM, DM, DM, WSP(bf16_t, WS_WOUT) + (size_t)l * DM * DM, nullptr, 0, scr, r, F.lane); }
        const u32x4 z = {0u, 0u, 0u, 0u};
        { u32x4* p0 = (u32x4*)(WSP(bf16_t, WS_WIN) + ((size_t)l * INP + INW) * DM); const size_t n0 = (size_t)(INP - INW) * DM * 2 / 16; for (size_t i = (size_t)wi * NTHR + F.tid; i < n0; i += (size_t)nw * NTHR) p0[i] = z;
          u32x4* p1 = (u32x4*)(WSP(bf16_t, WS_WUQ) + ((size_t)l * QWP + QW) * 384); const size_t n1 = (size_t)(QWP - QW) * 384 * 2 / 16; for (size_t i = (size_t)wi * NTHR + F.tid; i < n1; i += (size_t)nw * NTHR) p1[i] = z; }
    } else if (set == 1) {
        for (int it = gw; it < I_OUT; it += NGW) transpose_item64(F.w_out, DM, DM, WSP(bf16_t, WS_WOUT), nullptr, 0, scr, it, F.lane);
    } else {
        for (int it = gw; it < 2 * I_G + I_D; it += NGW) { int r = it;
            if (r < I_G) { transpose_item64(F.w_gate, DM, DFF, WSP(bf16_t, WS_WGU), nullptr, 2, scr, r, F.lane); continue; } r -= I_G;
            if (r < I_G) { transpose_item64(F.w_up, DM, DFF, WSP(bf16_t, WS_WGU), nullptr, 3, scr, r, F.lane); continue; } r -= I_G;
            transpose_item64(F.w_down, DFF, DM, WSP(bf16_t, WS_WD), nullptr, 0, scr, r, F.lane); }
    }
    __syncthreads();
}
__device__ __forceinline__ void p_prologue(Frame& F) {
    mod_gemv(F, 0, F.vcu, F.G);
    for (int set_ = 0; set_ < 2; ++set_) convert_set(F, set_, F.vcu, F.G);
    if (F.vcu == 0) { for (int i = F.tid; i < 64 * 8; i += NTHR) { const int pos = i >> 3, f = i & 7; const float inv = powf(10000.f, -(float)f / 8.f); const float ang = (float)pos * inv;
            WSP(f32x2, WS_MISC + MISC_ROPE)[i] = (f32x2){cosf(ang), sinf(ang)}; } }
    for (int i = F.vcu * NTHR + F.tid; i < 2 * 4 * 128 * 128 / 2; i += F.G * NTHR) { const f32x2 v = ((const f32x2*)F.w_sgu)[i]; WSP(unsigned, WS_WSGU)[i] = cvtpk(v.x, v.y); }
}
__device__ __forceinline__ bool tail_worker(int nwg, int G, int c, int& wi, int& nw) {
    const int rounds = (nwg + G - 1) / G, first = nwg - (rounds - 1) * G;
    if (first >= G) { wi = c; nw = G; return true; }
    if (c < first) return false;
    wi = c - first; nw = G - first; return true;
}
__device__ __forceinline__ void p_moe_weights(Frame& F) {
    __syncthreads();
    LAS float* scr = (LAS float*)(F.lds + F.wave * 16640);
    const int gw = F.vcu * NWAVES + F.wave, NGW = F.G * NWAVES;
    constexpr int I_G = 16 * 22, I_D = 22 * 16, PER_E = 2 * I_G + I_D;
    for (int it = gw; it < 8 * PER_E; it += NGW) {
        const int e = it / PER_E; int r = it - e * PER_E;
        bf16_t* gu = WSP(bf16_t, WS_MOEW_GU) + (size_t)e * 2 * DFE * DM;
        if (r < I_G) { transpose_item64(F.w_gate_e + (size_t)e * DM * DFE, DM, DFE, gu, nullptr, 2, scr, r, F.lane); continue; } r -= I_G;
        if (r < I_G) { transpose_item64(F.w_up_e + (size_t)e * DM * DFE, DM, DFE, gu, nullptr, 3, scr, r, F.lane); continue; } r -= I_G;
        transpose_item64(F.w_down_e + (size_t)e * DFE * DM, DFE, DM, WSP(bf16_t, WS_MOEW_D) + (size_t)e * DM * DFE, nullptr, 0, scr, r, F.lane);
    }
    __syncthreads();
}

template <bool ROUTE>
__device__ __forceinline__ void p_norm(Frame& F, int l, int which, int nrows, const float* srcL, const float* srcC, const float* slab = nullptr, const float* slabgate = nullptr) {
    const float* mod = WSP(float, WS_MOD) + (size_t)l * 9 * 6144;
    const float* g = (which == 0 ? F.g_mix : F.g_ffn) + l * DM;
    bf16_t* H = WSP(bf16_t, WS_H);
    LAS int* lcnt = (LAS int*)(F.lds + 32768);
    LAS int* rec = (LAS int*)(F.lds + 32768 + 64);
    int nrec = 0;
    if (ROUTE) { LAS float* wr = (LAS float*)F.lds; for (int i = F.tid; i < DM * 8; i += NTHR) wr[i] = F.w_router[i]; if (F.tid < 16) lcnt[F.tid] = 0; __syncthreads(); }
    const int gw = F.vcu * NWAVES + F.wave, NGW = F.G * NWAVES;
    for (int row = gw; row < nrows; row += NGW) {
        const bool isc = row >= NLAT; const int b = isc ? 8 : (row >> 11);
        const float* xr = isc ? srcC + (size_t)(row - NLAT) * DM : srcL + (size_t)row * DM;
        f32x4 v[4]; float s = 0.f;
#pragma unroll
        for (int j = 0; j < 4; ++j) v[j] = *(const f32x4*)(xr + 256 * j + 4 * F.lane);
        if (slab && isc) {
#pragma unroll
            for (int j = 0; j < 4; ++j) { const size_t o_ = (size_t)(row - NLAT) * DM + 256 * j + 4 * F.lane; const f32x4 gt = *(const f32x4*)(slabgate + 256 * j + 4 * F.lane);
                const f32x4 p0 = *(const f32x4*)(slab + o_), p1 = *(const f32x4*)(slab + (size_t)NCTX * DM + o_), p2 = *(const f32x4*)(slab + (size_t)2 * NCTX * DM + o_), p3 = *(const f32x4*)(slab + (size_t)3 * NCTX * DM + o_);
                v[j] = v[j] + gt * ((p0 + p1) + (p2 + p3)); } }
#pragma unroll
        for (int j = 0; j < 4; ++j) s += (v[j].x * v[j].x + v[j].y * v[j].y) + (v[j].z * v[j].z + v[j].w * v[j].w);
        const float rstd = rsqrtf(wave_sum(s) * (1.f / DM) + EPS);
        const float* sh = mod + (size_t)b * 6144 + (which * 3) * DM; const float* sc = sh + DM;
        float lg[8];
        if (ROUTE) {
#pragma unroll
            for (int e = 0; e < 8; ++e) lg[e] = 0.f; }
#pragma unroll
        for (int j = 0; j < 4; ++j) { const int k = 256 * j + 4 * F.lane;
            const f32x4 gg = *(const f32x4*)(g + k), s1 = *(const f32x4*)(sc + k), s0 = *(const f32x4*)(sh + k);
            f32x4 h = (v[j] * rstd) * gg * (s1 + 1.f) + s0;
            u32x2 w; w.x = cvtpk(h.x, h.y); w.y = cvtpk(h.z, h.w);
            *(u32x2*)(H + (size_t)row * DM + k) = w;
            if (ROUTE) { const LAS float* wr = (const LAS float*)F.lds + k * 8;
#pragma unroll
                for (int i = 0; i < 4; ++i) { const f32x4 w0 = *(const LAS f32x4*)(wr + 8 * i), w1 = *(const LAS f32x4*)(wr + 8 * i + 4); const float hv = h[i];
                    lg[0] += hv * w0.x; lg[1] += hv * w0.y; lg[2] += hv * w0.z; lg[3] += hv * w0.w; lg[4] += hv * w1.x; lg[5] += hv * w1.y; lg[6] += hv * w1.z; lg[7] += hv * w1.w; }
                asm volatile("" ::: "memory"); }
        }
        if (ROUTE) {
#pragma unroll
            for (int e = 0; e < 8; ++e) lg[e] = wave_sum(lg[e]);
            int i0 = 0; float m0 = lg[0];
#pragma unroll
            for (int e = 1; e < 8; ++e) if (lg[e] > m0) { m0 = lg[e]; i0 = e; }
            int i1 = -1; float m1 = -3.0e38f;
#pragma unroll
            for (int e = 0; e < 8; ++e) if (e != i0 && lg[e] > m1) { m1 = lg[e]; i1 = e; }
            const float w1 = 1.f / (1.f + __expf(m0 - m1)), w0 = 1.f - w1;
            if (F.lane == 0) { float* tw = WSP(float, WS_MISC + MISC_TOPW);
                const int p0 = __hip_atomic_fetch_add(lcnt + i0, 1, __ATOMIC_RELAXED, __HIP_MEMORY_SCOPE_WORKGROUP), p1 = __hip_atomic_fetch_add(lcnt + i1, 1, __ATOMIC_RELAXED, __HIP_MEMORY_SCOPE_WORKGROUP);
                LAS int* r = rec + (F.wave * 16 + nrec) * 4; r[0] = row; r[1] = i0 | (i1 << 8); r[2] = p0; r[3] = p1; tw[row * 2] = w0; tw[row * 2 + 1] = w1; }
            ++nrec;
        }
    }
    if (ROUTE) {
        __syncthreads();
        if (F.tid < 8) lcnt[8 + F.tid] = (int)atomicAdd(WSP(unsigned, WS_CTL) + CW_CNT + 64 * F.tid, (unsigned)lcnt[F.tid]);
        __syncthreads();
        int* list = WSP(int, WS_LIST);
        if (F.lane < nrec) { const LAS int* r = rec + (F.wave * 16 + F.lane) * 4; const int row = r[0], i0 = r[1] & 255, i1 = r[1] >> 8;
            list[i0 * NLAT + lcnt[8 + i0] + r[2]] = row * 2; list[i1 * NLAT + lcnt[8 + i1] + r[3]] = row * 2 + 1; }
        __syncthreads();
    }
}
__device__ __forceinline__ void p_final(Frame& F) {
    const float* mod = WSP(float, WS_MOD) + (size_t)1 * 9 * 6144; const bf16_t* Y = WSP(bf16_t, WS_Y);
    const int gw = F.vcu * NWAVES + F.wave, NGW = F.G * NWAVES;
    for (int row = gw; row < NLAT; row += NGW) {
        const int b = row >> 11; float* xr = F.out + (size_t)row * DM; const float* gt = mod + (size_t)b * 6144 + 5 * DM;
        f32x4 v[4]; float s = 0.f;
#pragma unroll
        for (int j = 0; j < 4; ++j) { const int k = 256 * j + 4 * F.lane; const f32x4 xv = *(const f32x4*)(xr + k), gv = *(const f32x4*)(gt + k);
            const u32x2 a = *(const u32x2*)(Y + (size_t)(2 * row) * DM + k), c = *(const u32x2*)(Y + (size_t)(2 * row + 1) * DM + k);
            f32x4 y; y.x = bflo(a.x) + bflo(c.x); y.y = bfhi(a.x) + bfhi(c.x); y.z = bflo(a.y) + bflo(c.y); y.w = bfhi(a.y) + bfhi(c.y);
            v[j] = xv + gv * y; s += (v[j].x * v[j].x + v[j].y * v[j].y) + (v[j].z * v[j].z + v[j].w * v[j].w); }
        const float rstd = rsqrtf(wave_sum(s) * (1.f / DM) + EPS);
#pragma unroll
        for (int j = 0; j < 4; ++j) { const int k = 256 * j + 4 * F.lane; *(f32x4*)(xr + k) = (v[j] * rstd) * *(const f32x4*)(F.g_final + k); }
    }
}
constexpr int LP = 272;
__device__ __forceinline__ void chunk_rows(int u, int& row0, bool& isc) {
    if (u < 128) { row0 = (u >> 4) * SEQ + (u & 15) * 128; isc = false; } else { const int uu = u - 128; row0 = NLAT + (uu >> 1) * CTXL + (uu & 1) * 128; isc = true; }
}
__device__ __forceinline__ void krope_unit(Frame& F, int u) {
    int row0; bool isc; chunk_rows(u, row0, isc);
    const bf16_t* P = WSP(bf16_t, WS_P);
    if (F.tid < 128) {
        const int row = row0 + F.tid; const u32x4* src = (const u32x4*)(P + (size_t)row * INP + PC_KR);
        u32x4 q[4];
#pragma unroll
        for (int i = 0; i < 4; ++i) q[i] = src[i];
        if (!isc) {
            const int tok = row & (SEQ - 1); const f32x2* rt = WSP(f32x2, WS_MISC + MISC_ROPE);
            float v[32];
#pragma unroll
            for (int i = 0; i < 4; ++i) { v[8 * i] = bflo(q[i].x); v[8 * i + 1] = bfhi(q[i].x); v[8 * i + 2] = bflo(q[i].y); v[8 * i + 3] = bfhi(q[i].y); v[8 * i + 4] = bflo(q[i].z); v[8 * i + 5] = bfhi(q[i].z); v[8 * i + 6] = bflo(q[i].w); v[8 * i + 7] = bfhi(q[i].w); }
#pragma unroll
            for (int ax = 0; ax < 2; ++ax) { const int pos = ax == 0 ? (tok >> 6) : (tok & 63);
#pragma unroll
                for (int f = 0; f < 8; ++f) { const f32x2 cs = rt[pos * 8 + f]; const float t1 = v[16 * ax + f], t2 = v[16 * ax + 8 + f];
                    v[16 * ax + f] = t1 * cs.x - t2 * cs.y; v[16 * ax + 8 + f] = t1 * cs.y + t2 * cs.x; } }
#pragma unroll
            for (int i = 0; i < 4; ++i) { q[i].x = cvtpk(v[8 * i], v[8 * i + 1]); q[i].y = cvtpk(v[8 * i + 2], v[8 * i + 3]); q[i].z = cvtpk(v[8 * i + 4], v[8 * i + 5]); q[i].w = cvtpk(v[8 * i + 6], v[8 * i + 7]); }
        }
        u32x4* dst = (u32x4*)(WSP(bf16_t, WS_KR) + (size_t)row * 32);
#pragma unroll
        for (int i = 0; i < 4; ++i) dst[i] = q[i];
    }
}
__device__ __forceinline__ void sgu_unit(Frame& F, int l, int u) {
    int row0; bool isc; chunk_rows(u, row0, isc);
    const bf16_t* P = WSP(bf16_t, WS_P); bf16_t* CAT = WSP(bf16_t, WS_CAT);
    LAS unsigned char* VT = F.lds;
    LAS unsigned char* WB = F.lds + 256 * LP;
    const int w = F.wave, lane = F.lane;
    {
        const f32x4 gs = *(const f32x4*)(F.g_sgu + l * 256 + 4 * lane), bs = *(const f32x4*)(F.beta_sgu + l * 256 + 4 * lane);
#pragma unroll
        for (int grp = 0; grp < 2; ++grp) {
            const int s0 = 16 * w + 8 * grp;
            float v[8][4];
#pragma unroll
            for (int tt = 0; tt < 8; ++tt) { const u32x2 r = *(const u32x2*)(P + (size_t)(row0 + s0 + tt) * INP + PC_V + 4 * lane);
                v[tt][0] = gelu_tanh(bflo(r.x)); v[tt][1] = gelu_tanh(bfhi(r.x)); v[tt][2] = gelu_tanh(bflo(r.y)); v[tt][3] = gelu_tanh(bfhi(r.y)); }
#pragma unroll
            for (int tt = 0; tt < 8; ++tt) {
                const float mu = wave_sum((v[tt][0] + v[tt][1]) + (v[tt][2] + v[tt][3])) * (1.f / 256.f);
                float d0 = v[tt][0] - mu, d1 = v[tt][1] - mu, d2 = v[tt][2] - mu, d3 = v[tt][3] - mu;
                const float rstd = rsqrtf(wave_sum((d0 * d0 + d1 * d1) + (d2 * d2 + d3 * d3)) * (1.f / 256.f) + EPS);
                v[tt][0] = d0 * rstd * gs.x + bs.x; v[tt][1] = d1 * rstd * gs.y + bs.y; v[tt][2] = d2 * rstd * gs.z + bs.z; v[tt][3] = d3 * rstd * gs.w + bs.w; }
#pragma unroll
            for (int i = 0; i < 4; ++i) { u32x4 o; o.x = cvtpk(v[0][i], v[1][i]); o.y = cvtpk(v[2][i], v[3][i]); o.z = cvtpk(v[4][i], v[5][i]); o.w = cvtpk(v[6][i], v[7][i]);
                *(LAS u32x4*)(VT + (4 * lane + i) * LP + s0 * 2) = o; }
        }
    }
    const bf16_t* Wg = WSP(bf16_t, WS_WSGU) + (size_t)l * 4 * 128 * 128;
#define SGU_STAGE_W(h, buf) do { _Pragma("unroll") for (int _i = 0; _i < 4; ++_i) { const int q_ = F.tid + NTHR * _i, r_ = q_ >> 4, c_ = q_ & 15; \
        *(LAS u32x4*)(WB + (buf) * 128 * LP + r_ * LP + c_ * 16) = *(const u32x4*)(Wg + (size_t)(h) * 16384 + r_ * 128 + c_ * 8); } } while (0)
    SGU_STAGE_W(0, 0);
    u32x2 upre[4][4];
    { const int t_ = 16 * w + (lane & 15), row_ = row0 + t_;
#pragma unroll
        for (int h = 0; h < 4; ++h)
#pragma unroll
            for (int dt = 0; dt < 4; ++dt) upre[h][dt] = *(const u32x2*)(P + (size_t)row_ * INP + PC_U + h * 64 + dt * 16 + 4 * (lane >> 4)); }
    __syncthreads();
    f32x4 acc[4][4];
#pragma unroll
    for (int h = 0; h < 4; ++h)
#pragma unroll
        for (int dt = 0; dt < 4; ++dt) acc[h][dt] = (f32x4){0.f, 0.f, 0.f, 0.f};
    const int fr = lane & 15, fq = lane >> 4;
#pragma unroll
    for (int h = 0; h < 4; ++h) {
        if (h + 1 < 4) SGU_STAGE_W(h + 1, (h + 1) & 1);
        const LAS unsigned char* Wh = WB + (h & 1) * 128 * LP;
#pragma unroll
        for (int ks = 0; ks < 4; ++ks) {
            const bf16x8 bw = *(const LAS bf16x8*)(Wh + (16 * w + fr) * LP + (32 * ks + 8 * fq) * 2);
#pragma unroll
            for (int dt = 0; dt < 4; ++dt) { const bf16x8 av = *(const LAS bf16x8*)(VT + (h * 64 + dt * 16 + fr) * LP + (32 * ks + 8 * fq) * 2);
                acc[h][dt] = MFMA16(av, bw, acc[h][dt]); }
        }
        __syncthreads();
    }
#undef SGU_STAGE_W
    { const int t = 16 * w + fr, row = row0 + t;
#pragma unroll
        for (int h = 0; h < 4; ++h) { const float bsv = F.b_sgu[(l * 4 + h) * 128 + t];
#pragma unroll
            for (int dt = 0; dt < 4; ++dt) { const int c = h * 64 + dt * 16 + 4 * fq; const u32x2 r = upre[h][dt];
                const float o0 = gelu_tanh(bflo(r.x)) * (acc[h][dt][0] + bsv), o1 = gelu_tanh(bfhi(r.x)) * (acc[h][dt][1] + bsv), o2 = gelu_tanh(bflo(r.y)) * (acc[h][dt][2] + bsv), o3 = gelu_tanh(bfhi(r.y)) * (acc[h][dt][3] + bsv);
                u32x2 o; o.x = cvtpk(o0, o1); o.y = cvtpk(o2, o3); *(u32x2*)(CAT + (size_t)row * DM + c) = o; } } }
    __syncthreads();
}

__device__ __forceinline__ void ssd_local_unit(Frame& F, int l, int u) {
    int b, c, g, row0, seq0, seqlen; bool isc;
    if (u < 256) { b = u >> 5; c = (u >> 1) & 15; g = u & 1; row0 = b * SEQ + c * 128; seq0 = b * SEQ; seqlen = SEQ; isc = false; }
    else { const int uu = u - 256; b = uu >> 2; c = (uu >> 1) & 1; g = uu & 1; row0 = NLAT + b * CTXL + c * 128; seq0 = NLAT + b * CTXL; seqlen = CTXL; isc = true; }
    const bf16_t* P = WSP(bf16_t, WS_P);
    LAS unsigned char* R1 = F.lds;
    LAS unsigned char* R2 = F.lds + 128 * LP;
    LAS unsigned char* XT = F.lds + 256 * LP;
    LAS float* dtv = (LAS float*)(F.lds + 448 * LP);
    LAS float* acsv = dtv + 768;
    LAS float* wv = acsv + 768;
    const int w = F.wave, lane = F.lane, tid = F.tid, fr = lane & 15, fq = lane >> 4;
    const float* cw = F.conv_w + (size_t)l * 5 * 896; const float* cb = F.conv_b + l * 896;
    LAS float* wlb = (LAS float*)(F.lds + 448 * LP + 9216);
    if (tid < 56) { const int chx0 = tid < 24 ? g * 192 + 8 * tid : (tid < 40 ? 384 + g * 128 + 8 * (tid - 24) : 640 + g * 128 + 8 * (tid - 40));
#pragma unroll
        for (int k = 0; k < 5; ++k) { *(LAS f32x4*)(wlb + tid * 48 + 8 * k) = *(const f32x4*)(cw + k * 896 + chx0); *(LAS f32x4*)(wlb + tid * 48 + 8 * k + 4) = *(const f32x4*)(cw + k * 896 + chx0 + 4); }
        *(LAS f32x4*)(wlb + tid * 48 + 40) = *(const f32x4*)(cb + chx0); *(LAS f32x4*)(wlb + tid * 48 + 44) = *(const f32x4*)(cb + chx0 + 4); }
    __syncthreads();
    if (tid < 448) {
        const int cg = tid % 56, seg = tid / 56;
        int pcol, role, lch;
        if (cg < 24) { role = 0; lch = 8 * cg; pcol = PC_X + g * 192 + lch; }
        else if (cg < 40) { role = 1; lch = 8 * (cg - 24); pcol = PC_B + g * 128 + lch; }
        else { role = 2; lch = 8 * (cg - 40); pcol = PC_C + g * 128 + lch; }
        const LAS float* wl = wlb + cg * 48;
#pragma unroll 1
        for (int hb = 0; hb < 2; ++hb) {
            const int t0 = 16 * seg + 8 * hb;
            u32x4 rows[12];
#pragma unroll
            for (int i = 0; i < 12; ++i) { const int grow = row0 + t0 - 2 + i;
                if (i >= 2 && i < 10) rows[i] = *(const u32x4*)(P + (size_t)grow * INP + pcol);
                else { const bool ok = grow >= seq0 && grow < seq0 + seqlen; const int gcl = i < 2 ? (grow < seq0 ? seq0 : grow) : (grow >= seq0 + seqlen ? seq0 + seqlen - 1 : grow);
                    const u32x4 v_ = *(const u32x4*)(P + (size_t)gcl * INP + pcol); rows[i] = ok ? v_ : (u32x4){0u, 0u, 0u, 0u}; } }
            unsigned pk[8][4];
#pragma unroll
            for (int o2 = 0; o2 < 4; ++o2) {
                float y[2][8];
#pragma unroll
                for (int e = 0; e < 2; ++e) { const int o = 2 * o2 + e; f32x4 ya = *(const LAS f32x4*)(wl + 40), yb = *(const LAS f32x4*)(wl + 44);
#pragma unroll
                    for (int k = 0; k < 5; ++k) { const u32x4 r = rows[o + k]; const f32x4 xa = {bflo(r.x), bfhi(r.x), bflo(r.y), bfhi(r.y)}, xb = {bflo(r.z), bfhi(r.z), bflo(r.w), bfhi(r.w)};
                        ya += *(const LAS f32x4*)(wl + 8 * k) * xa; yb += *(const LAS f32x4*)(wl + 8 * k + 4) * xb; }
#pragma unroll
                    for (int c8 = 0; c8 < 4; ++c8) { y[e][c8] = silu_f(ya[c8]); y[e][4 + c8] = silu_f(yb[c8]); }
                    if (role != 0) { u32x4 st; st.x = cvtpk(y[e][0], y[e][1]); st.y = cvtpk(y[e][2], y[e][3]); st.z = cvtpk(y[e][4], y[e][5]); st.w = cvtpk(y[e][6], y[e][7]);
                        *(u32x4*)((role == 1 ? R2 : R1) + (t0 + o) * LP + lch * 2) = st;
                        if (role == 2) *(u32x4*)(WSP(bf16_t, WS_CC) + (size_t)(row0 + t0 + o) * 256 + g * 128 + lch) = st; }
                }
#pragma unroll
                for (int c8 = 0; c8 < 8; ++c8) pk[c8][o2] = cvtpk(y[0][c8], y[1][c8]);
            }
            if (role == 0) {
#pragma unroll
                for (int c8 = 0; c8 < 8; ++c8) *(LAS u32x4*)(XT + (lch + c8) * LP + t0 * 2) = (u32x4){pk[c8][0], pk[c8][1], pk[c8][2], pk[c8][3]}; }
        }
    }
    else {
        bf16_t draw[6][2];
#pragma unroll
        for (int q = 0; q < 6; ++q) { const int d = q / 3, h = g * 3 + q % 3; const int e0 = 2 * lane, t0 = d == 0 ? e0 : 127 - e0, t1 = d == 0 ? e0 + 1 : 126 - e0;
            draw[q][0] = P[(size_t)(row0 + t0) * INP + PC_DT + d * 6 + h]; draw[q][1] = P[(size_t)(row0 + t1) * INP + PC_DT + d * 6 + h]; }
        asm volatile("" ::: "memory");
#pragma unroll
        for (int q = 0; q < 6; ++q) { const int d = q / 3, j = q % 3, h = g * 3 + j;
            const float a = -__expf(F.a_log[l * 12 + d * 6 + h]), bias = F.dt_bias[l * 12 + d * 6 + h];
            const int e0 = 2 * lane, e1 = 2 * lane + 1, t0 = d == 0 ? e0 : 127 - e0, t1 = d == 0 ? e1 : 127 - e1;
            const float dt0 = softplus_f(bf1(draw[q][0]) + bias), dt1 = softplus_f(bf1(draw[q][1]) + bias);
            const float x0 = dt0 * a, x1 = dt1 * a; float s = x0 + x1;
#pragma unroll
            for (int off = 1; off < 64; off <<= 1) { const float t = __shfl_up(s, off); if (lane >= off) s += t; }
            const float a1v = s, a0v = s - x1, tot = __shfl(s, 63);
            dtv[q * 128 + t0] = dt0; dtv[q * 128 + t1] = dt1; acsv[q * 128 + t0] = a0v; acsv[q * 128 + t1] = a1v;
            wv[q * 128 + t0] = __expf(tot - a0v) * dt0; wv[q * 128 + t1] = __expf(tot - a1v) * dt1;
            float* ACS = WSP(float, WS_ACS); ACS[(size_t)(row0 + t0) * 12 + d * 6 + h] = a0v; ACS[(size_t)(row0 + t1) * 12 + d * 6 + h] = a1v;
            if (lane == 0) { const int pos = isc ? (d == 0 ? c : 1 - c) : (d == 0 ? 2 + c : 17 - c); WSP(float, WS_MISC + MISC_DEC)[((b * 2 + d) * NPOS + pos) * 6 + h] = __expf(tot); }
        }
    }
    __syncthreads();
    f32x4 G[8];
#pragma unroll
    for (int t = 0; t < 8; ++t) G[t] = (f32x4){0.f, 0.f, 0.f, 0.f};
#pragma unroll
    for (int ks = 0; ks < 4; ++ks) { const bf16x8 cf = *(const LAS bf16x8*)(R1 + (16 * w + fr) * LP + (32 * ks + 8 * fq) * 2);
#pragma unroll
        for (int t = 0; t < 8; ++t) { const bf16x8 bfm = *(const LAS bf16x8*)(R2 + (16 * t + fr) * LP + (32 * ks + 8 * fq) * 2); G[t] = MFMA16(bfm, cf, G[t]); } }
    __syncthreads();
    if (tid < 256) { const int sb = tid >> 4, nb = tid & 15; u32x4 r[8];
#pragma unroll
        for (int i = 0; i < 8; ++i) r[i] = *(const LAS u32x4*)(R2 + (8 * sb + i) * LP + nb * 16);
#pragma unroll
        for (int j = 0; j < 8; ++j) { u32x4 o;
            if ((j & 1) == 0) { o.x = (r[0][j >> 1] & 0xffffu) | (r[1][j >> 1] << 16); o.y = (r[2][j >> 1] & 0xffffu) | (r[3][j >> 1] << 16); o.z = (r[4][j >> 1] & 0xffffu) | (r[5][j >> 1] << 16); o.w = (r[6][j >> 1] & 0xffffu) | (r[7][j >> 1] << 16); }
            else { o.x = (r[0][j >> 1] >> 16) | (r[1][j >> 1] & 0xffff0000u); o.y = (r[2][j >> 1] >> 16) | (r[3][j >> 1] & 0xffff0000u); o.z = (r[4][j >> 1] >> 16) | (r[5][j >> 1] & 0xffff0000u); o.w = (r[6][j >> 1] >> 16) | (r[7][j >> 1] & 0xffff0000u); }
            *(LAS u32x4*)(R1 + (8 * nb + j) * LP + sb * 16) = o; } }
    __syncthreads();
    LAS unsigned char* Mw = R2 + w * 16 * LP;
    bf16_t* ST = WSP(bf16_t, WS_ST); float* YP = WSP(float, WS_YP);
    const bool needy = !(isc && l == DEPTH - 1);
    const int lrow = 16 * w + fr;
#pragma unroll 1
    for (int j = 0; j < 3; ++j) {
        const int h = g * 3 + j;
        f32x4 ay[4];
#pragma unroll
        for (int pt = 0; pt < 4; ++pt) ay[pt] = (f32x4){0.f, 0.f, 0.f, 0.f};
#pragma unroll 1
        for (int d = 0; d < 2; ++d) {
            const int q = d * 3 + j; const float al = acsv[q * 128 + lrow];
            if (needy) {
#pragma unroll
            for (int t = 0; t < 8; ++t) { const int s4 = 16 * t + 4 * fq; u32x2 o = {0u, 0u};
                if (d == 0 ? (t <= w) : (t >= w)) {
                    const f32x4 as = *(const LAS f32x4*)(acsv + q * 128 + s4), ds = *(const LAS f32x4*)(dtv + q * 128 + s4);
                    float mv[4];
#pragma unroll
                    for (int r = 0; r < 4; ++r) { const int s = s4 + r; const bool ok = (t != w) || (d == 0 ? (s <= lrow) : (s >= lrow)); mv[r] = ok ? G[t][r] * __expf(al - as[r]) * ds[r] : 0.f; }
                    o.x = cvtpk(mv[0], mv[1]); o.y = cvtpk(mv[2], mv[3]); }
                *(LAS u32x2*)(Mw + fr * LP + s4 * 2) = o; }
            LDS_WAIT();
#pragma unroll
            for (int ks = 0; ks < 4; ++ks) if (d == 0 ? (2 * ks <= w) : (2 * ks + 1 >= w)) { const bf16x8 mf = *(const LAS bf16x8*)(Mw + fr * LP + (32 * ks + 8 * fq) * 2);
#pragma unroll
                for (int pt = 0; pt < 4; ++pt) { const bf16x8 xf = *(const LAS bf16x8*)(XT + (j * 64 + 16 * pt + fr) * LP + (32 * ks + 8 * fq) * 2); ay[pt] = MFMA16(xf, mf, ay[pt]); } }
            }
            f32x4 as4[4];
#pragma unroll
            for (int pt = 0; pt < 4; ++pt) as4[pt] = (f32x4){0.f, 0.f, 0.f, 0.f};
#pragma unroll
            for (int ks = 0; ks < 4; ++ks) { const u32x4 raw = *(const LAS u32x4*)(R1 + (16 * w + fr) * LP + (32 * ks + 8 * fq) * 2);
                const f32x4 wa = *(const LAS f32x4*)(wv + q * 128 + 32 * ks + 8 * fq), wb = *(const LAS f32x4*)(wv + q * 128 + 32 * ks + 8 * fq + 4);
                u32x4 sc; sc.x = cvtpk(bflo(raw.x) * wa.x, bfhi(raw.x) * wa.y); sc.y = cvtpk(bflo(raw.y) * wa.z, bfhi(raw.y) * wa.w); sc.z = cvtpk(bflo(raw.z) * wb.x, bfhi(raw.z) * wb.y); sc.w = cvtpk(bflo(raw.w) * wb.z, bfhi(raw.w) * wb.w);
                const bf16x8 bsf = __builtin_bit_cast(bf16x8, sc);
#pragma unroll
                for (int pt = 0; pt < 4; ++pt) { const bf16x8 xf = *(const LAS bf16x8*)(XT + (j * 64 + 16 * pt + fr) * LP + (32 * ks + 8 * fq) * 2); as4[pt] = MFMA16(bsf, xf, as4[pt]); } }
            { const int pos = isc ? (d == 0 ? c : 1 - c) : (d == 0 ? 2 + c : 17 - c); bf16_t* sp = ST + ((size_t)((b * 2 + d) * NPOS + pos) * 6 + h) * 8192;
#pragma unroll
                for (int pt = 0; pt < 4; ++pt) { u32x2 o; o.x = cvtpk(as4[pt][0], as4[pt][1]); o.y = cvtpk(as4[pt][2], as4[pt][3]); *(u32x2*)(sp + (16 * pt + fr) * 128 + 16 * w + 4 * fq) = o; } }
        }
        if (needy) { const float skip = F.d_skip[l * 6 + h];
#pragma unroll
            for (int pt = 0; pt < 4; ++pt) { f32x4 o;
#pragma unroll
                for (int r = 0; r < 4; ++r) o[r] = ay[pt][r] + skip * bf1(*(const LAS bf16_t*)(XT + (j * 64 + 16 * pt + 4 * fq + r) * LP + lrow * 2));
                *(f32x4*)(YP + (size_t)(row0 + lrow) * 384 + h * 64 + 16 * pt + 4 * fq) = o; } }
    }
    __syncthreads();
}

__device__ __forceinline__ void ssd_scan(Frame& F) {
    bf16_t* ST = WSP(bf16_t, WS_ST); const float* DEC = WSP(float, WS_MISC + MISC_DEC);
    for (int gt = F.vcu * NTHR + F.tid; gt < 96 * 1024; gt += F.G * NTHR) {
        const int combo = gt >> 10, e8 = gt & 1023, bd = combo / 6, h = combo - bd * 6;
        u32x4 st[17]; float dec[17];
#pragma unroll
        for (int q = 0; q < 17; ++q) { const size_t sidx = (size_t)(bd * NPOS + q) * 6 + h; st[q] = *(const u32x4*)(ST + sidx * 8192 + e8 * 8); dec[q] = DEC[sidx]; }
        float hv[8];
#pragma unroll
        for (int i = 0; i < 8; ++i) hv[i] = 0.f;
#pragma unroll
        for (int q = 0; q < 17; ++q) { const size_t sidx = (size_t)(bd * NPOS + q) * 6 + h; const float dq = dec[q];
            hv[0] = dq * hv[0] + bflo(st[q].x); hv[1] = dq * hv[1] + bfhi(st[q].x); hv[2] = dq * hv[2] + bflo(st[q].y); hv[3] = dq * hv[3] + bfhi(st[q].y);
            hv[4] = dq * hv[4] + bflo(st[q].z); hv[5] = dq * hv[5] + bfhi(st[q].z); hv[6] = dq * hv[6] + bflo(st[q].w); hv[7] = dq * hv[7] + bfhi(st[q].w);
            u32x4 o; o.x = cvtpk(hv[0], hv[1]); o.y = cvtpk(hv[2], hv[3]); o.z = cvtpk(hv[4], hv[5]); o.w = cvtpk(hv[6], hv[7]);
            *(u32x4*)(ST + sidx * 8192 + e8 * 8) = o; }
    }
}

__device__ __forceinline__ void ssd_final_unit(Frame& F, int l, int u) {
    int row0; bool isc; chunk_rows(u, row0, isc);
    const int b = isc ? ((u - 128) >> 1) : (u >> 4), c = isc ? ((u - 128) & 1) : (u & 15);
    constexpr int CPITCH = 528;
    LAS unsigned char* Cs = F.lds;
    LAS unsigned char* Hs = F.lds + 128 * CPITCH;
    const int w = F.wave, lane = F.lane, tid = F.tid, fr = lane & 15, fq = lane >> 4;
    const bf16_t* CC = WSP(bf16_t, WS_CC); const bf16_t* ST = WSP(bf16_t, WS_ST); const float* ACS = WSP(float, WS_ACS);
#pragma unroll
    for (int i = 0; i < 8; ++i) { const int q = tid + NTHR * i, r = q >> 5, cc = q & 31; *(LAS u32x4*)(Cs + r * CPITCH + cc * 16) = *(const u32x4*)(CC + (size_t)(row0 + r) * 256 + cc * 8); }
    const int lrow = 16 * w + fr, row = row0 + lrow;
    const int hp = tid >> 3, hn0 = (tid & 7) * 16;
    const float* YP = WSP(float, WS_YP); const bf16_t* P = WSP(bf16_t, WS_P); bf16_t* CAT = WSP(bf16_t, WS_CAT);
    float ss = 0.f;
    const f32x4 ac0 = *(const f32x4*)(ACS + (size_t)row * 12), ac1 = *(const f32x4*)(ACS + (size_t)row * 12 + 4), ac2 = *(const f32x4*)(ACS + (size_t)row * 12 + 8);
    const float acv[12] = {ac0[0], ac0[1], ac0[2], ac0[3], ac1[0], ac1[1], ac1[2], ac1[3], ac2[0], ac2[1], ac2[2], ac2[3]};
    u32x4 hpre[2][2][2]; f32x4 ypre[2][4]; u32x2 zpre[2][4];
#define SSDF_LOAD(hh, S_) do { \
        _Pragma("unroll") for (int d = 0; d < 2; ++d) { const int pos = isc ? (d == 0 ? c : 1 - c) : (d == 0 ? 2 + c : 17 - c); hpre[S_][d][0] = (u32x4){0u, 0u, 0u, 0u}; hpre[S_][d][1] = hpre[S_][d][0]; \
            if (pos > 0) { const size_t sidx = (size_t)((b * 2 + d) * NPOS + pos - 1) * 6 + (hh); hpre[S_][d][0] = *(const u32x4*)(ST + sidx * 8192 + hp * 128 + hn0); hpre[S_][d][1] = *(const u32x4*)(ST + sidx * 8192 + hp * 128 + hn0 + 8); } } \
        _Pragma("unroll") for (int pt = 0; pt < 4; ++pt) { const int cidx = (hh) * 64 + 16 * pt + 4 * fq; ypre[S_][pt] = *(const f32x4*)(YP + (size_t)row * 384 + cidx); zpre[S_][pt] = *(const u32x2*)(P + (size_t)row * INP + PC_Z + cidx); } } while (0)
    SSDF_LOAD(0, 1);
#pragma unroll 1
    for (int h = 0; h < 6; ++h) {
        const int g = h / 3; constexpr int S = 0;
#pragma unroll
        for (int d = 0; d < 2; ++d) { hpre[0][d][0] = hpre[1][d][0]; hpre[0][d][1] = hpre[1][d][1]; }
#pragma unroll
        for (int pt = 0; pt < 4; ++pt) { ypre[0][pt] = ypre[1][pt]; zpre[0][pt] = zpre[1][pt]; }
        if (h + 1 < 6) SSDF_LOAD(h + 1, 1);
        LAS unsigned char* Hset = Hs + (h & 1) * 2 * 64 * LP;
#pragma unroll
        for (int d = 0; d < 2; ++d) { LAS unsigned char* Hb = Hset + d * 64 * LP;
            *(LAS u32x4*)(Hb + hp * LP + hn0 * 2) = hpre[S][d][0]; *(LAS u32x4*)(Hb + hp * LP + hn0 * 2 + 16) = hpre[S][d][1]; }
        LDS_BARRIER();
        f32x4 yh[4];
#pragma unroll
        for (int pt = 0; pt < 4; ++pt) yh[pt] = (f32x4){0.f, 0.f, 0.f, 0.f};
#pragma unroll
        for (int d = 0; d < 2; ++d) {
            const LAS unsigned char* Hb = Hset + d * 64 * LP;
            f32x4 tm[4];
#pragma unroll
            for (int pt = 0; pt < 4; ++pt) tm[pt] = (f32x4){0.f, 0.f, 0.f, 0.f};
#pragma unroll
            for (int ks = 0; ks < 4; ++ks) { const bf16x8 cf = *(const LAS bf16x8*)(Cs + lrow * CPITCH + (g * 128 + 32 * ks + 8 * fq) * 2);
#pragma unroll
                for (int pt = 0; pt < 4; ++pt) { const bf16x8 hf = *(const LAS bf16x8*)(Hb + (16 * pt + fr) * LP + (32 * ks + 8 * fq) * 2); tm[pt] = MFMA16(hf, cf, tm[pt]); } }
            const float e = __expf(d == 0 ? (h == 0 ? acv[0] : h == 1 ? acv[1] : h == 2 ? acv[2] : h == 3 ? acv[3] : h == 4 ? acv[4] : acv[5]) : (h == 0 ? acv[6] : h == 1 ? acv[7] : h == 2 ? acv[8] : h == 3 ? acv[9] : h == 4 ? acv[10] : acv[11]));
#pragma unroll
            for (int pt = 0; pt < 4; ++pt) yh[pt] += tm[pt] * e;
        }
#pragma unroll
        for (int pt = 0; pt < 4; ++pt) { const int cidx = h * 64 + 16 * pt + 4 * fq; const u32x2 z = zpre[S][pt];
            f32x4 v = yh[pt] + ypre[S][pt]; v[0] *= silu_f(bflo(z.x)); v[1] *= silu_f(bfhi(z.x)); v[2] *= silu_f(bflo(z.y)); v[3] *= silu_f(bfhi(z.y));
            u32x2 o; o.x = cvtpk(v[0], v[1]); o.y = cvtpk(v[2], v[3]); *(u32x2*)(CAT + (size_t)row * DM + 256 + cidx) = o; ss += (v[0] * v[0] + v[1] * v[1]) + (v[2] * v[2] + v[3] * v[3]); }
    }
#undef SSDF_LOAD
    ss += __shfl_xor(ss, 16); ss += __shfl_xor(ss, 32);
    const float rstd = rsqrtf(ss * (1.f / 384.f) + EPS);
    u32x2 st[6][4];
#pragma unroll
    for (int h = 0; h < 6; ++h)
#pragma unroll
        for (int pt = 0; pt < 4; ++pt) st[h][pt] = *(const u32x2*)(CAT + (size_t)row * DM + 256 + h * 64 + 16 * pt + 4 * fq);
    asm volatile("" ::: "memory");
#pragma unroll
    for (int h = 0; h < 6; ++h)
#pragma unroll
        for (int pt = 0; pt < 4; ++pt) { const int cidx = h * 64 + 16 * pt + 4 * fq; const f32x4 gg = *(const f32x4*)(F.g_ssd + l * 384 + cidx); const u32x2 t = st[h][pt]; f32x4 v = {bflo(t.x), bfhi(t.x), bflo(t.y), bfhi(t.y)}; v = v * rstd * gg;
            u32x2 o; o.x = cvtpk(v[0], v[1]); o.y = cvtpk(v[2], v[3]); *(u32x2*)(CAT + (size_t)row * DM + 256 + cidx) = o; }
    __syncthreads();
}

__device__ __forceinline__ void build_vt_item(Frame& F, int gt, int h) {
    const bf16_t* KV = WSP(bf16_t, WS_KV); bf16_t* VT = WSP(bf16_t, WS_VT);
    const int t7 = F.tid & 127, kq = t7 & 15, ch = t7 >> 4; u32x4 v[4];
#pragma unroll
    for (int r = 0; r < 4; ++r) v[r] = *(const u32x4*)(KV + (size_t)(gt * 64 + 4 * kq + r) * KVW + h * 128 + 64 + ch * 8);
    bf16_t* dst = VT + ((size_t)gt * 6 + h) * 4096 + 4 * kq;
#pragma unroll
    for (int j = 0; j < 4; ++j) { const unsigned a0 = v[0][j], a1 = v[1][j], a2 = v[2][j], a3 = v[3][j];
        u32x2 lo, hi; lo.x = (a0 & 0xffffu) | (a1 << 16); lo.y = (a2 & 0xffffu) | (a3 << 16); hi.x = (a0 >> 16) | (a1 & 0xffff0000u); hi.y = (a2 >> 16) | (a3 & 0xffff0000u);
        *(u32x2*)(dst + (8 * ch + 2 * j) * 64) = lo; *(u32x2*)(dst + (8 * ch + 2 * j + 1) * 64) = hi; }
}
template <class Sched> __device__ __forceinline__ void build_vt_own(Frame& F, const Sched& S) {
    asm volatile("s_waitcnt vmcnt(0)" ::: "memory"); __syncthreads();
    pg8::Unit u; const int sub = F.tid >> 7;
    for (int i = 0; S.next(i, u); ++i) {
#pragma unroll
        for (int k = 0; k < 2; ++k) { const int item = sub + 4 * k;
            build_vt_item(F, u.pm * 4 + (item & 3), u.pn * 2 + (item >> 2)); }
    }
}

__device__ __forceinline__ void attn_unit(Frame& F, int u) {
    int b, h, q0, nt; bool isc;
    if (u < 768) { b = u / 96; const int rem = u % 96; h = rem >> 4; q0 = b * SEQ + (rem & 15) * 128; nt = 36; isc = false; }
    else { const int uu = u - 768; b = uu / 12; const int rem = uu % 12; h = rem >> 1; q0 = NLAT + b * CTXL + (rem & 1) * 128; nt = 4; isc = true; }
    constexpr int KP = 208, VP = 136, TILEB = 64 * KP + 64 * VP;
    const bf16_t* Q = WSP(bf16_t, WS_Q); const bf16_t* KV = WSP(bf16_t, WS_KV); const bf16_t* KR = WSP(bf16_t, WS_KR); const bf16_t* VTg = WSP(bf16_t, WS_VT); bf16_t* CAT = WSP(bf16_t, WS_CAT);
    const int w = F.wave, lane = F.lane, tid = F.tid, qs = w & 3, par = w >> 2, r32 = lane & 31, hf = lane >> 5;
    bf16x8 qf[6];
    { const int qrow = q0 + 32 * qs + r32; const bf16_t* qp = Q + (size_t)qrow * QW + h * 96 + 8 * hf;
#pragma unroll
        for (int ks = 0; ks < 6; ++ks) qf[ks] = *(const bf16x8*)(qp + 16 * ks);
        if (!isc) { const int tok = qrow & (SEQ - 1); const f32x2* rt = WSP(f32x2, WS_MISC + MISC_ROPE);
#pragma unroll
            for (int ax = 0; ax < 2; ++ax) { const int pos = ax == 0 ? (tok >> 6) : (tok & 63); u32x4 own = __builtin_bit_cast(u32x4, qf[4 + ax]); u32x4 oth;
                oth.x = __shfl_xor(own.x, 32); oth.y = __shfl_xor(own.y, 32); oth.z = __shfl_xor(own.z, 32); oth.w = __shfl_xor(own.w, 32);
                float a[8], o[8], r[8];
                a[0] = bflo(own.x); a[1] = bfhi(own.x); a[2] = bflo(own.y); a[3] = bfhi(own.y); a[4] = bflo(own.z); a[5] = bfhi(own.z); a[6] = bflo(own.w); a[7] = bfhi(own.w);
                o[0] = bflo(oth.x); o[1] = bfhi(oth.x); o[2] = bflo(oth.y); o[3] = bfhi(oth.y); o[4] = bflo(oth.z); o[5] = bfhi(oth.z); o[6] = bflo(oth.w); o[7] = bfhi(oth.w);
#pragma unroll
                for (int f = 0; f < 8; ++f) { const f32x2 cs = rt[pos * 8 + f]; r[f] = hf == 0 ? (a[f] * cs.x - o[f] * cs.y) : (o[f] * cs.y + a[f] * cs.x); }
                u32x4 res; res.x = cvtpk(r[0], r[1]); res.y = cvtpk(r[2], r[3]); res.z = cvtpk(r[4], r[5]); res.w = cvtpk(r[6], r[7]); qf[4 + ax] = __builtin_bit_cast(bf16x8, res); } }
    }
    u32x4 knA[2], krA, vregA[2], knB[2], krB, vregB[2];
    const unsigned voffK = (unsigned)((tid >> 3) * KVW + (tid & 7) * 8) * 2u, voffR = (unsigned)tid * 16u, voffV = (unsigned)tid * 16u;
    const unsigned ldsK = (unsigned)((tid >> 3) * KP + (tid & 7) * 16), ldsR = (unsigned)((tid >> 8) * TILEB + ((tid >> 2) & 63) * KP + (8 + (tid & 3)) * 16), ldsV = (unsigned)(64 * KP + (tid >> 3) * VP + (tid & 7) * 16);
#define ATT_R(tp) ((isc || (tp) < 2) ? (NLAT + b * CTXL + (tp) * 128) : (b * SEQ + ((tp) - 2) * 128))
#define ATT_LOAD(kn, kr, vreg, tp) do { const int R_ = __builtin_amdgcn_readfirstlane(ATT_R(tp)); \
        const unsigned char* kb_ = (const unsigned char*)(KV + (size_t)R_ * KVW + h * 128); \
        kn[0] = *(const u32x4*)(kb_ + voffK); kn[1] = *(const u32x4*)(kb_ + 64 * KVW * 2 + voffK); \
        kr = *(const u32x4*)((const unsigned char*)(KR + (size_t)R_ * 32) + voffR); \
        const unsigned char* vb_ = (const unsigned char*)(VTg + ((size_t)(R_ >> 6) * 6 + h) * 4096); \
        vreg[0] = *(const u32x4*)(vb_ + voffV); vreg[1] = *(const u32x4*)(vb_ + 6 * 4096 * 2 + voffV); } while (0)
#define ATT_WRITE(kn, kr, vreg, buf) do { LAS unsigned char* base_ = F.lds + (buf) * 2 * TILEB; \
        *(LAS u32x4*)(base_ + ldsK) = kn[0]; *(LAS u32x4*)(base_ + TILEB + ldsK) = kn[1]; *(LAS u32x4*)(base_ + ldsR) = kr; \
        _Pragma("unroll") for (int i = 0; i < 2; ++i) { LAS unsigned char* vt = base_ + i * TILEB + ldsV; \
            *(LAS u32x2*)vt = (u32x2){vreg[i].x, vreg[i].y}; *(LAS u32x2*)(vt + 8) = (u32x2){vreg[i].z, vreg[i].w}; } } while (0)
    const int np = nt / 2;
    ATT_LOAD(knA, krA, vregA, 0); ATT_WRITE(knA, krA, vregA, 0);
    __syncthreads();
    ATT_LOAD(knB, krB, vregB, 1);
    f32x16 o0, o1;
#pragma unroll
    for (int r = 0; r < 16; ++r) { o0[r] = 0.f; o1[r] = 0.f; }
    float mrun = 0.f, lrun = 0.f;
    const unsigned kfo = (unsigned)(r32 * KP + 16 * hf), vfo = (unsigned)(64 * KP + r32 * VP + 8 * hf);
#define ATT_STEP(tp) do { \
        const LAS unsigned char* Kt = F.lds + ((((tp)) & 1) * 2 + par) * TILEB; \
        bf16x8 ka[6], kb[6]; \
        _Pragma("unroll") \
        for (int ks = 0; ks < 6; ++ks) ka[ks] = *(const LAS bf16x8*)(Kt + kfo + 32 * ks); \
        _Pragma("unroll") \
        for (int ks = 0; ks < 6; ++ks) kb[ks] = *(const LAS bf16x8*)(Kt + kfo + 32 * KP + 32 * ks); \
        f32x16 p0, p1; \
        _Pragma("unroll") \
        for (int r = 0; r < 16; ++r) { p0[r] = -mrun; p1[r] = -mrun; } \
        __builtin_amdgcn_sched_barrier(0); \
        _Pragma("unroll") \
        for (int ks = 0; ks < 6; ++ks) { p0 = MFMA32(ka[ks], qf[ks], p0); p1 = MFMA32(kb[ks], qf[ks], p1); } \
        u32x2 va[4][2], vc[4][2]; \
        _Pragma("unroll") \
        for (int s2 = 0; s2 < 4; ++s2) { \
            va[s2][0] = *(const LAS u32x2*)(Kt + vfo + 32 * s2); va[s2][1] = *(const LAS u32x2*)(Kt + vfo + 32 * s2 + 16); \
            vc[s2][0] = *(const LAS u32x2*)(Kt + vfo + 32 * VP + 32 * s2); vc[s2][1] = *(const LAS u32x2*)(Kt + vfo + 32 * VP + 32 * s2 + 16); } \
        __builtin_amdgcn_sched_barrier(0); \
        float mx = p0[0]; \
        _Pragma("unroll") \
        for (int r = 1; r < 16; ++r) mx = fmaxf(mx, p0[r]); \
        _Pragma("unroll") \
        for (int r = 0; r < 16; ++r) mx = fmaxf(mx, p1[r]); \
        mx = fmaxf(mx, __shfl_xor(mx, 32)); \
        if ((tp) == 0 || __any(mx > 8.f)) { const float dl = (tp) == 0 ? mx : fmaxf(mx, 0.f), alpha = __builtin_amdgcn_exp2f(-dl); lrun *= alpha; mrun += dl; \
        _Pragma("unroll") \
            for (int r = 0; r < 16; ++r) { o0[r] *= alpha; o1[r] *= alpha; p0[r] -= dl; p1[r] -= dl; } } \
        _Pragma("unroll") \
        for (int r = 0; r < 16; ++r) { p0[r] = __builtin_amdgcn_exp2f(p0[r]); p1[r] = __builtin_amdgcn_exp2f(p1[r]); } \
        float sa = p0[0], sb = p0[1], sc = p1[0], sd = p1[1]; \
        _Pragma("unroll") \
        for (int r = 2; r < 16; r += 2) { sa += p0[r]; sb += p0[r + 1]; sc += p1[r]; sd += p1[r + 1]; } \
        lrun += (sa + sb) + (sc + sd); \
        bf16x8 pf[4]; \
        _Pragma("unroll") \
        for (int s2 = 0; s2 < 4; ++s2) { u32x4 t; \
            if (s2 < 2) { t.x = cvtpk(p0[8 * s2], p0[8 * s2 + 1]); t.y = cvtpk(p0[8 * s2 + 2], p0[8 * s2 + 3]); t.z = cvtpk(p0[8 * s2 + 4], p0[8 * s2 + 5]); t.w = cvtpk(p0[8 * s2 + 6], p0[8 * s2 + 7]); } \
            else { const int s = s2 - 2; t.x = cvtpk(p1[8 * s], p1[8 * s + 1]); t.y = cvtpk(p1[8 * s + 2], p1[8 * s + 3]); t.z = cvtpk(p1[8 * s + 4], p1[8 * s + 5]); t.w = cvtpk(p1[8 * s + 6], p1[8 * s + 7]); } \
            pf[s2] = __builtin_bit_cast(bf16x8, t); } \
        _Pragma("unroll") \
        for (int s2 = 0; s2 < 4; ++s2) { \
            const u32x4 va4 = {va[s2][0].x, va[s2][0].y, va[s2][1].x, va[s2][1].y}, vc4 = {vc[s2][0].x, vc[s2][0].y, vc[s2][1].x, vc[s2][1].y}; \
            o0 = MFMA32(__builtin_bit_cast(bf16x8, va4), pf[s2], o0); o1 = MFMA32(__builtin_bit_cast(bf16x8, vc4), pf[s2], o1); } \
    } while (0)
    for (int tp = 0; tp < np; tp += 2) {
        ATT_LOAD(knA, krA, vregA, min(tp + 2, np - 1));
        ATT_STEP(tp);
        if (tp + 1 < np) ATT_WRITE(knB, krB, vregB, 1);
        LDS_BARRIER();
        if (tp + 1 < np) {
            ATT_LOAD(knB, krB, vregB, min(tp + 3, np - 1));
            ATT_STEP(tp + 1);
            if (tp + 2 < np) ATT_WRITE(knA, krA, vregA, 0);
            LDS_BARRIER();
        }
    }
#undef ATT_STEP
#undef ATT_R
#undef ATT_LOAD
#undef ATT_WRITE
    lrun += __shfl_xor(lrun, 32);
    LAS float* mg = (LAS float*)(F.lds + 4 * TILEB);
    if (par == 1) { LAS float* d = mg + ((qs * 64 + lane) * 36);
#pragma unroll
        for (int r = 0; r < 16; r += 4) { *(LAS f32x4*)(d + r) = (f32x4){o0[r], o0[r + 1], o0[r + 2], o0[r + 3]}; *(LAS f32x4*)(d + 16 + r) = (f32x4){o1[r], o1[r + 1], o1[r + 2], o1[r + 3]}; }
        d[32] = mrun; d[33] = lrun; }
    __syncthreads();
    if (par == 0) { const LAS float* d = mg + ((qs * 64 + lane) * 36);
        const float m2 = d[32], l2 = d[33], mm = fmaxf(mrun, m2), a1 = __builtin_amdgcn_exp2f(mrun - mm), a2 = __builtin_amdgcn_exp2f(m2 - mm), inv = 1.f / (lrun * a1 + l2 * a2);
        const int qrow = q0 + 32 * qs + r32; bf16_t* op = CAT + (size_t)qrow * DM + 640 + h * 64;
#pragma unroll
        for (int g4 = 0; g4 < 4; ++g4) { const f32x4 e0 = *(const LAS f32x4*)(d + 4 * g4), e1 = *(const LAS f32x4*)(d + 16 + 4 * g4);
            float r0[4], r1[4];
#pragma unroll
            for (int r = 0; r < 4; ++r) { r0[r] = (o0[4 * g4 + r] * a1 + e0[r] * a2) * inv; r1[r] = (o1[4 * g4 + r] * a1 + e1[r] * a2) * inv; }
            u32x2 w0, w1; w0.x = cvtpk(r0[0], r0[1]); w0.y = cvtpk(r0[2], r0[3]); w1.x = cvtpk(r1[0], r1[1]); w1.y = cvtpk(r1[2], r1[3]);
            *(u32x2*)(op + 8 * g4 + 4 * hf) = w0; *(u32x2*)(op + 32 + 8 * g4 + 4 * hf) = w1; } }
    __syncthreads();
}
#ifndef MK_PER_PHASE
#define MK_PER_PHASE 0
#endif
constexpr int N_PHASES = 20;
struct Args { const float* in[32]; float* out; unsigned char* ws; int ph_lo, ph_hi; };
typedef __attribute__((address_space(4))) const Args CArgs;
#define GPF(k) ((const float*)(GAS const float*)ap_->in[k])

__global__ void __launch_bounds__(NTHR, 2) fwd_megakernel(Args args) {
    extern __shared__ __attribute__((aligned(16))) unsigned char lds_raw[];
    Frame F;
    F.sm = lds_raw; F.lds = (LAS unsigned char*)lds_raw;
    F.G = gridDim.x; { const int bx = blockIdx.x; F.vcu = (F.G % 8 == 0) ? (bx % 8) * (F.G / 8) + bx / 8 : bx; }
#define PHASE_BEGIN() do { int t_ = threadIdx.x; asm volatile("" : "+v"(t_)); t_ &= 511; F.tid = t_; F.lane = t_ & 63; F.wave = __builtin_amdgcn_readfirstlane(t_ >> 6); \
    CArgs* ap_ = (CArgs*)__builtin_amdgcn_kernarg_segment_ptr(); asm volatile("" : "+s"(ap_)); \
    F.x = GPF(0); F.c = GPF(1); F.ctx = GPF(2); F.c_ctx = GPF(3); F.w_mod = GPF(4); F.b_mod = GPF(5); F.g_mix = GPF(6); F.w_in = GPF(7); \
    F.w_sgu = GPF(8); F.b_sgu = GPF(9); F.g_sgu = GPF(10); F.beta_sgu = GPF(11); F.conv_w = GPF(12); F.conv_b = GPF(13); F.dt_bias = GPF(14); F.a_log = GPF(15); \
    F.d_skip = GPF(16); F.g_ssd = GPF(17); F.g_q = GPF(18); F.w_uq = GPF(19); F.g_kv = GPF(20); F.w_ukv = GPF(21); F.w_out = GPF(22); F.g_ffn = GPF(23); \
    F.w_gate = GPF(24); F.w_up = GPF(25); F.w_down = GPF(26); F.w_router = GPF(27); F.w_gate_e = GPF(28); F.w_up_e = GPF(29); F.w_down_e = GPF(30); F.g_final = GPF(31); \
    F.out = (float*)(GAS float*)ap_->out; F.ws = (unsigned char*)(GAS unsigned char*)ap_->ws; } while (0)
    PHASE_BEGIN();
    volatile LAS unsigned* MISC = (volatile LAS unsigned*)(F.lds + MISC_OFF);
    for (int u = F.tid; u < (LDS_BYTES - LDSCTL_OFF) / 4; u += NTHR) ((LAS unsigned*)(F.lds + LDSCTL_OFF))[u] = 0u;
    __syncthreads();
    XcdBarrier bar = xcd_barrier_post(WSP(unsigned, WS_CTL) + CW_BAR, MISC + 8, threadIdx.x == 0);
    { long pc0_; int clen_; asm volatile("mk_code_beg:\n\ts_getpc_b64 %0\n\ts_mov_b32 %1, mk_code_end - mk_code_beg" : "=s"(pc0_), "=s"(clen_));
      if (threadIdx.x == 0) { volatile LAS unsigned* cw = (volatile LAS unsigned*)(F.lds + LDSCTL_OFF + 960); cw[0] = (unsigned)pc0_; cw[1] = (unsigned)((unsigned long)pc0_ >> 32); cw[2] = (unsigned)clen_; }
      const int ln_ = ((int)blockIdx.x >> 3) * NTHR + (int)threadIdx.x; if (ln_ * 128 < clen_) (void)*(volatile const unsigned*)((const char*)pc0_ + (size_t)ln_ * 128); }
#ifndef WARM_AT
#define WARM_AT(k) 0
#endif
#define CODE_WARM() do { const volatile LAS unsigned* cw_ = (const volatile LAS unsigned*)(F.lds + LDSCTL_OFF + 960); const int ln_ = ((int)blockIdx.x >> 3) * NTHR + (int)threadIdx.x; \
    if (ln_ * 128 < (int)cw_[2]) { const char* cb_ = (const char*)(((unsigned long)cw_[1] << 32) | (unsigned long)cw_[0]); (void)*(volatile const unsigned*)(cb_ + (size_t)ln_ * 128); } } while (0)
#if MK_PER_PHASE
    const int lo = args.ph_lo, hi = args.ph_hi;
#else
    constexpr int lo = 0, hi = N_PHASES;
#endif
#ifndef PH_MASK
#define PH_MASK 0xFFFFFFFFu
#endif
#define PE(b) ((PH_MASK >> (b)) & 1u)
#ifndef REP_MASK
#define REP_MASK 0u
#endif
#ifndef SSD_DRY_LIMIT
#define SSD_DRY_LIMIT 0
#endif
#define NREP(b) (1 + (int)((REP_MASK >> (b)) & 1u))
#define IN(k) (lo <= (k) && (k) < hi)
#define SEAM(k) do { if (IN(k) && IN((k) + 1)) { if (WARM_AT(k)) CODE_WARM(); for (int rep_ = 0; rep_ < NREP(20); ++rep_) xcd_barrier(bar, threadIdx.x == 0); } } while (0)
#define XC WSP(float, WS_XC)
#define SSQ WSP(float, WS_SSQP)
#define ctl WSP(unsigned, WS_CTL)

    if (IN(0) && PE(0)) { for (int rep = 0; rep < NREP(0); ++rep) { PHASE_BEGIN(); p_prologue(F); } }
    SEAM(0);
#pragma unroll 1
    for (int l = 0; l < DEPTH; ++l) {
        const int pb = 1 + 9 * l;
#define modl (WSP(float, WS_MOD) + (size_t)l * 9 * 6144)
#define srcL (l == 0 ? F.x : (const float*)F.out)
#define srcC (l == 0 ? F.ctx : (const float*)XC)
        if (IN(pb + 0) && PE(1)) for (int rep = 0; rep < NREP(1); ++rep) { PHASE_BEGIN(); p_norm<false>(F, l, 0, MT, srcL, srcC, l == 1 ? WSP(float, WS_SLAB) : nullptr, WSP(float, WS_MOD) + (size_t)8 * 6144 + 5 * DM); }
        SEAM(pb + 0);
        if (IN(pb + 1) && PE(2)) for (int rep = 0; rep < NREP(2); ++rep) {
            PHASE_BEGIN();
            pg8::Gemm g{WSP(bf16_t, WS_H), WSP(bf16_t, WS_WIN) + (size_t)l * INP * DM, DM, DM, 0};
            pg8::StaticOrder S; S.init(MT, INP, F.G, (int)blockIdx.x);
            pg8::EpiInProj E{WSP(bf16_t, WS_P), SSQ, rep < NREP(2) - 1};
            pg8::gemm_phase<pg8::EpiInProj, pg8::StaticOrder, true, false>(F.lds, F.tid, g, S, E);
        }
        SEAM(pb + 1);
        if (IN(pb + 2)) {
            if (PE(3)) for (int rep = 0; rep < NREP(3); ++rep) { PHASE_BEGIN(); pg8::Gemm g{WSP(bf16_t, WS_P) + PC_CQ, WSP(bf16_t, WS_WUQ) + (size_t)l * QWP * 384, INP, 384, 0};
              pg8::StaticOrder S; S.init(l == 0 ? MT : NLAT, QWP, F.G, l == 0 ? (int)blockIdx.x : (int)((blockIdx.x + 136u) % (unsigned)F.G));
              pg8::EpiScaleBf16 E{WSP(bf16_t, WS_Q), QW, QW, SSQ, 0, 1.f / 384.f, QSCALE};
              pg8::gemm_phase<pg8::EpiScaleBf16, pg8::StaticOrder, true, false>(F.lds, F.tid, g, S, E); }
            if (PE(4)) for (int rep = 0; rep < NREP(4); ++rep) { PHASE_BEGIN(); pg8::Gemm g{WSP(bf16_t, WS_P) + PC_CKV, WSP(bf16_t, WS_WUKV) + (size_t)l * KVW * 256, INP, 256, 0};
              pg8::StaticOrder S; S.init(MT, KVW, F.G, (int)((blockIdx.x + 128u) % (unsigned)F.G));
              pg8::EpiScaleBf16 E{WSP(bf16_t, WS_KV), KVW, KVW, SSQ, 1, 1.f / 256.f, 1.f};
              pg8::gemm_phase<pg8::EpiScaleBf16, pg8::StaticOrder, true, false>(F.lds, F.tid, g, S, E);
              build_vt_own(F, S); }
            if (PE(5)) for (int rep = 0; rep < NREP(5); ++rep) { PHASE_BEGIN();
                for (int k = 0; k < 2; ++k) {
                    const int bx_ = (int)blockIdx.x; int u;
                    if (F.G == 256) u = k == 0 ? F.vcu : ((bx_ >= 88 && bx_ < 120) ? 256 + bx_ - 88 : -1); else u = F.vcu + k * F.G;
                    if (u >= 0 && u < 288) ssd_local_unit(F, l, u); } }
            if (PE(6)) { PHASE_BEGIN(); for (int u = F.vcu; u < 144; u += F.G) krope_unit(F, u); }
            if (PE(6) && !(l == 1 && F.G == 256)) for (int rep = 0; rep < NREP(6); ++rep) { PHASE_BEGIN();
                const int bx_ = (int)blockIdx.x;
                if (F.G == 256) { const int u = bx_ >= 120 ? bx_ - 120 : (bx_ < 8 ? 136 + bx_ : -1); if (u >= 0 && u < 144) sgu_unit(F, l, u); }
                else { for (int u = F.G - 1 - F.vcu; u < 144; u += F.G) sgu_unit(F, l, u); } }
        }
        SEAM(pb + 2);
        if (IN(pb + 3)) {
            if (PE(5)) { PHASE_BEGIN(); ssd_scan(F); }
        }
        SEAM(pb + 3);
        if (IN(pb + 4)) {
            const int nat = l == 0 ? 864 : 768, nsf = l == 0 ? 144 : 128;
            if (PE(7)) for (int rep = 0; rep < NREP(7); ++rep) { PHASE_BEGIN();
                const bool l1p = l == 1 && F.G == 256;
                const int nk = l1p ? 4 : (nat + F.G - 1) / F.G;
                for (int k = 0; k < nk; ++k) { const int u = (l1p && k >= 2) ? (F.vcu < 128 ? 512 + 128 * (k - 2) + F.vcu : nat) : F.vcu + F.G * k; if (u < nat) attn_unit(F, u); } }
            if (PE(8)) for (int rep = 0; rep < NREP(8); ++rep) { PHASE_BEGIN(); for (int u = F.G - 1 - F.vcu; u < nsf; u += F.G) ssd_final_unit(F, l, u); }
            if (PE(6) && l == 1 && F.G == 256) { PHASE_BEGIN();
                if (F.vcu >= 128) sgu_unit(F, l, F.vcu - 128); }
        }
        SEAM(pb + 4);
        if (IN(pb + 5) && PE(9)) {
          for (int rep = 0; rep < NREP(9); ++rep) {
            PHASE_BEGIN();
            pg8::Gemm g{WSP(bf16_t, WS_CAT), WSP(bf16_t, WS_WOUT) + (size_t)l * DM * DM, DM, DM, 0};
            pg8::StaticOrder S; S.init(l == 0 ? MT : NLAT, DM, F.G, (int)blockIdx.x);
            pg8::EpiResid E{srcL, srcC, F.out, XC, modl, 2, rep < NREP(9) - 1, nullptr};
            pg8::gemm_phase<pg8::EpiResid, pg8::StaticOrder, true, false>(F.lds, F.tid, g, S, E);
            if (l == 0 && rep == NREP(9) - 1) { PHASE_BEGIN(); int wi_, nw_; if (tail_worker(MT / 256 * (DM / 256), F.G, (int)blockIdx.x, wi_, nw_)) { for (int set_ = 2; set_ < 4; ++set_) convert_set(F, set_, wi_, nw_); mod_gemv(F, 1, wi_, nw_); } }
          }
            if (l == 1 && PE(10)) for (int rep = 0; rep < NREP(10); ++rep) { PHASE_BEGIN(); p_moe_weights(F); }
        }
        SEAM(pb + 5);
        if (IN(pb + 6) && PE(11)) { PHASE_BEGIN(); if (l == 0) { for (int rep = 0; rep < NREP(11); ++rep) p_norm<false>(F, l, 1, MT, F.out, XC); } else p_norm<true>(F, l, 1, NLAT, F.out, XC); }
        SEAM(pb + 6);
        if (IN(pb + 7)) {
            if (l == 0 && PE(12)) for (int rep = 0; rep < NREP(12); ++rep) {
                PHASE_BEGIN();
                pg8::Gemm g{WSP(bf16_t, WS_H), WSP(bf16_t, WS_WGU), DM, DM, 0};
                pg8::StaticOrder S; S.init(MT, 2 * DFF, F.G, (int)blockIdx.x);
                pg8::EpiSwiglu E{WSP(bf16_t, WS_ACT), DFF};
                pg8::gemm_phase<pg8::EpiSwiglu, pg8::StaticOrder, true, false>(F.lds, F.tid, g, S, E);
            } else if (l == 1 && PE(13)) for (int rep = 0; rep < NREP(13); ++rep) {
                PHASE_BEGIN();
                pg8::Gemm g{WSP(bf16_t, WS_H), WSP(bf16_t, WS_MOEW_GU), DM, DM, (size_t)2 * DFE * DM};
                pg8::MoeOrder S; S.init(ctl + CW_CNT, 11, F.G, (int)blockIdx.x, WSP(int, WS_LIST), true);
                pg8::EpiSwiglu E{WSP(bf16_t, WS_MACT), DFE};
                pg8::gemm_phase<pg8::EpiSwiglu, pg8::MoeOrder, true, true>(F.lds, F.tid, g, S, E);
            }
        }
        SEAM(pb + 7);
        if (IN(pb + 8)) {
            if (l == 0 && PE(14)) for (int rep = 0; rep < NREP(14); ++rep) {
                PHASE_BEGIN();
                pg8::Gemm g{WSP(bf16_t, WS_ACT), WSP(bf16_t, WS_WD), DFF, DFF, 0};
                pg8::DownSplitOrder S; S.init(F.G, (int)blockIdx.x);
                pg8::EpiResid E{F.out, XC, F.out, XC, modl, 5, rep < NREP(14) - 1, WSP(float, WS_SLAB)};
                pg8::gemm_phase<pg8::EpiResid, pg8::DownSplitOrder, true, false, true>(F.lds, F.tid, g, S, E);
            } else if (l == 1 && PE(15)) for (int rep = 0; rep < NREP(15); ++rep) {
                PHASE_BEGIN();
                pg8::Gemm g{WSP(bf16_t, WS_MACT), WSP(bf16_t, WS_MOEW_D), DFE, DFE, (size_t)DM * DFE};
                pg8::MoeOrder S; S.init(ctl + CW_CNT, 4, F.G, (int)blockIdx.x, WSP(int, WS_LIST), false);
                pg8::EpiMoeDown E{WSP(bf16_t, WS_Y), WSP(int, WS_LIST), WSP(float, WS_MISC + MISC_TOPW), S};
                pg8::gemm_phase<pg8::EpiMoeDown, pg8::MoeOrder, true, false>(F.lds, F.tid, g, S, E);
            }
        }
        SEAM(pb + 8);
    }
    if (IN(19) && PE(16)) { PHASE_BEGIN(); p_final(F); }
#undef IN
#undef SEAM
#undef XC
#undef SSQ
#undef ctl
#undef modl
#undef srcL
#undef srcC
#undef PHASE_BEGIN
    asm volatile("mk_code_end:");
}

extern "C" void kernel_launch(void* const* d_in, const int* in_sizes, int n_in, void* d_out, int out_size, void* d_ws, size_t ws_size, hipStream_t stream) {
    static int grid = 0;
    if (grid == 0) {
        if (n_in != 32 || out_size != NLAT * DM || ws_size < WS_END) { fprintf(stderr, "kernel_launch: unexpected shapes (n_in %d, out %d, ws %zu); nothing launched\n", n_in, out_size, ws_size); grid = -1; return; }
        int dev = 0, cus = 0, per_cu = 0;
        if (hipGetDevice(&dev) != hipSuccess || hipDeviceGetAttribute(&cus, hipDeviceAttributeMultiprocessorCount, dev) != hipSuccess) { grid = -1; return; }
        if (hipFuncSetAttribute((const void*)fwd_megakernel, hipFuncAttributeMaxDynamicSharedMemorySize, LDS_BYTES) != hipSuccess) { fprintf(stderr, "kernel_launch: hipFuncSetAttribute failed\n"); grid = -1; return; }
        if (hipOccupancyMaxActiveBlocksPerMultiprocessor(&per_cu, (const void*)fwd_megakernel, NTHR, LDS_BYTES) != hipSuccess || per_cu < 1) { fprintf(stderr, "kernel_launch: occupancy query says %d blocks/CU\n", per_cu); (void)hipGetLastError(); grid = -1; return; }
        grid = cus;
    }
    if (grid < 0) return;
    (void)hipMemsetAsync((char*)d_ws + WS_CTL, 0, CTL_BYTES, stream);
    Args a{};
    for (int i = 0; i < 32; ++i) a.in[i] = (const float*)d_in[i];
    a.out = (float*)d_out; a.ws = (unsigned char*)d_ws;
#if MK_PER_PHASE
    for (int k = 0; k < N_PHASES; ++k) { a.ph_lo = k; a.ph_hi = k + 1; hipLaunchKernelGGL(fwd_megakernel, dim3(grid), dim3(NTHR), LDS_BYTES, stream, a); }
#else
    a.ph_lo = 0; a.ph_hi = N_PHASES;
    void* kargs[] = {&a};
    hipError_t e = hipLaunchCooperativeKernel((const void*)fwd_megakernel, dim3(grid), dim3(NTHR), kargs, LDS_BYTES, stream);
    if (e != hipSuccess) fprintf(stderr, "kernel_launch: cooperative launch failed: %s (grid %d)\n", hipGetErrorString(e), grid);
#endif
}
```

```cpp
#include <hip/hip_runtime.h>
#include <cstdio>
#include <cstdint>

#define LAS __attribute__((address_space(3)))
#define GAS __attribute__((address_space(1)))
typedef unsigned short bf16_t;
typedef short bf16x8 __attribute__((ext_vector_type(8)));
typedef float f32x4 __attribute__((ext_vector_type(4)));
typedef float f32x16 __attribute__((ext_vector_type(16)));
typedef float f32x2 __attribute__((ext_vector_type(2)));
typedef unsigned u32x4 __attribute__((ext_vector_type(4)));
typedef unsigned u32x2 __attribute__((ext_vector_type(2)));
typedef __bf16 bf16x2_t __attribute__((ext_vector_type(2)));

constexpr int BATCH = 8, SEQ = 2048, DM = 1024, CTXL = 256, DEPTH = 2;
constexpr int NLAT = BATCH * SEQ, NCTX = BATCH * CTXL, MT = NLAT + NCTX;
constexpr int INW = 2476, INP = 2560;
constexpr int PC_U = 0, PC_V = 256, PC_Z = 512, PC_X = 896, PC_B = 1280, PC_C = 1536, PC_CQ = 1792, PC_CKV = 2176, PC_KR = 2432, PC_DT = 2464;
constexpr int DFF = 2816, NEXP = 8, DFE = 1408;
constexpr int QW = 576, QWP = 768, KVW = 768;
constexpr float EPS = 1e-6f;
constexpr float QSCALE = 0.10206207261596577f * 1.4426950408889634f;
constexpr int NPOS = 18;

constexpr size_t MiB = 1u << 20;
constexpr size_t WS_CTL = 0, CTL_BYTES = 64 * 1024;
constexpr size_t WS_MOD = 1 * MiB;
constexpr size_t WS_ACS = 2 * MiB;
constexpr size_t WS_MISC = 3 * MiB;
constexpr size_t WS_LIST = 4 * MiB;
constexpr size_t WS_WSGU = 5 * MiB;
constexpr size_t WS_WIN = 6 * MiB;
constexpr size_t WS_WUQ = 16 * MiB;
constexpr size_t WS_WUKV = 18 * MiB;
constexpr size_t WS_WOUT = 19 * MiB;
constexpr size_t WS_WGU = 23 * MiB;
constexpr size_t WS_WD = 34 * MiB;
constexpr size_t WS_XC = 40 * MiB;
constexpr size_t WS_H = 48 * MiB;
constexpr size_t WS_Q = 48 * MiB;
constexpr size_t WS_KR = 70 * MiB;
constexpr size_t WS_P = 84 * MiB;
constexpr size_t WS_CAT = 174 * MiB;
constexpr size_t WS_KV = 210 * MiB;
constexpr size_t WS_CC = 237 * MiB;
constexpr size_t WS_YP = 246 * MiB;
constexpr size_t WS_ST = 273 * MiB;
constexpr size_t WS_ACT = 84 * MiB;
constexpr size_t WS_MOEW_GU = 84 * MiB;
constexpr size_t WS_MOEW_D = 128 * MiB;
constexpr size_t WS_MACT = 150 * MiB;
constexpr size_t WS_Y = 244 * MiB;
constexpr size_t WS_SSQP = 300 * MiB;
constexpr size_t WS_VT = 302 * MiB;
constexpr size_t WS_SLAB = 200 * MiB;
constexpr size_t WS_END = 316 * MiB;
constexpr size_t MISC_SSQ = 0, MISC_DEC = 256 * 1024, MISC_ROPE = 320 * 1024, MISC_TOPW = 384 * 1024;
constexpr int CW_CNT = 64;
constexpr int CW_BAR = 4096;

__device__ __forceinline__ unsigned cvtpk(float lo, float hi) { f32x2 v = {lo, hi}; bf16x2_t b = __builtin_convertvector(v, bf16x2_t); return __builtin_bit_cast(unsigned, b); }
__device__ __forceinline__ float bflo(unsigned u) { return __uint_as_float(u << 16); }
__device__ __forceinline__ float bfhi(unsigned u) { return __uint_as_float(u & 0xffff0000u); }
__device__ __forceinline__ float bf1(bf16_t h) { return __uint_as_float((unsigned)h << 16); }
__device__ __forceinline__ bf16_t f2bf(float f) { return (bf16_t)(cvtpk(f, 0.f) & 0xffffu); }
__device__ __forceinline__ float wave_sum(float v) {
#pragma unroll
    for (int o = 1; o < 64; o <<= 1) v += __shfl_xor(v, o);
    return v;
}
__device__ __forceinline__ float silu_f(float x) { return x * __builtin_amdgcn_rcpf(1.f + __expf(-x)); }
__device__ __forceinline__ float gelu_tanh(float x) { const float u = 0.7978845608028654f * (x + 0.044715f * x * x * x); const float t = 1.f - 2.f * __builtin_amdgcn_rcpf(1.f + __expf(2.f * u)); return 0.5f * x * (1.f + t); }
__device__ __forceinline__ float softplus_f(float x) { return x > 20.f ? x : log1pf(__expf(x)); }
#define LDS_WAIT() asm volatile("s_waitcnt lgkmcnt(0)" ::: "memory")
#define LDS_BARRIER() asm volatile("s_waitcnt lgkmcnt(0)\n\ts_barrier" ::: "memory")
#define MFMA16(a, b, c) __builtin_amdgcn_mfma_f32_16x16x32_bf16((a), (b), (c), 0, 0, 0)
#define MFMA32(a, b, c) __builtin_amdgcn_mfma_f32_32x32x16_bf16((a), (b), (c), 0, 0, 0)

namespace pg8 {
constexpr int BM = 256, BK = 64, HALF = 128, HTB = HALF * BK * 2, STAGE_BYTES = 8 * HTB, NXCD = 8, WGM = 8;
__host__ __device__ __forceinline__ int lds_byte(int r, int c) { const int st = (r >> 4) * 2 + (c >> 5), rr = r & 15, cc = c & 31, ob = rr * 64 + cc * 2; return st * 1024 + (ob ^ (((ob >> 9) & 1) << 5)); }
__host__ __device__ __forceinline__ void stage_rc(int b, int& R, int& C) { const int st = b / 1024, sb = b % 1024, swz = sb ^ (((sb >> 9) & 1) << 5); R = (st >> 1) * 16 + swz / 64; C = (st & 1) * 32 + (swz % 64) / 2; }
__host__ __device__ __forceinline__ int perm32(int rho) { const int n = rho >> 4, i = rho & 15; return 8 * (i >> 2) + 4 * n + (i & 3); }

struct Unit { int pm, pn, e, kt0, nkt; };
struct Gemm { const bf16_t* A; const bf16_t* Bt; int lda; int K; size_t bstride_e; };

struct StaticOrder {
    int nM, nN, nwg, G, c, lim;
    __device__ void init(int M, int N, int G_, int c_) { nM = M / BM; nN = N / BM; nwg = nM * nN; G = G_; c = c_; lim = 0x7fffffff; }
    __device__ void init_plan(int M, int N, int r, int off0, int cnt) { nM = M / BM; nN = N / BM; nwg = nM * nN; G = NXCD; c = off0 * NXCD + r; lim = cnt; }
    __device__ bool next(int i, Unit& u) const {
        const long L = (long)i * G + c; if (i >= lim || L >= nwg) return false;
        int wgid = (int)L; { const int q = nwg / NXCD, r = nwg % NXCD, xcd = wgid % NXCD, off = wgid / NXCD; wgid = (xcd < r ? xcd * (q + 1) : r * (q + 1) + (xcd - r) * q) + off; }
        const int nig = WGM * nN, gid = wgid / nig, fm = gid * WGM, gsz = (nM - fm) < WGM ? (nM - fm) : WGM;
        u.pm = fm + ((wgid % nig) % gsz); u.pn = (wgid % nig) / gsz; u.e = 0; return true;
    }
    __device__ __forceinline__ int arow(const Unit& u, int r) const { return u.pm * BM + r; }
};

template <class Epi, class Sched, bool ALIGN_EPI, bool GATHER, bool KSPLIT = false>
__device__ __forceinline__ void gemm_phase(LAS unsigned char* lds, const int tid, const Gemm g, const Sched& S, const Epi& E) {
    const int wid = __builtin_amdgcn_readfirstlane(tid >> 6), lane = tid & 63, wr = wid >> 2, wc = wid & 3, fr = lane & 15, fq = lane >> 4;
    const int K = g.K; int nt = K / BK;
    int Rr[2], Cc[2]; unsigned voffA[2], voffB[2];
#pragma unroll
    for (int i = 0; i < 2; ++i) { int R, C; stage_rc(tid * 16 + i * 8192, R, C); Rr[i] = R; Cc[i] = C; const int Rb = Epi::PERM ? ((R & ~31) + perm32(R & 31)) : R;
        voffA[i] = (unsigned)(R * g.lda + C) * 2u; voffB[i] = (unsigned)(Rb * K + C) * 2u; }
    const size_t kstep = (size_t)(BK * 2);
    const size_t hstepB = (size_t)HALF * K * 2, tstepB = 2 * hstepB;
    const size_t hstepA = (size_t)HALF * g.lda * 2, tstepA = 2 * hstepA;
    const unsigned ldsw = (unsigned)wid * 1024u;
    const int aoff = lds_byte(wr * 64 + fr, fq * 8), boff = lds_byte(wc * 32 + fr, fq * 8);
    const char* const Abase = (const char*)g.A;
#define PG8_SA(b, h) (((b) * 2 + (h)) * HTB)
#define PG8_SB(b, h) ((4 + (b) * 2 + (h)) * HTB)
#define PG8_GL(gp, off) __builtin_amdgcn_global_load_lds((const unsigned*)(gp), (LAS unsigned*)(lds + (off)), 16, 0, 0)
#define PG8_STAGE_B(bufoff, gbase) do { PG8_GL((const char*)(gbase) + voffB[0], (bufoff) + ldsw); PG8_GL((const char*)(gbase) + voffB[1], (bufoff) + ldsw + 8192); } while (0)
#define PG8_STAGE_A_CUR(bufoff, kt, h) do { if constexpr (GATHER) { const char* _p = Abase + (size_t)(kt) * kstep; PG8_GL(_p + ((h) ? c10 : c00), (bufoff) + ldsw); PG8_GL(_p + ((h) ? c11 : c01), (bufoff) + ldsw + 8192); } \
        else { const char* _p = cA + (size_t)(kt) * kstep + (h) * hstepA; PG8_GL(_p + voffA[0], (bufoff) + ldsw); PG8_GL(_p + voffA[1], (bufoff) + ldsw + 8192); } } while (0)
#define PG8_STAGE_A_SEL(bufoff, kt, h) do { if constexpr (GATHER) { const char* _p = Abase + (size_t)(kt) * kstep; PG8_GL(_p + ((h) ? x10 : x00), (bufoff) + ldsw); PG8_GL(_p + ((h) ? x11 : x01), (bufoff) + ldsw + 8192); } \
        else { const char* _p = xA + (size_t)(kt) * kstep + (h) * hstepA; PG8_GL(_p + voffA[0], (bufoff) + ldsw); PG8_GL(_p + voffA[1], (bufoff) + ldsw + 8192); } } while (0)
#define PG8_LDA(dst, b, h) do { _Pragma("unroll") for (int m = 0; m < 4; ++m) _Pragma("unroll") for (int k = 0; k < 2; ++k) dst[m][k] = *(const LAS bf16x8*)(lds + PG8_SA(b, h) + aoff + m * 2048 + k * 1024); } while (0)
#define PG8_LDB(dst, b, h) do { _Pragma("unroll") for (int n = 0; n < 2; ++n) _Pragma("unroll") for (int k = 0; k < 2; ++k) dst[n][k] = *(const LAS bf16x8*)(lds + PG8_SB(b, h) + boff + n * 2048 + k * 1024); } while (0)
#define PG8_MMA(ai, bj, At, Bt) do { __builtin_amdgcn_s_setprio(1); _Pragma("unroll") for (int m = 0; m < 4; ++m) _Pragma("unroll") for (int n = 0; n < 2; ++n) _Pragma("unroll") for (int k = 0; k < 2; ++k) \
        acc[ai][bj][m][n] = __builtin_amdgcn_mfma_f32_16x16x32_bf16(Bt[n][k], At[m][k], acc[ai][bj][m][n], 0, 0, 0); __builtin_amdgcn_s_setprio(0); } while (0)
#define PG8_WAIT_V(n) asm volatile("s_waitcnt vmcnt(" #n ")" ::: "memory")
#define PG8_WAIT_L(n) asm volatile("s_waitcnt lgkmcnt(" #n ")" ::: "memory")
#define PG8_BAR __builtin_amdgcn_s_barrier()
#define PG8_SCHED __builtin_amdgcn_sched_barrier(0)
#define PG8_AOFFS(u, o00, o01, o10, o11) do { if constexpr (GATHER) { \
        o00 = (unsigned)(((size_t)S.arow(u, Rr[0]) * g.lda + Cc[0]) * 2); o01 = (unsigned)(((size_t)S.arow(u, Rr[1]) * g.lda + Cc[1]) * 2); \
        o10 = (unsigned)(((size_t)S.arow(u, HALF + Rr[0]) * g.lda + Cc[0]) * 2); o11 = (unsigned)(((size_t)S.arow(u, HALF + Rr[1]) * g.lda + Cc[1]) * 2); } } while (0)
    Unit cur, nxt; int ui = 0;
    if (!S.next(0, cur)) return;
    f32x4 acc[2][2][4][2];
#pragma unroll
    for (int a = 0; a < 2; ++a)
#pragma unroll
        for (int b = 0; b < 2; ++b)
#pragma unroll
            for (int m = 0; m < 4; ++m)
#pragma unroll
                for (int n = 0; n < 2; ++n) acc[a][b][m][n] = (f32x4){0.f, 0.f, 0.f, 0.f};
    bf16x8 At[4][2], B0[2][2], B1[2][2];
    unsigned c00 = 0, c01 = 0, c10 = 0, c11 = 0, n00 = 0, n01 = 0, n10 = 0, n11 = 0;
    PG8_AOFFS(cur, c00, c01, c10, c11);
    const char* cA = Abase + (size_t)cur.pm * tstepA;
    const char* cB = (const char*)g.Bt + ((size_t)cur.e * g.bstride_e) * 2 + (size_t)cur.pn * tstepB;
    if constexpr (KSPLIT) { cA += (size_t)cur.kt0 * kstep; cB += (size_t)cur.kt0 * kstep; nt = cur.nkt; }
    PG8_STAGE_B(PG8_SB(0, 0), cB); PG8_STAGE_B(PG8_SB(0, 1), cB + hstepB); PG8_STAGE_A_CUR(PG8_SA(0, 0), 0, 0); PG8_STAGE_A_CUR(PG8_SA(0, 1), 0, 1);
    if (wr == 1) PG8_BAR;
    PG8_WAIT_V(2); PG8_BAR;
    PG8_STAGE_B(PG8_SB(1, 0), cB + kstep); PG8_STAGE_A_CUR(PG8_SA(1, 0), 1, 0); PG8_STAGE_B(PG8_SB(1, 1), cB + hstepB + kstep);
    PG8_WAIT_V(6); PG8_BAR;
    for (;;) {
        const bool has_next = S.next(ui + 1, nxt);
        const char* nB = cB; const char* nA = cA;
        if (has_next) { PG8_AOFFS(nxt, n00, n01, n10, n11); nA = Abase + (size_t)nxt.pm * tstepA; nB = (const char*)g.Bt + ((size_t)nxt.e * g.bstride_e) * 2 + (size_t)nxt.pn * tstepB;
            if constexpr (KSPLIT) { nA += (size_t)nxt.kt0 * kstep; nB += (size_t)nxt.kt0 * kstep; } }
        else { n00 = c00; n01 = c01; n10 = c10; n11 = c11; }
#pragma unroll 1
        for (int t = 0; t < nt; t += 2) {
            const bool last = (t == nt - 2);
            const int kt2 = last ? 0 : t + 2, kt3 = kt2 + 1;
            const unsigned x00 = last ? n00 : c00, x01 = last ? n01 : c01, x10 = last ? n10 : c10, x11 = last ? n11 : c11;
            const char* xA = last ? nA : cA;
            const char* b2 = last ? nB : cB + (size_t)(t + 2) * kstep; const char* b3 = b2 + kstep;
            (void)x00; (void)x01; (void)x10; (void)x11; (void)xA;
            PG8_LDB(B0, 0, 0); PG8_LDB(B1, 0, 1); PG8_SCHED; PG8_LDA(At, 0, 0); PG8_STAGE_A_CUR(PG8_SA(1, 1), t + 1, 1);
            PG8_WAIT_V(8); PG8_WAIT_L(0); PG8_BAR; PG8_MMA(0, 0, At, B0); PG8_MMA(0, 1, At, B1); PG8_BAR; PG8_SCHED;
            PG8_LDA(At, 0, 1); PG8_STAGE_B(PG8_SB(0, 0), b2); PG8_STAGE_B(PG8_SB(0, 1), b2 + hstepB); PG8_STAGE_A_SEL(PG8_SA(0, 0), kt2, 0);
            PG8_WAIT_V(8); PG8_WAIT_L(0); PG8_BAR; PG8_MMA(1, 0, At, B0); PG8_MMA(1, 1, At, B1); PG8_BAR; PG8_SCHED;
            PG8_LDB(B0, 1, 0); PG8_LDB(B1, 1, 1); PG8_SCHED; PG8_LDA(At, 1, 0); PG8_STAGE_A_SEL(PG8_SA(0, 1), kt2, 1);
            PG8_WAIT_V(8); PG8_WAIT_L(0); PG8_BAR; PG8_MMA(0, 0, At, B0); PG8_MMA(0, 1, At, B1); PG8_BAR; PG8_SCHED;
            PG8_LDA(At, 1, 1); PG8_STAGE_B(PG8_SB(1, 0), b3); PG8_STAGE_B(PG8_SB(1, 1), b3 + hstepB); PG8_STAGE_A_SEL(PG8_SA(1, 0), kt3, 0);
            PG8_WAIT_V(8); PG8_WAIT_L(0); PG8_BAR; PG8_MMA(1, 0, At, B0); PG8_MMA(1, 1, At, B1); PG8_BAR; PG8_SCHED;
        }
        if constexpr (ALIGN_EPI) { if (wr == 0) PG8_BAR; }
        E(acc, cur, wr, wc, fr, fq);
        if (!has_next) break;
#pragma unroll
        for (int a = 0; a < 2; ++a)
#pragma unroll
            for (int b = 0; b < 2; ++b)
#pragma unroll
                for (int m = 0; m < 4; ++m)
#pragma unroll
                    for (int n = 0; n < 2; ++n) acc[a][b][m][n] = (f32x4){0.f, 0.f, 0.f, 0.f};
        cur = nxt; cA = nA; cB = nB; c00 = n00; c01 = n01; c10 = n10; c11 = n11; ++ui;
        if constexpr (KSPLIT) nt = cur.nkt;
        if constexpr (ALIGN_EPI) { if (wr == 1) PG8_BAR; }
    }
    PG8_WAIT_V(0);
    if constexpr (!ALIGN_EPI) { if (wr == 0) PG8_BAR; }
    PG8_BAR;
#undef PG8_SA
#undef PG8_SB
#undef PG8_GL
#undef PG8_STAGE_A_CUR
#undef PG8_STAGE_A_SEL
#undef PG8_STAGE_B
#undef PG8_LDA
#undef PG8_LDB
#undef PG8_MMA
#undef PG8_WAIT_V
#undef PG8_WAIT_L
#undef PG8_BAR
#undef PG8_SCHED
#undef PG8_AOFFS
}
}
namespace pg8 {
struct EpiInProj {
    static constexpr bool PERM = true;
    bf16_t* O; float* ssq; bool dry;
    __device__ __forceinline__ void operator()(const f32x4 (&acc)[2][2][4][2], const Unit& u, int wr, int wc, int fr, int fq) const {
        if (dry) return;
        const int row0 = u.pm * BM + wr * 64 + fr, col0 = u.pn * BM + wc * 32 + 8 * fq;
#pragma unroll
        for (int ai = 0; ai < 2; ++ai)
#pragma unroll
            for (int m = 0; m < 4; ++m) { const int row = row0 + ai * HALF + m * 16; bf16_t* rowp = O + (size_t)row * INP + col0;
                float sq = 0.f, sk = 0.f;
#pragma unroll
                for (int bj = 0; bj < 2; ++bj) { const f32x4 v0 = acc[ai][bj][m][0], v1 = acc[ai][bj][m][1];
                    u32x4 w; w.x = cvtpk(v0[0], v0[1]); w.y = cvtpk(v0[2], v0[3]); w.z = cvtpk(v1[0], v1[1]); w.w = cvtpk(v1[2], v1[3]);
                    *(u32x4*)(rowp + bj * HALF) = w;
                    const int hidx = 2 * u.pn + bj;
                    const float s = (v0[0] * v0[0] + v0[1] * v0[1]) + (v0[2] * v0[2] + v0[3] * v0[3]) + (v1[0] * v1[0] + v1[1] * v1[1]) + (v1[2] * v1[2] + v1[3] * v1[3]);
                    if (hidx >= 14 && hidx <= 16) sq += s;
                    if (hidx >= 17 && hidx <= 18) sk += s; }
                if (u.pn >= 7 && u.pn <= 9) {
                    sq += __shfl_xor(sq, 16); sq += __shfl_xor(sq, 32); sk += __shfl_xor(sk, 16); sk += __shfl_xor(sk, 32);
                    if (fq == 0) { float* sp = ssq + (size_t)row * 16;
                        if (u.pn == 7) sp[wc] = sq; if (u.pn == 8) { sp[4 + wc] = sq; sp[8 + wc] = sk; } if (u.pn == 9) sp[12 + wc] = sk; } } }
    }
};
struct EpiScaleBf16 {
    static constexpr bool PERM = true;
    bf16_t* O; int ldc, ncols; const float* ssq; int idx; float invn, mul;
    __device__ __forceinline__ void operator()(const f32x4 (&acc)[2][2][4][2], const Unit& u, int wr, int wc, int fr, int fq) const {
        const int row0 = u.pm * BM + wr * 64 + fr, col0 = u.pn * BM + wc * 32 + 8 * fq;
#pragma unroll
        for (int ai = 0; ai < 2; ++ai) {
            float scv[4];
#pragma unroll
            for (int m = 0; m < 4; ++m) { const int row = row0 + ai * HALF + m * 16;
                const f32x4 pa = *(const f32x4*)(ssq + (size_t)row * 16 + 8 * idx), pb = *(const f32x4*)(ssq + (size_t)row * 16 + 8 * idx + 4);
                scv[m] = rsqrtf((((pa[0] + pa[1]) + (pa[2] + pa[3])) + ((pb[0] + pb[1]) + (pb[2] + pb[3]))) * invn + EPS) * mul; }
            asm volatile("" ::: "memory");
#pragma unroll
            for (int m = 0; m < 4; ++m) { const int row = row0 + ai * HALF + m * 16; bf16_t* rowp = O + (size_t)row * ldc + col0;
                const float sc = scv[m];
#pragma unroll
                for (int bj = 0; bj < 2; ++bj) if (col0 + bj * HALF < ncols) { const f32x4 v0 = acc[ai][bj][m][0] * sc, v1 = acc[ai][bj][m][1] * sc;
                    u32x4 w; w.x = cvtpk(v0[0], v0[1]); w.y = cvtpk(v0[2], v0[3]); w.z = cvtpk(v1[0], v1[1]); w.w = cvtpk(v1[2], v1[3]);
                    *(u32x4*)(rowp + bj * HALF) = w; } } }
    }
};
struct EpiResid {
    static constexpr bool PERM = false;
    const float* oldL; const float* oldC; float* newL; float* newC; const float* mod; int gi; bool dry; float* slab;
    __device__ __forceinline__ void operator()(const f32x4 (&acc)[2][2][4][2], const Unit& u, int wr, int wc, int fr, int fq) const {
        if (dry) return;
        if (slab && u.e > 0) {
            float* sp = slab + ((size_t)(u.e - 1) * NCTX + (u.pm * BM - NLAT) + wr * 64 + fr) * DM + u.pn * BM + wc * 32 + 4 * fq;
#pragma unroll
            for (int ai = 0; ai < 2; ++ai)
#pragma unroll
                for (int m = 0; m < 4; ++m)
#pragma unroll
                    for (int bj = 0; bj < 2; ++bj)
#pragma unroll
                        for (int n = 0; n < 2; ++n) *(f32x4*)(sp + (size_t)(ai * HALF + m * 16) * DM + bj * HALF + n * 16) = acc[ai][bj][m][n];
            return; }
        const int rbase = u.pm * BM; const bool isc = rbase >= NLAT; const int b = isc ? 8 : (rbase >> 11);
        const float* xo = isc ? oldC - (size_t)NLAT * DM : oldL; float* xn = isc ? newC - (size_t)NLAT * DM : newL;
        const int row0 = rbase + wr * 64 + fr, col0 = u.pn * BM + wc * 32 + 4 * fq;
        const float* gp = mod + (size_t)b * 6144 + gi * DM + col0;
        f32x4 gv[2][2];
#pragma unroll
        for (int bj = 0; bj < 2; ++bj)
#pragma unroll
            for (int n = 0; n < 2; ++n) gv[bj][n] = *(const f32x4*)(gp + bj * HALF + n * 16);
#pragma unroll
        for (int am = 0; am < 4; ++am) { const int ai = am >> 1, m0 = (am & 1) * 2;
            f32x4 xv[2][2][2];
#pragma unroll
            for (int mm = 0; mm < 2; ++mm) { const size_t off = (size_t)(row0 + ai * HALF + (m0 + mm) * 16) * DM + col0;
#pragma unroll
                for (int bj = 0; bj < 2; ++bj)
#pragma unroll
                    for (int n = 0; n < 2; ++n) xv[mm][bj][n] = *(const f32x4*)(xo + off + bj * HALF + n * 16); }
            asm volatile("" ::: "memory");
#pragma unroll
            for (int mm = 0; mm < 2; ++mm) { const size_t off = (size_t)(row0 + ai * HALF + (m0 + mm) * 16) * DM + col0;
#pragma unroll
                for (int bj = 0; bj < 2; ++bj)
#pragma unroll
                    for (int n = 0; n < 2; ++n) *(f32x4*)(xn + off + bj * HALF + n * 16) = xv[mm][bj][n] + gv[bj][n] * acc[ai][bj][m0 + mm][n]; }
            asm volatile("" ::: "memory"); }
    }
};
struct EpiSwiglu {
    static constexpr bool PERM = true;
    bf16_t* O; int ldc;
    __device__ __forceinline__ void operator()(const f32x4 (&acc)[2][2][4][2], const Unit& u, int wr, int wc, int fr, int fq) const {
        const int row0 = u.pm * BM + wr * 64 + fr, col0 = u.pn * HALF + wc * 32 + 8 * fq;
#pragma unroll
        for (int ai = 0; ai < 2; ++ai)
#pragma unroll
            for (int m = 0; m < 4; ++m) { bf16_t* rowp = O + (size_t)(row0 + ai * HALF + m * 16) * ldc + col0;
                float r[8];
#pragma unroll
                for (int n = 0; n < 2; ++n)
#pragma unroll
                    for (int j = 0; j < 4; ++j) { const float gt = acc[ai][0][m][n][j], up = acc[ai][1][m][n][j]; r[4 * n + j] = silu_f(gt) * up; }
                u32x4 w; w.x = cvtpk(r[0], r[1]); w.y = cvtpk(r[2], r[3]); w.z = cvtpk(r[4], r[5]); w.w = cvtpk(r[6], r[7]);
                *(u32x4*)rowp = w; }
    }
};
struct DownSplitOrder {
    StaticOrder so; int G, c;
    __device__ void init(int G_, int c_) { so.init(NLAT, DM, G_, c_); G = G_; c = c_; }
    __device__ bool next(int i, Unit& u) const {
        if (so.next(i, u)) { u.kt0 = 0; u.nkt = DFF / BK; return true; }
        const int rounds = (so.nwg + G - 1) / G; const int j = (i - rounds) * G + c; if (i < rounds || j >= 128) return false;
        const int tile = j >> 2, part = j & 3; u.pm = NLAT / BM + (tile >> 2); u.pn = tile & 3; u.e = 1 + part;
        u.kt0 = part == 0 ? 0 : part == 1 ? 12 : part == 2 ? 24 : 34; u.nkt = part < 2 ? 12 : 10; return true;
    }
    __device__ __forceinline__ int arow(const Unit& u, int r) const { return u.pm * BM + r; }
};
struct MoeOrder {
    int c0, c1, c2, c3, c4, c5, c6, c7, t1, t2, t3, t4, t5, t6, t7, t8; int npn, G, c; const int* list; bool gather;
    __device__ void init(const unsigned* cw, int npn_, int G_, int c_, const int* list_, bool gather_) {
        #define RFL_(x) __builtin_amdgcn_readfirstlane((int)(x))
        c0 = RFL_(cw[0]); c1 = RFL_(cw[64]); c2 = RFL_(cw[128]); c3 = RFL_(cw[192]); c4 = RFL_(cw[256]); c5 = RFL_(cw[320]); c6 = RFL_(cw[384]); c7 = RFL_(cw[448]);
#undef RFL_
        t1 = (c0 + 255) >> 8; t2 = t1 + ((c1 + 255) >> 8); t3 = t2 + ((c2 + 255) >> 8); t4 = t3 + ((c3 + 255) >> 8); t5 = t4 + ((c4 + 255) >> 8); t6 = t5 + ((c5 + 255) >> 8); t7 = t6 + ((c6 + 255) >> 8); t8 = t7 + ((c7 + 255) >> 8);
        npn = npn_; G = G_; c = c_; list = list_; gather = gather_;
    }
    __device__ bool next(int i, Unit& u) const {
        const int L = i * G + c, nwg = t8 * npn; if (L >= nwg) return false;
        int wgid = L; { const int q = nwg / NXCD, r = nwg % NXCD, xcd = wgid % NXCD, off = wgid / NXCD; wgid = (xcd < r ? xcd * (q + 1) : r * (q + 1) + (xcd - r) * q) + off; }
        const int nig = WGM * npn, gid = wgid / nig, fm = gid * WGM, gsz = (t8 - fm) < WGM ? (t8 - fm) : WGM;
        const int ti = fm + ((wgid % nig) % gsz); u.pn = (wgid % nig) / gsz; u.pm = ti;
        u.e = (ti >= t1) + (ti >= t2) + (ti >= t3) + (ti >= t4) + (ti >= t5) + (ti >= t6) + (ti >= t7); return true;
    }
    __device__ __forceinline__ int ecnt(int e) const { return e == 0 ? c0 : e == 1 ? c1 : e == 2 ? c2 : e == 3 ? c3 : e == 4 ? c4 : e == 5 ? c5 : e == 6 ? c6 : c7; }
    __device__ __forceinline__ int etb(int e) const { return e == 0 ? 0 : e == 1 ? t1 : e == 2 ? t2 : e == 3 ? t3 : e == 4 ? t4 : e == 5 ? t5 : e == 6 ? t6 : t7; }
    __device__ __forceinline__ int arow(const Unit& u, int r) const {
        if (!gather) return u.pm * BM + r;
        const int pos = (u.pm - etb(u.e)) * BM + r;
        const int n_e = ecnt(u.e); const int v = list[u.e * NLAT + (pos < n_e ? pos : 0)] >> 1; return pos < n_e ? v : 0;
    }
};
struct EpiMoeDown {
    static constexpr bool PERM = true;
    bf16_t* Y; const int* list; const float* topw; MoeOrder mo;
    __device__ __forceinline__ void operator()(const f32x4 (&acc)[2][2][4][2], const Unit& u, int wr, int wc, int fr, int fq) const {
        const int pos0 = (u.pm - mo.etb(u.e)) * BM + wr * 64 + fr, n_e = mo.ecnt(u.e), col0 = u.pn * BM + wc * 32 + 8 * fq;
        int tkv[8]; float wgv[8];
#pragma unroll
        for (int i = 0; i < 8; ++i) { const int pos = pos0 + (i >> 2) * HALF + (i & 3) * 16; tkv[i] = list[u.e * NLAT + (pos < n_e ? pos : 0)]; }
#pragma unroll
        for (int i = 0; i < 8; ++i) wgv[i] = topw[tkv[i]];
#pragma unroll
        for (int ai = 0; ai < 2; ++ai)
#pragma unroll
            for (int m = 0; m < 4; ++m) { const int pos = pos0 + ai * HALF + m * 16;
                if (pos < n_e) { const int tk = tkv[ai * 4 + m]; const float wgt = wgv[ai * 4 + m]; bf16_t* rowp = Y + (size_t)tk * DM + col0;
#pragma unroll
                    for (int bj = 0; bj < 2; ++bj) { const f32x4 v0 = acc[ai][bj][m][0] * wgt, v1 = acc[ai][bj][m][1] * wgt;
                        u32x4 w; w.x = cvtpk(v0[0], v0[1]); w.y = cvtpk(v0[2], v0[3]); w.z = cvtpk(v1[0], v1[1]); w.w = cvtpk(v1[2], v1[3]);
                        *(u32x4*)(rowp + bj * HALF) = w; } } }
    }
};
}
constexpr int NWAVES = 8, NTHR = 512;
constexpr int RING_BYTES = 147456;
constexpr int LDSCTL_OFF = RING_BYTES, MISC_OFF = LDSCTL_OFF + 320;
constexpr int LDS_BYTES = RING_BYTES + 1024;
typedef GAS unsigned gu32;
#define RLX_AGENT __ATOMIC_RELAXED, __HIP_MEMORY_SCOPE_AGENT

#define XB_TMO      128
#define XB_XCNT(j)  (256  + 64 * (j))
#define XB_XSUB(j)  (1280 + 64 * (j))
#define XB_XGEN(j)  (2304 + 64 * (j))
#define XB_TOP      3328
#define XB_TOPGEN   3392
#define XCD_BAR_WORDS 3456
#define XB_SPIN_CAP (1u << 18)
__device__ __forceinline__ unsigned xb_ld(unsigned* p)              { return __hip_atomic_load(p, __ATOMIC_RELAXED, __HIP_MEMORY_SCOPE_AGENT); }
__device__ __forceinline__ unsigned xb_add(unsigned* p, unsigned v) { return __hip_atomic_fetch_add(p, v, __ATOMIC_RELAXED, __HIP_MEMORY_SCOPE_AGENT); }
__device__ __forceinline__ unsigned xb_xcc_id() { return (unsigned)__builtin_amdgcn_s_getreg((3 << 11) | 20) & 0xFu; }
#define XB_SPIN(cond, bar) do { unsigned _sp = 0; while (cond) { __builtin_amdgcn_s_sleep(1); \
    if ((++_sp & 255u) == 0u) { if (xb_ld(&(bar)[XB_TMO])) break; if (_sp > XB_SPIN_CAP) { atomicAdd(&(bar)[XB_TMO], 1u); break; } } } } while (0)
struct XcdBarrier { unsigned* bar; unsigned x; volatile LAS unsigned* st; };
__device__ __forceinline__ XcdBarrier xcd_barrier_post(unsigned* bar, volatile LAS unsigned* st, bool leader) {
    XcdBarrier b; b.bar = bar; b.x = xb_xcc_id(); b.st = st;
    if (leader) (void)xb_add(&bar[XB_XCNT(b.x)], 1u);
    return b;
}
__device__ __forceinline__ void xcd_barrier_complete(unsigned* bar, unsigned x, unsigned& nloc, unsigned& nx) {
    const unsigned G = gridDim.x * gridDim.y * gridDim.z;
    unsigned sum, cnt, mine, sp = 0u;
    for (;;) {
        sum = 0u; cnt = 0u; mine = 0u;
#pragma unroll
        for (unsigned j = 0; j < 16; ++j) { const unsigned c = xb_ld(&bar[XB_XCNT(j)]); sum += c; cnt += (c > 0u) ? 1u : 0u; mine = (j == x) ? c : mine; }
        if (sum == G) break;
        __builtin_amdgcn_s_sleep(1);
        if ((++sp & 255u) == 0u) { if (xb_ld(&bar[XB_TMO])) break; if (sp > XB_SPIN_CAP) { atomicAdd(&bar[XB_TMO], 1u); break; } }
    }
    nloc = mine > 0u ? mine : 1u; nx = cnt > 0u ? cnt : 1u;
}
__device__ __forceinline__ void xcd_barrier(const XcdBarrier& b, bool leader) {
    asm volatile("s_waitcnt vmcnt(0)" ::: "memory");
    __syncthreads();
    if (leader) {
        unsigned* bar = b.bar;
        __builtin_amdgcn_s_waitcnt(0);
        unsigned nloc = b.st[0], nx = b.st[1];
        if (nloc == 0u) { xcd_barrier_complete(bar, b.x, nloc, nx); b.st[0] = nloc; b.st[1] = nx; }
        const unsigned old = xb_add(&bar[XB_XSUB(b.x)], 1u);
        const unsigned gen = old / nloc;
        if (old + 1u == (gen + 1u) * nloc) {
            __builtin_amdgcn_fence(__ATOMIC_RELEASE, "agent");
            asm volatile("s_waitcnt vmcnt(0)" ::: "memory");
            const unsigned og = xb_add(&bar[XB_TOP], 1u);
            const unsigned tg = og / nx;
            if (og + 1u == (tg + 1u) * nx) xb_add(&bar[XB_TOPGEN], 1u);
            else XB_SPIN(xb_ld(&bar[XB_TOPGEN]) == tg, bar);
            __builtin_amdgcn_fence(__ATOMIC_ACQUIRE, "agent");
            xb_add(&bar[XB_XGEN(b.x)], 1u);
            asm volatile("s_waitcnt vmcnt(0)" ::: "memory");
        } else {
            XB_SPIN(xb_ld(&bar[XB_XGEN(b.x)]) == gen, bar);
            __builtin_amdgcn_fence(__ATOMIC_ACQUIRE, "agent");
            asm volatile("s_waitcnt vmcnt(0)" ::: "memory");
        }
    }
    __syncthreads();
}

struct Frame {
    unsigned char* sm;
    LAS unsigned char* lds;
    int tid, lane, wave, G, vcu;
    const float *x, *c, *ctx, *c_ctx, *w_mod, *b_mod, *g_mix, *w_in, *w_sgu, *b_sgu, *g_sgu, *beta_sgu, *conv_w, *conv_b, *dt_bias, *a_log, *d_skip, *g_ssd, *g_q, *w_uq, *g_kv, *w_ukv,
                *w_out, *g_ffn, *w_gate, *w_up, *w_down, *w_router, *w_gate_e, *w_up_e, *w_down_e, *g_final;
    float* out; unsigned char* ws;
};
#define WSP(T, off) ((T*)(F.ws + (off)))

__device__ __forceinline__ int rowmap(int mode, int n) {
    if (mode == 1) { if (n < 1792) return n; if (n < 1804) return n + 672; return n - 12; }
    if (mode == 2) return ((n >> 7) << 8) + (n & 127);
    if (mode == 3) return ((n >> 7) << 8) + 128 + (n & 127);
    return n;
}
__device__ __forceinline__ void transpose_item(const float* W, int K, int N, bf16_t* WT, const float* ks, int mode, LAS float* scr, int item, int lane) {
    const int nblk = (N + 31) / 32, kb = item / nblk, nb = item % nblk, k0 = 64 * kb, n0 = 32 * nb;
    const int nn = n0 + (lane & 31); const bool nok = nn < N;
#pragma unroll 16
    for (int i = 0; i < 32; ++i) { const int kk = 2 * i + (lane >> 5); float v = W[(size_t)(k0 + kk) * N + (nok ? nn : N - 1)]; v = nok ? v : 0.f; if (ks) v *= ks[k0 + kk]; scr[kk * 33 + (lane & 31)] = v; }
    LDS_WAIT(); asm volatile("" ::: "memory");
    const int cch = lane & 7;
#pragma unroll
    for (int j = 0; j < 4; ++j) { const int n = (lane >> 3) + 8 * j; const LAS float* s = scr + (8 * cch) * 33 + n;
        u32x4 o; o.x = cvtpk(s[0 * 33], s[1 * 33]); o.y = cvtpk(s[2 * 33], s[3 * 33]); o.z = cvtpk(s[4 * 33], s[5 * 33]); o.w = cvtpk(s[6 * 33], s[7 * 33]);
        if (n0 + n < N) *(u32x4*)(WT + (size_t)rowmap(mode, n0 + n) * K + k0 + 8 * cch) = o; }
    LDS_WAIT(); asm volatile("" ::: "memory");
}
__device__ __forceinline__ void transpose_item64(const float* W, int K, int N, bf16_t* WT, const float* ks, int mode, LAS float* scr, int item, int lane) {
    const int nblk = (N + 63) / 64, kb = item / nblk, nb = item % nblk, k0 = 64 * kb, n0 = 64 * nb;
    const int lr = lane >> 4, lc = (lane & 15) * 4; const bool nok = n0 + lc < N; const int ncol = nok ? n0 + lc : N - 4;
#pragma unroll
    for (int i = 0; i < 16; ++i) { const int kk = 4 * i + lr; f32x4 v = *(const f32x4*)(W + (size_t)(k0 + kk) * N + ncol); if (ks) v = v * ks[k0 + kk];
        scr[kk * 65 + lc] = v[0]; scr[kk * 65 + lc + 1] = v[1]; scr[kk * 65 + lc + 2] = v[2]; scr[kk * 65 + lc + 3] = v[3]; }
    LDS_WAIT(); asm volatile("" ::: "memory");
    const int cch = lane & 7;
#pragma unroll
    for (int j = 0; j < 8; ++j) { const int n = (lane >> 3) + 8 * j; const LAS float* s = scr + (8 * cch) * 65 + n;
        u32x4 o; o.x = cvtpk(s[0 * 65], s[1 * 65]); o.y = cvtpk(s[2 * 65], s[3 * 65]); o.z = cvtpk(s[4 * 65], s[5 * 65]); o.w = cvtpk(s[6 * 65], s[7 * 65]);
        if (n0 + n < N) *(u32x4*)(WT + (size_t)rowmap(mode, n0 + n) * K + k0 + 8 * cch) = o; }
    LDS_WAIT(); asm volatile("" ::: "memory");
}
__device__ __forceinline__ void zero_fill16(Frame& F, void* p, size_t bytes) {
    const size_t n = bytes / 16; const u32x4 z = {0u, 0u, 0u, 0u};
    for (size_t i = (size_t)F.vcu * NTHR + F.tid; i < n; i += (size_t)F.G * NTHR) ((u32x4*)p)[i] = z;
}
__device__ __forceinline__ void mod_gemv(Frame& F, int l, int wi, int nw) {
    LAS float* cond = (LAS float*)F.lds;
    LAS float* red = (LAS float*)(F.lds + 36864);
    __syncthreads();
    for (int i = F.tid; i < 9 * DM; i += NTHR) { const float v = i < 8 * DM ? F.c[i] : F.c_ctx[i - 8 * DM]; cond[i] = silu_f(v); }
    __syncthreads();
    for (int ch = wi; ch < 192; ch += nw) {
        const int cl = F.lane & 31, kh = F.lane >> 5, col = ch * 32 + cl, kg = F.wave;
        const float* wp = F.w_mod + (size_t)l * DM * 6144 + (size_t)(kg * 128 + kh) * 6144 + col;
        float a[9];
#pragma unroll
        for (int r = 0; r < 9; ++r) a[r] = 0.f;
#pragma unroll 8
        for (int k4 = 0; k4 < 16; ++k4) { const float w0 = wp[(size_t)(8 * k4) * 6144], w1 = wp[(size_t)(8 * k4 + 2) * 6144], w2 = wp[(size_t)(8 * k4 + 4) * 6144], w3 = wp[(size_t)(8 * k4 + 6) * 6144];
#pragma unroll
            for (int r = 0; r < 9; ++r) { const LAS float* cp = cond + r * DM + kg * 128 + 8 * k4 + kh; a[r] += (cp[0] * w0 + cp[2] * w1) + (cp[4] * w2 + cp[6] * w3); } }
#pragma unroll
        for (int r = 0; r < 9; ++r) { a[r] += __shfl_xor(a[r], 32); if (kh == 0) red[(kg * 9 + r) * 32 + cl] = a[r]; }
        __syncthreads();
        for (int idx = F.tid; idx < 9 * 32; idx += NTHR) { const int r = idx >> 5, cc = idx & 31; float s = 0.f;
#pragma unroll
            for (int g = 0; g < 8; ++g) s += red[(g * 9 + r) * 32 + cc];
            WSP(float, WS_MOD)[((size_t)l * 9 + r) * 6144 + ch * 32 + cc] = s + F.b_mod[l * 6144 + ch * 32 + cc]; }
        __syncthreads();
    }
}
__device__ __forceinline__ void convert_set(Frame& F, int set, int wi, int nw) {
    __syncthreads();
    LAS float* scr = (LAS float*)(F.lds + F.wave * 16640);
    const int gw = wi * NWAVES + F.wave, NGW = nw * NWAVES;
    constexpr int I_IN = 16 * 39, I_UQ = 6 * 9, I_UKV = 4 * 12, I_OUT = 16 * 16, I_G = 16 * 44, I_D = 44 * 16;
    if (set == 0 || set == 3) { const int l = set == 0 ? 0 : 1; const int n = I_IN + I_UQ + I_UKV + (l == 1 ? I_OUT : 0);
        for (int it = gw; it < n; it += NGW) { int r = it;
            if (r < I_IN) { transpose_item64(F.w_in + (size_t)l * DM * INW, DM, INW, WSP(bf16_t, WS_WIN) + (size_t)l * INP * DM, nullptr, 1, scr, r, F.lane); continue; } r -= I_IN;
            if (r < I_UQ) { transpose_item64(F.w_uq + (size_t)l * 384 * QW, 384, QW, WSP(bf16_t, WS_WUQ) + (size_t)l * QWP * 384, F.g_q + l * 384, 0, scr, r, F.lane); continue; } r -= I_UQ;
            if (r < I_UKV) { transpose_item64(F.w_ukv + (size_t)l * 256 * KVW, 256, KVW, WSP(bf16_t, WS_WUKV) + (size_t)l * KVW * 256, F.g_kv + l * 256, 0, scr, r, F.lane); continue; } r -= I_UKV;
            transpose_item64(F.w_out + (size_t)l * DM * DM, DM, DM, WSP(bf16_t, WS_WOUT) + (size_t)l * DM * DM, nullptr, 0, scr, r, F.lane); }
        const u32x4 z = {0u, 0u, 0u, 0u};
        { u32x4* p0 = (u32x4*)(WSP(bf16_t, WS_WIN) + ((size_t)l * INP + INW) * DM); const size_t n0 = (size_t)(INP - INW) * DM * 2 / 16; for (size_t i = (size_t)wi * NTHR + F.tid; i < n0; i += (size_t)nw * NTHR) p0[i] = z;
          u32x4* p1 = (u32x4*)(WSP(bf16_t, WS_WUQ) + ((size_t)l * QWP + QW) * 384); const size_t n1 = (size_t)(QWP - QW) * 384 * 2 / 16; for (size_t i = (size_t)wi * NTHR + F.tid; i < n1; i += (size_t)nw * NTHR) p1[i] = z; }
    } else if (set == 1) {
        for (int it = gw; it < I_OUT; it += NGW) transpose_item64(F.w_out, DM, DM, WSP(bf16_t, WS_WOUT), nullptr, 0, scr, it, F.lane);
    } else {
        for (int it = gw; it < 2 * I_G + I_D; it += NGW) { int r = it;
            if (r < I_G) { transpose_item64(F.w_gate, DM, DFF, WSP(bf16_t, WS_WGU), nullptr, 2, scr, r, F.lane); continue; } r -= I_G;
            if (r < I_G) { transpose_item64(F.w_up, DM, DFF, WSP(bf16_t, WS_WGU), nullptr, 3, scr, r, F.lane); continue; } r -= I_G;
            transpose_item64(F.w_down, DFF, DM, WSP(bf16_t, WS_WD), nullptr, 0, scr, r, F.lane); }
    }
    __syncthreads();
}
__device__ __forceinline__ void p_prologue(Frame& F) {
    mod_gemv(F, 0, F.vcu, F.G);
    for (int set_ = 0; set_ < 2; ++set_) convert_set(F, set_, F.vcu, F.G);
    if (F.vcu == 0) { for (int i = F.tid; i < 64 * 8; i += NTHR) { const int pos = i >> 3, f = i & 7; const float inv = powf(10000.f, -(float)f / 8.f); const float ang = (float)pos * inv;
            WSP(f32x2, WS_MISC + MISC_ROPE)[i] = (f32x2){cosf(ang), sinf(ang)}; } }
    for (int i = F.vcu * NTHR + F.tid; i < 2 * 4 * 128 * 128 / 2; i += F.G * NTHR) { const f32x2 v = ((const f32x2*)F.w_sgu)[i]; WSP(unsigned, WS_WSGU)[i] = cvtpk(v.x, v.y); }
}
__device__ __forceinline__ bool tail_worker(int nwg, int G, int c, int& wi, int& nw) {
    const int rounds = (nwg + G - 1) / G, first = nwg - (rounds - 1) * G;
    if (first >= G) { wi = c; nw = G; return true; }
    if (c < first) return false;
    wi = c - first; nw = G - first; return true;
}
__device__ __forceinline__ void p_moe_weights(Frame& F) {
    __syncthreads();
    LAS float* scr = (LAS float*)(F.lds + F.wave * 16640);
    const int gw = F.vcu * NWAVES + F.wave, NGW = F.G * NWAVES;
    constexpr int I_G = 16 * 22, I_D = 22 * 16, PER_E = 2 * I_G + I_D;
    for (int it = gw; it < 8 * PER_E; it += NGW) {
        const int e = it / PER_E; int r = it - e * PER_E;
        bf16_t* gu = WSP(bf16_t, WS_MOEW_GU) + (size_t)e * 2 * DFE * DM;
        if (r < I_G) { transpose_item64(F.w_gate_e + (size_t)e * DM * DFE, DM, DFE, gu, nullptr, 2, scr, r, F.lane); continue; } r -= I_G;
        if (r < I_G) { transpose_item64(F.w_up_e + (size_t)e * DM * DFE, DM, DFE, gu, nullptr, 3, scr, r, F.lane); continue; } r -= I_G;
        transpose_item64(F.w_down_e + (size_t)e * DFE * DM, DFE, DM, WSP(bf16_t, WS_MOEW_D) + (size_t)e * DM * DFE, nullptr, 0, scr, r, F.lane);
    }
    __syncthreads();
}

template <bool ROUTE>
__device__ __forceinline__ void p_norm(Frame& F, int l, int which, int nrows, const float* srcL, const float* srcC, const float* slab = nullptr, const float* slabgate = nullptr) {
    const float* mod = WSP(float, WS_MOD) + (size_t)l * 9 * 6144;
    const float* g = (which == 0 ? F.g_mix : F.g_ffn) + l * DM;
    bf16_t* H = WSP(bf16_t, WS_H);
    LAS int* lcnt = (LAS int*)(F.lds + 32768);
    LAS int* rec = (LAS int*)(F.lds + 32768 + 64);
    int nrec = 0;
    if (ROUTE) { LAS float* wr = (LAS float*)F.lds; for (int i = F.tid; i < DM * 8; i += NTHR) wr[i] = F.w_router[i]; if (F.tid < 16) lcnt[F.tid] = 0; __syncthreads(); }
    const int gw = F.vcu * NWAVES + F.wave, NGW = F.G * NWAVES;
    for (int row = gw; row < nrows; row += NGW) {
        const bool isc = row >= NLAT; const int b = isc ? 8 : (row >> 11);
        const float* xr = isc ? srcC + (size_t)(row - NLAT) * DM : srcL + (size_t)row * DM;
        f32x4 v[4]; float s = 0.f;
#pragma unroll
        for (int j = 0; j < 4; ++j) v[j] = *(const f32x4*)(xr + 256 * j + 4 * F.lane);
        if (slab && isc) {
#pragma unroll
            for (int j = 0; j < 4; ++j) { const size_t o_ = (size_t)(row - NLAT) * DM + 256 * j + 4 * F.lane; const f32x4 gt = *(const f32x4*)(slabgate + 256 * j + 4 * F.lane);
                const f32x4 p0 = *(const f32x4*)(slab + o_), p1 = *(const f32x4*)(slab + (size_t)NCTX * DM + o_), p2 = *(const f32x4*)(slab + (size_t)2 * NCTX * DM + o_), p3 = *(const f32x4*)(slab + (size_t)3 * NCTX * DM + o_);
                v[j] = v[j] + gt * ((p0 + p1) + (p2 + p3)); } }
#pragma unroll
        for (int j = 0; j < 4; ++j) s += (v[j].x * v[j].x + v[j].y * v[j].y) + (v[j].z * v[j].z + v[j].w * v[j].w);
        const float rstd = rsqrtf(wave_sum(s) * (1.f / DM) + EPS);
        const float* sh = mod + (size_t)b * 6144 + (which * 3) * DM; const float* sc = sh + DM;
        float lg[8];
        if (ROUTE) {
#pragma unroll
            for (int e = 0; e < 8; ++e) lg[e] = 0.f; }
#pragma unroll
        for (int j = 0; j < 4; ++j) { const int k = 256 * j + 4 * F.lane;
            const f32x4 gg = *(const f32x4*)(g + k), s1 = *(const f32x4*)(sc + k), s0 = *(const f32x4*)(sh + k);
            f32x4 h = (v[j] * rstd) * gg * (s1 + 1.f) + s0;
            u32x2 w; w.x = cvtpk(h.x, h.y); w.y = cvtpk(h.z, h.w);
            *(u32x2*)(H + (size_t)row * DM + k) = w;
            if (ROUTE) { const LAS float* wr = (const LAS float*)F.lds + k * 8;
#pragma unroll
                for (int i = 0; i < 4; ++i) { const f32x4 w0 = *(const LAS f32x4*)(wr + 8 * i), w1 = *(const LAS f32x4*)(wr + 8 * i + 4); const float hv = h[i];
                    lg[0] += hv * w0.x; lg[1] += hv * w0.y; lg[2] += hv * w0.z; lg[3] += hv * w0.w; lg[4] += hv * w1.x; lg[5] += hv * w1.y; lg[6] += hv * w1.z; lg[7] += hv * w1.w; }
                asm volatile("" ::: "memory"); }
        }
        if (ROUTE) {
#pragma unroll
            for (int e = 0; e < 8; ++e) lg[e] = wave_sum(lg[e]);
            int i0 = 0; float m0 = lg[0];
#pragma unroll
            for (int e = 1; e < 8; ++e) if (lg[e] > m0) { m0 = lg[e]; i0 = e; }
            int i1 = -1; float m1 = -3.0e38f;
#pragma unroll
            for (int e = 0; e < 8; ++e) if (e != i0 && lg[e] > m1) { m1 = lg[e]; i1 = e; }
            const float w1 = 1.f / (1.f + __expf(m0 - m1)), w0 = 1.f - w1;
            if (F.lane == 0) { float* tw = WSP(float, WS_MISC + MISC_TOPW);
                const int p0 = __hip_atomic_fetch_add(lcnt + i0, 1, __ATOMIC_RELAXED, __HIP_MEMORY_SCOPE_WORKGROUP), p1 = __hip_atomic_fetch_add(lcnt + i1, 1, __ATOMIC_RELAXED, __HIP_MEMORY_SCOPE_WORKGROUP);
                LAS int* r = rec + (F.wave * 16 + nrec) * 4; r[0] = row; r[1] = i0 | (i1 << 8); r[2] = p0; r[3] = p1; tw[row * 2] = w0; tw[row * 2 + 1] = w1; }
            ++nrec;
        }
    }
    if (ROUTE) {
        __syncthreads();
        if (F.tid < 8) lcnt[8 + F.tid] = (int)atomicAdd(WSP(unsigned, WS_CTL) + CW_CNT + 64 * F.tid, (unsigned)lcnt[F.tid]);
        __syncthreads();
        int* list = WSP(int, WS_LIST);
        if (F.lane < nrec) { const LAS int* r = rec + (F.wave * 16 + F.lane) * 4; const int row = r[0], i0 = r[1] & 255, i1 = r[1] >> 8;
            list[i0 * NLAT + lcnt[8 + i0] + r[2]] = row * 2; list[i1 * NLAT + lcnt[8 + i1] + r[3]] = row * 2 + 1; }
        __syncthreads();
    }
}
__device__ __forceinline__ void p_final(Frame& F) {
    const float* mod = WSP(float, WS_MOD) + (size_t)1 * 9 * 6144; const bf16_t* Y = WSP(bf16_t, WS_Y);
    const int gw = F.vcu * NWAVES + F.wave, NGW = F.G * NWAVES;
    for (int row = gw; row < NLAT; row += NGW) {
        const int b = row >> 11; float* xr = F.out + (size_t)row * DM; const float* gt = mod + (size_t)b * 6144 + 5 * DM;
        f32x4 v[4]; float s = 0.f;
#pragma unroll
        for (int j = 0; j < 4; ++j) { const int k = 256 * j + 4 * F.lane; const f32x4 xv = *(const f32x4*)(xr + k), gv = *(const f32x4*)(gt + k);
            const u32x2 a = *(const u32x2*)(Y + (size_t)(2 * row) * DM + k), c = *(const u32x2*)(Y + (size_t)(2 * row + 1) * DM + k);
            f32x4 y; y.x = bflo(a.x) + bflo(c.x); y.y = bfhi(a.x) + bfhi(c.x); y.z = bflo(a.y) + bflo(c.y); y.w = bfhi(a.y) + bfhi(c.y);
            v[j] = xv + gv * y; s += (v[j].x * v[j].x + v[j].y * v[j].y) + (v[j].z * v[j].z + v[j].w * v[j].w); }
        const float rstd = rsqrtf(wave_sum(s) * (1.f / DM) + EPS);
#pragma unroll
        for (int j = 0; j < 4; ++j) { const int k = 256 * j + 4 * F.lane; *(f32x4*)(xr + k) = (v[j] * rstd) * *(const f32x4*)(F.g_final + k); }
    }
}
constexpr int LP = 272;
__device__ __forceinline__ void chunk_rows(int u, int& row0, bool& isc) {
    if (u < 128) { row0 = (u >> 4) * SEQ + (u & 15) * 128; isc = false; } else { const int uu = u - 128; row0 = NLAT + (uu >> 1) * CTXL + (uu & 1) * 128; isc = true; }
}
__device__ __forceinline__ void krope_unit(Frame& F, int u) {
    int row0; bool isc; chunk_rows(u, row0, isc);
    const bf16_t* P = WSP(bf16_t, WS_P);
    if (F.tid < 128) {
        const int row = row0 + F.tid; const u32x4* src = (const u32x4*)(P + (size_t)row * INP + PC_KR);
        u32x4 q[4];
#pragma unroll
        for (int i = 0; i < 4; ++i) q[i] = src[i];
        if (!isc) {
            const int tok = row & (SEQ - 1); const f32x2* rt = WSP(f32x2, WS_MISC + MISC_ROPE);
            float v[32];
#pragma unroll
            for (int i = 0; i < 4; ++i) { v[8 * i] = bflo(q[i].x); v[8 * i + 1] = bfhi(q[i].x); v[8 * i + 2] = bflo(q[i].y); v[8 * i + 3] = bfhi(q[i].y); v[8 * i + 4] = bflo(q[i].z); v[8 * i + 5] = bfhi(q[i].z); v[8 * i + 6] = bflo(q[i].w); v[8 * i + 7] = bfhi(q[i].w); }
#pragma unroll
            for (int ax = 0; ax < 2; ++ax) { const int pos = ax == 0 ? (tok >> 6) : (tok & 63);
#pragma unroll
                for (int f = 0; f < 8; ++f) { const f32x2 cs = rt[pos * 8 + f]; const float t1 = v[16 * ax + f], t2 = v[16 * ax + 8 + f];
                    v[16 * ax + f] = t1 * cs.x - t2 * cs.y; v[16 * ax + 8 + f] = t1 * cs.y + t2 * cs.x; } }
#pragma unroll
            for (int i = 0; i < 4; ++i) { q[i].x = cvtpk(v[8 * i], v[8 * i + 1]); q[i].y = cvtpk(v[8 * i + 2], v[8 * i + 3]); q[i].z = cvtpk(v[8 * i + 4], v[8 * i + 5]); q[i].w = cvtpk(v[8 * i + 6], v[8 * i + 7]); }
        }
        u32x4* dst = (u32x4*)(WSP(bf16_t, WS_KR) + (size_t)row * 32);
#pragma unroll
        for (int i = 0; i < 4; ++i) dst[i] = q[i];
    }
}
__device__ __forceinline__ void sgu_unit(Frame& F, int l, int u) {
    int row0; bool isc; chunk_rows(u, row0, isc);
    const bf16_t* P = WSP(bf16_t, WS_P); bf16_t* CAT = WSP(bf16_t, WS_CAT);
    LAS unsigned char* VT = F.lds;
    LAS unsigned char* WB = F.lds + 256 * LP;
    const int w = F.wave, lane = F.lane;
    {
        const f32x4 gs = *(const f32x4*)(F.g_sgu + l * 256 + 4 * lane), bs = *(const f32x4*)(F.beta_sgu + l * 256 + 4 * lane);
#pragma unroll
        for (int grp = 0; grp < 2; ++grp) {
            const int s0 = 16 * w + 8 * grp;
            float v[8][4];
#pragma unroll
            for (int tt = 0; tt < 8; ++tt) { const u32x2 r = *(const u32x2*)(P + (size_t)(row0 + s0 + tt) * INP + PC_V + 4 * lane);
                v[tt][0] = gelu_tanh(bflo(r.x)); v[tt][1] = gelu_tanh(bfhi(r.x)); v[tt][2] = gelu_tanh(bflo(r.y)); v[tt][3] = gelu_tanh(bfhi(r.y)); }
#pragma unroll
            for (int tt = 0; tt < 8; ++tt) {
                const float mu = wave_sum((v[tt][0] + v[tt][1]) + (v[tt][2] + v[tt][3])) * (1.f / 256.f);
                float d0 = v[tt][0] - mu, d1 = v[tt][1] - mu, d2 = v[tt][2] - mu, d3 = v[tt][3] - mu;
                const float rstd = rsqrtf(wave_sum((d0 * d0 + d1 * d1) + (d2 * d2 + d3 * d3)) * (1.f / 256.f) + EPS);
                v[tt][0] = d0 * rstd * gs.x + bs.x; v[tt][1] = d1 * rstd * gs.y + bs.y; v[tt][2] = d2 * rstd * gs.z + bs.z; v[tt][3] = d3 * rstd * gs.w + bs.w; }
#pragma unroll
            for (int i = 0; i < 4; ++i) { u32x4 o; o.x = cvtpk(v[0][i], v[1][i]); o.y = cvtpk(v[2][i], v[3][i]); o.z = cvtpk(v[4][i], v[5][i]); o.w = cvtpk(v[6][i], v[7][i]);
                *(LAS u32x4*)(VT + (4 * lane + i) * LP + s0 * 2) = o; }
        }
    }
    const bf16_t* Wg = WSP(bf16_t, WS_WSGU) + (size_t)l * 4 * 128 * 128;
#define SGU_STAGE_W(h, buf) do { _Pragma("unroll") for (int _i = 0; _i < 4; ++_i) { const int q_ = F.tid + NTHR * _i, r_ = q_ >> 4, c_ = q_ & 15; \
        *(LAS u32x4*)(WB + (buf) * 128 * LP + r_ * LP + c_ * 16) = *(const u32x4*)(Wg + (size_t)(h) * 16384 + r_ * 128 + c_ * 8); } } while (0)
    SGU_STAGE_W(0, 0);
    u32x2 upre[4][4];
    { const int t_ = 16 * w + (lane & 15), row_ = row0 + t_;
#pragma unroll
        for (int h = 0; h < 4; ++h)
#pragma unroll
            for (int dt = 0; dt < 4; ++dt) upre[h][dt] = *(const u32x2*)(P + (size_t)row_ * INP + PC_U + h * 64 + dt * 16 + 4 * (lane >> 4)); }
    __syncthreads();
    f32x4 acc[4][4];
#pragma unroll
    for (int h = 0; h < 4; ++h)
#pragma unroll
        for (int dt = 0; dt < 4; ++dt) acc[h][dt] = (f32x4){0.f, 0.f, 0.f, 0.f};
    const int fr = lane & 15, fq = lane >> 4;
#pragma unroll
    for (int h = 0; h < 4; ++h) {
        if (h + 1 < 4) SGU_STAGE_W(h + 1, (h + 1) & 1);
        const LAS unsigned char* Wh = WB + (h & 1) * 128 * LP;
#pragma unroll
        for (int ks = 0; ks < 4; ++ks) {
            const bf16x8 bw = *(const LAS bf16x8*)(Wh + (16 * w + fr) * LP + (32 * ks + 8 * fq) * 2);
#pragma unroll
            for (int dt = 0; dt < 4; ++dt) { const bf16x8 av = *(const LAS bf16x8*)(VT + (h * 64 + dt * 16 + fr) * LP + (32 * ks + 8 * fq) * 2);
                acc[h][dt] = MFMA16(av, bw, acc[h][dt]); }
        }
        __syncthreads();
    }
#undef SGU_STAGE_W
    { const int t = 16 * w + fr, row = row0 + t;
#pragma unroll
        for (int h = 0; h < 4; ++h) { const float bsv = F.b_sgu[(l * 4 + h) * 128 + t];
#pragma unroll
            for (int dt = 0; dt < 4; ++dt) { const int c = h * 64 + dt * 16 + 4 * fq; const u32x2 r = upre[h][dt];
                const float o0 = gelu_tanh(bflo(r.x)) * (acc[h][dt][0] + bsv), o1 = gelu_tanh(bfhi(r.x)) * (acc[h][dt][1] + bsv), o2 = gelu_tanh(bflo(r.y)) * (acc[h][dt][2] + bsv), o3 = gelu_tanh(bfhi(r.y)) * (acc[h][dt][3] + bsv);
                u32x2 o; o.x = cvtpk(o0, o1); o.y = cvtpk(o2, o3); *(u32x2*)(CAT + (size_t)row * DM + c) = o; } } }
    __syncthreads();
}

__device__ __forceinline__ void ssd_local_unit(Frame& F, int l, int u) {
    int b, c, g, row0, seq0, seqlen; bool isc;
    if (u < 256) { b = u >> 5; c = (u >> 1) & 15; g = u & 1; row0 = b * SEQ + c * 128; seq0 = b * SEQ; seqlen = SEQ; isc = false; }
    else { const int uu = u - 256; b = uu >> 2; c = (uu >> 1) & 1; g = uu & 1; row0 = NLAT + b * CTXL + c * 128; seq0 = NLAT + b * CTXL; seqlen = CTXL; isc = true; }
    const bf16_t* P = WSP(bf16_t, WS_P);
    LAS unsigned char* R1 = F.lds;
    LAS unsigned char* R2 = F.lds + 128 * LP;
    LAS unsigned char* XT = F.lds + 256 * LP;
    LAS float* dtv = (LAS float*)(F.lds + 448 * LP);
    LAS float* acsv = dtv + 768;
    LAS float* wv = acsv + 768;
    const int w = F.wave, lane = F.lane, tid = F.tid, fr = lane & 15, fq = lane >> 4;
    const float* cw = F.conv_w + (size_t)l * 5 * 896; const float* cb = F.conv_b + l * 896;
    LAS float* wlb = (LAS float*)(F.lds + 448 * LP + 9216);
    if (tid < 56) { const int chx0 = tid < 24 ? g * 192 + 8 * tid : (tid < 40 ? 384 + g * 128 + 8 * (tid - 24) : 640 + g * 128 + 8 * (tid - 40));
#pragma unroll
        for (int k = 0; k < 5; ++k) { *(LAS f32x4*)(wlb + tid * 48 + 8 * k) = *(const f32x4*)(cw + k * 896 + chx0); *(LAS f32x4*)(wlb + tid * 48 + 8 * k + 4) = *(const f32x4*)(cw + k * 896 + chx0 + 4); }
        *(LAS f32x4*)(wlb + tid * 48 + 40) = *(const f32x4*)(cb + chx0); *(LAS f32x4*)(wlb + tid * 48 + 44) = *(const f32x4*)(cb + chx0 + 4); }
    __syncthreads();
    if (tid < 448) {
        const int cg = tid % 56, seg = tid / 56;
        int pcol, role, lch;
        if (cg < 24) { role = 0; lch = 8 * cg; pcol = PC_X + g * 192 + lch; }
        else if (cg < 40) { role = 1; lch = 8 * (cg - 24); pcol = PC_B + g * 128 + lch; }
        else { role = 2; lch = 8 * (cg - 40); pcol = PC_C + g * 128 + lch; }
        const LAS float* wl = wlb + cg * 48;
#pragma unroll 1
        for (int hb = 0; hb < 2; ++hb) {
            const int t0 = 16 * seg + 8 * hb;
            u32x4 rows[12];
#pragma unroll
            for (int i = 0; i < 12; ++i) { const int grow = row0 + t0 - 2 + i;
                if (i >= 2 && i < 10) rows[i] = *(const u32x4*)(P + (size_t)grow * INP + pcol);
                else { const bool ok = grow >= seq0 && grow < seq0 + seqlen; const int gcl = i < 2 ? (grow < seq0 ? seq0 : grow) : (grow >= seq0 + seqlen ? seq0 + seqlen - 1 : grow);
                    const u32x4 v_ = *(const u32x4*)(P + (size_t)gcl * INP + pcol); rows[i] = ok ? v_ : (u32x4){0u, 0u, 0u, 0u}; } }
            unsigned pk[8][4];
#pragma unroll
            for (int o2 = 0; o2 < 4; ++o2) {
                float y[2][8];
#pragma unroll
                for (int e = 0; e < 2; ++e) { const int o = 2 * o2 + e; f32x4 ya = *(const LAS f32x4*)(wl + 40), yb = *(const LAS f32x4*)(wl + 44);
#pragma unroll
                    for (int k = 0; k < 5; ++k) { const u32x4 r = rows[o + k]; const f32x4 xa = {bflo(r.x), bfhi(r.x), bflo(r.y), bfhi(r.y)}, xb = {bflo(r.z), bfhi(r.z), bflo(r.w), bfhi(r.w)};
                        ya += *(const LAS f32x4*)(wl + 8 * k) * xa; yb += *(const LAS f32x4*)(wl + 8 * k + 4) * xb; }
#pragma unroll
                    for (int c8 = 0; c8 < 4; ++c8) { y[e][c8] = silu_f(ya[c8]); y[e][4 + c8] = silu_f(yb[c8]); }
                    if (role != 0) { u32x4 st; st.x = cvtpk(y[e][0], y[e][1]); st.y = cvtpk(y[e][2], y[e][3]); st.z = cvtpk(y[e][4], y[e][5]); st.w = cvtpk(y[e][6], y[e][7]);
                        *(u32x4*)((role == 1 ? R2 : R1) + (t0 + o) * LP + lch * 2) = st;
                        if (role == 2) *(u32x4*)(WSP(bf16_t, WS_CC) + (size_t)(row0 + t0 + o) * 256 + g * 128 + lch) = st; }
                }
#pragma unroll
                for (int c8 = 0; c8 < 8; ++c8) pk[c8][o2] = cvtpk(y[0][c8], y[1][c8]);
            }
            if (role == 0) {
#pragma unroll
                for (int c8 = 0; c8 < 8; ++c8) *(LAS u32x4*)(XT + (lch + c8) * LP + t0 * 2) = (u32x4){pk[c8][0], pk[c8][1], pk[c8][2], pk[c8][3]}; }
        }
    }
    else {
        bf16_t draw[6][2];
#pragma unroll
        for (int q = 0; q < 6; ++q) { const int d = q / 3, h = g * 3 + q % 3; const int e0 = 2 * lane, t0 = d == 0 ? e0 : 127 - e0, t1 = d == 0 ? e0 + 1 : 126 - e0;
            draw[q][0] = P[(size_t)(row0 + t0) * INP + PC_DT + d * 6 + h]; draw[q][1] = P[(size_t)(row0 + t1) * INP + PC_DT + d * 6 + h]; }
        asm volatile("" ::: "memory");
#pragma unroll
        for (int q = 0; q < 6; ++q) { const int d = q / 3, j = q % 3, h = g * 3 + j;
            const float a = -__expf(F.a_log[l * 12 + d * 6 + h]), bias = F.dt_bias[l * 12 + d * 6 + h];
            const int e0 = 2 * lane, e1 = 2 * lane + 1, t0 = d == 0 ? e0 : 127 - e0, t1 = d == 0 ? e1 : 127 - e1;
            const float dt0 = softplus_f(bf1(draw[q][0]) + bias), dt1 = softplus_f(bf1(draw[q][1]) + bias);
            const float x0 = dt0 * a, x1 = dt1 * a; float s = x0 + x1;
#pragma unroll
            for (int off = 1; off < 64; off <<= 1) { const float t = __shfl_up(s, off); if (lane >= off) s += t; }
            const float a1v = s, a0v = s - x1, tot = __shfl(s, 63);
            dtv[q * 128 + t0] = dt0; dtv[q * 128 + t1] = dt1; acsv[q * 128 + t0] = a0v; acsv[q * 128 + t1] = a1v;
            wv[q * 128 + t0] = __expf(tot - a0v) * dt0; wv[q * 128 + t1] = __expf(tot - a1v) * dt1;
            float* ACS = WSP(float, WS_ACS); ACS[(size_t)(row0 + t0) * 12 + d * 6 + h] = a0v; ACS[(size_t)(row0 + t1) * 12 + d * 6 + h] = a1v;
            if (lane == 0) { const int pos = isc ? (d == 0 ? c : 1 - c) : (d == 0 ? 2 + c : 17 - c); WSP(float, WS_MISC + MISC_DEC)[((b * 2 + d) * NPOS + pos) * 6 + h] = __expf(tot); }
        }
    }
    __syncthreads();
    f32x4 G[8];
#pragma unroll
    for (int t = 0; t < 8; ++t) G[t] = (f32x4){0.f, 0.f, 0.f, 0.f};
#pragma unroll
    for (int ks = 0; ks < 4; ++ks) { const bf16x8 cf = *(const LAS bf16x8*)(R1 + (16 * w + fr) * LP + (32 * ks + 8 * fq) * 2);
#pragma unroll
        for (int t = 0; t < 8; ++t) { const bf16x8 bfm = *(const LAS bf16x8*)(R2 + (16 * t + fr) * LP + (32 * ks + 8 * fq) * 2); G[t] = MFMA16(bfm, cf, G[t]); } }
    __syncthreads();
    if (tid < 256) { const int sb = tid >> 4, nb = tid & 15; u32x4 r[8];
#pragma unroll
        for (int i = 0; i < 8; ++i) r[i] = *(const LAS u32x4*)(R2 + (8 * sb + i) * LP + nb * 16);
#pragma unroll
        for (int j = 0; j < 8; ++j) { u32x4 o;
            if ((j & 1) == 0) { o.x = (r[0][j >> 1] & 0xffffu) | (r[1][j >> 1] << 16); o.y = (r[2][j >> 1] & 0xffffu) | (r[3][j >> 1] << 16); o.z = (r[4][j >> 1] & 0xffffu) | (r[5][j >> 1] << 16); o.w = (r[6][j >> 1] & 0xffffu) | (r[7][j >> 1] << 16); }
            else { o.x = (r[0][j >> 1] >> 16) | (r[1][j >> 1] & 0xffff0000u); o.y = (r[2][j >> 1] >> 16) | (r[3][j >> 1] & 0xffff0000u); o.z = (r[4][j >> 1] >> 16) | (r[5][j >> 1] & 0xffff0000u); o.w = (r[6][j >> 1] >> 16) | (r[7][j >> 1] & 0xffff0000u); }
            *(LAS u32x4*)(R1 + (8 * nb + j) * LP + sb * 16) = o; } }
    __syncthreads();
    LAS unsigned char* Mw = R2 + w * 16 * LP;
    bf16_t* ST = WSP(bf16_t, WS_ST); float* YP = WSP(float, WS_YP);
    const bool needy = !(isc && l == DEPTH - 1);
    const int lrow = 16 * w + fr;
#pragma unroll 1
    for (int j = 0; j < 3; ++j) {
        const int h = g * 3 + j;
        f32x4 ay[4];
#pragma unroll
        for (int pt = 0; pt < 4; ++pt) ay[pt] = (f32x4){0.f, 0.f, 0.f, 0.f};
#pragma unroll 1
        for (int d = 0; d < 2; ++d) {
            const int q = d * 3 + j; const float al = acsv[q * 128 + lrow];
            if (needy) {
#pragma unroll
            for (int t = 0; t < 8; ++t) { const int s4 = 16 * t + 4 * fq; u32x2 o = {0u, 0u};
                if (d == 0 ? (t <= w) : (t >= w)) {
                    const f32x4 as = *(const LAS f32x4*)(acsv + q * 128 + s4), ds = *(const LAS f32x4*)(dtv + q * 128 + s4);
                    float mv[4];
#pragma unroll
                    for (int r = 0; r < 4; ++r) { const int s = s4 + r; const bool ok = (t != w) || (d == 0 ? (s <= lrow) : (s >= lrow)); mv[r] = ok ? G[t][r] * __expf(al - as[r]) * ds[r] : 0.f; }
                    o.x = cvtpk(mv[0], mv[1]); o.y = cvtpk(mv[2], mv[3]); }
                *(LAS u32x2*)(Mw + fr * LP + s4 * 2) = o; }
            LDS_WAIT();
#pragma unroll
            for (int ks = 0; ks < 4; ++ks) if (d == 0 ? (2 * ks <= w) : (2 * ks + 1 >= w)) { const bf16x8 mf = *(const LAS bf16x8*)(Mw + fr * LP + (32 * ks + 8 * fq) * 2);
#pragma unroll
                for (int pt = 0; pt < 4; ++pt) { const bf16x8 xf = *(const LAS bf16x8*)(XT + (j * 64 + 16 * pt + fr) * LP + (32 * ks + 8 * fq) * 2); ay[pt] = MFMA16(xf, mf, ay[pt]); } }
            }
            f32x4 as4[4];
#pragma unroll
            for (int pt = 0; pt < 4; ++pt) as4[pt] = (f32x4){0.f, 0.f, 0.f, 0.f};
#pragma unroll
            for (int ks = 0; ks < 4; ++ks) { const u32x4 raw = *(const LAS u32x4*)(R1 + (16 * w + fr) * LP + (32 * ks + 8 * fq) * 2);
                const f32x4 wa = *(const LAS f32x4*)(wv + q * 128 + 32 * ks + 8 * fq), wb = *(const LAS f32x4*)(wv + q * 128 + 32 * ks + 8 * fq + 4);
                u32x4 sc; sc.x = cvtpk(bflo(raw.x) * wa.x, bfhi(raw.x) * wa.y); sc.y = cvtpk(bflo(raw.y) * wa.z, bfhi(raw.y) * wa.w); sc.z = cvtpk(bflo(raw.z) * wb.x, bfhi(raw.z) * wb.y); sc.w = cvtpk(bflo(raw.w) * wb.z, bfhi(raw.w) * wb.w);
                const bf16x8 bsf = __builtin_bit_cast(bf16x8, sc);
#pragma unroll
                for (int pt = 0; pt < 4; ++pt) { const bf16x8 xf = *(const LAS bf16x8*)(XT + (j * 64 + 16 * pt + fr) * LP + (32 * ks + 8 * fq) * 2); as4[pt] = MFMA16(bsf, xf, as4[pt]); } }
            { const int pos = isc ? (d == 0 ? c : 1 - c) : (d == 0 ? 2 + c : 17 - c); bf16_t* sp = ST + ((size_t)((b * 2 + d) * NPOS + pos) * 6 + h) * 8192;
#pragma unroll
                for (int pt = 0; pt < 4; ++pt) { u32x2 o; o.x = cvtpk(as4[pt][0], as4[pt][1]); o.y = cvtpk(as4[pt][2], as4[pt][3]); *(u32x2*)(sp + (16 * pt + fr) * 128 + 16 * w + 4 * fq) = o; } }
        }
        if (needy) { const float skip = F.d_skip[l * 6 + h];
#pragma unroll
            for (int pt = 0; pt < 4; ++pt) { f32x4 o;
#pragma unroll
                for (int r = 0; r < 4; ++r) o[r] = ay[pt][r] + skip * bf1(*(const LAS bf16_t*)(XT + (j * 64 + 16 * pt + 4 * fq + r) * LP + lrow * 2));
                *(f32x4*)(YP + (size_t)(row0 + lrow) * 384 + h * 64 + 16 * pt + 4 * fq) = o; } }
    }
    __syncthreads();
}

__device__ __forceinline__ void ssd_scan(Frame& F) {
    bf16_t* ST = WSP(bf16_t, WS_ST); const float* DEC = WSP(float, WS_MISC + MISC_DEC);
    for (int gt = F.vcu * NTHR + F.tid; gt < 96 * 1024; gt += F.G * NTHR) {
        const int combo = gt >> 10, e8 = gt & 1023, bd = combo / 6, h = combo - bd * 6;
        u32x4 st[17]; float dec[17];
#pragma unroll
        for (int q = 0; q < 17; ++q) { const size_t sidx = (size_t)(bd * NPOS + q) * 6 + h; st[q] = *(const u32x4*)(ST + sidx * 8192 + e8 * 8); dec[q] = DEC[sidx]; }
        float hv[8];
#pragma unroll
        for (int i = 0; i < 8; ++i) hv[i] = 0.f;
#pragma unroll
        for (int q = 0; q < 17; ++q) { const size_t sidx = (size_t)(bd * NPOS + q) * 6 + h; const float dq = dec[q];
            hv[0] = dq * hv[0] + bflo(st[q].x); hv[1] = dq * hv[1] + bfhi(st[q].x); hv[2] = dq * hv[2] + bflo(st[q].y); hv[3] = dq * hv[3] + bfhi(st[q].y);
            hv[4] = dq * hv[4] + bflo(st[q].z); hv[5] = dq * hv[5] + bfhi(st[q].z); hv[6] = dq * hv[6] + bflo(st[q].w); hv[7] = dq * hv[7] + bfhi(st[q].w);
            u32x4 o; o.x = cvtpk(hv[0], hv[1]); o.y = cvtpk(hv[2], hv[3]); o.z = cvtpk(hv[4], hv[5]); o.w = cvtpk(hv[6], hv[7]);
            *(u32x4*)(ST + sidx * 8192 + e8 * 8) = o; }
    }
}

__device__ __forceinline__ void ssd_final_unit(Frame& F, int l, int u) {
    int row0; bool isc; chunk_rows(u, row0, isc);
    const int b = isc ? ((u - 128) >> 1) : (u >> 4), c = isc ? ((u - 128) & 1) : (u & 15);
    constexpr int CPITCH = 528;
    LAS unsigned char* Cs = F.lds;
    LAS unsigned char* Hs = F.lds + 128 * CPITCH;
    const int w = F.wave, lane = F.lane, tid = F.tid, fr = lane & 15, fq = lane >> 4;
    const bf16_t* CC = WSP(bf16_t, WS_CC); const bf16_t* ST = WSP(bf16_t, WS_ST); const float* ACS = WSP(float, WS_ACS);
#pragma unroll
    for (int i = 0; i < 8; ++i) { const int q = tid + NTHR * i, r = q >> 5, cc = q & 31; *(LAS u32x4*)(Cs + r * CPITCH + cc * 16) = *(const u32x4*)(CC + (size_t)(row0 + r) * 256 + cc * 8); }
    const int lrow = 16 * w + fr, row = row0 + lrow;
    const int hp = tid >> 3, hn0 = (tid & 7) * 16;
    const float* YP = WSP(float, WS_YP); const bf16_t* P = WSP(bf16_t, WS_P); bf16_t* CAT = WSP(bf16_t, WS_CAT);
    float ss = 0.f;
    const f32x4 ac0 = *(const f32x4*)(ACS + (size_t)row * 12), ac1 = *(const f32x4*)(ACS + (size_t)row * 12 + 4), ac2 = *(const f32x4*)(ACS + (size_t)row * 12 + 8);
    const float acv[12] = {ac0[0], ac0[1], ac0[2], ac0[3], ac1[0], ac1[1], ac1[2], ac1[3], ac2[0], ac2[1], ac2[2], ac2[3]};
    u32x4 hpre[2][2][2]; f32x4 ypre[2][4]; u32x2 zpre[2][4];
#define SSDF_LOAD(hh, S_) do { \
        _Pragma("unroll") for (int d = 0; d < 2; ++d) { const int pos = isc ? (d == 0 ? c : 1 - c) : (d == 0 ? 2 + c : 17 - c); hpre[S_][d][0] = (u32x4){0u, 0u, 0u, 0u}; hpre[S_][d][1] = hpre[S_][d][0]; \
            if (pos > 0) { const size_t sidx = (size_t)((b * 2 + d) * NPOS + pos - 1) * 6 + (hh); hpre[S_][d][0] = *(const u32x4*)(ST + sidx * 8192 + hp * 128 + hn0); hpre[S_][d][1] = *(const u32x4*)(ST + sidx * 8192 + hp * 128 + hn0 + 8); } } \
        _Pragma("unroll") for (int pt = 0; pt < 4; ++pt) { const int cidx = (hh) * 64 + 16 * pt + 4 * fq; ypre[S_][pt] = *(const f32x4*)(YP + (size_t)row * 384 + cidx); zpre[S_][pt] = *(const u32x2*)(P + (size_t)row * INP + PC_Z + cidx); } } while (0)
    SSDF_LOAD(0, 1);
#pragma unroll 1
    for (int h = 0; h < 6; ++h) {
        const int g = h / 3; constexpr int S = 0;
#pragma unroll
        for (int d = 0; d < 2; ++d) { hpre[0][d][0] = hpre[1][d][0]; hpre[0][d][1] = hpre[1][d][1]; }
#pragma unroll
        for (int pt = 0; pt < 4; ++pt) { ypre[0][pt] = ypre[1][pt]; zpre[0][pt] = zpre[1][pt]; }
        if (h + 1 < 6) SSDF_LOAD(h + 1, 1);
        LAS unsigned char* Hset = Hs + (h & 1) * 2 * 64 * LP;
#pragma unroll
        for (int d = 0; d < 2; ++d) { LAS unsigned char* Hb = Hset + d * 64 * LP;
            *(LAS u32x4*)(Hb + hp * LP + hn0 * 2) = hpre[S][d][0]; *(LAS u32x4*)(Hb + hp * LP + hn0 * 2 + 16) = hpre[S][d][1]; }
        LDS_BARRIER();
        f32x4 yh[4];
#pragma unroll
        for (int pt = 0; pt < 4; ++pt) yh[pt] = (f32x4){0.f, 0.f, 0.f, 0.f};
#pragma unroll
        for (int d = 0; d < 2; ++d) {
            const LAS unsigned char* Hb = Hset + d * 64 * LP;
            f32x4 tm[4];
#pragma unroll
            for (int pt = 0; pt < 4; ++pt) tm[pt] = (f32x4){0.f, 0.f, 0.f, 0.f};
#pragma unroll
            for (int ks = 0; ks < 4; ++ks) { const bf16x8 cf = *(const LAS bf16x8*)(Cs + lrow * CPITCH + (g * 128 + 32 * ks + 8 * fq) * 2);
#pragma unroll
                for (int pt = 0; pt < 4; ++pt) { const bf16x8 hf = *(const LAS bf16x8*)(Hb + (16 * pt + fr) * LP + (32 * ks + 8 * fq) * 2); tm[pt] = MFMA16(hf, cf, tm[pt]); } }
            const float e = __expf(d == 0 ? (h == 0 ? acv[0] : h == 1 ? acv[1] : h == 2 ? acv[2] : h == 3 ? acv[3] : h == 4 ? acv[4] : acv[5]) : (h == 0 ? acv[6] : h == 1 ? acv[7] : h == 2 ? acv[8] : h == 3 ? acv[9] : h == 4 ? acv[10] : acv[11]));
#pragma unroll
            for (int pt = 0; pt < 4; ++pt) yh[pt] += tm[pt] * e;
        }
#pragma unroll
        for (int pt = 0; pt < 4; ++pt) { const int cidx = h * 64 + 16 * pt + 4 * fq; const u32x2 z = zpre[S][pt];
            f32x4 v = yh[pt] + ypre[S][pt]; v[0] *= silu_f(bflo(z.x)); v[1] *= silu_f(bfhi(z.x)); v[2] *= silu_f(bflo(z.y)); v[3] *= silu_f(bfhi(z.y));
            u32x2 o; o.x = cvtpk(v[0], v[1]); o.y = cvtpk(v[2], v[3]); *(u32x2*)(CAT + (size_t)row * DM + 256 + cidx) = o; ss += (v[0] * v[0] + v[1] * v[1]) + (v[2] * v[2] + v[3] * v[3]); }
    }
#undef SSDF_LOAD
    ss += __shfl_xor(ss, 16); ss += __shfl_xor(ss, 32);
    const float rstd = rsqrtf(ss * (1.f / 384.f) + EPS);
    u32x2 st[6][4];
#pragma unroll
    for (int h = 0; h < 6; ++h)
#pragma unroll
        for (int pt = 0; pt < 4; ++pt) st[h][pt] = *(const u32x2*)(CAT + (size_t)row * DM + 256 + h * 64 + 16 * pt + 4 * fq);
    asm volatile("" ::: "memory");
#pragma unroll
    for (int h = 0; h < 6; ++h)
#pragma unroll
        for (int pt = 0; pt < 4; ++pt) { const int cidx = h * 64 + 16 * pt + 4 * fq; const f32x4 gg = *(const f32x4*)(F.g_ssd + l * 384 + cidx); const u32x2 t = st[h][pt]; f32x4 v = {bflo(t.x), bfhi(t.x), bflo(t.y), bfhi(t.y)}; v = v * rstd * gg;
            u32x2 o; o.x = cvtpk(v[0], v[1]); o.y = cvtpk(v[2], v[3]); *(u32x2*)(CAT + (size_t)row * DM + 256 + cidx) = o; }
    __syncthreads();
}

__device__ __forceinline__ void build_vt_item(Frame& F, int gt, int h) {
    const bf16_t* KV = WSP(bf16_t, WS_KV); bf16_t* VT = WSP(bf16_t, WS_VT);
    const int t7 = F.tid & 127, kq = t7 & 15, ch = t7 >> 4; u32x4 v[4];
#pragma unroll
    for (int r = 0; r < 4; ++r) v[r] = *(const u32x4*)(KV + (size_t)(gt * 64 + 4 * kq + r) * KVW + h * 128 + 64 + ch * 8);
    bf16_t* dst = VT + ((size_t)gt * 6 + h) * 4096 + 4 * kq;
#pragma unroll
    for (int j = 0; j < 4; ++j) { const unsigned a0 = v[0][j], a1 = v[1][j], a2 = v[2][j], a3 = v[3][j];
        u32x2 lo, hi; lo.x = (a0 & 0xffffu) | (a1 << 16); lo.y = (a2 & 0xffffu) | (a3 << 16); hi.x = (a0 >> 16) | (a1 & 0xffff0000u); hi.y = (a2 >> 16) | (a3 & 0xffff0000u);
        *(u32x2*)(dst + (8 * ch + 2 * j) * 64) = lo; *(u32x2*)(dst + (8 * ch + 2 * j + 1) * 64) = hi; }
}
template <class Sched> __device__ __forceinline__ void build_vt_own(Frame& F, const Sched& S) {
    asm volatile("s_waitcnt vmcnt(0)" ::: "memory"); __syncthreads();
    pg8::Unit u; const int sub = F.tid >> 7;
    for (int i = 0; S.next(i, u); ++i) {
#pragma unroll
        for (int k = 0; k < 2; ++k) { const int item = sub + 4 * k;
            build_vt_item(F, u.pm * 4 + (item & 3), u.pn * 2 + (item >> 2)); }
    }
}

__device__ __forceinline__ void attn_unit(Frame& F, int u) {
    int b, h, q0, nt; bool isc;
    if (u < 768) { b = u / 96; const int rem = u % 96; h = rem >> 4; q0 = b * SEQ + (rem & 15) * 128; nt = 36; isc = false; }
    else { const int uu = u - 768; b = uu / 12; const int rem = uu % 12; h = rem >> 1; q0 = NLAT + b * CTXL + (rem & 1) * 128; nt = 4; isc = true; }
    constexpr int KP = 208, VP = 136, TILEB = 64 * KP + 64 * VP;
    const bf16_t* Q = WSP(bf16_t, WS_Q); const bf16_t* KV = WSP(bf16_t, WS_KV); const bf16_t* KR = WSP(bf16_t, WS_KR); const bf16_t* VTg = WSP(bf16_t, WS_VT); bf16_t* CAT = WSP(bf16_t, WS_CAT);
    const int w = F.wave, lane = F.lane, tid = F.tid, qs = w & 3, par = w >> 2, r32 = lane & 31, hf = lane >> 5;
    bf16x8 qf[6];
    { const int qrow = q0 + 32 * qs + r32; const bf16_t* qp = Q + (size_t)qrow * QW + h * 96 + 8 * hf;
#pragma unroll
        for (int ks = 0; ks < 6; ++ks) qf[ks] = *(const bf16x8*)(qp + 16 * ks);
        if (!isc) { const int tok = qrow & (SEQ - 1); const f32x2* rt = WSP(f32x2, WS_MISC + MISC_ROPE);
#pragma unroll
            for (int ax = 0; ax < 2; ++ax) { const int pos = ax == 0 ? (tok >> 6) : (tok & 63); u32x4 own = __builtin_bit_cast(u32x4, qf[4 + ax]); u32x4 oth;
                oth.x = __shfl_xor(own.x, 32); oth.y = __shfl_xor(own.y, 32); oth.z = __shfl_xor(own.z, 32); oth.w = __shfl_xor(own.w, 32);
                float a[8], o[8], r[8];
                a[0] = bflo(own.x); a[1] = bfhi(own.x); a[2] = bflo(own.y); a[3] = bfhi(own.y); a[4] = bflo(own.z); a[5] = bfhi(own.z); a[6] = bflo(own.w); a[7] = bfhi(own.w);
                o[0] = bflo(oth.x); o[1] = bfhi(oth.x); o[2] = bflo(oth.y); o[3] = bfhi(oth.y); o[4] = bflo(oth.z); o[5] = bfhi(oth.z); o[6] = bflo(oth.w); o[7] = bfhi(oth.w);
#pragma unroll
                for (int f = 0; f < 8; ++f) { const f32x2 cs = rt[pos * 8 + f]; r[f] = hf == 0 ? (a[f] * cs.x - o[f] * cs.y) : (o[f] * cs.y + a[f] * cs.x); }
                u32x4 res; res.x = cvtpk(r[0], r[1]); res.y = cvtpk(r[2], r[3]); res.z = cvtpk(r[4], r[5]); res.w = cvtpk(r[6], r[7]); qf[4 + ax] = __builtin_bit_cast(bf16x8, res); } }
    }
    u32x4 knA[2], krA, vregA[2], knB[2], krB, vregB[2];
    const unsigned voffK = (unsigned)((tid >> 3) * KVW + (tid & 7) * 8) * 2u, voffR = (unsigned)tid * 16u, voffV = (unsigned)tid * 16u;
    const unsigned ldsK = (unsigned)((tid >> 3) * KP + (tid & 7) * 16), ldsR = (unsigned)((tid >> 8) * TILEB + ((tid >> 2) & 63) * KP + (8 + (tid & 3)) * 16), ldsV = (unsigned)(64 * KP + (tid >> 3) * VP + (tid & 7) * 16);
#define ATT_R(tp) ((isc || (tp) < 2) ? (NLAT + b * CTXL + (tp) * 128) : (b * SEQ + ((tp) - 2) * 128))
#define ATT_LOAD(kn, kr, vreg, tp) do { const int R_ = __builtin_amdgcn_readfirstlane(ATT_R(tp)); \
        const unsigned char* kb_ = (const unsigned char*)(KV + (size_t)R_ * KVW + h * 128); \
        kn[0] = *(const u32x4*)(kb_ + voffK); kn[1] = *(const u32x4*)(kb_ + 64 * KVW * 2 + voffK); \
        kr = *(const u32x4*)((const unsigned char*)(KR + (size_t)R_ * 32) + voffR); \
        const unsigned char* vb_ = (const unsigned char*)(VTg + ((size_t)(R_ >> 6) * 6 + h) * 4096); \
        vreg[0] = *(const u32x4*)(vb_ + voffV); vreg[1] = *(const u32x4*)(vb_ + 6 * 4096 * 2 + voffV); } while (0)
#define ATT_WRITE(kn, kr, vreg, buf) do { LAS unsigned char* base_ = F.lds + (buf) * 2 * TILEB; \
        *(LAS u32x4*)(base_ + ldsK) = kn[0]; *(LAS u32x4*)(base_ + TILEB + ldsK) = kn[1]; *(LAS u32x4*)(base_ + ldsR) = kr; \
        _Pragma("unroll") for (int i = 0; i < 2; ++i) { LAS unsigned char* vt = base_ + i * TILEB + ldsV; \
            *(LAS u32x2*)vt = (u32x2){vreg[i].x, vreg[i].y}; *(LAS u32x2*)(vt + 8) = (u32x2){vreg[i].z, vreg[i].w}; } } while (0)
    const int np = nt / 2;
    ATT_LOAD(knA, krA, vregA, 0); ATT_WRITE(knA, krA, vregA, 0);
    __syncthreads();
    ATT_LOAD(knB, krB, vregB, 1);
    f32x16 o0, o1;
#pragma unroll
    for (int r = 0; r < 16; ++r) { o0[r] = 0.f; o1[r] = 0.f; }
    float mrun = 0.f, lrun = 0.f;
    const unsigned kfo = (unsigned)(r32 * KP + 16 * hf), vfo = (unsigned)(64 * KP + r32 * VP + 8 * hf);
#define ATT_STEP(tp) do { \
        const LAS unsigned char* Kt = F.lds + ((((tp)) & 1) * 2 + par) * TILEB; \
        bf16x8 ka[6], kb[6]; \
        _Pragma("unroll") \
        for (int ks = 0; ks < 6; ++ks) ka[ks] = *(const LAS bf16x8*)(Kt + kfo + 32 * ks); \
        _Pragma("unroll") \
        for (int ks = 0; ks < 6; ++ks) kb[ks] = *(const LAS bf16x8*)(Kt + kfo + 32 * KP + 32 * ks); \
        f32x16 p0, p1; \
        _Pragma("unroll") \
        for (int r = 0; r < 16; ++r) { p0[r] = -mrun; p1[r] = -mrun; } \
        __builtin_amdgcn_sched_barrier(0); \
        _Pragma("unroll") \
        for (int ks = 0; ks < 6; ++ks) { p0 = MFMA32(ka[ks], qf[ks], p0); p1 = MFMA32(kb[ks], qf[ks], p1); } \
        u32x2 va[4][2], vc[4][2]; \
        _Pragma("unroll") \
        for (int s2 = 0; s2 < 4; ++s2) { \
            va[s2][0] = *(const LAS u32x2*)(Kt + vfo + 32 * s2); va[s2][1] = *(const LAS u32x2*)(Kt + vfo + 32 * s2 + 16); \
            vc[s2][0] = *(const LAS u32x2*)(Kt + vfo + 32 * VP + 32 * s2); vc[s2][1] = *(const LAS u32x2*)(Kt + vfo + 32 * VP + 32 * s2 + 16); } \
        __builtin_amdgcn_sched_barrier(0); \
        float mx = p0[0]; \
        _Pragma("unroll") \
        for (int r = 1; r < 16; ++r) mx = fmaxf(mx, p0[r]); \
        _Pragma("unroll") \
        for (int r = 0; r < 16; ++r) mx = fmaxf(mx, p1[r]); \
        mx = fmaxf(mx, __shfl_xor(mx, 32)); \
        if ((tp) == 0 || __any(mx > 8.f)) { const float dl = (tp) == 0 ? mx : fmaxf(mx, 0.f), alpha = __builtin_amdgcn_exp2f(-dl); lrun *= alpha; mrun += dl; \
        _Pragma("unroll") \
            for (int r = 0; r < 16; ++r) { o0[r] *= alpha; o1[r] *= alpha; p0[r] -= dl; p1[r] -= dl; } } \
        _Pragma("unroll") \
        for (int r = 0; r < 16; ++r) { p0[r] = __builtin_amdgcn_exp2f(p0[r]); p1[r] = __builtin_amdgcn_exp2f(p1[r]); } \
        float sa = p0[0], sb = p0[1], sc = p1[0], sd = p1[1]; \
        _Pragma("unroll") \
        for (int r = 2; r < 16; r += 2) { sa += p0[r]; sb += p0[r + 1]; sc += p1[r]; sd += p1[r + 1]; } \
        lrun += (sa + sb) + (sc + sd); \
        bf16x8 pf[4]; \
        _Pragma("unroll") \
        for (int s2 = 0; s2 < 4; ++s2) { u32x4 t; \
            if (s2 < 2) { t.x = cvtpk(p0[8 * s2], p0[8 * s2 + 1]); t.y = cvtpk(p0[8 * s2 + 2], p0[8 * s2 + 3]); t.z = cvtpk(p0[8 * s2 + 4], p0[8 * s2 + 5]); t.w = cvtpk(p0[8 * s2 + 6], p0[8 * s2 + 7]); } \
            else { const int s = s2 - 2; t.x = cvtpk(p1[8 * s], p1[8 * s + 1]); t.y = cvtpk(p1[8 * s + 2], p1[8 * s + 3]); t.z = cvtpk(p1[8 * s + 4], p1[8 * s + 5]); t.w = cvtpk(p1[8 * s + 6], p1[8 * s + 7]); } \
            pf[s2] = __builtin_bit_cast(bf16x8, t); } \
        _Pragma("unroll") \
        for (int s2 = 0; s2 < 4; ++s2) { \
            const u32x4 va4 = {va[s2][0].x, va[s2][0].y, va[s2][1].x, va[s2][1].y}, vc4 = {vc[s2][0].x, vc[s2][0].y, vc[s2][1].x, vc[s2][1].y}; \
            o0 = MFMA32(__builtin_bit_cast(bf16x8, va4), pf[s2], o0); o1 = MFMA32(__builtin_bit_cast(bf16x8, vc4), pf[s2], o1); } \
    } while (0)
    for (int tp = 0; tp < np; tp += 2) {
        ATT_LOAD(knA, krA, vregA, min(tp + 2, np - 1));
        ATT_STEP(tp);
        if (tp + 1 < np) ATT_WRITE(knB, krB, vregB, 1);
        LDS_BARRIER();
        if (tp + 1 < np) {
            ATT_LOAD(knB, krB, vregB, min(tp + 3, np - 1));
            ATT_STEP(tp + 1);
            if (tp + 2 < np) ATT_WRITE(knA, krA, vregA, 0);
            LDS_BARRIER();
        }
    }
#undef ATT_STEP
#undef ATT_R
#undef ATT_LOAD
#undef ATT_WRITE
    lrun += __shfl_xor(lrun, 32);
    LAS float* mg = (LAS float*)(F.lds + 4 * TILEB);
    if (par == 1) { LAS float* d = mg + ((qs * 64 + lane) * 36);
#pragma unroll
        for (int r = 0; r < 16; r += 4) { *(LAS f32x4*)(d + r) = (f32x4){o0[r], o0[r + 1], o0[r + 2], o0[r + 3]}; *(LAS f32x4*)(d + 16 + r) = (f32x4){o1[r], o1[r + 1], o1[r + 2], o1[r + 3]}; }
        d[32] = mrun; d[33] = lrun; }
    __syncthreads();
    if (par == 0) { const LAS float* d = mg + ((qs * 64 + lane) * 36);
        const float m2 = d[32], l2 = d[33], mm = fmaxf(mrun, m2), a1 = __builtin_amdgcn_exp2f(mrun - mm), a2 = __builtin_amdgcn_exp2f(m2 - mm), inv = 1.f / (lrun * a1 + l2 * a2);
        const int qrow = q0 + 32 * qs + r32; bf16_t* op = CAT + (size_t)qrow * DM + 640 + h * 64;
#pragma unroll
        for (int g4 = 0; g4 < 4; ++g4) { const f32x4 e0 = *(const LAS f32x4*)(d + 4 * g4), e1 = *(const LAS f32x4*)(d + 16 + 4 * g4);
            float r0[4], r1[4];
#pragma unroll
            for (int r = 0; r < 4; ++r) { r0[r] = (o0[4 * g4 + r] * a1 + e0[r] * a2) * inv; r1[r] = (o1[4 * g4 + r] * a1 + e1[r] * a2) * inv; }
            u32x2 w0, w1; w0.x = cvtpk(r0[0], r0[1]); w0.y = cvtpk(r0[2], r0[3]); w1.x = cvtpk(r1[0], r1[1]); w1.y = cvtpk(r1[2], r1[3]);
            *(u32x2*)(op + 8 * g4 + 4 * hf) = w0; *(u32x2*)(op + 32 + 8 * g4 + 4 * hf) = w1; } }
    __syncthreads();
}
#ifndef MK_PER_PHASE
#define MK_PER_PHASE 0
#endif
constexpr int N_PHASES = 20;
struct Args { const float* in[32]; float* out; unsigned char* ws; int ph_lo, ph_hi; };
typedef __attribute__((address_space(4))) const Args CArgs;
#define GPF(k) ((const float*)(GAS const float*)ap_->in[k])

__global__ void __launch_bounds__(NTHR, 2) fwd_megakernel(Args args) {
    extern __shared__ __attribute__((aligned(16))) unsigned char lds_raw[];
    Frame F;
    F.sm = lds_raw; F.lds = (LAS unsigned char*)lds_raw;
    F.G = gridDim.x; { const int bx = blockIdx.x; F.vcu = (F.G % 8 == 0) ? (bx % 8) * (F.G / 8) + bx / 8 : bx; }
#define PHASE_BEGIN() do { int t_ = threadIdx.x; asm volatile("" : "+v"(t_)); t_ &= 511; F.tid = t_; F.lane = t_ & 63; F.wave = __builtin_amdgcn_readfirstlane(t_ >> 6); \
    CArgs* ap_ = (CArgs*)__builtin_amdgcn_kernarg_segment_ptr(); asm volatile("" : "+s"(ap_)); \
    F.x = GPF(0); F.c = GPF(1); F.ctx = GPF(2); F.c_ctx = GPF(3); F.w_mod = GPF(4); F.b_mod = GPF(5); F.g_mix = GPF(6); F.w_in = GPF(7); \
    F.w_sgu = GPF(8); F.b_sgu = GPF(9); F.g_sgu = GPF(10); F.beta_sgu = GPF(11); F.conv_w = GPF(12); F.conv_b = GPF(13); F.dt_bias = GPF(14); F.a_log = GPF(15); \
    F.d_skip = GPF(16); F.g_ssd = GPF(17); F.g_q = GPF(18); F.w_uq = GPF(19); F.g_kv = GPF(20); F.w_ukv = GPF(21); F.w_out = GPF(22); F.g_ffn = GPF(23); \
    F.w_gate = GPF(24); F.w_up = GPF(25); F.w_down = GPF(26); F.w_router = GPF(27); F.w_gate_e = GPF(28); F.w_up_e = GPF(29); F.w_down_e = GPF(30); F.g_final = GPF(31); \
    F.out = (float*)(GAS float*)ap_->out; F.ws = (unsigned char*)(GAS unsigned char*)ap_->ws; } while (0)
    PHASE_BEGIN();
    volatile LAS unsigned* MISC = (volatile LAS unsigned*)(F.lds + MISC_OFF);
    for (int u = F.tid; u < (LDS_BYTES - LDSCTL_OFF) / 4; u += NTHR) ((LAS unsigned*)(F.lds + LDSCTL_OFF))[u] = 0u;
    __syncthreads();
    XcdBarrier bar = xcd_barrier_post(WSP(unsigned, WS_CTL) + CW_BAR, MISC + 8, threadIdx.x == 0);
    { long pc0_; int clen_; asm volatile("mk_code_beg:\n\ts_getpc_b64 %0\n\ts_mov_b32 %1, mk_code_end - mk_code_beg" : "=s"(pc0_), "=s"(clen_));
      if (threadIdx.x == 0) { volatile LAS unsigned* cw = (volatile LAS unsigned*)(F.lds + LDSCTL_OFF + 960); cw[0] = (unsigned)pc0_; cw[1] = (unsigned)((unsigned long)pc0_ >> 32); cw[2] = (unsigned)clen_; }
      const int ln_ = ((int)blockIdx.x >> 3) * NTHR + (int)threadIdx.x; if (ln_ * 128 < clen_) (void)*(volatile const unsigned*)((const char*)pc0_ + (size_t)ln_ * 128); }
#ifndef WARM_AT
#define WARM_AT(k) 0
#endif
#define CODE_WARM() do { const volatile LAS unsigned* cw_ = (const volatile LAS unsigned*)(F.lds + LDSCTL_OFF + 960); const int ln_ = ((int)blockIdx.x >> 3) * NTHR + (int)threadIdx.x; \
    if (ln_ * 128 < (int)cw_[2]) { const char* cb_ = (const char*)(((unsigned long)cw_[1] << 32) | (unsigned long)cw_[0]); (void)*(volatile const unsigned*)(cb_ + (size_t)ln_ * 128); } } while (0)
#if MK_PER_PHASE
    const int lo = args.ph_lo, hi = args.ph_hi;
#else
    constexpr int lo = 0, hi = N_PHASES;
#endif
#ifndef PH_MASK
#define PH_MASK 0xFFFFFFFFu
#endif
#define PE(b) ((PH_MASK >> (b)) & 1u)
#ifndef REP_MASK
#define REP_MASK 0u
#endif
#ifndef SSD_DRY_LIMIT
#define SSD_DRY_LIMIT 0
#endif
#define NREP(b) (1 + (int)((REP_MASK >> (b)) & 1u))
#define IN(k) (lo <= (k) && (k) < hi)
#define SEAM(k) do { if (IN(k) && IN((k) + 1)) { if (WARM_AT(k)) CODE_WARM(); for (int rep_ = 0; rep_ < NREP(20); ++rep_) xcd_barrier(bar, threadIdx.x == 0); } } while (0)
#define XC WSP(float, WS_XC)
#define SSQ WSP(float, WS_SSQP)
#define ctl WSP(unsigned, WS_CTL)

    if (IN(0) && PE(0)) { for (int rep = 0; rep < NREP(0); ++rep) { PHASE_BEGIN(); p_prologue(F); } }
    SEAM(0);
#pragma unroll 1
    for (int l = 0; l < DEPTH; ++l) {
        const int pb = 1 + 9 * l;
#define modl (WSP(float, WS_MOD) + (size_t)l * 9 * 6144)
#define srcL (l == 0 ? F.x : (const float*)F.out)
#define srcC (l == 0 ? F.ctx : (const float*)XC)
        if (IN(pb + 0) && PE(1)) for (int rep = 0; rep < NREP(1); ++rep) { PHASE_BEGIN(); p_norm<false>(F, l, 0, MT, srcL, srcC, l == 1 ? WSP(float, WS_SLAB) : nullptr, WSP(float, WS_MOD) + (size_t)8 * 6144 + 5 * DM); }
        SEAM(pb + 0);
        if (IN(pb + 1) && PE(2)) for (int rep = 0; rep < NREP(2); ++rep) {
            PHASE_BEGIN();
            pg8::Gemm g{WSP(bf16_t, WS_H), WSP(bf16_t, WS_WIN) + (size_t)l * INP * DM, DM, DM, 0};
            pg8::StaticOrder S; S.init(MT, INP, F.G, (int)blockIdx.x);
            pg8::EpiInProj E{WSP(bf16_t, WS_P), SSQ, rep < NREP(2) - 1};
            pg8::gemm_phase<pg8::EpiInProj, pg8::StaticOrder, true, false>(F.lds, F.tid, g, S, E);
        }
        SEAM(pb + 1);
        if (IN(pb + 2)) {
            if (PE(3)) for (int rep = 0; rep < NREP(3); ++rep) { PHASE_BEGIN(); pg8::Gemm g{WSP(bf16_t, WS_P) + PC_CQ, WSP(bf16_t, WS_WUQ) + (size_t)l * QWP * 384, INP, 384, 0};
              pg8::StaticOrder S;
              if (l == 0 && F.G == 256) { const int k_ = (int)blockIdx.x >> 3; S.init_plan(MT, QWP, (int)blockIdx.x & 7, k_ <= 10 ? k_ : (k_ == 15 ? 11 : (k_ == 19 ? 12 : (k_ == 20 ? 14 : k_ - 5))), (k_ >= 11 && k_ <= 18 && k_ != 15) ? 0 : ((k_ == 19 || k_ == 20) ? 2 : 1)); }
              else S.init(l == 0 ? MT : NLAT, QWP, F.G, l == 0 ? (int)blockIdx.x : (int)((blockIdx.x + 136u) % (unsigned)F.G));
              pg8::EpiScaleBf16 E{WSP(bf16_t, WS_Q), QW, QW, SSQ, 0, 1.f / 384.f, QSCALE};
              pg8::gemm_phase<pg8::EpiScaleBf16, pg8::StaticOrder, true, false>(F.lds, F.tid, g, S, E); }
            if (PE(4)) for (int rep = 0; rep < NREP(4); ++rep) { PHASE_BEGIN(); pg8::Gemm g{WSP(bf16_t, WS_P) + PC_CKV, WSP(bf16_t, WS_WUKV) + (size_t)l * KVW * 256, INP, 256, 0};
              pg8::StaticOrder S;
              if (l == 0 && F.G == 256) { const int k_ = (int)blockIdx.x >> 3; S.init_plan(MT, KVW, (int)blockIdx.x & 7, k_ <= 10 ? k_ : k_ - 5, (k_ >= 11 && k_ <= 15) ? 0 : 1); }
              else S.init(MT, KVW, F.G, (int)((blockIdx.x + 128u) % (unsigned)F.G));
              pg8::EpiScaleBf16 E{WSP(bf16_t, WS_KV), KVW, KVW, SSQ, 1, 1.f / 256.f, 1.f};
              pg8::gemm_phase<pg8::EpiScaleBf16, pg8::StaticOrder, true, false>(F.lds, F.tid, g, S, E);
              build_vt_own(F, S); }
            if (PE(5)) for (int rep = 0; rep < NREP(5); ++rep) { PHASE_BEGIN();
                for (int k = 0; k < 2; ++k) {
                    const int bx_ = (int)blockIdx.x; int u;
                    if (F.G == 256) u = k == 0 ? F.vcu : ((bx_ >= 88 && bx_ < 120) ? 256 + bx_ - 88 : -1); else u = F.vcu + k * F.G;
                    if (u >= 0 && u < 288) ssd_local_unit(F, l, u); } }
            if (PE(6)) { PHASE_BEGIN(); for (int u = F.vcu; u < 144; u += F.G) krope_unit(F, u); }
            if (PE(6) && !(l == 1 && F.G == 256)) for (int rep = 0; rep < NREP(6); ++rep) { PHASE_BEGIN();
                const int bx_ = (int)blockIdx.x;
                if (F.G == 256) { const int k_ = bx_ >> 3; if (k_ >= 15 && k_ <= 18) sgu_unit(F, l, 112 + (k_ - 15) * 8 + (bx_ & 7)); }
                else { for (int u = F.G - 1 - F.vcu; u < 144; u += F.G) sgu_unit(F, l, u); } }
        }
        SEAM(pb + 2);
        if (IN(pb + 3)) {
            if (PE(5)) { PHASE_BEGIN(); ssd_scan(F); }
        }
        SEAM(pb + 3);
        if (IN(pb + 4)) {
            const int nat = l == 0 ? 864 : 768, nsf = l == 0 ? 144 : 128;
            if (PE(7)) for (int rep = 0; rep < NREP(7); ++rep) { PHASE_BEGIN();
                const bool l1p = l == 1 && F.G == 256;
                const int nk = l1p ? 4 : (nat + F.G - 1) / F.G;
                for (int k = 0; k < nk; ++k) { const int u = (l1p && k >= 2) ? (F.vcu < 128 ? 512 + 128 * (k - 2) + F.vcu : nat) : F.vcu + F.G * k; if (u < nat) attn_unit(F, u); } }
            if (PE(8)) for (int rep = 0; rep < NREP(8); ++rep) { PHASE_BEGIN(); for (int u = F.G - 1 - F.vcu; u < nsf; u += F.G) ssd_final_unit(F, l, u); }
            if (PE(6) && F.G == 256) { PHASE_BEGIN();
                const int u = l == 1 ? (F.vcu >= 128 ? F.vcu - 128 : -1) : (F.vcu < 112 ? F.vcu : -1);
                if (u >= 0) sgu_unit(F, l, u); }
        }
        SEAM(pb + 4);
        if (IN(pb + 5) && PE(9)) {
          for (int rep = 0; rep < NREP(9); ++rep) {
            PHASE_BEGIN();
            pg8::Gemm g{WSP(bf16_t, WS_CAT), WSP(bf16_t, WS_WOUT) + (size_t)l * DM * DM, DM, DM, 0};
            pg8::StaticOrder S; S.init(l == 0 ? MT : NLAT, DM, F.G, (int)blockIdx.x);
            pg8::EpiResid E{srcL, srcC, F.out, XC, modl, 2, rep < NREP(9) - 1, nullptr};
            pg8::gemm_phase<pg8::EpiResid, pg8::StaticOrder, true, false>(F.lds, F.tid, g, S, E);
            if (l == 0 && rep == NREP(9) - 1) { PHASE_BEGIN(); int wi_, nw_; if (tail_worker(MT / 256 * (DM / 256), F.G, (int)blockIdx.x, wi_, nw_)) { for (int set_ = 2; set_ < 4; ++set_) convert_set(F, set_, wi_, nw_); mod_gemv(F, 1, wi_, nw_); } }
          }
            if (l == 1 && PE(10)) for (int rep = 0; rep < NREP(10); ++rep) { PHASE_BEGIN(); p_moe_weights(F); }
        }
        SEAM(pb + 5);
        if (IN(pb + 6) && PE(11)) { PHASE_BEGIN(); if (l == 0) { for (int rep = 0; rep < NREP(11); ++rep) p_norm<false>(F, l, 1, MT, F.out, XC); } else p_norm<true>(F, l, 1, NLAT, F.out, XC); }
        SEAM(pb + 6);
        if (IN(pb + 7)) {
            if (l == 0 && PE(12)) for (int rep = 0; rep < NREP(12); ++rep) {
                PHASE_BEGIN();
                pg8::Gemm g{WSP(bf16_t, WS_H), WSP(bf16_t, WS_WGU), DM, DM, 0};
                pg8::StaticOrder S; S.init(MT, 2 * DFF, F.G, (int)blockIdx.x);
                pg8::EpiSwiglu E{WSP(bf16_t, WS_ACT), DFF};
                pg8::gemm_phase<pg8::EpiSwiglu, pg8::StaticOrder, true, false>(F.lds, F.tid, g, S, E);
            } else if (l == 1 && PE(13)) for (int rep = 0; rep < NREP(13); ++rep) {
                PHASE_BEGIN();
                pg8::Gemm g{WSP(bf16_t, WS_H), WSP(bf16_t, WS_MOEW_GU), DM, DM, (size_t)2 * DFE * DM};
                pg8::MoeOrder S; S.init(ctl + CW_CNT, 11, F.G, (int)blockIdx.x, WSP(int, WS_LIST), true);
                pg8::EpiSwiglu E{WSP(bf16_t, WS_MACT), DFE};
                pg8::gemm_phase<pg8::EpiSwiglu, pg8::MoeOrder, true, true>(F.lds, F.tid, g, S, E);
            }
        }
        SEAM(pb + 7);
        if (IN(pb + 8)) {
            if (l == 0 && PE(14)) for (int rep = 0; rep < NREP(14); ++rep) {
                PHASE_BEGIN();
                pg8::Gemm g{WSP(bf16_t, WS_ACT), WSP(bf16_t, WS_WD), DFF, DFF, 0};
                pg8::DownSplitOrder S; S.init(F.G, (int)blockIdx.x);
                pg8::EpiResid E{F.out, XC, F.out, XC, modl, 5, rep < NREP(14) - 1, WSP(float, WS_SLAB)};
                pg8::gemm_phase<pg8::EpiResid, pg8::DownSplitOrder, true, false, true>(F.lds, F.tid, g, S, E);
            } else if (l == 1 && PE(15)) for (int rep = 0; rep < NREP(15); ++rep) {
                PHASE_BEGIN();
                pg8::Gemm g{WSP(bf16_t, WS_MACT), WSP(bf16_t, WS_MOEW_D), DFE, DFE, (size_t)DM * DFE};
                pg8::MoeOrder S; S.init(ctl + CW_CNT, 4, F.G, (int)blockIdx.x, WSP(int, WS_LIST), false);
                pg8::EpiMoeDown E{WSP(bf16_t, WS_Y), WSP(int, WS_LIST), WSP(float, WS_MISC + MISC_TOPW), S};
                pg8::gemm_phase<pg8::EpiMoeDown, pg8::MoeOrder, true, false>(F.lds, F.tid, g, S, E);
            }
        }
        SEAM(pb + 8);
    }
    if (IN(19) && PE(16)) { PHASE_BEGIN(); p_final(F); }
#undef IN
#undef SEAM
#undef XC
#undef SSQ
#undef ctl
#undef modl
#undef srcL
#undef srcC
#undef PHASE_BEGIN
    asm volatile("mk_code_end:");
}

extern "C" void kernel_launch(void* const* d_in, const int* in_sizes, int n_in, void* d_out, int out_size, void* d_ws, size_t ws_size, hipStream_t stream) {
    static int grid = 0;
    if (grid == 0) {
        if (n_in != 32 || out_size != NLAT * DM || ws_size < WS_END) { fprintf(stderr, "kernel_launch: unexpected shapes (n_in %d, out %d, ws %zu); nothing launched\n", n_in, out_size, ws_size); grid = -1; return; }
        int dev = 0, cus = 0, per_cu = 0;
        if (hipGetDevice(&dev) != hipSuccess || hipDeviceGetAttribute(&cus, hipDeviceAttributeMultiprocessorCount, dev) != hipSuccess) { grid = -1; return; }
        if (hipFuncSetAttribute((const void*)fwd_megakernel, hipFuncAttributeMaxDynamicSharedMemorySize, LDS_BYTES) != hipSuccess) { fprintf(stderr, "kernel_launch: hipFuncSetAttribute failed\n"); grid = -1; return; }
        if (hipOccupancyMaxActiveBlocksPerMultiprocessor(&per_cu, (const void*)fwd_megakernel, NTHR, LDS_BYTES) != hipSuccess || per_cu < 1) { fprintf(stderr, "kernel_launch: occupancy query says %d blocks/CU\n", per_cu); (void)hipGetLastError(); grid = -1; return; }
        grid = cus;
    }
    if (grid < 0) return;
    (void)hipMemsetAsync((char*)d_ws + WS_CTL, 0, CTL_BYTES, stream);
    Args a{};
    for (int i = 0; i < 32; ++i) a.in[i] = (const float*)d_in[i];
    a.out = (float*)d_out; a.ws = (unsigned char*)d_ws;
#if MK_PER_PHASE
    for (int k = 0; k < N_PHASES; ++k) { a.ph_lo = k; a.ph_hi = k + 1; hipLaunchKernelGGL(fwd_megakernel, dim3(grid), dim3(NTHR), LDS_BYTES, stream, a); }
#else
    a.ph_lo = 0; a.ph_hi = N_PHASES;
    void* kargs[] = {&a};
    hipError_t e = hipLaunchCooperativeKernel((const void*)fwd_megakernel, dim3(grid), dim3(NTHR), kargs, LDS_BYTES, stream);
    if (e != hipSuccess) fprintf(stderr, "kernel_launch: cooperative launch failed: %s (grid %d)\n", hipGetErrorString(e), grid);
#endif
}
```

```cpp
#include <hip/hip_runtime.h>
#include <cstdio>
#include <cstdint>

#define LAS __attribute__((address_space(3)))
#define GAS __attribute__((address_space(1)))
typedef unsigned short bf16_t;
typedef short bf16x8 __attribute__((ext_vector_type(8)));
typedef float f32x4 __attribute__((ext_vector_type(4)));
typedef float f32x16 __attribute__((ext_vector_type(16)));
typedef float f32x2 __attribute__((ext_vector_type(2)));
typedef unsigned u32x4 __attribute__((ext_vector_type(4)));
typedef unsigned u32x2 __attribute__((ext_vector_type(2)));
typedef __bf16 bf16x2_t __attribute__((ext_vector_type(2)));

constexpr int BATCH = 8, SEQ = 2048, DM = 1024, CTXL = 256, DEPTH = 2;
constexpr int NLAT = BATCH * SEQ, NCTX = BATCH * CTXL, MT = NLAT + NCTX;
constexpr int INW = 2476, INP = 2560;
constexpr int PC_U = 0, PC_V = 256, PC_Z = 512, PC_X = 896, PC_B = 1280, PC_C = 1536, PC_CQ = 1792, PC_CKV = 2176, PC_KR = 2432, PC_DT = 2464;
constexpr int DFF = 2816, NEXP = 8, DFE = 1408;
constexpr int QW = 576, QWP = 768, KVW = 768;
constexpr float EPS = 1e-6f;
constexpr float QSCALE = 0.10206207261596577f * 1.4426950408889634f;
constexpr int NPOS = 18;

constexpr size_t MiB = 1u << 20;
constexpr size_t WS_CTL = 0, CTL_BYTES = 64 * 1024;
constexpr size_t WS_MOD = 1 * MiB;
constexpr size_t WS_ACS = 2 * MiB;
constexpr size_t WS_MISC = 3 * MiB;
constexpr size_t WS_LIST = 4 * MiB;
constexpr size_t WS_WSGU = 5 * MiB;
constexpr size_t WS_WIN = 6 * MiB;
constexpr size_t WS_WUQ = 16 * MiB;
constexpr size_t WS_WUKV = 18 * MiB;
constexpr size_t WS_WOUT = 19 * MiB;
constexpr size_t WS_WGU = 23 * MiB;
constexpr size_t WS_WD = 34 * MiB;
constexpr size_t WS_XC = 40 * MiB;
constexpr size_t WS_H = 48 * MiB;
constexpr size_t WS_Q = 48 * MiB;
constexpr size_t WS_KR = 70 * MiB;
constexpr size_t WS_P = 84 * MiB;
constexpr size_t WS_CAT = 174 * MiB;
constexpr size_t WS_KV = 210 * MiB;
constexpr size_t WS_CC = 237 * MiB;
constexpr size_t WS_YP = 246 * MiB;
constexpr size_t WS_ST = 273 * MiB;
constexpr size_t WS_ACT = 84 * MiB;
constexpr size_t WS_MOEW_GU = 84 * MiB;
constexpr size_t WS_MOEW_D = 128 * MiB;
constexpr size_t WS_MACT = 150 * MiB;
constexpr size_t WS_Y = 244 * MiB;
constexpr size_t WS_SSQP = 300 * MiB;
constexpr size_t WS_VT = 302 * MiB;
constexpr size_t WS_SLAB = 200 * MiB;
constexpr size_t WS_END = 316 * MiB;
constexpr size_t MISC_SSQ = 0, MISC_DEC = 256 * 1024, MISC_ROPE = 320 * 1024, MISC_TOPW = 384 * 1024;
constexpr int CW_CNT = 64;
constexpr int CW_BAR = 4096;

__device__ __forceinline__ unsigned cvtpk(float lo, float hi) { f32x2 v = {lo, hi}; bf16x2_t b = __builtin_convertvector(v, bf16x2_t); return __builtin_bit_cast(unsigned, b); }
__device__ __forceinline__ float bflo(unsigned u) { return __uint_as_float(u << 16); }
__device__ __forceinline__ float bfhi(unsigned u) { return __uint_as_float(u & 0xffff0000u); }
__device__ __forceinline__ float bf1(bf16_t h) { return __uint_as_float((unsigned)h << 16); }
__device__ __forceinline__ bf16_t f2bf(float f) { return (bf16_t)(cvtpk(f, 0.f) & 0xffffu); }
__device__ __forceinline__ float wave_sum(float v) {
#pragma unroll
    for (int o = 1; o < 64; o <<= 1) v += __shfl_xor(v, o);
    return v;
}
__device__ __forceinline__ float silu_f(float x) { return x * __builtin_amdgcn_rcpf(1.f + __expf(-x)); }
__device__ __forceinline__ float gelu_tanh(float x) { const float u = 0.7978845608028654f * (x + 0.044715f * x * x * x); const float t = 1.f - 2.f * __builtin_amdgcn_rcpf(1.f + __expf(2.f * u)); return 0.5f * x * (1.f + t); }
__device__ __forceinline__ float softplus_f(float x) { return x > 20.f ? x : log1pf(__expf(x)); }
#define LDS_WAIT() asm volatile("s_waitcnt lgkmcnt(0)" ::: "memory")
#define LDS_BARRIER() asm volatile("s_waitcnt lgkmcnt(0)\n\ts_barrier" ::: "memory")
#define MFMA16(a, b, c) __builtin_amdgcn_mfma_f32_16x16x32_bf16((a), (b), (c), 0, 0, 0)
#define MFMA32(a, b, c) __builtin_amdgcn_mfma_f32_32x32x16_bf16((a), (b), (c), 0, 0, 0)

namespace pg8 {
constexpr int BM = 256, BK = 64, HALF = 128, HTB = HALF * BK * 2, STAGE_BYTES = 8 * HTB, NXCD = 8, WGM = 8;
__host__ __device__ __forceinline__ int lds_byte(int r, int c) { const int st = (r >> 4) * 2 + (c >> 5), rr = r & 15, cc = c & 31, ob = rr * 64 + cc * 2; return st * 1024 + (ob ^ (((ob >> 9) & 1) << 5)); }
__host__ __device__ __forceinline__ void stage_rc(int b, int& R, int& C) { const int st = b / 1024, sb = b % 1024, swz = sb ^ (((sb >> 9) & 1) << 5); R = (st >> 1) * 16 + swz / 64; C = (st & 1) * 32 + (swz % 64) / 2; }
__host__ __device__ __forceinline__ int perm32(int rho) { const int n = rho >> 4, i = rho & 15; return 8 * (i >> 2) + 4 * n + (i & 3); }

struct Unit { int pm, pn, e, kt0, nkt; };
struct Gemm { const bf16_t* A; const bf16_t* Bt; int lda; int K; size_t bstride_e; };

struct StaticOrder {
    int nM, nN, nwg, G, c, lim;
    __device__ void init(int M, int N, int G_, int c_) { nM = M / BM; nN = N / BM; nwg = nM * nN; G = G_; c = c_; lim = 0x7fffffff; }
    __device__ void init_plan(int M, int N, int r, int off0, int cnt) { nM = M / BM; nN = N / BM; nwg = nM * nN; G = NXCD; c = off0 * NXCD + r; lim = cnt; }
    __device__ bool next(int i, Unit& u) const {
        const long L = (long)i * G + c; if (i >= lim || L >= nwg) return false;
        int wgid = (int)L; { const int q = nwg / NXCD, r = nwg % NXCD, xcd = wgid % NXCD, off = wgid / NXCD; wgid = (xcd < r ? xcd * (q + 1) : r * (q + 1) + (xcd - r) * q) + off; }
        const int nig = WGM * nN, gid = wgid / nig, fm = gid * WGM, gsz = (nM - fm) < WGM ? (nM - fm) : WGM;
        u.pm = fm + ((wgid % nig) % gsz); u.pn = (wgid % nig) / gsz; u.e = 0; return true;
    }
    __device__ __forceinline__ int arow(const Unit& u, int r) const { return u.pm * BM + r; }
};

template <class Epi, class Sched, bool ALIGN_EPI, bool GATHER, bool KSPLIT = false>
__device__ __forceinline__ void gemm_phase(LAS unsigned char* lds, const int tid, const Gemm g, const Sched& S, const Epi& E) {
    const int wid = __builtin_amdgcn_readfirstlane(tid >> 6), lane = tid & 63, wr = wid >> 2, wc = wid & 3, fr = lane & 15, fq = lane >> 4;
    const int K = g.K; int nt = K / BK;
    int Rr[2], Cc[2]; unsigned voffA[2], voffB[2];
#pragma unroll
    for (int i = 0; i < 2; ++i) { int R, C; stage_rc(tid * 16 + i * 8192, R, C); Rr[i] = R; Cc[i] = C; const int Rb = Epi::PERM ? ((R & ~31) + perm32(R & 31)) : R;
        voffA[i] = (unsigned)(R * g.lda + C) * 2u; voffB[i] = (unsigned)(Rb * K + C) * 2u; }
    const size_t kstep = (size_t)(BK * 2);
    const size_t hstepB = (size_t)HALF * K * 2, tstepB = 2 * hstepB;
    const size_t hstepA = (size_t)HALF * g.lda * 2, tstepA = 2 * hstepA;
    const unsigned ldsw = (unsigned)wid * 1024u;
    const int aoff = lds_byte(wr * 64 + fr, fq * 8), boff = lds_byte(wc * 32 + fr, fq * 8);
    const char* const Abase = (const char*)g.A;
#define PG8_SA(b, h) (((b) * 2 + (h)) * HTB)
#define PG8_SB(b, h) ((4 + (b) * 2 + (h)) * HTB)
#define PG8_GL(gp, off) __builtin_amdgcn_global_load_lds((const unsigned*)(gp), (LAS unsigned*)(lds + (off)), 16, 0, 0)
#define PG8_STAGE_B(bufoff, gbase) do { PG8_GL((const char*)(gbase) + voffB[0], (bufoff) + ldsw); PG8_GL((const char*)(gbase) + voffB[1], (bufoff) + ldsw + 8192); } while (0)
#define PG8_STAGE_A_CUR(bufoff, kt, h) do { if constexpr (GATHER) { const char* _p = Abase + (size_t)(kt) * kstep; PG8_GL(_p + ((h) ? c10 : c00), (bufoff) + ldsw); PG8_GL(_p + ((h) ? c11 : c01), (bufoff) + ldsw + 8192); } \
        else { const char* _p = cA + (size_t)(kt) * kstep + (h) * hstepA; PG8_GL(_p + voffA[0], (bufoff) + ldsw); PG8_GL(_p + voffA[1], (bufoff) + ldsw + 8192); } } while (0)
#define PG8_STAGE_A_SEL(bufoff, kt, h) do { if constexpr (GATHER) { const char* _p = Abase + (size_t)(kt) * kstep; PG8_GL(_p + ((h) ? x10 : x00), (bufoff) + ldsw); PG8_GL(_p + ((h) ? x11 : x01), (bufoff) + ldsw + 8192); } \
        else { const char* _p = xA + (size_t)(kt) * kstep + (h) * hstepA; PG8_GL(_p + voffA[0], (bufoff) + ldsw); PG8_GL(_p + voffA[1], (bufoff) + ldsw + 8192); } } while (0)
#define PG8_LDA(dst, b, h) do { _Pragma("unroll") for (int m = 0; m < 4; ++m) _Pragma("unroll") for (int k = 0; k < 2; ++k) dst[m][k] = *(const LAS bf16x8*)(lds + PG8_SA(b, h) + aoff + m * 2048 + k * 1024); } while (0)
#define PG8_LDB(dst, b, h) do { _Pragma("unroll") for (int n = 0; n < 2; ++n) _Pragma("unroll") for (int k = 0; k < 2; ++k) dst[n][k] = *(const LAS bf16x8*)(lds + PG8_SB(b, h) + boff + n * 2048 + k * 1024); } while (0)
#define PG8_MMA(ai, bj, At, Bt) do { __builtin_amdgcn_s_setprio(1); _Pragma("unroll") for (int m = 0; m < 4; ++m) _Pragma("unroll") for (int n = 0; n < 2; ++n) _Pragma("unroll") for (int k = 0; k < 2; ++k) \
        acc[ai][bj][m][n] = __builtin_amdgcn_mfma_f32_16x16x32_bf16(Bt[n][k], At[m][k], acc[ai][bj][m][n], 0, 0, 0); __builtin_amdgcn_s_setprio(0); } while (0)
#define PG8_WAIT_V(n) asm volatile("s_waitcnt vmcnt(" #n ")" ::: "memory")
#define PG8_WAIT_L(n) asm volatile("s_waitcnt lgkmcnt(" #n ")" ::: "memory")
#define PG8_BAR __builtin_amdgcn_s_barrier()
#define PG8_SCHED __builtin_amdgcn_sched_barrier(0)
#define PG8_AOFFS(u, o00, o01, o10, o11) do { if constexpr (GATHER) { \
        o00 = (unsigned)(((size_t)S.arow(u, Rr[0]) * g.lda + Cc[0]) * 2); o01 = (unsigned)(((size_t)S.arow(u, Rr[1]) * g.lda + Cc[1]) * 2); \
        o10 = (unsigned)(((size_t)S.arow(u, HALF + Rr[0]) * g.lda + Cc[0]) * 2); o11 = (unsigned)(((size_t)S.arow(u, HALF + Rr[1]) * g.lda + Cc[1]) * 2); } } while (0)
    Unit cur, nxt; int ui = 0;
    if (!S.next(0, cur)) return;
    f32x4 acc[2][2][4][2];
#pragma unroll
    for (int a = 0; a < 2; ++a)
#pragma unroll
        for (int b = 0; b < 2; ++b)
#pragma unroll
            for (int m = 0; m < 4; ++m)
#pragma unroll
                for (int n = 0; n < 2; ++n) acc[a][b][m][n] = (f32x4){0.f, 0.f, 0.f, 0.f};
    bf16x8 At[4][2], B0[2][2], B1[2][2];
    unsigned c00 = 0, c01 = 0, c10 = 0, c11 = 0, n00 = 0, n01 = 0, n10 = 0, n11 = 0;
    PG8_AOFFS(cur, c00, c01, c10, c11);
    const char* cA = Abase + (size_t)cur.pm * tstepA;
    const char* cB = (const char*)g.Bt + ((size_t)cur.e * g.bstride_e) * 2 + (size_t)cur.pn * tstepB;
    if constexpr (KSPLIT) { cA += (size_t)cur.kt0 * kstep; cB += (size_t)cur.kt0 * kstep; nt = cur.nkt; }
    PG8_STAGE_B(PG8_SB(0, 0), cB); PG8_STAGE_B(PG8_SB(0, 1), cB + hstepB); PG8_STAGE_A_CUR(PG8_SA(0, 0), 0, 0); PG8_STAGE_A_CUR(PG8_SA(0, 1), 0, 1);
    if (wr == 1) PG8_BAR;
    PG8_WAIT_V(2); PG8_BAR;
    PG8_STAGE_B(PG8_SB(1, 0), cB + kstep); PG8_STAGE_A_CUR(PG8_SA(1, 0), 1, 0); PG8_STAGE_B(PG8_SB(1, 1), cB + hstepB + kstep);
    PG8_WAIT_V(6); PG8_BAR;
    for (;;) {
        const bool has_next = S.next(ui + 1, nxt);
        const char* nB = cB; const char* nA = cA;
        if (has_next) { PG8_AOFFS(nxt, n00, n01, n10, n11); nA = Abase + (size_t)nxt.pm * tstepA; nB = (const char*)g.Bt + ((size_t)nxt.e * g.bstride_e) * 2 + (size_t)nxt.pn * tstepB;
            if constexpr (KSPLIT) { nA += (size_t)nxt.kt0 * kstep; nB += (size_t)nxt.kt0 * kstep; } }
        else { n00 = c00; n01 = c01; n10 = c10; n11 = c11; }
#pragma unroll 1
        for (int t = 0; t < nt; t += 2) {
            const bool last = (t == nt - 2);
            const int kt2 = last ? 0 : t + 2, kt3 = kt2 + 1;
            const unsigned x00 = last ? n00 : c00, x01 = last ? n01 : c01, x10 = last ? n10 : c10, x11 = last ? n11 : c11;
            const char* xA = last ? nA : cA;
            const char* b2 = last ? nB : cB + (size_t)(t + 2) * kstep; const char* b3 = b2 + kstep;
            (void)x00; (void)x01; (void)x10; (void)x11; (void)xA;
            PG8_LDB(B0, 0, 0); PG8_LDB(B1, 0, 1); PG8_SCHED; PG8_LDA(At, 0, 0); PG8_STAGE_A_CUR(PG8_SA(1, 1), t + 1, 1);
            PG8_WAIT_V(8); PG8_WAIT_L(0); PG8_BAR; PG8_MMA(0, 0, At, B0); PG8_MMA(0, 1, At, B1); PG8_BAR; PG8_SCHED;
            PG8_LDA(At, 0, 1); PG8_STAGE_B(PG8_SB(0, 0), b2); PG8_STAGE_B(PG8_SB(0, 1), b2 + hstepB); PG8_STAGE_A_SEL(PG8_SA(0, 0), kt2, 0);
            PG8_WAIT_V(8); PG8_WAIT_L(0); PG8_BAR; PG8_MMA(1, 0, At, B0); PG8_MMA(1, 1, At, B1); PG8_BAR; PG8_SCHED;
            PG8_LDB(B0, 1, 0); PG8_LDB(B1, 1, 1); PG8_SCHED; PG8_LDA(At, 1, 0); PG8_STAGE_A_SEL(PG8_SA(0, 1), kt2, 1);
            PG8_WAIT_V(8); PG8_WAIT_L(0); PG8_BAR; PG8_MMA(0, 0, At, B0); PG8_MMA(0, 1, At, B1); PG8_BAR; PG8_SCHED;
            PG8_LDA(At, 1, 1); PG8_STAGE_B(PG8_SB(1, 0), b3); PG8_STAGE_B(PG8_SB(1, 1), b3 + hstepB); PG8_STAGE_A_SEL(PG8_SA(1, 0), kt3, 0);
            PG8_WAIT_V(8); PG8_WAIT_L(0); PG8_BAR; PG8_MMA(1, 0, At, B0); PG8_MMA(1, 1, At, B1); PG8_BAR; PG8_SCHED;
        }
        if constexpr (ALIGN_EPI) { if (wr == 0) PG8_BAR; }
        E(acc, cur, wr, wc, fr, fq);
        if (!has_next) break;
#pragma unroll
        for (int a = 0; a < 2; ++a)
#pragma unroll
            for (int b = 0; b < 2; ++b)
#pragma unroll
                for (int m = 0; m < 4; ++m)
#pragma unroll
                    for (int n = 0; n < 2; ++n) acc[a][b][m][n] = (f32x4){0.f, 0.f, 0.f, 0.f};
        cur = nxt; cA = nA; cB = nB; c00 = n00; c01 = n01; c10 = n10; c11 = n11; ++ui;
        if constexpr (KSPLIT) nt = cur.nkt;
        if constexpr (ALIGN_EPI) { if (wr == 1) PG8_BAR; }
    }
    PG8_WAIT_V(0);
    if constexpr (!ALIGN_EPI) { if (wr == 0) PG8_BAR; }
    PG8_BAR;
#undef PG8_SA
#undef PG8_SB
#undef PG8_GL
#undef PG8_STAGE_A_CUR
#undef PG8_STAGE_A_SEL
#undef PG8_STAGE_B
#undef PG8_LDA
#undef PG8_LDB
#undef PG8_MMA
#undef PG8_WAIT_V
#undef PG8_WAIT_L
#undef PG8_BAR
#undef PG8_SCHED
#undef PG8_AOFFS
}
}
namespace pg8 {
struct EpiInProj {
    static constexpr bool PERM = true;
    bf16_t* O; float* ssq; bool dry;
    __device__ __forceinline__ void operator()(const f32x4 (&acc)[2][2][4][2], const Unit& u, int wr, int wc, int fr, int fq) const {
        if (dry) return;
        const int row0 = u.pm * BM + wr * 64 + fr, col0 = u.pn * BM + wc * 32 + 8 * fq;
#pragma unroll
        for (int ai = 0; ai < 2; ++ai)
#pragma unroll
            for (int m = 0; m < 4; ++m) { const int row = row0 + ai * HALF + m * 16; bf16_t* rowp = O + (size_t)row * INP + col0;
                float sq = 0.f, sk = 0.f;
#pragma unroll
                for (int bj = 0; bj < 2; ++bj) { const f32x4 v0 = acc[ai][bj][m][0], v1 = acc[ai][bj][m][1];
                    u32x4 w; w.x = cvtpk(v0[0], v0[1]); w.y = cvtpk(v0[2], v0[3]); w.z = cvtpk(v1[0], v1[1]); w.w = cvtpk(v1[2], v1[3]);
                    *(u32x4*)(rowp + bj * HALF) = w;
                    const int hidx = 2 * u.pn + bj;
                    const float s = (v0[0] * v0[0] + v0[1] * v0[1]) + (v0[2] * v0[2] + v0[3] * v0[3]) + (v1[0] * v1[0] + v1[1] * v1[1]) + (v1[2] * v1[2] + v1[3] * v1[3]);
                    if (hidx >= 14 && hidx <= 16) sq += s;
                    if (hidx >= 17 && hidx <= 18) sk += s; }
                if (u.pn >= 7 && u.pn <= 9) {
                    sq += __shfl_xor(sq, 16); sq += __shfl_xor(sq, 32); sk += __shfl_xor(sk, 16); sk += __shfl_xor(sk, 32);
                    if (fq == 0) { float* sp = ssq + (size_t)row * 16;
                        if (u.pn == 7) sp[wc] = sq; if (u.pn == 8) { sp[4 + wc] = sq; sp[8 + wc] = sk; } if (u.pn == 9) sp[12 + wc] = sk; } } }
    }
};
struct EpiScaleBf16 {
    static constexpr bool PERM = true;
    bf16_t* O; int ldc, ncols; const float* ssq; int idx; float invn, mul;
    __device__ __forceinline__ void operator()(const f32x4 (&acc)[2][2][4][2], const Unit& u, int wr, int wc, int fr, int fq) const {
        const int row0 = u.pm * BM + wr * 64 + fr, col0 = u.pn * BM + wc * 32 + 8 * fq;
#pragma unroll
        for (int ai = 0; ai < 2; ++ai) {
            float scv[4];
#pragma unroll
            for (int m = 0; m < 4; ++m) { const int row = row0 + ai * HALF + m * 16;
                const f32x4 pa = *(const f32x4*)(ssq + (size_t)row * 16 + 8 * idx), pb = *(const f32x4*)(ssq + (size_t)row * 16 + 8 * idx + 4);
                scv[m] = rsqrtf((((pa[0] + pa[1]) + (pa[2] + pa[3])) + ((pb[0] + pb[1]) + (pb[2] + pb[3]))) * invn + EPS) * mul; }
            asm volatile("" ::: "memory");
#pragma unroll
            for (int m = 0; m < 4; ++m) { const int row = row0 + ai * HALF + m * 16; bf16_t* rowp = O + (size_t)row * ldc + col0;
                const float sc = scv[m];
#pragma unroll
                for (int bj = 0; bj < 2; ++bj) if (col0 + bj * HALF < ncols) { const f32x4 v0 = acc[ai][bj][m][0] * sc, v1 = acc[ai][bj][m][1] * sc;
                    u32x4 w; w.x = cvtpk(v0[0], v0[1]); w.y = cvtpk(v0[2], v0[3]); w.z = cvtpk(v1[0], v1[1]); w.w = cvtpk(v1[2], v1[3]);
                    *(u32x4*)(rowp + bj * HALF) = w; } } }
    }
};
struct EpiResid {
    static constexpr bool PERM = false;
    const float* oldL; const float* oldC; float* newL; float* newC; const float* mod; int gi; bool dry; float* slab;
    __device__ __forceinline__ void operator()(const f32x4 (&acc)[2][2][4][2], const Unit& u, int wr, int wc, int fr, int fq) const {
        if (dry) return;
        if (slab && u.e > 0) {
            float* sp = slab + ((size_t)(u.e - 1) * NCTX + (u.pm * BM - NLAT) + wr * 64 + fr) * DM + u.pn * BM + wc * 32 + 4 * fq;
#pragma unroll
            for (int ai = 0; ai < 2; ++ai)
#pragma unroll
                for (int m = 0; m < 4; ++m)
#pragma unroll
                    for (int bj = 0; bj < 2; ++bj)
#pragma unroll
                        for (int n = 0; n < 2; ++n) *(f32x4*)(sp + (size_t)(ai * HALF + m * 16) * DM + bj * HALF + n * 16) = acc[ai][bj][m][n];
            return; }
        const int rbase = u.pm * BM; const bool isc = rbase >= NLAT; const int b = isc ? 8 : (rbase >> 11);
        const float* xo = isc ? oldC - (size_t)NLAT * DM : oldL; float* xn = isc ? newC - (size_t)NLAT * DM : newL;
        const int row0 = rbase + wr * 64 + fr, col0 = u.pn * BM + wc * 32 + 4 * fq;
        const float* gp = mod + (size_t)b * 6144 + gi * DM + col0;
        f32x4 gv[2][2];
#pragma unroll
        for (int bj = 0; bj < 2; ++bj)
#pragma unroll
            for (int n = 0; n < 2; ++n) gv[bj][n] = *(const f32x4*)(gp + bj * HALF + n * 16);
#pragma unroll
        for (int am = 0; am < 4; ++am) { const int ai = am >> 1, m0 = (am & 1) * 2;
            f32x4 xv[2][2][2];
#pragma unroll
            for (int mm = 0; mm < 2; ++mm) { const size_t off = (size_t)(row0 + ai * HALF + (m0 + mm) * 16) * DM + col0;
#pragma unroll
                for (int bj = 0; bj < 2; ++bj)
#pragma unroll
                    for (int n = 0; n < 2; ++n) xv[mm][bj][n] = *(const f32x4*)(xo + off + bj * HALF + n * 16); }
            asm volatile("" ::: "memory");
#pragma unroll
            for (int mm = 0; mm < 2; ++mm) { const size_t off = (size_t)(row0 + ai * HALF + (m0 + mm) * 16) * DM + col0;
#pragma unroll
                for (int bj = 0; bj < 2; ++bj)
#pragma unroll
                    for (int n = 0; n < 2; ++n) *(f32x4*)(xn + off + bj * HALF + n * 16) = xv[mm][bj][n] + gv[bj][n] * acc[ai][bj][m0 + mm][n]; }
            asm volatile("" ::: "memory"); }
    }
};
struct EpiSwiglu {
    static constexpr bool PERM = true;
    bf16_t* O; int ldc;
    __device__ __forceinline__ void operator()(const f32x4 (&acc)[2][2][4][2], const Unit& u, int wr, int wc, int fr, int fq) const {
        const int row0 = u.pm * BM + wr * 64 + fr, col0 = u.pn * HALF + wc * 32 + 8 * fq;
#pragma unroll
        for (int ai = 0; ai < 2; ++ai)
#pragma unroll
            for (int m = 0; m < 4; ++m) { bf16_t* rowp = O + (size_t)(row0 + ai * HALF + m * 16) * ldc + col0;
                float r[8];
#pragma unroll
                for (int n = 0; n < 2; ++n)
#pragma unroll
                    for (int j = 0; j < 4; ++j) { const float gt = acc[ai][0][m][n][j], up = acc[ai][1][m][n][j]; r[4 * n + j] = silu_f(gt) * up; }
                u32x4 w; w.x = cvtpk(r[0], r[1]); w.y = cvtpk(r[2], r[3]); w.z = cvtpk(r[4], r[5]); w.w = cvtpk(r[6], r[7]);
                *(u32x4*)rowp = w; }
    }
};
struct DownSplitOrder {
    StaticOrder so; int G, c;
    __device__ void init(int G_, int c_) { so.init(NLAT, DM, G_, c_); G = G_; c = c_; }
    __device__ bool next(int i, Unit& u) const {
        if (so.next(i, u)) { u.kt0 = 0; u.nkt = DFF / BK; return true; }
        const int rounds = (so.nwg + G - 1) / G; const int j = (i - rounds) * G + c; if (i < rounds || j >= 128) return false;
        const int tile = j >> 2, part = j & 3; u.pm = NLAT / BM + (tile >> 2); u.pn = tile & 3; u.e = 1 + part;
        u.kt0 = part == 0 ? 0 : part == 1 ? 12 : part == 2 ? 24 : 34; u.nkt = part < 2 ? 12 : 10; return true;
    }
    __device__ __forceinline__ int arow(const Unit& u, int r) const { return u.pm * BM + r; }
};
struct MoeOrder {
    int c0, c1, c2, c3, c4, c5, c6, c7, t1, t2, t3, t4, t5, t6, t7, t8; int npn, G, c; const int* list; bool gather;
    __device__ void init(const unsigned* cw, int npn_, int G_, int c_, const int* list_, bool gather_) {
        #define RFL_(x) __builtin_amdgcn_readfirstlane((int)(x))
        c0 = RFL_(cw[0]); c1 = RFL_(cw[64]); c2 = RFL_(cw[128]); c3 = RFL_(cw[192]); c4 = RFL_(cw[256]); c5 = RFL_(cw[320]); c6 = RFL_(cw[384]); c7 = RFL_(cw[448]);
#undef RFL_
        t1 = (c0 + 255) >> 8; t2 = t1 + ((c1 + 255) >> 8); t3 = t2 + ((c2 + 255) >> 8); t4 = t3 + ((c3 + 255) >> 8); t5 = t4 + ((c4 + 255) >> 8); t6 = t5 + ((c5 + 255) >> 8); t7 = t6 + ((c6 + 255) >> 8); t8 = t7 + ((c7 + 255) >> 8);
        npn = npn_; G = G_; c = c_; list = list_; gather = gather_;
    }
    __device__ bool next(int i, Unit& u) const {
        const int L = i * G + c, nwg = t8 * npn; if (L >= nwg) return false;
        int wgid = L; { const int q = nwg / NXCD, r = nwg % NXCD, xcd = wgid % NXCD, off = wgid / NXCD; wgid = (xcd < r ? xcd * (q + 1) : r * (q + 1) + (xcd - r) * q) + off; }
        const int nig = WGM * npn, gid = wgid / nig, fm = gid * WGM, gsz = (t8 - fm) < WGM ? (t8 - fm) : WGM;
        const int ti = fm + ((wgid % nig) % gsz); u.pn = (wgid % nig) / gsz; u.pm = ti;
        u.e = (ti >= t1) + (ti >= t2) + (ti >= t3) + (ti >= t4) + (ti >= t5) + (ti >= t6) + (ti >= t7); return true;
    }
    __device__ __forceinline__ int ecnt(int e) const { return e == 0 ? c0 : e == 1 ? c1 : e == 2 ? c2 : e == 3 ? c3 : e == 4 ? c4 : e == 5 ? c5 : e == 6 ? c6 : c7; }
    __device__ __forceinline__ int etb(int e) const { return e == 0 ? 0 : e == 1 ? t1 : e == 2 ? t2 : e == 3 ? t3 : e == 4 ? t4 : e == 5 ? t5 : e == 6 ? t6 : t7; }
    __device__ __forceinline__ int arow(const Unit& u, int r) const {
        if (!gather) return u.pm * BM + r;
        const int pos = (u.pm - etb(u.e)) * BM + r;
        const int n_e = ecnt(u.e); const int v = list[u.e * NLAT + (pos < n_e ? pos : 0)] >> 1; return pos < n_e ? v : 0;
    }
};
struct EpiMoeDown {
    static constexpr bool PERM = true;
    bf16_t* Y; const int* list; const float* topw; MoeOrder mo;
    __device__ __forceinline__ void operator()(const f32x4 (&acc)[2][2][4][2], const Unit& u, int wr, int wc, int fr, int fq) const {
        const int pos0 = (u.pm - mo.etb(u.e)) * BM + wr * 64 + fr, n_e = mo.ecnt(u.e), col0 = u.pn * BM + wc * 32 + 8 * fq;
        int tkv[8]; float wgv[8];
#pragma unroll
        for (int i = 0; i < 8; ++i) { const int pos = pos0 + (i >> 2) * HALF + (i & 3) * 16; tkv[i] = list[u.e * NLAT + (pos < n_e ? pos : 0)]; }
#pragma unroll
        for (int i = 0; i < 8; ++i) wgv[i] = topw[tkv[i]];
#pragma unroll
        for (int ai = 0; ai < 2; ++ai)
#pragma unroll
            for (int m = 0; m < 4; ++m) { const int pos = pos0 + ai * HALF + m * 16;
                if (pos < n_e) { const int tk = tkv[ai * 4 + m]; const float wgt = wgv[ai * 4 + m]; bf16_t* rowp = Y + (size_t)tk * DM + col0;
#pragma unroll
                    for (int bj = 0; bj < 2; ++bj) { const f32x4 v0 = acc[ai][bj][m][0] * wgt, v1 = acc[ai][bj][m][1] * wgt;
                        u32x4 w; w.x = cvtpk(v0[0], v0[1]); w.y = cvtpk(v0[2], v0[3]); w.z = cvtpk(v1[0], v1[1]); w.w = cvtpk(v1[2], v1[3]);
                        *(u32x4*)(rowp + bj * HALF) = w; } } }
    }
};
}
constexpr int NWAVES = 8, NTHR = 512;
constexpr int RING_BYTES = 147456;
constexpr int LDSCTL_OFF = RING_BYTES, MISC_OFF = LDSCTL_OFF + 320;
constexpr int LDS_BYTES = RING_BYTES + 1024;
typedef GAS unsigned gu32;
#define RLX_AGENT __ATOMIC_RELAXED, __HIP_MEMORY_SCOPE_AGENT

#define XB_TMO      128
#define XB_XCNT(j)  (256  + 64 * (j))
#define XB_XSUB(j)  (1280 + 64 * (j))
#define XB_XGEN(j)  (2304 + 64 * (j))
#define XB_TOP      3328
#define XB_TOPGEN   3392
#define XCD_BAR_WORDS 3456
#define XB_SPIN_CAP (1u << 18)
__device__ __forceinline__ unsigned xb_ld(unsigned* p)              { return __hip_atomic_load(p, __ATOMIC_RELAXED, __HIP_MEMORY_SCOPE_AGENT); }
__device__ __forceinline__ unsigned xb_add(unsigned* p, unsigned v) { return __hip_atomic_fetch_add(p, v, __ATOMIC_RELAXED, __HIP_MEMORY_SCOPE_AGENT); }
__device__ __forceinline__ unsigned xb_xcc_id() { return (unsigned)__builtin_amdgcn_s_getreg((3 << 11) | 20) & 0xFu; }
#define XB_SPIN(cond, bar) do { unsigned _sp = 0; while (cond) { __builtin_amdgcn_s_sleep(1); \
    if ((++_sp & 255u) == 0u) { if (xb_ld(&(bar)[XB_TMO])) break; if (_sp > XB_SPIN_CAP) { atomicAdd(&(bar)[XB_TMO], 1u); break; } } } } while (0)
struct XcdBarrier { unsigned* bar; unsigned x; volatile LAS unsigned* st; };
__device__ __forceinline__ XcdBarrier xcd_barrier_post(unsigned* bar, volatile LAS unsigned* st, bool leader) {
    XcdBarrier b; b.bar = bar; b.x = xb_xcc_id(); b.st = st;
    if (leader) (void)xb_add(&bar[XB_XCNT(b.x)], 1u);
    return b;
}
__device__ __forceinline__ void xcd_barrier_complete(unsigned* bar, unsigned x, unsigned& nloc, unsigned& nx) {
    const unsigned G = gridDim.x * gridDim.y * gridDim.z;
    unsigned sum, cnt, mine, sp = 0u;
    for (;;) {
        sum = 0u; cnt = 0u; mine = 0u;
#pragma unroll
        for (unsigned j = 0; j < 16; ++j) { const unsigned c = xb_ld(&bar[XB_XCNT(j)]); sum += c; cnt += (c > 0u) ? 1u : 0u; mine = (j == x) ? c : mine; }
        if (sum == G) break;
        __builtin_amdgcn_s_sleep(1);
        if ((++sp & 255u) == 0u) { if (xb_ld(&bar[XB_TMO])) break; if (sp > XB_SPIN_CAP) { atomicAdd(&bar[XB_TMO], 1u); break; } }
    }
    nloc = mine > 0u ? mine : 1u; nx = cnt > 0u ? cnt : 1u;
}
__device__ __forceinline__ void xcd_barrier(const XcdBarrier& b, bool leader) {
    asm volatile("s_waitcnt vmcnt(0)" ::: "memory");
    __syncthreads();
    if (leader) {
        unsigned* bar = b.bar;
        __builtin_amdgcn_s_waitcnt(0);
        unsigned nloc = b.st[0], nx = b.st[1];
        if (nloc == 0u) { xcd_barrier_complete(bar, b.x, nloc, nx); b.st[0] = nloc; b.st[1] = nx; }
        const unsigned old = xb_add(&bar[XB_XSUB(b.x)], 1u);
        const unsigned gen = old / nloc;
        if (old + 1u == (gen + 1u) * nloc) {
            __builtin_amdgcn_fence(__ATOMIC_RELEASE, "agent");
            asm volatile("s_waitcnt vmcnt(0)" ::: "memory");
            const unsigned og = xb_add(&bar[XB_TOP], 1u);
            const unsigned tg = og / nx;
            if (og + 1u == (tg + 1u) * nx) xb_add(&bar[XB_TOPGEN], 1u);
            else XB_SPIN(xb_ld(&bar[XB_TOPGEN]) == tg, bar);
            __builtin_amdgcn_fence(__ATOMIC_ACQUIRE, "agent");
            xb_add(&bar[XB_XGEN(b.x)], 1u);
            asm volatile("s_waitcnt vmcnt(0)" ::: "memory");
        } else {
            XB_SPIN(xb_ld(&bar[XB_XGEN(b.x)]) == gen, bar);
            __builtin_amdgcn_fence(__ATOMIC_ACQUIRE, "agent");
            asm volatile("s_waitcnt vmcnt(0)" ::: "memory");
        }
    }
    __syncthreads();
}

struct Frame {
    unsigned char* sm;
    LAS unsigned char* lds;
    int tid, lane, wave, G, vcu;
    const float *x, *c, *ctx, *c_ctx, *w_mod, *b_mod, *g_mix, *w_in, *w_sgu, *b_sgu, *g_sgu, *beta_sgu, *conv_w, *conv_b, *dt_bias, *a_log, *d_skip, *g_ssd, *g_q, *w_uq, *g_kv, *w_ukv,
                *w_out, *g_ffn, *w_gate, *w_up, *w_down, *w_router, *w_gate_e, *w_up_e, *w_down_e, *g_final;
    float* out; unsigned char* ws;
};
#define WSP(T, off) ((T*)(F.ws + (off)))

__device__ __forceinline__ int rowmap(int mode, int n) {
    if (mode == 1) { if (n < 1792) return n; if (n < 1804) return n + 672; return n - 12; }
    if (mode == 2) return ((n >> 7) << 8) + (n & 127);
    if (mode == 3) return ((n >> 7) << 8) + 128 + (n & 127);
    return n;
}
__device__ __forceinline__ void transpose_item(const float* W, int K, int N, bf16_t* WT, const float* ks, int mode, LAS float* scr, int item, int lane) {
    const int nblk = (N + 31) / 32, kb = item / nblk, nb = item % nblk, k0 = 64 * kb, n0 = 32 * nb;
    const int nn = n0 + (lane & 31); const bool nok = nn < N;
#pragma unroll 16
    for (int i = 0; i < 32; ++i) { const int kk = 2 * i + (lane >> 5); float v = W[(size_t)(k0 + kk) * N + (nok ? nn : N - 1)]; v = nok ? v : 0.f; if (ks) v *= ks[k0 + kk]; scr[kk * 33 + (lane & 31)] = v; }
    LDS_WAIT(); asm volatile("" ::: "memory");
    const int cch = lane & 7;
#pragma unroll
    for (int j = 0; j < 4; ++j) { const int n = (lane >> 3) + 8 * j; const LAS float* s = scr + (8 * cch) * 33 + n;
        u32x4 o; o.x = cvtpk(s[0 * 33], s[1 * 33]); o.y = cvtpk(s[2 * 33], s[3 * 33]); o.z = cvtpk(s[4 * 33], s[5 * 33]); o.w = cvtpk(s[6 * 33], s[7 * 33]);
        if (n0 + n < N) *(u32x4*)(WT + (size_t)rowmap(mode, n0 + n) * K + k0 + 8 * cch) = o; }
    LDS_WAIT(); asm volatile("" ::: "memory");
}
__device__ __forceinline__ void transpose_item64(const float* W, int K, int N, bf16_t* WT, const float* ks, int mode, LAS float* scr, int item, int lane) {
    const int nblk = (N + 63) / 64, kb = item / nblk, nb = item % nblk, k0 = 64 * kb, n0 = 64 * nb;
    const int lr = lane >> 4, lc = (lane & 15) * 4; const bool nok = n0 + lc < N; const int ncol = nok ? n0 + lc : N - 4;
#pragma unroll
    for (int i = 0; i < 16; ++i) { const int kk = 4 * i + lr; f32x4 v = *(const f32x4*)(W + (size_t)(k0 + kk) * N + ncol); if (ks) v = v * ks[k0 + kk];
        scr[kk * 65 + lc] = v[0]; scr[kk * 65 + lc + 1] = v[1]; scr[kk * 65 + lc + 2] = v[2]; scr[kk * 65 + lc + 3] = v[3]; }
    LDS_WAIT(); asm volatile("" ::: "memory");
    const int cch = lane & 7;
#pragma unroll
    for (int j = 0; j < 8; ++j) { const int n = (lane >> 3) + 8 * j; const LAS float* s = scr + (8 * cch) * 65 + n;
        u32x4 o; o.x = cvtpk(s[0 * 65], s[1 * 65]); o.y = cvtpk(s[2 * 65], s[3 * 65]); o.z = cvtpk(s[4 * 65], s[5 * 65]); o.w = cvtpk(s[6 * 65], s[7 * 65]);
        if (n0 + n < N) *(u32x4*)(WT + (size_t)rowmap(mode, n0 + n) * K + k0 + 8 * cch) = o; }
    LDS_WAIT(); asm volatile("" ::: "memory");
}
__device__ __forceinline__ void zero_fill16(Frame& F, void* p, size_t bytes) {
    const size_t n = bytes / 16; const u32x4 z = {0u, 0u, 0u, 0u};
    for (size_t i = (size_t)F.vcu * NTHR + F.tid; i < n; i += (size_t)F.G * NTHR) ((u32x4*)p)[i] = z;
}
__device__ __forceinline__ void mod_gemv(Frame& F, int l, int wi, int nw) {
    LAS float* cond = (LAS float*)F.lds;
    LAS float* red = (LAS float*)(F.lds + 36864);
    __syncthreads();
    for (int i = F.tid; i < 9 * DM; i += NTHR) { const float v = i < 8 * DM ? F.c[i] : F.c_ctx[i - 8 * DM]; cond[i] = silu_f(v); }
    __syncthreads();
    for (int ch = wi; ch < 192; ch += nw) {
        const int cl = F.lane & 31, kh = F.lane >> 5, col = ch * 32 + cl, kg = F.wave;
        const float* wp = F.w_mod + (size_t)l * DM * 6144 + (size_t)(kg * 128 + kh) * 6144 + col;
        float a[9];
#pragma unroll
        for (int r = 0; r < 9; ++r) a[r] = 0.f;
#pragma unroll 8
        for (int k4 = 0; k4 < 16; ++k4) { const float w0 = wp[(size_t)(8 * k4) * 6144], w1 = wp[(size_t)(8 * k4 + 2) * 6144], w2 = wp[(size_t)(8 * k4 + 4) * 6144], w3 = wp[(size_t)(8 * k4 + 6) * 6144];
#pragma unroll
            for (int r = 0; r < 9; ++r) { const LAS float* cp = cond + r * DM + kg * 128 + 8 * k4 + kh; a[r] += (cp[0] * w0 + cp[2] * w1) + (cp[4] * w2 + cp[6] * w3); } }
#pragma unroll
        for (int r = 0; r < 9; ++r) { a[r] += __shfl_xor(a[r], 32); if (kh == 0) red[(kg * 9 + r) * 32 + cl] = a[r]; }
        __syncthreads();
        for (int idx = F.tid; idx < 9 * 32; idx += NTHR) { const int r = idx >> 5, cc = idx & 31; float s = 0.f;
#pragma unroll
            for (int g = 0; g < 8; ++g) s += red[(g * 9 + r) * 32 + cc];
            WSP(float, WS_MOD)[((size_t)l * 9 + r) * 6144 + ch * 32 + cc] = s + F.b_mod[l * 6144 + ch * 32 + cc]; }
        __syncthreads();
    }
}
__device__ __forceinline__ void convert_set(Frame& F, int set, int wi, int nw) {
    __syncthreads();
    LAS float* scr = (LAS float*)(F.lds + F.wave * 16640);
    const int gw = wi * NWAVES + F.wave, NGW = nw * NWAVES;
    constexpr int I_IN = 16 * 39, I_UQ = 6 * 9, I_UKV = 4 * 12, I_OUT = 16 * 16, I_G = 16 * 44, I_D = 44 * 16;
    if (set == 0 || set == 3) { const int l = set == 0 ? 0 : 1; const int n = I_IN + I_UQ + I_UKV + (l == 1 ? I_OUT : 0);
        for (int it = gw; it < n; it += NGW) { int r = it;
            if (r < I_IN) { transpose_item64(F.w_in + (size_t)l * DM * INW, DM, INW, WSP(bf16_t, WS_WIN) + (size_t)l * INP * DM, nullptr, 1, scr, r, F.lane); continue; } r -= I_IN;
            if (r < I_UQ) { transpose_item64(F.w_uq + (size_t)l * 384 * QW, 384, QW, WSP(bf16_t, WS_WUQ) + (size_t)l * QWP * 384, F.g_q + l * 384, 0, scr, r, F.lane); continue; } r -= I_UQ;
            if (r < I_UKV) { transpose_item64(F.w_ukv + (size_t)l * 256 * KVW, 256, KVW, WSP(bf16_t, WS_WUKV) + (size_t)l * KVW * 256, F.g_kv + l * 256, 0, scr, r, F.lane); continue; } r -= I_UKV;
            transpose_item64(F.w_out + (size_t)l * DM * DM, DM, DM, WSP(bf16_t, WS_WOUT) + (size_t)l * DM * DM, nullptr, 0, scr, r, F.lane); }
        const u32x4 z = {0u, 0u, 0u, 0u};
        { u32x4* p0 = (u32x4*)(WSP(bf16_t, WS_WIN) + ((size_t)l * INP + INW) * DM); const size_t n0 = (size_t)(INP - INW) * DM * 2 / 16; for (size_t i = (size_t)wi * NTHR + F.tid; i < n0; i += (size_t)nw * NTHR) p0[i] = z;
          u32x4* p1 = (u32x4*)(WSP(bf16_t, WS_WUQ) + ((size_t)l * QWP + QW) * 384); const size_t n1 = (size_t)(QWP - QW) * 384 * 2 / 16; for (size_t i = (size_t)wi * NTHR + F.tid; i < n1; i += (size_t)nw * NTHR) p1[i] = z; }
    } else if (set == 1) {
        for (int it = gw; it < I_OUT; it += NGW) transpose_item64(F.w_out, DM, DM, WSP(bf16_t, WS_WOUT), nullptr, 0, scr, it, F.lane);
    } else {
        for (int it = gw; it < 2 * I_G + I_D; it += NGW) { int r = it;
            if (r < I_G) { transpose_item64(F.w_gate, DM, DFF, WSP(bf16_t, WS_WGU), nullptr, 2, scr, r, F.lane); continue; } r -= I_G;
            if (r < I_G) { transpose_item64(F.w_up, DM, DFF, WSP(bf16_t, WS_WGU), nullptr, 3, scr, r, F.lane); continue; } r -= I_G;
            transpose_item64(F.w_down, DFF, DM, WSP(bf16_t, WS_WD), nullptr, 0, scr, r, F.lane); }
    }
    __syncthreads();
}
__device__ __forceinline__ void p_prologue(Frame& F) {
    mod_gemv(F, 0, F.vcu, F.G);
    for (int set_ = 0; set_ < 2; ++set_) convert_set(F, set_, F.vcu, F.G);
    if (F.vcu == 0) { for (int i = F.tid; i < 64 * 8; i += NTHR) { const int pos = i >> 3, f = i & 7; const float inv = powf(10000.f, -(float)f / 8.f); const float ang = (float)pos * inv;
            WSP(f32x2, WS_MISC + MISC_ROPE)[i] = (f32x2){cosf(ang), sinf(ang)}; } }
    for (int i = F.vcu * NTHR + F.tid; i < 2 * 4 * 128 * 128 / 2; i += F.G * NTHR) { const f32x2 v = ((const f32x2*)F.w_sgu)[i]; WSP(unsigned, WS_WSGU)[i] = cvtpk(v.x, v.y); }
}
__device__ __forceinline__ bool tail_worker(int nwg, int G, int c, int& wi, int& nw) {
    const int rounds = (nwg + G - 1) / G, first = nwg - (rounds - 1) * G;
    if (first >= G) { wi = c; nw = G; return true; }
    if (c < first) return false;
    wi = c - first; nw = G - first; return true;
}
__device__ __forceinline__ void p_moe_weights(Frame& F) {
    __syncthreads();
    LAS float* scr = (LAS float*)(F.lds + F.wave * 16640);
    const int gw = F.vcu * NWAVES + F.wave, NGW = F.G * NWAVES;
    constexpr int I_G = 16 * 22, I_D = 22 * 16, PER_E = 2 * I_G + I_D;
    for (int it = gw; it < 8 * PER_E; it += NGW) {
        const int e = it / PER_E; int r = it - e * PER_E;
        bf16_t* gu = WSP(bf16_t, WS_MOEW_GU) + (size_t)e * 2 * DFE * DM;
        if (r < I_G) { transpose_item64(F.w_gate_e + (size_t)e * DM * DFE, DM, DFE, gu, nullptr, 2, scr, r, F.lane); continue; } r -= I_G;
        if (r < I_G) { transpose_item64(F.w_up_e + (size_t)e * DM * DFE, DM, DFE, gu, nullptr, 3, scr, r, F.lane); continue; } r -= I_G;
        transpose_item64(F.w_down_e + (size_t)e * DFE * DM, DFE, DM, WSP(bf16_t, WS_MOEW_D) + (size_t)e * DM * DFE, nullptr, 0, scr, r, F.lane);
    }
    __syncthreads();
}

template <bool ROUTE>
__device__ __forceinline__ void p_norm(Frame& F, int l, int which, int nrows, const float* srcL, const float* srcC, const float* slab = nullptr, const float* slabgate = nullptr) {
    const float* mod = WSP(float, WS_MOD) + (size_t)l * 9 * 6144;
    const float* g = (which == 0 ? F.g_mix : F.g_ffn) + l * DM;
    bf16_t* H = WSP(bf16_t, WS_H);
    LAS int* lcnt = (LAS int*)(F.lds + 32768);
    LAS int* rec = (LAS int*)(F.lds + 32768 + 64);
    int nrec = 0;
    if (ROUTE) { LAS float* wr = (LAS float*)F.lds; for (int i = F.tid; i < DM * 8; i += NTHR) wr[i] = F.w_router[i]; if (F.tid < 16) lcnt[F.tid] = 0; __syncthreads(); }
    const int gw = F.vcu * NWAVES + F.wave, NGW = F.G * NWAVES;
    for (int row = gw; row < nrows; row += NGW) {
        const bool isc = row >= NLAT; const int b = isc ? 8 : (row >> 11);
        const float* xr = isc ? srcC + (size_t)(row - NLAT) * DM : srcL + (size_t)row * DM;
        f32x4 v[4]; float s = 0.f;
#pragma unroll
        for (int j = 0; j < 4; ++j) v[j] = *(const f32x4*)(xr + 256 * j + 4 * F.lane);
        if (slab && isc) {
#pragma unroll
            for (int j = 0; j < 4; ++j) { const size_t o_ = (size_t)(row - NLAT) * DM + 256 * j + 4 * F.lane; const f32x4 gt = *(const f32x4*)(slabgate + 256 * j + 4 * F.lane);
                const f32x4 p0 = *(const f32x4*)(slab + o_), p1 = *(const f32x4*)(slab + (size_t)NCTX * DM + o_), p2 = *(const f32x4*)(slab + (size_t)2 * NCTX * DM + o_), p3 = *(const f32x4*)(slab + (size_t)3 * NCTX * DM + o_);
                v[j] = v[j] + gt * ((p0 + p1) + (p2 + p3)); } }
#pragma unroll
        for (int j = 0; j < 4; ++j) s += (v[j].x * v[j].x + v[j].y * v[j].y) + (v[j].z * v[j].z + v[j].w * v[j].w);
        const float rstd = rsqrtf(wave_sum(s) * (1.f / DM) + EPS);
        const float* sh = mod + (size_t)b * 6144 + (which * 3) * DM; const float* sc = sh + DM;
        float lg[8];
        if (ROUTE) {
#pragma unroll
            for (int e = 0; e < 8; ++e) lg[e] = 0.f; }
#pragma unroll
        for (int j = 0; j < 4; ++j) { const int k = 256 * j + 4 * F.lane;
            const f32x4 gg = *(const f32x4*)(g + k), s1 = *(const f32x4*)(sc + k), s0 = *(const f32x4*)(sh + k);
            f32x4 h = (v[j] * rstd) * gg * (s1 + 1.f) + s0;
            u32x2 w; w.x = cvtpk(h.x, h.y); w.y = cvtpk(h.z, h.w);
            *(u32x2*)(H + (size_t)row * DM + k) = w;
            if (ROUTE) { const LAS float* wr = (const LAS float*)F.lds + k * 8;
#pragma unroll
                for (int i = 0; i < 4; ++i) { const f32x4 w0 = *(const LAS f32x4*)(wr + 8 * i), w1 = *(const LAS f32x4*)(wr + 8 * i + 4); const float hv = h[i];
                    lg[0] += hv * w0.x; lg[1] += hv * w0.y; lg[2] += hv * w0.z; lg[3] += hv * w0.w; lg[4] += hv * w1.x; lg[5] += hv * w1.y; lg[6] += hv * w1.z; lg[7] += hv * w1.w; }
                asm volatile("" ::: "memory"); }
        }
        if (ROUTE) {
#pragma unroll
            for (int e = 0; e < 8; ++e) lg[e] = wave_sum(lg[e]);
            int i0 = 0; float m0 = lg[0];
#pragma unroll
            for (int e = 1; e < 8; ++e) if (lg[e] > m0) { m0 = lg[e]; i0 = e; }
            int i1 = -1; float m1 = -3.0e38f;
#pragma unroll
            for (int e = 0; e < 8; ++e) if (e != i0 && lg[e] > m1) { m1 = lg[e]; i1 = e; }
            const float w1 = 1.f / (1.f + __expf(m0 - m1)), w0 = 1.f - w1;
            if (F.lane == 0) { float* tw = WSP(float, WS_MISC + MISC_TOPW);
                const int p0 = __hip_atomic_fetch_add(lcnt + i0, 1, __ATOMIC_RELAXED, __HIP_MEMORY_SCOPE_WORKGROUP), p1 = __hip_atomic_fetch_add(lcnt + i1, 1, __ATOMIC_RELAXED, __HIP_MEMORY_SCOPE_WORKGROUP);
                LAS int* r = rec + (F.wave * 16 + nrec) * 4; r[0] = row; r[1] = i0 | (i1 << 8); r[2] = p0; r[3] = p1; tw[row * 2] = w0; tw[row * 2 + 1] = w1; }
            ++nrec;
        }
    }
    if (ROUTE) {
        __syncthreads();
        if (F.tid < 8) lcnt[8 + F.tid] = (int)atomicAdd(WSP(unsigned, WS_CTL) + CW_CNT + 64 * F.tid, (unsigned)lcnt[F.tid]);
        __syncthreads();
        int* list = WSP(int, WS_LIST);
        if (F.lane < nrec) { const LAS int* r = rec + (F.wave * 16 + F.lane) * 4; const int row = r[0], i0 = r[1] & 255, i1 = r[1] >> 8;
            list[i0 * NLAT + lcnt[8 + i0] + r[2]] = row * 2; list[i1 * NLAT + lcnt[8 + i1] + r[3]] = row * 2 + 1; }
        __syncthreads();
    }
}
__device__ __forceinline__ void p_final(Frame& F) {
    const float* mod = WSP(float, WS_MOD) + (size_t)1 * 9 * 6144; const bf16_t* Y = WSP(bf16_t, WS_Y);
    const int gw = F.vcu * NWAVES + F.wave, NGW = F.G * NWAVES;
    for (int row = gw; row < NLAT; row += NGW) {
        const int b = row >> 11; float* xr = F.out + (size_t)row * DM; const float* gt = mod + (size_t)b * 6144 + 5 * DM;
        f32x4 v[4]; float s = 0.f;
#pragma unroll
        for (int j = 0; j < 4; ++j) { const int k = 256 * j + 4 * F.lane; const f32x4 xv = *(const f32x4*)(xr + k), gv = *(const f32x4*)(gt + k);
            const u32x2 a = *(const u32x2*)(Y + (size_t)(2 * row) * DM + k), c = *(const u32x2*)(Y + (size_t)(2 * row + 1) * DM + k);
            f32x4 y; y.x = bflo(a.x) + bflo(c.x); y.y = bfhi(a.x) + bfhi(c.x); y.z = bflo(a.y) + bflo(c.y); y.w = bfhi(a.y) + bfhi(c.y);
            v[j] = xv + gv * y; s += (v[j].x * v[j].x + v[j].y * v[j].y) + (v[j].z * v[j].z + v[j].w * v[j].w); }
        const float rstd = rsqrtf(wave_sum(s) * (1.f / DM) + EPS);
#pragma unroll
        for (int j = 0; j < 4; ++j) { const int k = 256 * j + 4 * F.lane; *(f32x4*)(xr + k) = (v[j] * rstd) * *(const f32x4*)(F.g_final + k); }
    }
}
constexpr int LP = 272;
__device__ __forceinline__ void chunk_rows(int u, int& row0, bool& isc) {
    if (u < 128) { row0 = (u >> 4) * SEQ + (u & 15) * 128; isc = false; } else { const int uu = u - 128; row0 = NLAT + (uu >> 1) * CTXL + (uu & 1) * 128; isc = true; }
}
__device__ __forceinline__ void krope_unit(Frame& F, int u) {
    int row0; bool isc; chunk_rows(u, row0, isc);
    const bf16_t* P = WSP(bf16_t, WS_P);
    if (F.tid < 128) {
        const int row = row0 + F.tid; const u32x4* src = (const u32x4*)(P + (size_t)row * INP + PC_KR);
        u32x4 q[4];
#pragma unroll
        for (int i = 0; i < 4; ++i) q[i] = src[i];
        if (!isc) {
            const int tok = row & (SEQ - 1); const f32x2* rt = WSP(f32x2, WS_MISC + MISC_ROPE);
            float v[32];
#pragma unroll
            for (int i = 0; i < 4; ++i) { v[8 * i] = bflo(q[i].x); v[8 * i + 1] = bfhi(q[i].x); v[8 * i + 2] = bflo(q[i].y); v[8 * i + 3] = bfhi(q[i].y); v[8 * i + 4] = bflo(q[i].z); v[8 * i + 5] = bfhi(q[i].z); v[8 * i + 6] = bflo(q[i].w); v[8 * i + 7] = bfhi(q[i].w); }
#pragma unroll
            for (int ax = 0; ax < 2; ++ax) { const int pos = ax == 0 ? (tok >> 6) : (tok & 63);
#pragma unroll
                for (int f = 0; f < 8; ++f) { const f32x2 cs = rt[pos * 8 + f]; const float t1 = v[16 * ax + f], t2 = v[16 * ax + 8 + f];
                    v[16 * ax + f] = t1 * cs.x - t2 * cs.y; v[16 * ax + 8 + f] = t1 * cs.y + t2 * cs.x; } }
#pragma unroll
            for (int i = 0; i < 4; ++i) { q[i].x = cvtpk(v[8 * i], v[8 * i + 1]); q[i].y = cvtpk(v[8 * i + 2], v[8 * i + 3]); q[i].z = cvtpk(v[8 * i + 4], v[8 * i + 5]); q[i].w = cvtpk(v[8 * i + 6], v[8 * i + 7]); }
        }
        u32x4* dst = (u32x4*)(WSP(bf16_t, WS_KR) + (size_t)row * 32);
#pragma unroll
        for (int i = 0; i < 4; ++i) dst[i] = q[i];
    }
}
__device__ __forceinline__ void sgu_unit(Frame& F, int l, int u) {
    int row0; bool isc; chunk_rows(u, row0, isc);
    const bf16_t* P = WSP(bf16_t, WS_P); bf16_t* CAT = WSP(bf16_t, WS_CAT);
    LAS unsigned char* VT = F.lds;
    LAS unsigned char* WB = F.lds + 256 * LP;
    const int w = F.wave, lane = F.lane;
    {
        const f32x4 gs = *(const f32x4*)(F.g_sgu + l * 256 + 4 * lane), bs = *(const f32x4*)(F.beta_sgu + l * 256 + 4 * lane);
#pragma unroll
        for (int grp = 0; grp < 2; ++grp) {
            const int s0 = 16 * w + 8 * grp;
            float v[8][4];
#pragma unroll
            for (int tt = 0; tt < 8; ++tt) { const u32x2 r = *(const u32x2*)(P + (size_t)(row0 + s0 + tt) * INP + PC_V + 4 * lane);
                v[tt][0] = gelu_tanh(bflo(r.x)); v[tt][1] = gelu_tanh(bfhi(r.x)); v[tt][2] = gelu_tanh(bflo(r.y)); v[tt][3] = gelu_tanh(bfhi(r.y)); }
#pragma unroll
            for (int tt = 0; tt < 8; ++tt) {
                const float mu = wave_sum((v[tt][0] + v[tt][1]) + (v[tt][2] + v[tt][3])) * (1.f / 256.f);
                float d0 = v[tt][0] - mu, d1 = v[tt][1] - mu, d2 = v[tt][2] - mu, d3 = v[tt][3] - mu;
                const float rstd = rsqrtf(wave_sum((d0 * d0 + d1 * d1) + (d2 * d2 + d3 * d3)) * (1.f / 256.f) + EPS);
                v[tt][0] = d0 * rstd * gs.x + bs.x; v[tt][1] = d1 * rstd * gs.y + bs.y; v[tt][2] = d2 * rstd * gs.z + bs.z; v[tt][3] = d3 * rstd * gs.w + bs.w; }
#pragma unroll
            for (int i = 0; i < 4; ++i) { u32x4 o; o.x = cvtpk(v[0][i], v[1][i]); o.y = cvtpk(v[2][i], v[3][i]); o.z = cvtpk(v[4][i], v[5][i]); o.w = cvtpk(v[6][i], v[7][i]);
                *(LAS u32x4*)(VT + (4 * lane + i) * LP + s0 * 2) = o; }
        }
    }
    const bf16_t* Wg = WSP(bf16_t, WS_WSGU) + (size_t)l * 4 * 128 * 128;
#define SGU_STAGE_W(h, buf) do { _Pragma("unroll") for (int _i = 0; _i < 4; ++_i) { const int q_ = F.tid + NTHR * _i, r_ = q_ >> 4, c_ = q_ & 15; \
        *(LAS u32x4*)(WB + (buf) * 128 * LP + r_ * LP + c_ * 16) = *(const u32x4*)(Wg + (size_t)(h) * 16384 + r_ * 128 + c_ * 8); } } while (0)
    SGU_STAGE_W(0, 0);
    u32x2 upre[4][4];
    { const int t_ = 16 * w + (lane & 15), row_ = row0 + t_;
#pragma unroll
        for (int h = 0; h < 4; ++h)
#pragma unroll
            for (int dt = 0; dt < 4; ++dt) upre[h][dt] = *(const u32x2*)(P + (size_t)row_ * INP + PC_U + h * 64 + dt * 16 + 4 * (lane >> 4)); }
    __syncthreads();
    f32x4 acc[4][4];
#pragma unroll
    for (int h = 0; h < 4; ++h)
#pragma unroll
        for (int dt = 0; dt < 4; ++dt) acc[h][dt] = (f32x4){0.f, 0.f, 0.f, 0.f};
    const int fr = lane & 15, fq = lane >> 4;
#pragma unroll
    for (int h = 0; h < 4; ++h) {
        if (h + 1 < 4) SGU_STAGE_W(h + 1, (h + 1) & 1);
        const LAS unsigned char* Wh = WB + (h & 1) * 128 * LP;
#pragma unroll
        for (int ks = 0; ks < 4; ++ks) {
            const bf16x8 bw = *(const LAS bf16x8*)(Wh + (16 * w + fr) * LP + (32 * ks + 8 * fq) * 2);
#pragma unroll
            for (int dt = 0; dt < 4; ++dt) { const bf16x8 av = *(const LAS bf16x8*)(VT + (h * 64 + dt * 16 + fr) * LP + (32 * ks + 8 * fq) * 2);
                acc[h][dt] = MFMA16(av, bw, acc[h][dt]); }
        }
        __syncthreads();
    }
#undef SGU_STAGE_W
    { const int t = 16 * w + fr, row = row0 + t;
#pragma unroll
        for (int h = 0; h < 4; ++h) { const float bsv = F.b_sgu[(l * 4 + h) * 128 + t];
#pragma unroll
            for (int dt = 0; dt < 4; ++dt) { const int c = h * 64 + dt * 16 + 4 * fq; const u32x2 r = upre[h][dt];
                const float o0 = gelu_tanh(bflo(r.x)) * (acc[h][dt][0] + bsv), o1 = gelu_tanh(bfhi(r.x)) * (acc[h][dt][1] + bsv), o2 = gelu_tanh(bflo(r.y)) * (acc[h][dt][2] + bsv), o3 = gelu_tanh(bfhi(r.y)) * (acc[h][dt][3] + bsv);
                u32x2 o; o.x = cvtpk(o0, o1); o.y = cvtpk(o2, o3); *(u32x2*)(CAT + (size_t)row * DM + c) = o; } } }
    __syncthreads();
}

__device__ __forceinline__ void ssd_local_unit(Frame& F, int l, int u) {
    int b, c, g, row0, seq0, seqlen; bool isc;
    if (u < 256) { b = u >> 5; c = (u >> 1) & 15; g = u & 1; row0 = b * SEQ + c * 128; seq0 = b * SEQ; seqlen = SEQ; isc = false; }
    else { const int uu = u - 256; b = uu >> 2; c = (uu >> 1) & 1; g = uu & 1; row0 = NLAT + b * CTXL + c * 128; seq0 = NLAT + b * CTXL; seqlen = CTXL; isc = true; }
    const bf16_t* P = WSP(bf16_t, WS_P);
    LAS unsigned char* R1 = F.lds;
    LAS unsigned char* R2 = F.lds + 128 * LP;
    LAS unsigned char* XT = F.lds + 256 * LP;
    LAS float* dtv = (LAS float*)(F.lds + 448 * LP);
    LAS float* acsv = dtv + 768;
    LAS float* wv = acsv + 768;
    const int w = F.wave, lane = F.lane, tid = F.tid, fr = lane & 15, fq = lane >> 4;
    const float* cw = F.conv_w + (size_t)l * 5 * 896; const float* cb = F.conv_b + l * 896;
    LAS float* wlb = (LAS float*)(F.lds + 448 * LP + 9216);
    if (tid < 56) { const int chx0 = tid < 24 ? g * 192 + 8 * tid : (tid < 40 ? 384 + g * 128 + 8 * (tid - 24) : 640 + g * 128 + 8 * (tid - 40));
#pragma unroll
        for (int k = 0; k < 5; ++k) { *(LAS f32x4*)(wlb + tid * 48 + 8 * k) = *(const f32x4*)(cw + k * 896 + chx0); *(LAS f32x4*)(wlb + tid * 48 + 8 * k + 4) = *(const f32x4*)(cw + k * 896 + chx0 + 4); }
        *(LAS f32x4*)(wlb + tid * 48 + 40) = *(const f32x4*)(cb + chx0); *(LAS f32x4*)(wlb + tid * 48 + 44) = *(const f32x4*)(cb + chx0 + 4); }
    __syncthreads();
    if (tid < 448) {
        const int cg = tid % 56, seg = tid / 56;
        int pcol, role, lch;
        if (cg < 24) { role = 0; lch = 8 * cg; pcol = PC_X + g * 192 + lch; }
        else if (cg < 40) { role = 1; lch = 8 * (cg - 24); pcol = PC_B + g * 128 + lch; }
        else { role = 2; lch = 8 * (cg - 40); pcol = PC_C + g * 128 + lch; }
        const LAS float* wl = wlb + cg * 48;
#pragma unroll 1
        for (int hb = 0; hb < 2; ++hb) {
            const int t0 = 16 * seg + 8 * hb;
            u32x4 rows[12];
#pragma unroll
            for (int i = 0; i < 12; ++i) { const int grow = row0 + t0 - 2 + i;
                if (i >= 2 && i < 10) rows[i] = *(const u32x4*)(P + (size_t)grow * INP + pcol);
                else { const bool ok = grow >= seq0 && grow < seq0 + seqlen; const int gcl = i < 2 ? (grow < seq0 ? seq0 : grow) : (grow >= seq0 + seqlen ? seq0 + seqlen - 1 : grow);
                    const u32x4 v_ = *(const u32x4*)(P + (size_t)gcl * INP + pcol); rows[i] = ok ? v_ : (u32x4){0u, 0u, 0u, 0u}; } }
            unsigned pk[8][4];
#pragma unroll
            for (int o2 = 0; o2 < 4; ++o2) {
                float y[2][8];
#pragma unroll
                for (int e = 0; e < 2; ++e) { const int o = 2 * o2 + e; f32x4 ya = *(const LAS f32x4*)(wl + 40), yb = *(const LAS f32x4*)(wl + 44);
#pragma unroll
                    for (int k = 0; k < 5; ++k) { const u32x4 r = rows[o + k]; const f32x4 xa = {bflo(r.x), bfhi(r.x), bflo(r.y), bfhi(r.y)}, xb = {bflo(r.z), bfhi(r.z), bflo(r.w), bfhi(r.w)};
                        ya += *(const LAS f32x4*)(wl + 8 * k) * xa; yb += *(const LAS f32x4*)(wl + 8 * k + 4) * xb; }
#pragma unroll
                    for (int c8 = 0; c8 < 4; ++c8) { y[e][c8] = silu_f(ya[c8]); y[e][4 + c8] = silu_f(yb[c8]); }
                    if (role != 0) { u32x4 st; st.x = cvtpk(y[e][0], y[e][1]); st.y = cvtpk(y[e][2], y[e][3]); st.z = cvtpk(y[e][4], y[e][5]); st.w = cvtpk(y[e][6], y[e][7]);
                        *(u32x4*)((role == 1 ? R2 : R1) + (t0 + o) * LP + lch * 2) = st;
                        if (role == 2) *(u32x4*)(WSP(bf16_t, WS_CC) + (size_t)(row0 + t0 + o) * 256 + g * 128 + lch) = st; }
                }
#pragma unroll
                for (int c8 = 0; c8 < 8; ++c8) pk[c8][o2] = cvtpk(y[0][c8], y[1][c8]);
            }
            if (role == 0) {
#pragma unroll
                for (int c8 = 0; c8 < 8; ++c8) *(LAS u32x4*)(XT + (lch + c8) * LP + t0 * 2) = (u32x4){pk[c8][0], pk[c8][1], pk[c8][2], pk[c8][3]}; }
        }
    }
    else {
        bf16_t draw[6][2];
#pragma unroll
        for (int q = 0; q < 6; ++q) { const int d = q / 3, h = g * 3 + q % 3; const int e0 = 2 * lane, t0 = d == 0 ? e0 : 127 - e0, t1 = d == 0 ? e0 + 1 : 126 - e0;
            draw[q][0] = P[(size_t)(row0 + t0) * INP + PC_DT + d * 6 + h]; draw[q][1] = P[(size_t)(row0 + t1) * INP + PC_DT + d * 6 + h]; }
        asm volatile("" ::: "memory");
#pragma unroll
        for (int q = 0; q < 6; ++q) { const int d = q / 3, j = q % 3, h = g * 3 + j;
            const float a = -__expf(F.a_log[l * 12 + d * 6 + h]), bias = F.dt_bias[l * 12 + d * 6 + h];
            const int e0 = 2 * lane, e1 = 2 * lane + 1, t0 = d == 0 ? e0 : 127 - e0, t1 = d == 0 ? e1 : 127 - e1;
            const float dt0 = softplus_f(bf1(draw[q][0]) + bias), dt1 = softplus_f(bf1(draw[q][1]) + bias);
            const float x0 = dt0 * a, x1 = dt1 * a; float s = x0 + x1;
#pragma unroll
            for (int off = 1; off < 64; off <<= 1) { const float t = __shfl_up(s, off); if (lane >= off) s += t; }
            const float a1v = s, a0v = s - x1, tot = __shfl(s, 63);
            dtv[q * 128 + t0] = dt0; dtv[q * 128 + t1] = dt1; acsv[q * 128 + t0] = a0v; acsv[q * 128 + t1] = a1v;
            wv[q * 128 + t0] = __expf(tot - a0v) * dt0; wv[q * 128 + t1] = __expf(tot - a1v) * dt1;
            float* ACS = WSP(float, WS_ACS); ACS[(size_t)(row0 + t0) * 12 + d * 6 + h] = a0v; ACS[(size_t)(row0 + t1) * 12 + d * 6 + h] = a1v;
            if (lane == 0) { const int pos = isc ? (d == 0 ? c : 1 - c) : (d == 0 ? 2 + c : 17 - c); WSP(float, WS_MISC + MISC_DEC)[((b * 2 + d) * NPOS + pos) * 6 + h] = __expf(tot); }
        }
    }
    __syncthreads();
    f32x4 G[8];
#pragma unroll
    for (int t = 0; t < 8; ++t) G[t] = (f32x4){0.f, 0.f, 0.f, 0.f};
#pragma unroll
    for (int ks = 0; ks < 4; ++ks) { const bf16x8 cf = *(const LAS bf16x8*)(R1 + (16 * w + fr) * LP + (32 * ks + 8 * fq) * 2);
#pragma unroll
        for (int t = 0; t < 8; ++t) { const bf16x8 bfm = *(const LAS bf16x8*)(R2 + (16 * t + fr) * LP + (32 * ks + 8 * fq) * 2); G[t] = MFMA16(bfm, cf, G[t]); } }
    __syncthreads();
    if (tid < 256) { const int sb = tid >> 4, nb = tid & 15; u32x4 r[8];
#pragma unroll
        for (int i = 0; i < 8; ++i) r[i] = *(const LAS u32x4*)(R2 + (8 * sb + i) * LP + nb * 16);
#pragma unroll
        for (int j = 0; j < 8; ++j) { u32x4 o;
            if ((j & 1) == 0) { o.x = (r[0][j >> 1] & 0xffffu) | (r[1][j >> 1] << 16); o.y = (r[2][j >> 1] & 0xffffu) | (r[3][j >> 1] << 16); o.z = (r[4][j >> 1] & 0xffffu) | (r[5][j >> 1] << 16); o.w = (r[6][j >> 1] & 0xffffu) | (r[7][j >> 1] << 16); }
            else { o.x = (r[0][j >> 1] >> 16) | (r[1][j >> 1] & 0xffff0000u); o.y = (r[2][j >> 1] >> 16) | (r[3][j >> 1] & 0xffff0000u); o.z = (r[4][j >> 1] >> 16) | (r[5][j >> 1] & 0xffff0000u); o.w = (r[6][j >> 1] >> 16) | (r[7][j >> 1] & 0xffff0000u); }
            *(LAS u32x4*)(R1 + (8 * nb + j) * LP + sb * 16) = o; } }
    __syncthreads();
    LAS unsigned char* Mw = R2 + w * 16 * LP;
    bf16_t* ST = WSP(bf16_t, WS_ST); float* YP = WSP(float, WS_YP);
    const bool needy = !(isc && l == DEPTH - 1);
    const int lrow = 16 * w + fr;
#pragma unroll 1
    for (int j = 0; j < 3; ++j) {
        const int h = g * 3 + j;
        f32x4 ay[4];
#pragma unroll
        for (int pt = 0; pt < 4; ++pt) ay[pt] = (f32x4){0.f, 0.f, 0.f, 0.f};
#pragma unroll 1
        for (int d = 0; d < 2; ++d) {
            const int q = d * 3 + j; const float al = acsv[q * 128 + lrow];
            if (needy) {
#pragma unroll
            for (int t = 0; t < 8; ++t) { const int s4 = 16 * t + 4 * fq; u32x2 o = {0u, 0u};
                if (d == 0 ? (t <= w) : (t >= w)) {
                    const f32x4 as = *(const LAS f32x4*)(acsv + q * 128 + s4), ds = *(const LAS f32x4*)(dtv + q * 128 + s4);
                    float mv[4];
#pragma unroll
                    for (int r = 0; r < 4; ++r) { const int s = s4 + r; const bool ok = (t != w) || (d == 0 ? (s <= lrow) : (s >= lrow)); mv[r] = ok ? G[t][r] * __expf(al - as[r]) * ds[r] : 0.f; }
                    o.x = cvtpk(mv[0], mv[1]); o.y = cvtpk(mv[2], mv[3]); }
                *(LAS u32x2*)(Mw + fr * LP + s4 * 2) = o; }
            LDS_WAIT();
#pragma unroll
            for (int ks = 0; ks < 4; ++ks) if (d == 0 ? (2 * ks <= w) : (2 * ks + 1 >= w)) { const bf16x8 mf = *(const LAS bf16x8*)(Mw + fr * LP + (32 * ks + 8 * fq) * 2);
#pragma unroll
                for (int pt = 0; pt < 4; ++pt) { const bf16x8 xf = *(const LAS bf16x8*)(XT + (j * 64 + 16 * pt + fr) * LP + (32 * ks + 8 * fq) * 2); ay[pt] = MFMA16(xf, mf, ay[pt]); } }
            }
            f32x4 as4[4];
#pragma unroll
            for (int pt = 0; pt < 4; ++pt) as4[pt] = (f32x4){0.f, 0.f, 0.f, 0.f};
#pragma unroll
            for (int ks = 0; ks < 4; ++ks) { const u32x4 raw = *(const LAS u32x4*)(R1 + (16 * w + fr) * LP + (32 * ks + 8 * fq) * 2);
                const f32x4 wa = *(const LAS f32x4*)(wv + q * 128 + 32 * ks + 8 * fq), wb = *(const LAS f32x4*)(wv + q * 128 + 32 * ks + 8 * fq + 4);
                u32x4 sc; sc.x = cvtpk(bflo(raw.x) * wa.x, bfhi(raw.x) * wa.y); sc.y = cvtpk(bflo(raw.y) * wa.z, bfhi(raw.y) * wa.w); sc.z = cvtpk(bflo(raw.z) * wb.x, bfhi(raw.z) * wb.y); sc.w = cvtpk(bflo(raw.w) * wb.z, bfhi(raw.w) * wb.w);
                const bf16x8 bsf = __builtin_bit_cast(bf16x8, sc);
#pragma unroll
                for (int pt = 0; pt < 4; ++pt) { const bf16x8 xf = *(const LAS bf16x8*)(XT + (j * 64 + 16 * pt + fr) * LP + (32 * ks + 8 * fq) * 2); as4[pt] = MFMA16(bsf, xf, as4[pt]); } }
            { const int pos = isc ? (d == 0 ? c : 1 - c) : (d == 0 ? 2 + c : 17 - c); bf16_t* sp = ST + ((size_t)((b * 2 + d) * NPOS + pos) * 6 + h) * 8192;
#pragma unroll
                for (int pt = 0; pt < 4; ++pt) { u32x2 o; o.x = cvtpk(as4[pt][0], as4[pt][1]); o.y = cvtpk(as4[pt][2], as4[pt][3]); *(u32x2*)(sp + (16 * pt + fr) * 128 + 16 * w + 4 * fq) = o; } }
        }
        if (needy) { const float skip = F.d_skip[l * 6 + h];
#pragma unroll
            for (int pt = 0; pt < 4; ++pt) { f32x4 o;
#pragma unroll
                for (int r = 0; r < 4; ++r) o[r] = ay[pt][r] + skip * bf1(*(const LAS bf16_t*)(XT + (j * 64 + 16 * pt + 4 * fq + r) * LP + lrow * 2));
                *(f32x4*)(YP + (size_t)(row0 + lrow) * 384 + h * 64 + 16 * pt + 4 * fq) = o; } }
    }
    __syncthreads();
}

__device__ __forceinline__ void ssd_scan(Frame& F) {
    bf16_t* ST = WSP(bf16_t, WS_ST); const float* DEC = WSP(float, WS_MISC + MISC_DEC);
    for (int gt = F.vcu * NTHR + F.tid; gt < 96 * 1024; gt += F.G * NTHR) {
        const int combo = gt >> 10, e8 = gt & 1023, bd = combo / 6, h = combo - bd * 6;
        u32x4 st[17]; float dec[17];
#pragma unroll
        for (int q = 0; q < 17; ++q) { const size_t sidx = (size_t)(bd * NPOS + q) * 6 + h; st[q] = *(const u32x4*)(ST + sidx * 8192 + e8 * 8); dec[q] = DEC[sidx]; }
        float hv[8];
#pragma unroll
        for (int i = 0; i < 8; ++i) hv[i] = 0.f;
#pragma unroll
        for (int q = 0; q < 17; ++q) { const size_t sidx = (size_t)(bd * NPOS + q) * 6 + h; const float dq = dec[q];
            hv[0] = dq * hv[0] + bflo(st[q].x); hv[1] = dq * hv[1] + bfhi(st[q].x); hv[2] = dq * hv[2] + bflo(st[q].y); hv[3] = dq * hv[3] + bfhi(st[q].y);
            hv[4] = dq * hv[4] + bflo(st[q].z); hv[5] = dq * hv[5] + bfhi(st[q].z); hv[6] = dq * hv[6] + bflo(st[q].w); hv[7] = dq * hv[7] + bfhi(st[q].w);
            u32x4 o; o.x = cvtpk(hv[0], hv[1]); o.y = cvtpk(hv[2], hv[3]); o.z = cvtpk(hv[4], hv[5]); o.w = cvtpk(hv[6], hv[7]);
            *(u32x4*)(ST + sidx * 8192 + e8 * 8) = o; }
    }
}

__device__ __forceinline__ void ssd_final_unit(Frame& F, int l, int u) {
    int row0; bool isc; chunk_rows(u, row0, isc);
    const int b = isc ? ((u - 128) >> 1) : (u >> 4), c = isc ? ((u - 128) & 1) : (u & 15);
    constexpr int CPITCH = 528;
    LAS unsigned char* Cs = F.lds;
    LAS unsigned char* Hs = F.lds + 128 * CPITCH;
    const int w = F.wave, lane = F.lane, tid = F.tid, fr = lane & 15, fq = lane >> 4;
    const bf16_t* CC = WSP(bf16_t, WS_CC); const bf16_t* ST = WSP(bf16_t, WS_ST); const float* ACS = WSP(float, WS_ACS);
#pragma unroll
    for (int i = 0; i < 8; ++i) { const int q = tid + NTHR * i, r = q >> 5, cc = q & 31; *(LAS u32x4*)(Cs + r * CPITCH + cc * 16) = *(const u32x4*)(CC + (size_t)(row0 + r) * 256 + cc * 8); }
    const int lrow = 16 * w + fr, row = row0 + lrow;
    const int hp = tid >> 3, hn0 = (tid & 7) * 16;
    const float* YP = WSP(float, WS_YP); const bf16_t* P = WSP(bf16_t, WS_P); bf16_t* CAT = WSP(bf16_t, WS_CAT);
    float ss = 0.f;
    const f32x4 ac0 = *(const f32x4*)(ACS + (size_t)row * 12), ac1 = *(const f32x4*)(ACS + (size_t)row * 12 + 4), ac2 = *(const f32x4*)(ACS + (size_t)row * 12 + 8);
    const float acv[12] = {ac0[0], ac0[1], ac0[2], ac0[3], ac1[0], ac1[1], ac1[2], ac1[3], ac2[0], ac2[1], ac2[2], ac2[3]};
    u32x4 hpre[2][2][2]; f32x4 ypre[2][4]; u32x2 zpre[2][4];
#define SSDF_LOAD(hh, S_) do { \
        _Pragma("unroll") for (int d = 0; d < 2; ++d) { const int pos = isc ? (d == 0 ? c : 1 - c) : (d == 0 ? 2 + c : 17 - c); hpre[S_][d][0] = (u32x4){0u, 0u, 0u, 0u}; hpre[S_][d][1] = hpre[S_][d][0]; \
            if (pos > 0) { const size_t sidx = (size_t)((b * 2 + d) * NPOS + pos - 1) * 6 + (hh); hpre[S_][d][0] = *(const u32x4*)(ST + sidx * 8192 + hp * 128 + hn0); hpre[S_][d][1] = *(const u32x4*)(ST + sidx * 8192 + hp * 128 + hn0 + 8); } } \
        _Pragma("unroll") for (int pt = 0; pt < 4; ++pt) { const int cidx = (hh) * 64 + 16 * pt + 4 * fq; ypre[S_][pt] = *(const f32x4*)(YP + (size_t)row * 384 + cidx); zpre[S_][pt] = *(const u32x2*)(P + (size_t)row * INP + PC_Z + cidx); } } while (0)
    SSDF_LOAD(0, 1);
#pragma unroll 1
    for (int h = 0; h < 6; ++h) {
        const int g = h / 3; constexpr int S = 0;
#pragma unroll
        for (int d = 0; d < 2; ++d) { hpre[0][d][0] = hpre[1][d][0]; hpre[0][d][1] = hpre[1][d][1]; }
#pragma unroll
        for (int pt = 0; pt < 4; ++pt) { ypre[0][pt] = ypre[1][pt]; zpre[0][pt] = zpre[1][pt]; }
        if (h + 1 < 6) SSDF_LOAD(h + 1, 1);
        LAS unsigned char* Hset = Hs + (h & 1) * 2 * 64 * LP;
#pragma unroll
        for (int d = 0; d < 2; ++d) { LAS unsigned char* Hb = Hset + d * 64 * LP;
            *(LAS u32x4*)(Hb + hp * LP + hn0 * 2) = hpre[S][d][0]; *(LAS u32x4*)(Hb + hp * LP + hn0 * 2 + 16) = hpre[S][d][1]; }
        LDS_BARRIER();
        f32x4 yh[4];
#pragma unroll
        for (int pt = 0; pt < 4; ++pt) yh[pt] = (f32x4){0.f, 0.f, 0.f, 0.f};
#pragma unroll
        for (int d = 0; d < 2; ++d) {
            const LAS unsigned char* Hb = Hset + d * 64 * LP;
            f32x4 tm[4];
#pragma unroll
            for (int pt = 0; pt < 4; ++pt) tm[pt] = (f32x4){0.f, 0.f, 0.f, 0.f};
#pragma unroll
            for (int ks = 0; ks < 4; ++ks) { const bf16x8 cf = *(const LAS bf16x8*)(Cs + lrow * CPITCH + (g * 128 + 32 * ks + 8 * fq) * 2);
#pragma unroll
                for (int pt = 0; pt < 4; ++pt) { const bf16x8 hf = *(const LAS bf16x8*)(Hb + (16 * pt + fr) * LP + (32 * ks + 8 * fq) * 2); tm[pt] = MFMA16(hf, cf, tm[pt]); } }
            const float e = __expf(d == 0 ? (h == 0 ? acv[0] : h == 1 ? acv[1] : h == 2 ? acv[2] : h == 3 ? acv[3] : h == 4 ? acv[4] : acv[5]) : (h == 0 ? acv[6] : h == 1 ? acv[7] : h == 2 ? acv[8] : h == 3 ? acv[9] : h == 4 ? acv[10] : acv[11]));
#pragma unroll
            for (int pt = 0; pt < 4; ++pt) yh[pt] += tm[pt] * e;
        }
#pragma unroll
        for (int pt = 0; pt < 4; ++pt) { const int cidx = h * 64 + 16 * pt + 4 * fq; const u32x2 z = zpre[S][pt];
            f32x4 v = yh[pt] + ypre[S][pt]; v[0] *= silu_f(bflo(z.x)); v[1] *= silu_f(bfhi(z.x)); v[2] *= silu_f(bflo(z.y)); v[3] *= silu_f(bfhi(z.y));
            u32x2 o; o.x = cvtpk(v[0], v[1]); o.y = cvtpk(v[2], v[3]); *(u32x2*)(CAT + (size_t)row * DM + 256 + cidx) = o; ss += (v[0] * v[0] + v[1] * v[1]) + (v[2] * v[2] + v[3] * v[3]); }
    }
#undef SSDF_LOAD
    ss += __shfl_xor(ss, 16); ss += __shfl_xor(ss, 32);
    const float rstd = rsqrtf(ss * (1.f / 384.f) + EPS);
    u32x2 st[6][4];
#pragma unroll
    for (int h = 0; h < 6; ++h)
#pragma unroll
        for (int pt = 0; pt < 4; ++pt) st[h][pt] = *(const u32x2*)(CAT + (size_t)row * DM + 256 + h * 64 + 16 * pt + 4 * fq);
    asm volatile("" ::: "memory");
#pragma unroll
    for (int h = 0; h < 6; ++h)
#pragma unroll
        for (int pt = 0; pt < 4; ++pt) { const int cidx = h * 64 + 16 * pt + 4 * fq; const f32x4 gg = *(const f32x4*)(F.g_ssd + l * 384 + cidx); const u32x2 t = st[h][pt]; f32x4 v = {bflo(t.x), bfhi(t.x), bflo(t.y), bfhi(t.y)}; v = v * rstd * gg;
            u32x2 o; o.x = cvtpk(v[0], v[1]); o.y = cvtpk(v[2], v[3]); *(u32x2*)(CAT + (size_t)row * DM + 256 + cidx) = o; }
    __syncthreads();
}

__device__ __forceinline__ void build_vt_item(Frame& F, int gt, int h) {
    const bf16_t* KV = WSP(bf16_t, WS_KV); bf16_t* VT = WSP(bf16_t, WS_VT);
    const int t7 = F.tid & 127, kq = t7 & 15, ch = t7 >> 4; u32x4 v[4];
#pragma unroll
    for (int r = 0; r < 4; ++r) v[r] = *(const u32x4*)(KV + (size_t)(gt * 64 + 4 * kq + r) * KVW + h * 128 + 64 + ch * 8);
    bf16_t* dst = VT + ((size_t)gt * 6 + h) * 4096 + 4 * kq;
#pragma unroll
    for (int j = 0; j < 4; ++j) { const unsigned a0 = v[0][j], a1 = v[1][j], a2 = v[2][j], a3 = v[3][j];
        u32x2 lo, hi; lo.x = (a0 & 0xffffu) | (a1 << 16); lo.y = (a2 & 0xffffu) | (a3 << 16); hi.x = (a0 >> 16) | (a1 & 0xffff0000u); hi.y = (a2 >> 16) | (a3 & 0xffff0000u);
        *(u32x2*)(dst + (8 * ch + 2 * j) * 64) = lo; *(u32x2*)(dst + (8 * ch + 2 * j + 1) * 64) = hi; }
}
template <class Sched> __device__ __forceinline__ void build_vt_own(Frame& F, const Sched& S) {
    asm volatile("s_waitcnt vmcnt(0)" ::: "memory"); __syncthreads();
    pg8::Unit u; const int sub = F.tid >> 7;
    for (int i = 0; S.next(i, u); ++i) {
#pragma unroll
        for (int k = 0; k < 2; ++k) { const int item = sub + 4 * k;
            build_vt_item(F, u.pm * 4 + (item & 3), u.pn * 2 + (item >> 2)); }
    }
}

__device__ __forceinline__ void attn_unit(Frame& F, int u) {
    int b, h, q0, nt; bool isc;
    if (u < 768) { b = u / 96; const int rem = u % 96; h = rem >> 4; q0 = b * SEQ + (rem & 15) * 128; nt = 36; isc = false; }
    else { const int uu = u - 768; b = uu / 12; const int rem = uu % 12; h = rem >> 1; q0 = NLAT + b * CTXL + (rem & 1) * 128; nt = 4; isc = true; }
    constexpr int KP = 208, VP = 136, TILEB = 64 * KP + 64 * VP;
    const bf16_t* Q = WSP(bf16_t, WS_Q); const bf16_t* KV = WSP(bf16_t, WS_KV); const bf16_t* KR = WSP(bf16_t, WS_KR); const bf16_t* VTg = WSP(bf16_t, WS_VT); bf16_t* CAT = WSP(bf16_t, WS_CAT);
    const int w = F.wave, lane = F.lane, tid = F.tid, qs = w & 3, par = w >> 2, r32 = lane & 31, hf = lane >> 5;
    bf16x8 qf[6];
    { const int qrow = q0 + 32 * qs + r32; const bf16_t* qp = Q + (size_t)qrow * QW + h * 96 + 8 * hf;
#pragma unroll
        for (int ks = 0; ks < 6; ++ks) qf[ks] = *(const bf16x8*)(qp + 16 * ks);
        if (!isc) { const int tok = qrow & (SEQ - 1); const f32x2* rt = WSP(f32x2, WS_MISC + MISC_ROPE);
#pragma unroll
            for (int ax = 0; ax < 2; ++ax) { const int pos = ax == 0 ? (tok >> 6) : (tok & 63); u32x4 own = __builtin_bit_cast(u32x4, qf[4 + ax]); u32x4 oth;
                oth.x = __shfl_xor(own.x, 32); oth.y = __shfl_xor(own.y, 32); oth.z = __shfl_xor(own.z, 32); oth.w = __shfl_xor(own.w, 32);
                float a[8], o[8], r[8];
                a[0] = bflo(own.x); a[1] = bfhi(own.x); a[2] = bflo(own.y); a[3] = bfhi(own.y); a[4] = bflo(own.z); a[5] = bfhi(own.z); a[6] = bflo(own.w); a[7] = bfhi(own.w);
                o[0] = bflo(oth.x); o[1] = bfhi(oth.x); o[2] = bflo(oth.y); o[3] = bfhi(oth.y); o[4] = bflo(oth.z); o[5] = bfhi(oth.z); o[6] = bflo(oth.w); o[7] = bfhi(oth.w);
#pragma unroll
                for (int f = 0; f < 8; ++f) { const f32x2 cs = rt[pos * 8 + f]; r[f] = hf == 0 ? (a[f] * cs.x - o[f] * cs.y) : (o[f] * cs.y + a[f] * cs.x); }
                u32x4 res; res.x = cvtpk(r[0], r[1]); res.y = cvtpk(r[2], r[3]); res.z = cvtpk(r[4], r[5]); res.w = cvtpk(r[6], r[7]); qf[4 + ax] = __builtin_bit_cast(bf16x8, res); } }
    }
    u32x4 knA[2], krA, vregA[2], knB[2], krB, vregB[2];
    const unsigned voffK = (unsigned)((tid >> 3) * KVW + (tid & 7) * 8) * 2u, voffR = (unsigned)tid * 16u, voffV = (unsigned)tid * 16u;
    const unsigned ldsK = (unsigned)((tid >> 3) * KP + (tid & 7) * 16), ldsR = (unsigned)((tid >> 8) * TILEB + ((tid >> 2) & 63) * KP + (8 + (tid & 3)) * 16), ldsV = (unsigned)(64 * KP + (tid >> 3) * VP + (tid & 7) * 16);
#define ATT_R(tp) ((isc || (tp) < 2) ? (NLAT + b * CTXL + (tp) * 128) : (b * SEQ + ((tp) - 2) * 128))
#define ATT_LOAD(kn, kr, vreg, tp) do { const int R_ = __builtin_amdgcn_readfirstlane(ATT_R(tp)); \
        const unsigned char* kb_ = (const unsigned char*)(KV + (size_t)R_ * KVW + h * 128); \
        kn[0] = *(const u32x4*)(kb_ + voffK); kn[1] = *(const u32x4*)(kb_ + 64 * KVW * 2 + voffK); \
        kr = *(const u32x4*)((const unsigned char*)(KR + (size_t)R_ * 32) + voffR); \
        const unsigned char* vb_ = (const unsigned char*)(VTg + ((size_t)(R_ >> 6) * 6 + h) * 4096); \
        vreg[0] = *(const u32x4*)(vb_ + voffV); vreg[1] = *(const u32x4*)(vb_ + 6 * 4096 * 2 + voffV); } while (0)
#define ATT_WRITE(kn, kr, vreg, buf) do { LAS unsigned char* base_ = F.lds + (buf) * 2 * TILEB; \
        *(LAS u32x4*)(base_ + ldsK) = kn[0]; *(LAS u32x4*)(base_ + TILEB + ldsK) = kn[1]; *(LAS u32x4*)(base_ + ldsR) = kr; \
        _Pragma("unroll") for (int i = 0; i < 2; ++i) { LAS unsigned char* vt = base_ + i * TILEB + ldsV; \
            *(LAS u32x2*)vt = (u32x2){vreg[i].x, vreg[i].y}; *(LAS u32x2*)(vt + 8) = (u32x2){vreg[i].z, vreg[i].w}; } } while (0)
    const int np = nt / 2;
    ATT_LOAD(knA, krA, vregA, 0); ATT_WRITE(knA, krA, vregA, 0);
    __syncthreads();
    ATT_LOAD(knB, krB, vregB, 1);
    f32x16 o0, o1;
#pragma unroll
    for (int r = 0; r < 16; ++r) { o0[r] = 0.f; o1[r] = 0.f; }
    float mrun = 0.f, lrun = 0.f;
    const unsigned kfo = (unsigned)(r32 * KP + 16 * hf), vfo = (unsigned)(64 * KP + r32 * VP + 8 * hf);
#define ATT_STEP(tp) do { \
        const LAS unsigned char* Kt = F.lds + ((((tp)) & 1) * 2 + par) * TILEB; \
        bf16x8 ka[6], kb[6]; \
        _Pragma("unroll") \
        for (int ks = 0; ks < 6; ++ks) ka[ks] = *(const LAS bf16x8*)(Kt + kfo + 32 * ks); \
        _Pragma("unroll") \
        for (int ks = 0; ks < 6; ++ks) kb[ks] = *(const LAS bf16x8*)(Kt + kfo + 32 * KP + 32 * ks); \
        f32x16 p0, p1; \
        _Pragma("unroll") \
        for (int r = 0; r < 16; ++r) { p0[r] = -mrun; p1[r] = -mrun; } \
        __builtin_amdgcn_sched_barrier(0); \
        _Pragma("unroll") \
        for (int ks = 0; ks < 6; ++ks) { p0 = MFMA32(ka[ks], qf[ks], p0); p1 = MFMA32(kb[ks], qf[ks], p1); } \
        u32x2 va[4][2], vc[4][2]; \
        _Pragma("unroll") \
        for (int s2 = 0; s2 < 4; ++s2) { \
            va[s2][0] = *(const LAS u32x2*)(Kt + vfo + 32 * s2); va[s2][1] = *(const LAS u32x2*)(Kt + vfo + 32 * s2 + 16); \
            vc[s2][0] = *(const LAS u32x2*)(Kt + vfo + 32 * VP + 32 * s2); vc[s2][1] = *(const LAS u32x2*)(Kt + vfo + 32 * VP + 32 * s2 + 16); } \
        __builtin_amdgcn_sched_barrier(0); \
        float mx = p0[0]; \
        _Pragma("unroll") \
        for (int r = 1; r < 16; ++r) mx = fmaxf(mx, p0[r]); \
        _Pragma("unroll") \
        for (int r = 0; r < 16; ++r) mx = fmaxf(mx, p1[r]); \
        mx = fmaxf(mx, __shfl_xor(mx, 32)); \
        if ((tp) == 0 || __any(mx > 8.f)) { const float dl = (tp) == 0 ? mx : fmaxf(mx, 0.f), alpha = __builtin_amdgcn_exp2f(-dl); lrun *= alpha; mrun += dl; \
        _Pragma("unroll") \
            for (int r = 0; r < 16; ++r) { o0[r] *= alpha; o1[r] *= alpha; p0[r] -= dl; p1[r] -= dl; } } \
        _Pragma("unroll") \
        for (int r = 0; r < 16; ++r) { p0[r] = __builtin_amdgcn_exp2f(p0[r]); p1[r] = __builtin_amdgcn_exp2f(p1[r]); } \
        float sa = p0[0], sb = p0[1], sc = p1[0], sd = p1[1]; \
        _Pragma("unroll") \
        for (int r = 2; r < 16; r += 2) { sa += p0[r]; sb += p0[r + 1]; sc += p1[r]; sd += p1[r + 1]; } \
        lrun += (sa + sb) + (sc + sd); \
        bf16x8 pf[4]; \
        _Pragma("unroll") \
        for (int s2 = 0; s2 < 4; ++s2) { u32x4 t; \
            if (s2 < 2) { t.x = cvtpk(p0[8 * s2], p0[8 * s2 + 1]); t.y = cvtpk(p0[8 * s2 + 2], p0[8 * s2 + 3]); t.z = cvtpk(p0[8 * s2 + 4], p0[8 * s2 + 5]); t.w = cvtpk(p0[8 * s2 + 6], p0[8 * s2 + 7]); } \
            else { const int s = s2 - 2; t.x = cvtpk(p1[8 * s], p1[8 * s + 1]); t.y = cvtpk(p1[8 * s + 2], p1[8 * s + 3]); t.z = cvtpk(p1[8 * s + 4], p1[8 * s + 5]); t.w = cvtpk(p1[8 * s + 6], p1[8 * s + 7]); } \
            pf[s2] = __builtin_bit_cast(bf16x8, t); } \
        _Pragma("unroll") \
        for (int s2 = 0; s2 < 4; ++s2) { \
            const u32x4 va4 = {va[s2][0].x, va[s2][0].y, va[s2][1].x, va[s2][1].y}, vc4 = {vc[s2][0].x, vc[s2][0].y, vc[s2][1].x, vc[s2][1].y}; \
            o0 = MFMA32(__builtin_bit_cast(bf16x8, va4), pf[s2], o0); o1 = MFMA32(__builtin_bit_cast(bf16x8, vc4), pf[s2], o1); } \
    } while (0)
    for (int tp = 0; tp < np; tp += 2) {
        ATT_LOAD(knA, krA, vregA, min(tp + 2, np - 1));
        ATT_STEP(tp);
        if (tp + 1 < np) ATT_WRITE(knB, krB, vregB, 1);
        LDS_BARRIER();
        if (tp + 1 < np) {
            ATT_LOAD(knB, krB, vregB, min(tp + 3, np - 1));
            ATT_STEP(tp + 1);
            if (tp + 2 < np) ATT_WRITE(knA, krA, vregA, 0);
            LDS_BARRIER();
        }
    }
#undef ATT_STEP
#undef ATT_R
#undef ATT_LOAD
#undef ATT_WRITE
    lrun += __shfl_xor(lrun, 32);
    LAS float* mg = (LAS float*)(F.lds + 4 * TILEB);
    if (par == 1) { LAS float* d = mg + ((qs * 64 + lane) * 36);
#pragma unroll
        for (int r = 0; r < 16; r += 4) { *(LAS f32x4*)(d + r) = (f32x4){o0[r], o0[r + 1], o0[r + 2], o0[r + 3]}; *(LAS f32x4*)(d + 16 + r) = (f32x4){o1[r], o1[r + 1], o1[r + 2], o1[r + 3]}; }
        d[32] = mrun; d[33] = lrun; }
    __syncthreads();
    if (par == 0) { const LAS float* d = mg + ((qs * 64 + lane) * 36);
        const float m2 = d[32], l2 = d[33], mm = fmaxf(mrun, m2), a1 = __builtin_amdgcn_exp2f(mrun - mm), a2 = __builtin_amdgcn_exp2f(m2 - mm), inv = 1.f / (lrun * a1 + l2 * a2);
        const int qrow = q0 + 32 * qs + r32; bf16_t* op = CAT + (size_t)qrow * DM + 640 + h * 64;
#pragma unroll
        for (int g4 = 0; g4 < 4; ++g4) { const f32x4 e0 = *(const LAS f32x4*)(d + 4 * g4), e1 = *(const LAS f32x4*)(d + 16 + 4 * g4);
            float r0[4], r1[4];
#pragma unroll
            for (int r = 0; r < 4; ++r) { r0[r] = (o0[4 * g4 + r] * a1 + e0[r] * a2) * inv; r1[r] = (o1[4 * g4 + r] * a1 + e1[r] * a2) * inv; }
            u32x2 w0, w1; w0.x = cvtpk(r0[0], r0[1]); w0.y = cvtpk(r0[2], r0[3]); w1.x = cvtpk(r1[0], r1[1]); w1.y = cvtpk(r1[2], r1[3]);
            *(u32x2*)(op + 8 * g4 + 4 * hf) = w0; *(u32x2*)(op + 32 + 8 * g4 + 4 * hf) = w1; } }
    __syncthreads();
}
#ifndef MK_PER_PHASE
#define MK_PER_PHASE 0
#endif
constexpr int N_PHASES = 20;
struct Args { const float* in[32]; float* out; unsigned char* ws; int ph_lo, ph_hi; };
typedef __attribute__((address_space(4))) const Args CArgs;
#define GPF(k) ((const float*)(GAS const float*)ap_->in[k])

__global__ void __launch_bounds__(NTHR, 2) fwd_megakernel(Args args) {
    extern __shared__ __attribute__((aligned(16))) unsigned char lds_raw[];
    Frame F;
    F.sm = lds_raw; F.lds = (LAS unsigned char*)lds_raw;
    F.G = gridDim.x; { const int bx = blockIdx.x; F.vcu = (F.G % 8 == 0) ? (bx % 8) * (F.G / 8) + bx / 8 : bx; }
#define PHASE_BEGIN() do { int t_ = threadIdx.x; asm volatile("" : "+v"(t_)); t_ &= 511; F.tid = t_; F.lane = t_ & 63; F.wave = __builtin_amdgcn_readfirstlane(t_ >> 6); \
    CArgs* ap_ = (CArgs*)__builtin_amdgcn_kernarg_segment_ptr(); asm volatile("" : "+s"(ap_)); \
    F.x = GPF(0); F.c = GPF(1); F.ctx = GPF(2); F.c_ctx = GPF(3); F.w_mod = GPF(4); F.b_mod = GPF(5); F.g_mix = GPF(6); F.w_in = GPF(7); \
    F.w_sgu = GPF(8); F.b_sgu = GPF(9); F.g_sgu = GPF(10); F.beta_sgu = GPF(11); F.conv_w = GPF(12); F.conv_b = GPF(13); F.dt_bias = GPF(14); F.a_log = GPF(15); \
    F.d_skip = GPF(16); F.g_ssd = GPF(17); F.g_q = GPF(18); F.w_uq = GPF(19); F.g_kv = GPF(20); F.w_ukv = GPF(21); F.w_out = GPF(22); F.g_ffn = GPF(23); \
    F.w_gate = GPF(24); F.w_up = GPF(25); F.w_down = GPF(26); F.w_router = GPF(27); F.w_gate_e = GPF(28); F.w_up_e = GPF(29); F.w_down_e = GPF(30); F.g_final = GPF(31); \
    F.out = (float*)(GAS float*)ap_->out; F.ws = (unsigned char*)(GAS unsigned char*)ap_->ws; } while (0)
    PHASE_BEGIN();
    volatile LAS unsigned* MISC = (volatile LAS unsigned*)(F.lds + MISC_OFF);
    for (int u = F.tid; u < (LDS_BYTES - LDSCTL_OFF) / 4; u += NTHR) ((LAS unsigned*)(F.lds + LDSCTL_OFF))[u] = 0u;
    __syncthreads();
    XcdBarrier bar = xcd_barrier_post(WSP(unsigned, WS_CTL) + CW_BAR, MISC + 8, threadIdx.x == 0);
    { long pc0_; int clen_; asm volatile("mk_code_beg:\n\ts_getpc_b64 %0\n\ts_mov_b32 %1, mk_code_end - mk_code_beg" : "=s"(pc0_), "=s"(clen_));
      if (threadIdx.x == 0) { volatile LAS unsigned* cw = (volatile LAS unsigned*)(F.lds + LDSCTL_OFF + 960); cw[0] = (unsigned)pc0_; cw[1] = (unsigned)((unsigned long)pc0_ >> 32); cw[2] = (unsigned)clen_; }
      const int ln_ = ((int)blockIdx.x >> 3) * NTHR + (int)threadIdx.x; if (ln_ * 128 < clen_) (void)*(volatile const unsigned*)((const char*)pc0_ + (size_t)ln_ * 128); }
#ifndef WARM_AT
#define WARM_AT(k) 0
#endif
#define CODE_WARM() do { const volatile LAS unsigned* cw_ = (const volatile LAS unsigned*)(F.lds + LDSCTL_OFF + 960); const int ln_ = ((int)blockIdx.x >> 3) * NTHR + (int)threadIdx.x; \
    if (ln_ * 128 < (int)cw_[2]) { const char* cb_ = (const char*)(((unsigned long)cw_[1] << 32) | (unsigned long)cw_[0]); (void)*(volatile const unsigned*)(cb_ + (size_t)ln_ * 128); } } while (0)
#if MK_PER_PHASE
    const int lo = args.ph_lo, hi = args.ph_hi;
#else
    constexpr int lo = 0, hi = N_PHASES;
#endif
#ifndef PH_MASK
#define PH_MASK 0xFFFFFFFFu
#endif
#define PE(b) ((PH_MASK >> (b)) & 1u)
#ifndef REP_MASK
#define REP_MASK 0u
#endif
#ifndef SSD_DRY_LIMIT
#define SSD_DRY_LIMIT 0
#endif
#define NREP(b) (1 + (int)((REP_MASK >> (b)) & 1u))
#define IN(k) (lo <= (k) && (k) < hi)
#define SEAM(k) do { if (IN(k) && IN((k) + 1)) { if (WARM_AT(k)) CODE_WARM(); for (int rep_ = 0; rep_ < NREP(20); ++rep_) xcd_barrier(bar, threadIdx.x == 0); } } while (0)
#define XC WSP(float, WS_XC)
#define SSQ WSP(float, WS_SSQP)
#define ctl WSP(unsigned, WS_CTL)

    if (IN(0) && PE(0)) { for (int rep = 0; rep < NREP(0); ++rep) { PHASE_BEGIN(); p_prologue(F); } }
    SEAM(0);
#pragma unroll 1
    for (int l = 0; l < DEPTH; ++l) {
        const int pb = 1 + 9 * l;
#define modl (WSP(float, WS_MOD) + (size_t)l * 9 * 6144)
#define srcL (l == 0 ? F.x : (const float*)F.out)
#define srcC (l == 0 ? F.ctx : (const float*)XC)
        if (IN(pb + 0) && PE(1)) for (int rep = 0; rep < NREP(1); ++rep) { PHASE_BEGIN(); p_norm<false>(F, l, 0, MT, srcL, srcC, l == 1 ? WSP(float, WS_SLAB) : nullptr, WSP(float, WS_MOD) + (size_t)8 * 6144 + 5 * DM); }
        SEAM(pb + 0);
        if (IN(pb + 1) && PE(2)) for (int rep = 0; rep < NREP(2); ++rep) {
            PHASE_BEGIN();
            pg8::Gemm g{WSP(bf16_t, WS_H), WSP(bf16_t, WS_WIN) + (size_t)l * INP * DM, DM, DM, 0};
            pg8::StaticOrder S; S.init(MT, INP, F.G, (int)blockIdx.x);
            pg8::EpiInProj E{WSP(bf16_t, WS_P), SSQ, rep < NREP(2) - 1};
            pg8::gemm_phase<pg8::EpiInProj, pg8::StaticOrder, true, false>(F.lds, F.tid, g, S, E);
        }
        SEAM(pb + 1);
        if (IN(pb + 2)) {
            if (PE(3)) for (int rep = 0; rep < NREP(3); ++rep) { PHASE_BEGIN(); pg8::Gemm g{WSP(bf16_t, WS_P) + PC_CQ, WSP(bf16_t, WS_WUQ) + (size_t)l * QWP * 384, INP, 384, 0};
              pg8::StaticOrder S;
              if (l == 0 && F.G == 256) { const int k_ = (int)blockIdx.x >> 3; S.init_plan(MT, QWP, (int)blockIdx.x & 7, k_ <= 10 ? k_ : (k_ == 15 ? 11 : (k_ == 19 ? 12 : (k_ == 20 ? 14 : k_ - 5))), (k_ >= 11 && k_ <= 18 && k_ != 15) ? 0 : ((k_ == 19 || k_ == 20) ? 2 : 1)); }
              else S.init(l == 0 ? MT : NLAT, QWP, F.G, l == 0 ? (int)blockIdx.x : (int)((blockIdx.x + 136u) % (unsigned)F.G));
              pg8::EpiScaleBf16 E{WSP(bf16_t, WS_Q), QW, QW, SSQ, 0, 1.f / 384.f, QSCALE};
              pg8::gemm_phase<pg8::EpiScaleBf16, pg8::StaticOrder, true, false>(F.lds, F.tid, g, S, E); }
            if (PE(4)) for (int rep = 0; rep < NREP(4); ++rep) { PHASE_BEGIN(); pg8::Gemm g{WSP(bf16_t, WS_P) + PC_CKV, WSP(bf16_t, WS_WUKV) + (size_t)l * KVW * 256, INP, 256, 0};
              pg8::StaticOrder S;
              if (l == 0 && F.G == 256) { const int k_ = (int)blockIdx.x >> 3; S.init_plan(MT, KVW, (int)blockIdx.x & 7, k_ <= 10 ? k_ : k_ - 5, (k_ >= 11 && k_ <= 15) ? 0 : 1); }
              else S.init(MT, KVW, F.G, (int)((blockIdx.x + 128u) % (unsigned)F.G));
              pg8::EpiScaleBf16 E{WSP(bf16_t, WS_KV), KVW, KVW, SSQ, 1, 1.f / 256.f, 1.f};
              pg8::gemm_phase<pg8::EpiScaleBf16, pg8::StaticOrder, true, false>(F.lds, F.tid, g, S, E);
              build_vt_own(F, S); }
            if (PE(5)) for (int rep = 0; rep < NREP(5); ++rep) { PHASE_BEGIN();
                for (int k = 0; k < 2; ++k) {
                    const int bx_ = (int)blockIdx.x; int u;
                    if (F.G == 256) u = k == 0 ? F.vcu : ((bx_ >= 88 && bx_ < 120) ? 256 + bx_ - 88 : -1); else u = F.vcu + k * F.G;
                    if (u >= 0 && u < 288) ssd_local_unit(F, l, u); } }
            if (PE(6)) { PHASE_BEGIN(); for (int u = F.vcu; u < 144; u += F.G) krope_unit(F, u); }
            if (PE(6) && !(l == 1 && F.G == 256)) for (int rep = 0; rep < NREP(6); ++rep) { PHASE_BEGIN();
                const int bx_ = (int)blockIdx.x;
                if (F.G == 256) { const int k_ = bx_ >> 3; if (k_ >= 15 && k_ <= 18) sgu_unit(F, l, 112 + (k_ - 15) * 8 + (bx_ & 7)); }
                else { for (int u = F.G - 1 - F.vcu; u < 144; u += F.G) sgu_unit(F, l, u); } }
        }
        SEAM(pb + 2);
        if (IN(pb + 3)) {
            if (PE(5)) { PHASE_BEGIN(); ssd_scan(F); }
        }
        SEAM(pb + 3);
        if (IN(pb + 4)) {
            const int nat = l == 0 ? 864 : 768, nsf = l == 0 ? 144 : 128;
            if (PE(7)) for (int rep = 0; rep < NREP(7); ++rep) { PHASE_BEGIN();
                const bool l1p = l == 1 && F.G == 256;
                const int nk = l1p ? 4 : (nat + F.G - 1) / F.G;
                for (int k = 0; k < nk; ++k) { const int u = (l1p && k >= 2) ? (F.vcu < 128 ? 512 + 128 * (k - 2) + F.vcu : nat) : F.vcu + F.G * k; if (u < nat) attn_unit(F, u); } }
            if (PE(8)) for (int rep = 0; rep < NREP(8); ++rep) { PHASE_BEGIN(); for (int u = F.G - 1 - F.vcu; u < nsf; u += F.G) ssd_final_unit(F, l, u); }
            if (PE(6) && F.G == 256) { PHASE_BEGIN();
                const int u = l == 1 ? (F.vcu >= 128 ? F.vcu - 128 : -1) : (F.vcu < 112 ? F.vcu : -1);
                if (u >= 0) sgu_unit(F, l, u); }
        }
        SEAM(pb + 4);
        if (IN(pb + 5) && PE(9)) {
         const int gst = l == 0 ? 0 : (int)((blockIdx.x >> 3) & 1u);
         for (int st = 0; st < (l == 0 ? 1 : 2); ++st) {
          if (st == gst) for (int rep = 0; rep < NREP(9); ++rep) {
            PHASE_BEGIN();
            pg8::Gemm g{WSP(bf16_t, WS_CAT), WSP(bf16_t, WS_WOUT) + (size_t)l * DM * DM, DM, DM, 0};
            pg8::StaticOrder S; S.init(l == 0 ? MT : NLAT, DM, F.G, (int)blockIdx.x);
            pg8::EpiResid E{srcL, srcC, F.out, XC, modl, 2, rep < NREP(9) - 1, nullptr};
            pg8::gemm_phase<pg8::EpiResid, pg8::StaticOrder, true, false>(F.lds, F.tid, g, S, E);
            if (l == 0 && rep == NREP(9) - 1) { PHASE_BEGIN(); int wi_, nw_; if (tail_worker(MT / 256 * (DM / 256), F.G, (int)blockIdx.x, wi_, nw_)) { for (int set_ = 2; set_ < 4; ++set_) convert_set(F, set_, wi_, nw_); mod_gemv(F, 1, wi_, nw_); } }
          }
          if (l == 1 && st != gst && PE(10)) for (int rep = 0; rep < NREP(10); ++rep) { PHASE_BEGIN(); p_moe_weights(F); }
         }
        }
        SEAM(pb + 5);
        if (IN(pb + 6) && PE(11)) { PHASE_BEGIN(); if (l == 0) { for (int rep = 0; rep < NREP(11); ++rep) p_norm<false>(F, l, 1, MT, F.out, XC); } else p_norm<true>(F, l, 1, NLAT, F.out, XC); }
        SEAM(pb + 6);
        if (IN(pb + 7)) {
            if (l == 0 && PE(12)) for (int rep = 0; rep < NREP(12); ++rep) {
                PHASE_BEGIN();
                pg8::Gemm g{WSP(bf16_t, WS_H), WSP(bf16_t, WS_WGU), DM, DM, 0};
                pg8::StaticOrder S; S.init(MT, 2 * DFF, F.G, (int)blockIdx.x);
                pg8::EpiSwiglu E{WSP(bf16_t, WS_ACT), DFF};
                pg8::gemm_phase<pg8::EpiSwiglu, pg8::StaticOrder, true, false>(F.lds, F.tid, g, S, E);
            } else if (l == 1 && PE(13)) for (int rep = 0; rep < NREP(13); ++rep) {
                PHASE_BEGIN();
                pg8::Gemm g{WSP(bf16_t, WS_H), WSP(bf16_t, WS_MOEW_GU), DM, DM, (size_t)2 * DFE * DM};
                pg8::MoeOrder S; S.init(ctl + CW_CNT, 11, F.G, (int)blockIdx.x, WSP(int, WS_LIST), true);
                pg8::EpiSwiglu E{WSP(bf16_t, WS_MACT), DFE};
                pg8::gemm_phase<pg8::EpiSwiglu, pg8::MoeOrder, true, true>(F.lds, F.tid, g, S, E);
            }
        }
        SEAM(pb + 7);
        if (IN(pb + 8)) {
            if (l == 0 && PE(14)) for (int rep = 0; rep < NREP(14); ++rep) {
                PHASE_BEGIN();
                pg8::Gemm g{WSP(bf16_t, WS_ACT), WSP(bf16_t, WS_WD), DFF, DFF, 0};
                pg8::DownSplitOrder S; S.init(F.G, (int)blockIdx.x);
                pg8::EpiResid E{F.out, XC, F.out, XC, modl, 5, rep < NREP(14) - 1, WSP(float, WS_SLAB)};
                pg8::gemm_phase<pg8::EpiResid, pg8::DownSplitOrder, true, false, true>(F.lds, F.tid, g, S, E);
            } else if (l == 1 && PE(15)) for (int rep = 0; rep < NREP(15); ++rep) {
                PHASE_BEGIN();
                pg8::Gemm g{WSP(bf16_t, WS_MACT), WSP(bf16_t, WS_MOEW_D), DFE, DFE, (size_t)DM * DFE};
                pg8::MoeOrder S; S.init(ctl + CW_CNT, 4, F.G, (int)blockIdx.x, WSP(int, WS_LIST), false);
                pg8::EpiMoeDown E{WSP(bf16_t, WS_Y), WSP(int, WS_LIST), WSP(float, WS_MISC + MISC_TOPW), S};
                pg8::gemm_phase<pg8::EpiMoeDown, pg8::MoeOrder, true, false>(F.lds, F.tid, g, S, E);
            }
        }
        SEAM(pb + 8);
    }
    if (IN(19) && PE(16)) { PHASE_BEGIN(); p_final(F); }
#undef IN
#undef SEAM
#undef XC
#undef SSQ
#undef ctl
#undef modl
#undef srcL
#undef srcC
#undef PHASE_BEGIN
    asm volatile("mk_code_end:");
}

extern "C" void kernel_launch(void* const* d_in, const int* in_sizes, int n_in, void* d_out, int out_size, void* d_ws, size_t ws_size, hipStream_t stream) {
    static int grid = 0;
    if (grid == 0) {
        if (n_in != 32 || out_size != NLAT * DM || ws_size < WS_END) { fprintf(stderr, "kernel_launch: unexpected shapes (n_in %d, out %d, ws %zu); nothing launched\n", n_in, out_size, ws_size); grid = -1; return; }
        int dev = 0, cus = 0, per_cu = 0;
        if (hipGetDevice(&dev) != hipSuccess || hipDeviceGetAttribute(&cus, hipDeviceAttributeMultiprocessorCount, dev) != hipSuccess) { grid = -1; return; }
        if (hipFuncSetAttribute((const void*)fwd_megakernel, hipFuncAttributeMaxDynamicSharedMemorySize, LDS_BYTES) != hipSuccess) { fprintf(stderr, "kernel_launch: hipFuncSetAttribute failed\n"); grid = -1; return; }
        if (hipOccupancyMaxActiveBlocksPerMultiprocessor(&per_cu, (const void*)fwd_megakernel, NTHR, LDS_BYTES) != hipSuccess || per_cu < 1) { fprintf(stderr, "kernel_launch: occupancy query says %d blocks/CU\n", per_cu); (void)hipGetLastError(); grid = -1; return; }
        grid = cus;
    }
    if (grid < 0) return;
    (void)hipMemsetAsync((char*)d_ws + WS_CTL, 0, CTL_BYTES, stream);
    Args a{};
    for (int i = 0; i < 32; ++i) a.in[i] = (const float*)d_in[i];
    a.out = (float*)d_out; a.ws = (unsigned char*)d_ws;
#if MK_PER_PHASE
    for (int k = 0; k < N_PHASES; ++k) { a.ph_lo = k; a.ph_hi = k + 1; hipLaunchKernelGGL(fwd_megakernel, dim3(grid), dim3(NTHR), LDS_BYTES, stream, a); }
#else
    a.ph_lo = 0; a.ph_hi = N_PHASES;
    void* kargs[] = {&a};
    hipError_t e = hipLaunchCooperativeKernel((const void*)fwd_megakernel, dim3(grid), dim3(NTHR), kargs, LDS_BYTES, stream);
    if (e != hipSuccess) fprintf(stderr, "kernel_launch: cooperative launch failed: %s (grid %d)\n", hipGetErrorString(e), grid);
#endif
}
```

```cpp
#include <hip/hip_runtime.h>
#include <cstdio>
#include <cstdint>

#define LAS __attribute__((address_space(3)))
#define GAS __attribute__((address_space(1)))
typedef unsigned short bf16_t;
typedef short bf16x8 __attribute__((ext_vector_type(8)));
typedef float f32x4 __attribute__((ext_vector_type(4)));
typedef float f32x16 __attribute__((ext_vector_type(16)));
typedef float f32x2 __attribute__((ext_vector_type(2)));
typedef unsigned u32x4 __attribute__((ext_vector_type(4)));
typedef unsigned u32x2 __attribute__((ext_vector_type(2)));
typedef __bf16 bf16x2_t __attribute__((ext_vector_type(2)));

constexpr int BATCH = 8, SEQ = 2048, DM = 1024, CTXL = 256, DEPTH = 2;
constexpr int NLAT = BATCH * SEQ, NCTX = BATCH * CTXL, MT = NLAT + NCTX;
constexpr int INW = 2476, INP = 2560;
constexpr int PC_U = 0, PC_V = 256, PC_Z = 512, PC_X = 896, PC_B = 1280, PC_C = 1536, PC_CQ = 1792, PC_CKV = 2176, PC_KR = 2432, PC_DT = 2464;
constexpr int DFF = 2816, NEXP = 8, DFE = 1408;
constexpr int QW = 576, QWP = 768, KVW = 768;
constexpr float EPS = 1e-6f;
constexpr float QSCALE = 0.10206207261596577f * 1.4426950408889634f;
constexpr int NPOS = 18;

constexpr size_t MiB = 1u << 20;
constexpr size_t WS_CTL = 0, CTL_BYTES = 64 * 1024;
constexpr size_t WS_MOD = 1 * MiB;
constexpr size_t WS_ACS = 2 * MiB;
constexpr size_t WS_MISC = 3 * MiB;
constexpr size_t WS_LIST = 4 * MiB;
constexpr size_t WS_WSGU = 5 * MiB;
constexpr size_t WS_WIN = 6 * MiB;
constexpr size_t WS_WUQ = 16 * MiB;
constexpr size_t WS_WUKV = 18 * MiB;
constexpr size_t WS_WOUT = 19 * MiB;
constexpr size_t WS_WGU = 23 * MiB;
constexpr size_t WS_WD = 34 * MiB;
constexpr size_t WS_XC = 40 * MiB;
constexpr size_t WS_H = 48 * MiB;
constexpr size_t WS_Q = 48 * MiB;
constexpr size_t WS_KR = 70 * MiB;
constexpr size_t WS_P = 84 * MiB;
constexpr size_t WS_CAT = 174 * MiB;
constexpr size_t WS_KV = 210 * MiB;
constexpr size_t WS_CC = 237 * MiB;
constexpr size_t WS_YP = 246 * MiB;
constexpr size_t WS_ST = 273 * MiB;
constexpr size_t WS_ACT = 84 * MiB;
constexpr size_t WS_MOEW_GU = 84 * MiB;
constexpr size_t WS_MOEW_D = 128 * MiB;
constexpr size_t WS_MACT = 150 * MiB;
constexpr size_t WS_Y = 244 * MiB;
constexpr size_t WS_SSQP = 300 * MiB;
constexpr size_t WS_VT = 302 * MiB;
constexpr size_t WS_SLAB = 200 * MiB;
constexpr size_t WS_END = 316 * MiB;
constexpr size_t MISC_SSQ = 0, MISC_DEC = 256 * 1024, MISC_ROPE = 320 * 1024, MISC_TOPW = 384 * 1024;
constexpr int CW_CNT = 64;
constexpr int CW_BAR = 4096;

__device__ __forceinline__ unsigned cvtpk(float lo, float hi) { f32x2 v = {lo, hi}; bf16x2_t b = __builtin_convertvector(v, bf16x2_t); return __builtin_bit_cast(unsigned, b); }
__device__ __forceinline__ float bflo(unsigned u) { return __uint_as_float(u << 16); }
__device__ __forceinline__ float bfhi(unsigned u) { return __uint_as_float(u & 0xffff0000u); }
__device__ __forceinline__ float bf1(bf16_t h) { return __uint_as_float((unsigned)h << 16); }
__device__ __forceinline__ bf16_t f2bf(float f) { return (bf16_t)(cvtpk(f, 0.f) & 0xffffu); }
__device__ __forceinline__ float wave_sum(float v) {
#pragma unroll
    for (int o = 1; o < 64; o <<= 1) v += __shfl_xor(v, o);
    return v;
}
__device__ __forceinline__ float silu_f(float x) { return x * __builtin_amdgcn_rcpf(1.f + __expf(-x)); }
__device__ __forceinline__ float gelu_tanh(float x) { const float u = 0.7978845608028654f * (x + 0.044715f * x * x * x); const float t = 1.f - 2.f * __builtin_amdgcn_rcpf(1.f + __expf(2.f * u)); return 0.5f * x * (1.f + t); }
__device__ __forceinline__ float softplus_f(float x) { return x > 20.f ? x : log1pf(__expf(x)); }
#define LDS_WAIT() asm volatile("s_waitcnt lgkmcnt(0)" ::: "memory")
#define LDS_BARRIER() asm volatile("s_waitcnt lgkmcnt(0)\n\ts_barrier" ::: "memory")
#define MFMA16(a, b, c) __builtin_amdgcn_mfma_f32_16x16x32_bf16((a), (b), (c), 0, 0, 0)
#define MFMA32(a, b, c) __builtin_amdgcn_mfma_f32_32x32x16_bf16((a), (b), (c), 0, 0, 0)

namespace pg8 {
constexpr int BM = 256, BK = 64, HALF = 128, HTB = HALF * BK * 2, STAGE_BYTES = 8 * HTB, NXCD = 8, WGM = 8;
__host__ __device__ __forceinline__ int lds_byte(int r, int c) { const int st = (r >> 4) * 2 + (c >> 5), rr = r & 15, cc = c & 31, ob = rr * 64 + cc * 2; return st * 1024 + (ob ^ (((ob >> 9) & 1) << 5)); }
__host__ __device__ __forceinline__ void stage_rc(int b, int& R, int& C) { const int st = b / 1024, sb = b % 1024, swz = sb ^ (((sb >> 9) & 1) << 5); R = (st >> 1) * 16 + swz / 64; C = (st & 1) * 32 + (swz % 64) / 2; }
__host__ __device__ __forceinline__ int perm32(int rho) { const int n = rho >> 4, i = rho & 15; return 8 * (i >> 2) + 4 * n + (i & 3); }

struct Unit { int pm, pn, e, kt0, nkt; };
struct Gemm { const bf16_t* A; const bf16_t* Bt; int lda; int K; size_t bstride_e; };

struct StaticOrder {
    int nM, nN, nwg, G, c, lim;
    __device__ void init(int M, int N, int G_, int c_) { nM = M / BM; nN = N / BM; nwg = nM * nN; G = G_; c = c_; lim = 0x7fffffff; }
    __device__ void init_plan(int M, int N, int r, int off0, int cnt) { nM = M / BM; nN = N / BM; nwg = nM * nN; G = NXCD; c = off0 * NXCD + r; lim = cnt; }
    __device__ bool next(int i, Unit& u) const {
        const long L = (long)i * G + c; if (i >= lim || L >= nwg) return false;
        int wgid = (int)L; { const int q = nwg / NXCD, r = nwg % NXCD, xcd = wgid % NXCD, off = wgid / NXCD; wgid = (xcd < r ? xcd * (q + 1) : r * (q + 1) + (xcd - r) * q) + off; }
        const int nig = WGM * nN, gid = wgid / nig, fm = gid * WGM, gsz = (nM - fm) < WGM ? (nM - fm) : WGM;
        u.pm = fm + ((wgid % nig) % gsz); u.pn = (wgid % nig) / gsz; u.e = 0; return true;
    }
    __device__ __forceinline__ int arow(const Unit& u, int r) const { return u.pm * BM + r; }
};

template <class Epi, class Sched, bool ALIGN_EPI, bool GATHER, bool KSPLIT = false>
__device__ __forceinline__ void gemm_phase(LAS unsigned char* lds, const int tid, const Gemm g, const Sched& S, const Epi& E) {
    const int wid = __builtin_amdgcn_readfirstlane(tid >> 6), lane = tid & 63, wr = wid >> 2, wc = wid & 3, fr = lane & 15, fq = lane >> 4;
    const int K = g.K; int nt = K / BK;
    int Rr[2], Cc[2]; unsigned voffA[2], voffB[2];
#pragma unroll
    for (int i = 0; i < 2; ++i) { int R, C; stage_rc(tid * 16 + i * 8192, R, C); Rr[i] = R; Cc[i] = C; const int Rb = Epi::PERM ? ((R & ~31) + perm32(R & 31)) : R;
        voffA[i] = (unsigned)(R * g.lda + C) * 2u; voffB[i] = (unsigned)(Rb * K + C) * 2u; }
    const size_t kstep = (size_t)(BK * 2);
    const size_t hstepB = (size_t)HALF * K * 2, tstepB = 2 * hstepB;
    const size_t hstepA = (size_t)HALF * g.lda * 2, tstepA = 2 * hstepA;
    const unsigned ldsw = (unsigned)wid * 1024u;
    const int aoff = lds_byte(wr * 64 + fr, fq * 8), boff = lds_byte(wc * 32 + fr, fq * 8);
    const char* const Abase = (const char*)g.A;
#define PG8_SA(b, h) (((b) * 2 + (h)) * HTB)
#define PG8_SB(b, h) ((4 + (b) * 2 + (h)) * HTB)
#define PG8_GL(gp, off) __builtin_amdgcn_global_load_lds((const unsigned*)(gp), (LAS unsigned*)(lds + (off)), 16, 0, 0)
#define PG8_STAGE_B(bufoff, gbase) do { PG8_GL((const char*)(gbase) + voffB[0], (bufoff) + ldsw); PG8_GL((const char*)(gbase) + voffB[1], (bufoff) + ldsw + 8192); } while (0)
#define PG8_STAGE_A_CUR(bufoff, kt, h) do { if constexpr (GATHER) { const char* _p = Abase + (size_t)(kt) * kstep; PG8_GL(_p + ((h) ? c10 : c00), (bufoff) + ldsw); PG8_GL(_p + ((h) ? c11 : c01), (bufoff) + ldsw + 8192); } \
        else { const char* _p = cA + (size_t)(kt) * kstep + (h) * hstepA; PG8_GL(_p + voffA[0], (bufoff) + ldsw); PG8_GL(_p + voffA[1], (bufoff) + ldsw + 8192); } } while (0)
#define PG8_STAGE_A_SEL(bufoff, kt, h) do { if constexpr (GATHER) { const char* _p = Abase + (size_t)(kt) * kstep; PG8_GL(_p + ((h) ? x10 : x00), (bufoff) + ldsw); PG8_GL(_p + ((h) ? x11 : x01), (bufoff) + ldsw + 8192); } \
        else { const char* _p = xA + (size_t)(kt) * kstep + (h) * hstepA; PG8_GL(_p + voffA[0], (bufoff) + ldsw); PG8_GL(_p + voffA[1], (bufoff) + ldsw + 8192); } } while (0)
#define PG8_LDA(dst, b, h) do { _Pragma("unroll") for (int m = 0; m < 4; ++m) _Pragma("unroll") for (int k = 0; k < 2; ++k) dst[m][k] = *(const LAS bf16x8*)(lds + PG8_SA(b, h) + aoff + m * 2048 + k * 1024); } while (0)
#define PG8_LDB(dst, b, h) do { _Pragma("unroll") for (int n = 0; n < 2; ++n) _Pragma("unroll") for (int k = 0; k < 2; ++k) dst[n][k] = *(const LAS bf16x8*)(lds + PG8_SB(b, h) + boff + n * 2048 + k * 1024); } while (0)
#define PG8_MMA(ai, bj, At, Bt) do { __builtin_amdgcn_s_setprio(1); _Pragma("unroll") for (int m = 0; m < 4; ++m) _Pragma("unroll") for (int n = 0; n < 2; ++n) _Pragma("unroll") for (int k = 0; k < 2; ++k) \
        acc[ai][bj][m][n] = __builtin_amdgcn_mfma_f32_16x16x32_bf16(Bt[n][k], At[m][k], acc[ai][bj][m][n], 0, 0, 0); __builtin_amdgcn_s_setprio(0); } while (0)
#define PG8_WAIT_V(n) asm volatile("s_waitcnt vmcnt(" #n ")" ::: "memory")
#define PG8_WAIT_L(n) asm volatile("s_waitcnt lgkmcnt(" #n ")" ::: "memory")
#define PG8_BAR __builtin_amdgcn_s_barrier()
#define PG8_SCHED __builtin_amdgcn_sched_barrier(0)
#define PG8_AOFFS(u, o00, o01, o10, o11) do { if constexpr (GATHER) { \
        o00 = (unsigned)(((size_t)S.arow(u, Rr[0]) * g.lda + Cc[0]) * 2); o01 = (unsigned)(((size_t)S.arow(u, Rr[1]) * g.lda + Cc[1]) * 2); \
        o10 = (unsigned)(((size_t)S.arow(u, HALF + Rr[0]) * g.lda + Cc[0]) * 2); o11 = (unsigned)(((size_t)S.arow(u, HALF + Rr[1]) * g.lda + Cc[1]) * 2); } } while (0)
    Unit cur, nxt; int ui = 0;
    if (!S.next(0, cur)) return;
    f32x4 acc[2][2][4][2];
#pragma unroll
    for (int a = 0; a < 2; ++a)
#pragma unroll
        for (int b = 0; b < 2; ++b)
#pragma unroll
            for (int m = 0; m < 4; ++m)
#pragma unroll
                for (int n = 0; n < 2; ++n) acc[a][b][m][n] = (f32x4){0.f, 0.f, 0.f, 0.f};
    bf16x8 At[4][2], B0[2][2], B1[2][2];
    unsigned c00 = 0, c01 = 0, c10 = 0, c11 = 0, n00 = 0, n01 = 0, n10 = 0, n11 = 0;
    PG8_AOFFS(cur, c00, c01, c10, c11);
    const char* cA = Abase + (size_t)cur.pm * tstepA;
    const char* cB = (const char*)g.Bt + ((size_t)cur.e * g.bstride_e) * 2 + (size_t)cur.pn * tstepB;
    if constexpr (KSPLIT) { cA += (size_t)cur.kt0 * kstep; cB += (size_t)cur.kt0 * kstep; nt = cur.nkt; }
    PG8_STAGE_B(PG8_SB(0, 0), cB); PG8_STAGE_B(PG8_SB(0, 1), cB + hstepB); PG8_STAGE_A_CUR(PG8_SA(0, 0), 0, 0); PG8_STAGE_A_CUR(PG8_SA(0, 1), 0, 1);
    if (wr == 1) PG8_BAR;
    PG8_WAIT_V(2); PG8_BAR;
    PG8_STAGE_B(PG8_SB(1, 0), cB + kstep); PG8_STAGE_A_CUR(PG8_SA(1, 0), 1, 0); PG8_STAGE_B(PG8_SB(1, 1), cB + hstepB + kstep);
    PG8_WAIT_V(6); PG8_BAR;
    for (;;) {
        const bool has_next = S.next(ui + 1, nxt);
        const char* nB = cB; const char* nA = cA;
        if (has_next) { PG8_AOFFS(nxt, n00, n01, n10, n11); nA = Abase + (size_t)nxt.pm * tstepA; nB = (const char*)g.Bt + ((size_t)nxt.e * g.bstride_e) * 2 + (size_t)nxt.pn * tstepB;
            if constexpr (KSPLIT) { nA += (size_t)nxt.kt0 * kstep; nB += (size_t)nxt.kt0 * kstep; } }
        else { n00 = c00; n01 = c01; n10 = c10; n11 = c11; }
#pragma unroll 1
        for (int t = 0; t < nt; t += 2) {
            const bool last = (t == nt - 2);
            const int kt2 = last ? 0 : t + 2, kt3 = kt2 + 1;
            const unsigned x00 = last ? n00 : c00, x01 = last ? n01 : c01, x10 = last ? n10 : c10, x11 = last ? n11 : c11;
            const char* xA = last ? nA : cA;
            const char* b2 = last ? nB : cB + (size_t)(t + 2) * kstep; const char* b3 = b2 + kstep;
            (void)x00; (void)x01; (void)x10; (void)x11; (void)xA;
            PG8_LDB(B0, 0, 0); PG8_LDB(B1, 0, 1); PG8_SCHED; PG8_LDA(At, 0, 0); PG8_STAGE_A_CUR(PG8_SA(1, 1), t + 1, 1);
            PG8_WAIT_V(8); PG8_WAIT_L(0); PG8_BAR; PG8_MMA(0, 0, At, B0); PG8_MMA(0, 1, At, B1); PG8_BAR; PG8_SCHED;
            PG8_LDA(At, 0, 1); PG8_STAGE_B(PG8_SB(0, 0), b2); PG8_STAGE_B(PG8_SB(0, 1), b2 + hstepB); PG8_STAGE_A_SEL(PG8_SA(0, 0), kt2, 0);
            PG8_WAIT_V(8); PG8_WAIT_L(0); PG8_BAR; PG8_MMA(1, 0, At, B0); PG8_MMA(1, 1, At, B1); PG8_BAR; PG8_SCHED;
            PG8_LDB(B0, 1, 0); PG8_LDB(B1, 1, 1); PG8_SCHED; PG8_LDA(At, 1, 0); PG8_STAGE_A_SEL(PG8_SA(0, 1), kt2, 1);
            PG8_WAIT_V(8); PG8_WAIT_L(0); PG8_BAR; PG8_MMA(0, 0, At, B0); PG8_MMA(0, 1, At, B1); PG8_BAR; PG8_SCHED;
            PG8_LDA(At, 1, 1); PG8_STAGE_B(PG8_SB(1, 0), b3); PG8_STAGE_B(PG8_SB(1, 1), b3 + hstepB); PG8_STAGE_A_SEL(PG8_SA(1, 0), kt3, 0);
            PG8_WAIT_V(8); PG8_WAIT_L(0); PG8_BAR; PG8_MMA(1, 0, At, B0); PG8_MMA(1, 1, At, B1); PG8_BAR; PG8_SCHED;
        }
        if constexpr (ALIGN_EPI) { if (wr == 0) PG8_BAR; }
        E(acc, cur, wr, wc, fr, fq);
        if (!has_next) break;
#pragma unroll
        for (int a = 0; a < 2; ++a)
#pragma unroll
            for (int b = 0; b < 2; ++b)
#pragma unroll
                for (int m = 0; m < 4; ++m)
#pragma unroll
                    for (int n = 0; n < 2; ++n) acc[a][b][m][n] = (f32x4){0.f, 0.f, 0.f, 0.f};
        cur = nxt; cA = nA; cB = nB; c00 = n00; c01 = n01; c10 = n10; c11 = n11; ++ui;
        if constexpr (KSPLIT) nt = cur.nkt;
        if constexpr (ALIGN_EPI) { if (wr == 1) PG8_BAR; }
    }
    PG8_WAIT_V(0);
    if constexpr (!ALIGN_EPI) { if (wr == 0) PG8_BAR; }
    PG8_BAR;
#undef PG8_SA
#undef PG8_SB
#undef PG8_GL
#undef PG8_STAGE_A_CUR
#undef PG8_STAGE_A_SEL
#undef PG8_STAGE_B
#undef PG8_LDA
#undef PG8_LDB
#undef PG8_MMA
#undef PG8_WAIT_V
#undef PG8_WAIT_L
#undef PG8_BAR
#undef PG8_SCHED
#undef PG8_AOFFS
}
}
namespace pg8 {
struct EpiInProj {
    static constexpr bool PERM = true;
    bf16_t* O; float* ssq; bool dry;
    __device__ __forceinline__ void operator()(const f32x4 (&acc)[2][2][4][2], const Unit& u, int wr, int wc, int fr, int fq) const {
        if (dry) return;
        const int row0 = u.pm * BM + wr * 64 + fr, col0 = u.pn * BM + wc * 32 + 8 * fq;
#pragma unroll
        for (int ai = 0; ai < 2; ++ai)
#pragma unroll
            for (int m = 0; m < 4; ++m) { const int row = row0 + ai * HALF + m * 16; bf16_t* rowp = O + (size_t)row * INP + col0;
                float sq = 0.f, sk = 0.f;
#pragma unroll
                for (int bj = 0; bj < 2; ++bj) { const f32x4 v0 = acc[ai][bj][m][0], v1 = acc[ai][bj][m][1];
                    u32x4 w; w.x = cvtpk(v0[0], v0[1]); w.y = cvtpk(v0[2], v0[3]); w.z = cvtpk(v1[0], v1[1]); w.w = cvtpk(v1[2], v1[3]);
                    *(u32x4*)(rowp + bj * HALF) = w;
                    const int hidx = 2 * u.pn + bj;
                    const float s = (v0[0] * v0[0] + v0[1] * v0[1]) + (v0[2] * v0[2] + v0[3] * v0[3]) + (v1[0] * v1[0] + v1[1] * v1[1]) + (v1[2] * v1[2] + v1[3] * v1[3]);
                    if (hidx >= 14 && hidx <= 16) sq += s;
                    if (hidx >= 17 && hidx <= 18) sk += s; }
                if (u.pn >= 7 && u.pn <= 9) {
                    sq += __shfl_xor(sq, 16); sq += __shfl_xor(sq, 32); sk += __shfl_xor(sk, 16); sk += __shfl_xor(sk, 32);
                    if (fq == 0) { float* sp = ssq + (size_t)row * 16;
                        if (u.pn == 7) sp[wc] = sq; if (u.pn == 8) { sp[4 + wc] = sq; sp[8 + wc] = sk; } if (u.pn == 9) sp[12 + wc] = sk; } } }
    }
};
struct EpiScaleBf16 {
    static constexpr bool PERM = true;
    bf16_t* O; int ldc, ncols; const float* ssq; int idx; float invn, mul;
    __device__ __forceinline__ void operator()(const f32x4 (&acc)[2][2][4][2], const Unit& u, int wr, int wc, int fr, int fq) const {
        const int row0 = u.pm * BM + wr * 64 + fr, col0 = u.pn * BM + wc * 32 + 8 * fq;
#pragma unroll
        for (int ai = 0; ai < 2; ++ai) {
            float scv[4];
#pragma unroll
            for (int m = 0; m < 4; ++m) { const int row = row0 + ai * HALF + m * 16;
                const f32x4 pa = *(const f32x4*)(ssq + (size_t)row * 16 + 8 * idx), pb = *(const f32x4*)(ssq + (size_t)row * 16 + 8 * idx + 4);
                scv[m] = rsqrtf((((pa[0] + pa[1]) + (pa[2] + pa[3])) + ((pb[0] + pb[1]) + (pb[2] + pb[3]))) * invn + EPS) * mul; }
            asm volatile("" ::: "memory");
#pragma unroll
            for (int m = 0; m < 4; ++m) { const int row = row0 + ai * HALF + m * 16; bf16_t* rowp = O + (size_t)row * ldc + col0;
                const float sc = scv[m];
#pragma unroll
                for (int bj = 0; bj < 2; ++bj) if (col0 + bj * HALF < ncols) { const f32x4 v0 = acc[ai][bj][m][0] * sc, v1 = acc[ai][bj][m][1] * sc;
                    u32x4 w; w.x = cvtpk(v0[0], v0[1]); w.y = cvtpk(v0[2], v0[3]); w.z = cvtpk(v1[0], v1[1]); w.w = cvtpk(v1[2], v1[3]);
                    *(u32x4*)(rowp + bj * HALF) = w; } } }
    }
};
struct EpiResid {
    static constexpr bool PERM = false;
    const float* oldL; const float* oldC; float* newL; float* newC; const float* mod; int gi; bool dry; float* slab;
    __device__ __forceinline__ void operator()(const f32x4 (&acc)[2][2][4][2], const Unit& u, int wr, int wc, int fr, int fq) const {
        if (dry) return;
        if (slab && u.e > 0) {
            float* sp = slab + ((size_t)(u.e - 1) * NCTX + (u.pm * BM - NLAT) + wr * 64 + fr) * DM + u.pn * BM + wc * 32 + 4 * fq;
#pragma unroll
            for (int ai = 0; ai < 2; ++ai)
#pragma unroll
                for (int m = 0; m < 4; ++m)
#pragma unroll
                    for (int bj = 0; bj < 2; ++bj)
#pragma unroll
                        for (int n = 0; n < 2; ++n) *(f32x4*)(sp + (size_t)(ai * HALF + m * 16) * DM + bj * HALF + n * 16) = acc[ai][bj][m][n];
            return; }
        const int rbase = u.pm * BM; const bool isc = rbase >= NLAT; const int b = isc ? 8 : (rbase >> 11);
        const float* xo = isc ? oldC - (size_t)NLAT * DM : oldL; float* xn = isc ? newC - (size_t)NLAT * DM : newL;
        const int row0 = rbase + wr * 64 + fr, col0 = u.pn * BM + wc * 32 + 4 * fq;
        const float* gp = mod + (size_t)b * 6144 + gi * DM + col0;
        f32x4 gv[2][2];
#pragma unroll
        for (int bj = 0; bj < 2; ++bj)
#pragma unroll
            for (int n = 0; n < 2; ++n) gv[bj][n] = *(const f32x4*)(gp + bj * HALF + n * 16);
#pragma unroll
        for (int am = 0; am < 4; ++am) { const int ai = am >> 1, m0 = (am & 1) * 2;
            f32x4 xv[2][2][2];
#pragma unroll
            for (int mm = 0; mm < 2; ++mm) { const size_t off = (size_t)(row0 + ai * HALF + (m0 + mm) * 16) * DM + col0;
#pragma unroll
                for (int bj = 0; bj < 2; ++bj)
#pragma unroll
                    for (int n = 0; n < 2; ++n) xv[mm][bj][n] = *(const f32x4*)(xo + off + bj * HALF + n * 16); }
            asm volatile("" ::: "memory");
#pragma unroll
            for (int mm = 0; mm < 2; ++mm) { const size_t off = (size_t)(row0 + ai * HALF + (m0 + mm) * 16) * DM + col0;
#pragma unroll
                for (int bj = 0; bj < 2; ++bj)
#pragma unroll
                    for (int n = 0; n < 2; ++n) *(f32x4*)(xn + off + bj * HALF + n * 16) = xv[mm][bj][n] + gv[bj][n] * acc[ai][bj][m0 + mm][n]; }
            asm volatile("" ::: "memory"); }
    }
};
struct EpiSwiglu {
    static constexpr bool PERM = true;
    bf16_t* O; int ldc;
    __device__ __forceinline__ void operator()(const f32x4 (&acc)[2][2][4][2], const Unit& u, int wr, int wc, int fr, int fq) const {
        const int row0 = u.pm * BM + wr * 64 + fr, col0 = u.pn * HALF + wc * 32 + 8 * fq;
#pragma unroll
        for (int ai = 0; ai < 2; ++ai)
#pragma unroll
            for (int m = 0; m < 4; ++m) { bf16_t* rowp = O + (size_t)(row0 + ai * HALF + m * 16) * ldc + col0;
                float r[8];
#pragma unroll
                for (int n = 0; n < 2; ++n)
#pragma unroll
                    for (int j = 0; j < 4; ++j) { const float gt = acc[ai][0][m][n][j], up = acc[ai][1][m][n][j]; r[4 * n + j] = silu_f(gt) * up; }
                u32x4 w; w.x = cvtpk(r[0], r[1]); w.y = cvtpk(r[2], r[3]); w.z = cvtpk(r[4], r[5]); w.w = cvtpk(r[6], r[7]);
                *(u32x4*)rowp = w; }
    }
};
struct DownSplitOrder {
    StaticOrder so; int G, c;
    __device__ void init(int G_, int c_) { so.init(NLAT, DM, G_, c_); G = G_; c = c_; }
    __device__ bool next(int i, Unit& u) const {
        if (so.next(i, u)) { u.kt0 = 0; u.nkt = DFF / BK; return true; }
        const int rounds = (so.nwg + G - 1) / G; const int j = (i - rounds) * G + c; if (i < rounds || j >= 128) return false;
        const int tile = j >> 2, part = j & 3; u.pm = NLAT / BM + (tile >> 2); u.pn = tile & 3; u.e = 1 + part;
        u.kt0 = part == 0 ? 0 : part == 1 ? 12 : part == 2 ? 24 : 34; u.nkt = part < 2 ? 12 : 10; return true;
    }
    __device__ __forceinline__ int arow(const Unit& u, int r) const { return u.pm * BM + r; }
};
struct MoeOrder {
    int c0, c1, c2, c3, c4, c5, c6, c7, t1, t2, t3, t4, t5, t6, t7, t8; int npn, G, c; const int* list; bool gather;
    __device__ void init(const unsigned* cw, int npn_, int G_, int c_, const int* list_, bool gather_) {
        #define RFL_(x) __builtin_amdgcn_readfirstlane((int)(x))
        c0 = RFL_(cw[0]); c1 = RFL_(cw[64]); c2 = RFL_(cw[128]); c3 = RFL_(cw[192]); c4 = RFL_(cw[256]); c5 = RFL_(cw[320]); c6 = RFL_(cw[384]); c7 = RFL_(cw[448]);
#undef RFL_
        t1 = (c0 + 255) >> 8; t2 = t1 + ((c1 + 255) >> 8); t3 = t2 + ((c2 + 255) >> 8); t4 = t3 + ((c3 + 255) >> 8); t5 = t4 + ((c4 + 255) >> 8); t6 = t5 + ((c5 + 255) >> 8); t7 = t6 + ((c6 + 255) >> 8); t8 = t7 + ((c7 + 255) >> 8);
        npn = npn_; G = G_; c = c_; list = list_; gather = gather_;
    }
    __device__ bool next(int i, Unit& u) const {
        const int L = i * G + c, nwg = t8 * npn; if (L >= nwg) return false;
        int wgid = L; { const int q = nwg / NXCD, r = nwg % NXCD, xcd = wgid % NXCD, off = wgid / NXCD; wgid = (xcd < r ? xcd * (q + 1) : r * (q + 1) + (xcd - r) * q) + off; }
        const int nig = WGM * npn, gid = wgid / nig, fm = gid * WGM, gsz = (t8 - fm) < WGM ? (t8 - fm) : WGM;
        const int ti = fm + ((wgid % nig) % gsz); u.pn = (wgid % nig) / gsz; u.pm = ti;
        u.e = (ti >= t1) + (ti >= t2) + (ti >= t3) + (ti >= t4) + (ti >= t5) + (ti >= t6) + (ti >= t7); return true;
    }
    __device__ __forceinline__ int ecnt(int e) const { return e == 0 ? c0 : e == 1 ? c1 : e == 2 ? c2 : e == 3 ? c3 : e == 4 ? c4 : e == 5 ? c5 : e == 6 ? c6 : c7; }
    __device__ __forceinline__ int etb(int e) const { return e == 0 ? 0 : e == 1 ? t1 : e == 2 ? t2 : e == 3 ? t3 : e == 4 ? t4 : e == 5 ? t5 : e == 6 ? t6 : t7; }
    __device__ __forceinline__ int arow(const Unit& u, int r) const {
        if (!gather) return u.pm * BM + r;
        const int pos = (u.pm - etb(u.e)) * BM + r;
        const int n_e = ecnt(u.e); const int v = list[u.e * NLAT + (pos < n_e ? pos : 0)] >> 1; return pos < n_e ? v : 0;
    }
};
struct EpiMoeDown {
    static constexpr bool PERM = true;
    bf16_t* Y; const int* list; const float* topw; MoeOrder mo;
    __device__ __forceinline__ void operator()(const f32x4 (&acc)[2][2][4][2], const Unit& u, int wr, int wc, int fr, int fq) const {
        const int pos0 = (u.pm - mo.etb(u.e)) * BM + wr * 64 + fr, n_e = mo.ecnt(u.e), col0 = u.pn * BM + wc * 32 + 8 * fq;
        int tkv[8]; float wgv[8];
#pragma unroll
        for (int i = 0; i < 8; ++i) { const int pos = pos0 + (i >> 2) * HALF + (i & 3) * 16; tkv[i] = list[u.e * NLAT + (pos < n_e ? pos : 0)]; }
#pragma unroll
        for (int i = 0; i < 8; ++i) wgv[i] = topw[tkv[i]];
#pragma unroll
        for (int ai = 0; ai < 2; ++ai)
#pragma unroll
            for (int m = 0; m < 4; ++m) { const int pos = pos0 + ai * HALF + m * 16;
                if (pos < n_e) { const int tk = tkv[ai * 4 + m]; const float wgt = wgv[ai * 4 + m]; bf16_t* rowp = Y + (size_t)tk * DM + col0;
#pragma unroll
                    for (int bj = 0; bj < 2; ++bj) { const f32x4 v0 = acc[ai][bj][m][0] * wgt, v1 = acc[ai][bj][m][1] * wgt;
                        u32x4 w; w.x = cvtpk(v0[0], v0[1]); w.y = cvtpk(v0[2], v0[3]); w.z = cvtpk(v1[0], v1[1]); w.w = cvtpk(v1[2], v1[3]);
                        *(u32x4*)(rowp + bj * HALF) = w; } } }
    }
};
}
constexpr int NWAVES = 8, NTHR = 512;
constexpr int RING_BYTES = 147456;
constexpr int LDSCTL_OFF = RING_BYTES, MISC_OFF = LDSCTL_OFF + 320;
constexpr int LDS_BYTES = RING_BYTES + 1024;
typedef GAS unsigned gu32;
#define RLX_AGENT __ATOMIC_RELAXED, __HIP_MEMORY_SCOPE_AGENT

#define XB_TMO      128
#define XB_XCNT(j)  (256  + 64 * (j))
#define XB_XSUB(j)  (1280 + 64 * (j))
#define XB_XGEN(j)  (2304 + 64 * (j))
#define XB_TOP      3328
#define XB_TOPGEN   3392
#define XCD_BAR_WORDS 3456
#define XB_SPIN_CAP (1u << 18)
__device__ __forceinline__ unsigned xb_ld(unsigned* p)              { return __hip_atomic_load(p, __ATOMIC_RELAXED, __HIP_MEMORY_SCOPE_AGENT); }
__device__ __forceinline__ unsigned xb_add(unsigned* p, unsigned v) { return __hip_atomic_fetch_add(p, v, __ATOMIC_RELAXED, __HIP_MEMORY_SCOPE_AGENT); }
__device__ __forceinline__ unsigned xb_xcc_id() { return (unsigned)__builtin_amdgcn_s_getreg((3 << 11) | 20) & 0xFu; }
#define XB_SPIN(cond, bar) do { unsigned _sp = 0; while (cond) { __builtin_amdgcn_s_sleep(1); \
    if ((++_sp & 255u) == 0u) { if (xb_ld(&(bar)[XB_TMO])) break; if (_sp > XB_SPIN_CAP) { atomicAdd(&(bar)[XB_TMO], 1u); break; } } } } while (0)
struct XcdBarrier { unsigned* bar; unsigned x; volatile LAS unsigned* st; };
__device__ __forceinline__ XcdBarrier xcd_barrier_post(unsigned* bar, volatile LAS unsigned* st, bool leader) {
    XcdBarrier b; b.bar = bar; b.x = xb_xcc_id(); b.st = st;
    if (leader) (void)xb_add(&bar[XB_XCNT(b.x)], 1u);
    return b;
}
__device__ __forceinline__ void xcd_barrier_complete(unsigned* bar, unsigned x, unsigned& nloc, unsigned& nx) {
    const unsigned G = gridDim.x * gridDim.y * gridDim.z;
    unsigned sum, cnt, mine, sp = 0u;
    for (;;) {
        sum = 0u; cnt = 0u; mine = 0u;
#pragma unroll
        for (unsigned j = 0; j < 16; ++j) { const unsigned c = xb_ld(&bar[XB_XCNT(j)]); sum += c; cnt += (c > 0u) ? 1u : 0u; mine = (j == x) ? c : mine; }
        if (sum == G) break;
        __builtin_amdgcn_s_sleep(1);
        if ((++sp & 255u) == 0u) { if (xb_ld(&bar[XB_TMO])) break; if (sp > XB_SPIN_CAP) { atomicAdd(&bar[XB_TMO], 1u); break; } }
    }
    nloc = mine > 0u ? mine : 1u; nx = cnt > 0u ? cnt : 1u;
}
__device__ __forceinline__ void xcd_barrier(const XcdBarrier& b, bool leader) {
    asm volatile("s_waitcnt vmcnt(0)" ::: "memory");
    __syncthreads();
    if (leader) {
        unsigned* bar = b.bar;
        __builtin_amdgcn_s_waitcnt(0);
        unsigned nloc = b.st[0], nx = b.st[1];
        if (nloc == 0u) { xcd_barrier_complete(bar, b.x, nloc, nx); b.st[0] = nloc; b.st[1] = nx; }
        const unsigned old = xb_add(&bar[XB_XSUB(b.x)], 1u);
        const unsigned gen = old / nloc;
        if (old + 1u == (gen + 1u) * nloc) {
            __builtin_amdgcn_fence(__ATOMIC_RELEASE, "agent");
            asm volatile("s_waitcnt vmcnt(0)" ::: "memory");
            const unsigned og = xb_add(&bar[XB_TOP], 1u);
            const unsigned tg = og / nx;
            if (og + 1u == (tg + 1u) * nx) xb_add(&bar[XB_TOPGEN], 1u);
            else XB_SPIN(xb_ld(&bar[XB_TOPGEN]) == tg, bar);
            __builtin_amdgcn_fence(__ATOMIC_ACQUIRE, "agent");
            xb_add(&bar[XB_XGEN(b.x)], 1u);
            asm volatile("s_waitcnt vmcnt(0)" ::: "memory");
        } else {
            XB_SPIN(xb_ld(&bar[XB_XGEN(b.x)]) == gen, bar);
            __builtin_amdgcn_fence(__ATOMIC_ACQUIRE, "agent");
            asm volatile("s_waitcnt vmcnt(0)" ::: "memory");
        }
    }
    __syncthreads();
}

struct Frame {
    unsigned char* sm;
    LAS unsigned char* lds;
    int tid, lane, wave, G, vcu;
    const float *x, *c, *ctx, *c_ctx, *w_mod, *b_mod, *g_mix, *w_in, *w_sgu, *b_sgu, *g_sgu, *beta_sgu, *conv_w, *conv_b, *dt_bias, *a_log, *d_skip, *g_ssd, *g_q, *w_uq, *g_kv, *w_ukv,
                *w_out, *g_ffn, *w_gate, *w_up, *w_down, *w_router, *w_gate_e, *w_up_e, *w_down_e, *g_final;
    float* out; unsigned char* ws;
};
#define WSP(T, off) ((T*)(F.ws + (off)))

__device__ __forceinline__ int rowmap(int mode, int n) {
    if (mode == 1) { if (n < 1792) return n; if (n < 1804) return n + 672; return n - 12; }
    if (mode == 2) return ((n >> 7) << 8) + (n & 127);
    if (mode == 3) return ((n >> 7) << 8) + 128 + (n & 127);
    return n;
}
__device__ __forceinline__ void transpose_item(const float* W, int K, int N, bf16_t* WT, const float* ks, int mode, LAS float* scr, int item, int lane) {
    const int nblk = (N + 31) / 32, kb = item / nblk, nb = item % nblk, k0 = 64 * kb, n0 = 32 * nb;
    const int nn = n0 + (lane & 31); const bool nok = nn < N;
#pragma unroll 16
    for (int i = 0; i < 32; ++i) { const int kk = 2 * i + (lane >> 5); float v = W[(size_t)(k0 + kk) * N + (nok ? nn : N - 1)]; v = nok ? v : 0.f; if (ks) v *= ks[k0 + kk]; scr[kk * 33 + (lane & 31)] = v; }
    LDS_WAIT(); asm volatile("" ::: "memory");
    const int cch = lane & 7;
#pragma unroll
    for (int j = 0; j < 4; ++j) { const int n = (lane >> 3) + 8 * j; const LAS float* s = scr + (8 * cch) * 33 + n;
        u32x4 o; o.x = cvtpk(s[0 * 33], s[1 * 33]); o.y = cvtpk(s[2 * 33], s[3 * 33]); o.z = cvtpk(s[4 * 33], s[5 * 33]); o.w = cvtpk(s[6 * 33], s[7 * 33]);
        if (n0 + n < N) *(u32x4*)(WT + (size_t)rowmap(mode, n0 + n) * K + k0 + 8 * cch) = o; }
    LDS_WAIT(); asm volatile("" ::: "memory");
}
__device__ __forceinline__ void transpose_item64(const float* W, int K, int N, bf16_t* WT, const float* ks, int mode, LAS float* scr, int item, int lane) {
    const int nblk = (N + 63) / 64, kb = item / nblk, nb = item % nblk, k0 = 64 * kb, n0 = 64 * nb;
    const int lr = lane >> 4, lc = (lane & 15) * 4; const bool nok = n0 + lc < N; const int ncol = nok ? n0 + lc : N - 4;
#pragma unroll
    for (int i = 0; i < 16; ++i) { const int kk = 4 * i + lr; f32x4 v = *(const f32x4*)(W + (size_t)(k0 + kk) * N + ncol); if (ks) v = v * ks[k0 + kk];
        scr[kk * 65 + lc] = v[0]; scr[kk * 65 + lc + 1] = v[1]; scr[kk * 65 + lc + 2] = v[2]; scr[kk * 65 + lc + 3] = v[3]; }
    LDS_WAIT(); asm volatile("" ::: "memory");
    const int cch = lane & 7;
#pragma unroll
    for (int j = 0; j < 8; ++j) { const int n = (lane >> 3) + 8 * j; const LAS float* s = scr + (8 * cch) * 65 + n;
        u32x4 o; o.x = cvtpk(s[0 * 65], s[1 * 65]); o.y = cvtpk(s[2 * 65], s[3 * 65]); o.z = cvtpk(s[4 * 65], s[5 * 65]); o.w = cvtpk(s[6 * 65], s[7 * 65]);
        if (n0 + n < N) *(u32x4*)(WT + (size_t)rowmap(mode, n0 + n) * K + k0 + 8 * cch) = o; }
    LDS_WAIT(); asm volatile("" ::: "memory");
}
__device__ __forceinline__ void zero_fill16(Frame& F, void* p, size_t bytes) {
    const size_t n = bytes / 16; const u32x4 z = {0u, 0u, 0u, 0u};
    for (size_t i = (size_t)F.vcu * NTHR + F.tid; i < n; i += (size_t)F.G * NTHR) ((u32x4*)p)[i] = z;
}
__device__ __forceinline__ void mod_gemv(Frame& F, int l, int wi, int nw) {
    LAS float* cond = (LAS float*)F.lds;
    LAS float* red = (LAS float*)(F.lds + 36864);
    __syncthreads();
    for (int i = F.tid; i < 9 * DM; i += NTHR) { const float v = i < 8 * DM ? F.c[i] : F.c_ctx[i - 8 * DM]; cond[i] = silu_f(v); }
    __syncthreads();
    for (int ch = wi; ch < 192; ch += nw) {
        const int cl = F.lane & 31, kh = F.lane >> 5, col = ch * 32 + cl, kg = F.wave;
        const float* wp = F.w_mod + (size_t)l * DM * 6144 + (size_t)(kg * 128 + kh) * 6144 + col;
        float a[9];
#pragma unroll
        for (int r = 0; r < 9; ++r) a[r] = 0.f;
#pragma unroll 8
        for (int k4 = 0; k4 < 16; ++k4) { const float w0 = wp[(size_t)(8 * k4) * 6144], w1 = wp[(size_t)(8 * k4 + 2) * 6144], w2 = wp[(size_t)(8 * k4 + 4) * 6144], w3 = wp[(size_t)(8 * k4 + 6) * 6144];
#pragma unroll
            for (int r = 0; r < 9; ++r) { const LAS float* cp = cond + r * DM + kg * 128 + 8 * k4 + kh; a[r] += (cp[0] * w0 + cp[2] * w1) + (cp[4] * w2 + cp[6] * w3); } }
#pragma unroll
        for (int r = 0; r < 9; ++r) { a[r] += __shfl_xor(a[r], 32); if (kh == 0) red[(kg * 9 + r) * 32 + cl] = a[r]; }
        __syncthreads();
        for (int idx = F.tid; idx < 9 * 32; idx += NTHR) { const int r = idx >> 5, cc = idx & 31; float s = 0.f;
#pragma unroll
            for (int g = 0; g < 8; ++g) s += red[(g * 9 + r) * 32 + cc];
            WSP(float, WS_MOD)[((size_t)l * 9 + r) * 6144 + ch * 32 + cc] = s + F.b_mod[l * 6144 + ch * 32 + cc]; }
        __syncthreads();
    }
}
__device__ __forceinline__ void convert_set(Frame& F, int set, int wi, int nw) {
    __syncthreads();
    LAS float* scr = (LAS float*)(F.lds + F.wave * 16640);
    const int gw = wi * NWAVES + F.wave, NGW = nw * NWAVES;
    constexpr int I_IN = 16 * 39, I_UQ = 6 * 9, I_UKV = 4 * 12, I_OUT = 16 * 16, I_G = 16 * 44, I_D = 44 * 16;
    if (set == 0 || set == 3) { const int l = set == 0 ? 0 : 1; const int n = I_IN + I_UQ + I_UKV + (l == 1 ? I_OUT : 0);
        for (int it = gw; it < n; it += NGW) { int r = it;
            if (r < I_IN) { transpose_item64(F.w_in + (size_t)l * DM * INW, DM, INW, WSP(bf16_t, WS_WIN) + (size_t)l * INP * DM, nullptr, 1, scr, r, F.lane); continue; } r -= I_IN;
            if (r < I_UQ) { transpose_item64(F.w_uq + (size_t)l * 384 * QW, 384, QW, WSP(bf16_t, WS_WUQ) + (size_t)l * QWP * 384, F.g_q + l * 384, 0, scr, r, F.lane); continue; } r -= I_UQ;
            if (r < I_UKV) { transpose_item64(F.w_ukv + (size_t)l * 256 * KVW, 256, KVW, WSP(bf16_t, WS_WUKV) + (size_t)l * KVW * 256, F.g_kv + l * 256, 0, scr, r, F.lane); continue; } r -= I_UKV;
            transpose_item64(F.w_out + (size_t)l * DM * DM, DM, DM, WSP(bf16_t, WS_WOUT) + (size_t)l * DM * DM, nullptr, 0, scr, r, F.lane); }
        const u32x4 z = {0u, 0u, 0u, 0u};
        { u32x4* p0 = (u32x4*)(WSP(bf16_t, WS_WIN) + ((size_t)l * INP + INW) * DM); const size_t n0 = (size_t)(INP - INW) * DM * 2 / 16; for (size_t i = (size_t)wi * NTHR + F.tid; i < n0; i += (size_t)nw * NTHR) p0[i] = z;
          u32x4* p1 = (u32x4*)(WSP(bf16_t, WS_WUQ) + ((size_t)l * QWP + QW) * 384); const size_t n1 = (size_t)(QWP - QW) * 384 * 2 / 16; for (size_t i = (size_t)wi * NTHR + F.tid; i < n1; i += (size_t)nw * NTHR) p1[i] = z; }
    } else if (set == 1) {
        for (int it = gw; it < I_OUT; it += NGW) transpose_item64(F.w_out, DM, DM, WSP(bf16_t, WS_WOUT), nullptr, 0, scr, it, F.lane);
    } else {
        for (int it = gw; it < 2 * I_G + I_D; it += NGW) { int r = it;
            if (r < I_G) { transpose_item64(F.w_gate, DM, DFF, WSP(bf16_t, WS_WGU), nullptr, 2, scr, r, F.lane); continue; } r -= I_G;
            if (r < I_G) { transpose_item64(F.w_up, DM, DFF, WSP(bf16_t, WS_WGU), nullptr, 3, scr, r, F.lane); continue; } r -= I_G;
            transpose_item64(F.w_down, DFF, DM, WSP(bf16_t, WS_WD), nullptr, 0, scr, r, F.lane); }
    }
    __syncthreads();
}
__device__ __forceinline__ void p_prologue(Frame& F) {
    const bool two = F.G == 256;
    if (!two || F.vcu < 192) mod_gemv(F, 0, F.vcu, two ? 192 : F.G);
    if (!two || F.vcu >= 192) for (int set_ = 0; set_ < 2; ++set_) convert_set(F, set_, two ? F.vcu - 192 : F.vcu, two ? 64 : F.G);
    if (F.vcu == 0) { for (int i = F.tid; i < 64 * 8; i += NTHR) { const int pos = i >> 3, f = i & 7; const float inv = powf(10000.f, -(float)f / 8.f); const float ang = (float)pos * inv;
            WSP(f32x2, WS_MISC + MISC_ROPE)[i] = (f32x2){cosf(ang), sinf(ang)}; } }
    for (int i = F.vcu * NTHR + F.tid; i < 2 * 4 * 128 * 128 / 2; i += F.G * NTHR) { const f32x2 v = ((const f32x2*)F.w_sgu)[i]; WSP(unsigned, WS_WSGU)[i] = cvtpk(v.x, v.y); }
}
__device__ __forceinline__ bool tail_worker(int nwg, int G, int c, int& wi, int& nw) {
    const int rounds = (nwg + G - 1) / G, first = nwg - (rounds - 1) * G;
    if (first >= G) { wi = c; nw = G; return true; }
    if (c < first) return false;
    wi = c - first; nw = G - first; return true;
}
__device__ __forceinline__ void p_moe_weights(Frame& F) {
    __syncthreads();
    LAS float* scr = (LAS float*)(F.lds + F.wave * 16640);
    const int gw = F.vcu * NWAVES + F.wave, NGW = F.G * NWAVES;
    constexpr int I_G = 16 * 22, I_D = 22 * 16, PER_E = 2 * I_G + I_D;
    for (int it = gw; it < 8 * PER_E; it += NGW) {
        const int e = it / PER_E; int r = it - e * PER_E;
        bf16_t* gu = WSP(bf16_t, WS_MOEW_GU) + (size_t)e * 2 * DFE * DM;
        if (r < I_G) { transpose_item64(F.w_gate_e + (size_t)e * DM * DFE, DM, DFE, gu, nullptr, 2, scr, r, F.lane); continue; } r -= I_G;
        if (r < I_G) { transpose_item64(F.w_up_e + (size_t)e * DM * DFE, DM, DFE, gu, nullptr, 3, scr, r, F.lane); continue; } r -= I_G;
        transpose_item64(F.w_down_e + (size_t)e * DFE * DM, DFE, DM, WSP(bf16_t, WS_MOEW_D) + (size_t)e * DM * DFE, nullptr, 0, scr, r, F.lane);
    }
    __syncthreads();
}

template <bool ROUTE>
__device__ __forceinline__ void p_norm(Frame& F, int l, int which, int nrows, const float* srcL, const float* srcC, const float* slab = nullptr, const float* slabgate = nullptr) {
    const float* mod = WSP(float, WS_MOD) + (size_t)l * 9 * 6144;
    const float* g = (which == 0 ? F.g_mix : F.g_ffn) + l * DM;
    bf16_t* H = WSP(bf16_t, WS_H);
    LAS int* lcnt = (LAS int*)(F.lds + 32768);
    LAS int* rec = (LAS int*)(F.lds + 32768 + 64);
    int nrec = 0;
    if (ROUTE) { LAS float* wr = (LAS float*)F.lds; for (int i = F.tid; i < DM * 8; i += NTHR) wr[i] = F.w_router[i]; if (F.tid < 16) lcnt[F.tid] = 0; __syncthreads(); }
    const int gw = F.vcu * NWAVES + F.wave, NGW = F.G * NWAVES;
    for (int row = gw; row < nrows; row += NGW) {
        const bool isc = row >= NLAT; const int b = isc ? 8 : (row >> 11);
        const float* xr = isc ? srcC + (size_t)(row - NLAT) * DM : srcL + (size_t)row * DM;
        f32x4 v[4]; float s = 0.f;
#pragma unroll
        for (int j = 0; j < 4; ++j) v[j] = *(const f32x4*)(xr + 256 * j + 4 * F.lane);
        if (slab && isc) {
#pragma unroll
            for (int j = 0; j < 4; ++j) { const size_t o_ = (size_t)(row - NLAT) * DM + 256 * j + 4 * F.lane; const f32x4 gt = *(const f32x4*)(slabgate + 256 * j + 4 * F.lane);
                const f32x4 p0 = *(const f32x4*)(slab + o_), p1 = *(const f32x4*)(slab + (size_t)NCTX * DM + o_), p2 = *(const f32x4*)(slab + (size_t)2 * NCTX * DM + o_), p3 = *(const f32x4*)(slab + (size_t)3 * NCTX * DM + o_);
                v[j] = v[j] + gt * ((p0 + p1) + (p2 + p3)); } }
#pragma unroll
        for (int j = 0; j < 4; ++j) s += (v[j].x * v[j].x + v[j].y * v[j].y) + (v[j].z * v[j].z + v[j].w * v[j].w);
        const float rstd = rsqrtf(wave_sum(s) * (1.f / DM) + EPS);
        const float* sh = mod + (size_t)b * 6144 + (which * 3) * DM; const float* sc = sh + DM;
        float lg[8];
        if (ROUTE) {
#pragma unroll
            for (int e = 0; e < 8; ++e) lg[e] = 0.f; }
#pragma unroll
        for (int j = 0; j < 4; ++j) { const int k = 256 * j + 4 * F.lane;
            const f32x4 gg = *(const f32x4*)(g + k), s1 = *(const f32x4*)(sc + k), s0 = *(const f32x4*)(sh + k);
            f32x4 h = (v[j] * rstd) * gg * (s1 + 1.f) + s0;
            u32x2 w; w.x = cvtpk(h.x, h.y); w.y = cvtpk(h.z, h.w);
            *(u32x2*)(H + (size_t)row * DM + k) = w;
            if (ROUTE) { const LAS float* wr = (const LAS float*)F.lds + k * 8;
#pragma unroll
                for (int i = 0; i < 4; ++i) { const f32x4 w0 = *(const LAS f32x4*)(wr + 8 * i), w1 = *(const LAS f32x4*)(wr + 8 * i + 4); const float hv = h[i];
                    lg[0] += hv * w0.x; lg[1] += hv * w0.y; lg[2] += hv * w0.z; lg[3] += hv * w0.w; lg[4] += hv * w1.x; lg[5] += hv * w1.y; lg[6] += hv * w1.z; lg[7] += hv * w1.w; }
                asm volatile("" ::: "memory"); }
        }
        if (ROUTE) {
#pragma unroll
            for (int e = 0; e < 8; ++e) lg[e] = wave_sum(lg[e]);
            int i0 = 0; float m0 = lg[0];
#pragma unroll
            for (int e = 1; e < 8; ++e) if (lg[e] > m0) { m0 = lg[e]; i0 = e; }
            int i1 = -1; float m1 = -3.0e38f;
#pragma unroll
            for (int e = 0; e < 8; ++e) if (e != i0 && lg[e] > m1) { m1 = lg[e]; i1 = e; }
            const float w1 = 1.f / (1.f + __expf(m0 - m1)), w0 = 1.f - w1;
            if (F.lane == 0) { float* tw = WSP(float, WS_MISC + MISC_TOPW);
                const int p0 = __hip_atomic_fetch_add(lcnt + i0, 1, __ATOMIC_RELAXED, __HIP_MEMORY_SCOPE_WORKGROUP), p1 = __hip_atomic_fetch_add(lcnt + i1, 1, __ATOMIC_RELAXED, __HIP_MEMORY_SCOPE_WORKGROUP);
                LAS int* r = rec + (F.wave * 16 + nrec) * 4; r[0] = row; r[1] = i0 | (i1 << 8); r[2] = p0; r[3] = p1; tw[row * 2] = w0; tw[row * 2 + 1] = w1; }
            ++nrec;
        }
    }
    if (ROUTE) {
        __syncthreads();
        if (F.tid < 8) lcnt[8 + F.tid] = (int)atomicAdd(WSP(unsigned, WS_CTL) + CW_CNT + 64 * F.tid, (unsigned)lcnt[F.tid]);
        __syncthreads();
        int* list = WSP(int, WS_LIST);
        if (F.lane < nrec) { const LAS int* r = rec + (F.wave * 16 + F.lane) * 4; const int row = r[0], i0 = r[1] & 255, i1 = r[1] >> 8;
            list[i0 * NLAT + lcnt[8 + i0] + r[2]] = row * 2; list[i1 * NLAT + lcnt[8 + i1] + r[3]] = row * 2 + 1; }
        __syncthreads();
    }
}
__device__ __forceinline__ void p_final(Frame& F) {
    const float* mod = WSP(float, WS_MOD) + (size_t)1 * 9 * 6144; const bf16_t* Y = WSP(bf16_t, WS_Y);
    const int gw = F.vcu * NWAVES + F.wave, NGW = F.G * NWAVES;
    for (int row = gw; row < NLAT; row += NGW) {
        const int b = row >> 11; float* xr = F.out + (size_t)row * DM; const float* gt = mod + (size_t)b * 6144 + 5 * DM;
        f32x4 v[4]; float s = 0.f;
#pragma unroll
        for (int j = 0; j < 4; ++j) { const int k = 256 * j + 4 * F.lane; const f32x4 xv = *(const f32x4*)(xr + k), gv = *(const f32x4*)(gt + k);
            const u32x2 a = *(const u32x2*)(Y + (size_t)(2 * row) * DM + k), c = *(const u32x2*)(Y + (size_t)(2 * row + 1) * DM + k);
            f32x4 y; y.x = bflo(a.x) + bflo(c.x); y.y = bfhi(a.x) + bfhi(c.x); y.z = bflo(a.y) + bflo(c.y); y.w = bfhi(a.y) + bfhi(c.y);
            v[j] = xv + gv * y; s += (v[j].x * v[j].x + v[j].y * v[j].y) + (v[j].z * v[j].z + v[j].w * v[j].w); }
        const float rstd = rsqrtf(wave_sum(s) * (1.f / DM) + EPS);
#pragma unroll
        for (int j = 0; j < 4; ++j) { const int k = 256 * j + 4 * F.lane; *(f32x4*)(xr + k) = (v[j] * rstd) * *(const f32x4*)(F.g_final + k); }
    }
}
constexpr int LP = 272;
__device__ __forceinline__ void chunk_rows(int u, int& row0, bool& isc) {
    if (u < 128) { row0 = (u >> 4) * SEQ + (u & 15) * 128; isc = false; } else { const int uu = u - 128; row0 = NLAT + (uu >> 1) * CTXL + (uu & 1) * 128; isc = true; }
}
__device__ __forceinline__ void krope_unit(Frame& F, int u) {
    int row0; bool isc; chunk_rows(u, row0, isc);
    const bf16_t* P = WSP(bf16_t, WS_P);
    if (F.tid < 128) {
        const int row = row0 + F.tid; const u32x4* src = (const u32x4*)(P + (size_t)row * INP + PC_KR);
        u32x4 q[4];
#pragma unroll
        for (int i = 0; i < 4; ++i) q[i] = src[i];
        if (!isc) {
            const int tok = row & (SEQ - 1); const f32x2* rt = WSP(f32x2, WS_MISC + MISC_ROPE);
            float v[32];
#pragma unroll
            for (int i = 0; i < 4; ++i) { v[8 * i] = bflo(q[i].x); v[8 * i + 1] = bfhi(q[i].x); v[8 * i + 2] = bflo(q[i].y); v[8 * i + 3] = bfhi(q[i].y); v[8 * i + 4] = bflo(q[i].z); v[8 * i + 5] = bfhi(q[i].z); v[8 * i + 6] = bflo(q[i].w); v[8 * i + 7] = bfhi(q[i].w); }
#pragma unroll
            for (int ax = 0; ax < 2; ++ax) { const int pos = ax == 0 ? (tok >> 6) : (tok & 63);
#pragma unroll
                for (int f = 0; f < 8; ++f) { const f32x2 cs = rt[pos * 8 + f]; const float t1 = v[16 * ax + f], t2 = v[16 * ax + 8 + f];
                    v[16 * ax + f] = t1 * cs.x - t2 * cs.y; v[16 * ax + 8 + f] = t1 * cs.y + t2 * cs.x; } }
#pragma unroll
            for (int i = 0; i < 4; ++i) { q[i].x = cvtpk(v[8 * i], v[8 * i + 1]); q[i].y = cvtpk(v[8 * i + 2], v[8 * i + 3]); q[i].z = cvtpk(v[8 * i + 4], v[8 * i + 5]); q[i].w = cvtpk(v[8 * i + 6], v[8 * i + 7]); }
        }
        u32x4* dst = (u32x4*)(WSP(bf16_t, WS_KR) + (size_t)row * 32);
#pragma unroll
        for (int i = 0; i < 4; ++i) dst[i] = q[i];
    }
}
__device__ __forceinline__ void sgu_unit(Frame& F, int l, int u) {
    int row0; bool isc; chunk_rows(u, row0, isc);
    const bf16_t* P = WSP(bf16_t, WS_P); bf16_t* CAT = WSP(bf16_t, WS_CAT);
    LAS unsigned char* VT = F.lds;
    LAS unsigned char* WB = F.lds + 256 * LP;
    const int w = F.wave, lane = F.lane;
    {
        const f32x4 gs = *(const f32x4*)(F.g_sgu + l * 256 + 4 * lane), bs = *(const f32x4*)(F.beta_sgu + l * 256 + 4 * lane);
#pragma unroll
        for (int grp = 0; grp < 2; ++grp) {
            const int s0 = 16 * w + 8 * grp;
            float v[8][4];
#pragma unroll
            for (int tt = 0; tt < 8; ++tt) { const u32x2 r = *(const u32x2*)(P + (size_t)(row0 + s0 + tt) * INP + PC_V + 4 * lane);
                v[tt][0] = gelu_tanh(bflo(r.x)); v[tt][1] = gelu_tanh(bfhi(r.x)); v[tt][2] = gelu_tanh(bflo(r.y)); v[tt][3] = gelu_tanh(bfhi(r.y)); }
#pragma unroll
            for (int tt = 0; tt < 8; ++tt) {
                const float mu = wave_sum((v[tt][0] + v[tt][1]) + (v[tt][2] + v[tt][3])) * (1.f / 256.f);
                float d0 = v[tt][0] - mu, d1 = v[tt][1] - mu, d2 = v[tt][2] - mu, d3 = v[tt][3] - mu;
                const float rstd = rsqrtf(wave_sum((d0 * d0 + d1 * d1) + (d2 * d2 + d3 * d3)) * (1.f / 256.f) + EPS);
                v[tt][0] = d0 * rstd * gs.x + bs.x; v[tt][1] = d1 * rstd * gs.y + bs.y; v[tt][2] = d2 * rstd * gs.z + bs.z; v[tt][3] = d3 * rstd * gs.w + bs.w; }
#pragma unroll
            for (int i = 0; i < 4; ++i) { u32x4 o; o.x = cvtpk(v[0][i], v[1][i]); o.y = cvtpk(v[2][i], v[3][i]); o.z = cvtpk(v[4][i], v[5][i]); o.w = cvtpk(v[6][i], v[7][i]);
                *(LAS u32x4*)(VT + (4 * lane + i) * LP + s0 * 2) = o; }
        }
    }
    const bf16_t* Wg = WSP(bf16_t, WS_WSGU) + (size_t)l * 4 * 128 * 128;
#define SGU_STAGE_W(h, buf) do { _Pragma("unroll") for (int _i = 0; _i < 4; ++_i) { const int q_ = F.tid + NTHR * _i, r_ = q_ >> 4, c_ = q_ & 15; \
        *(LAS u32x4*)(WB + (buf) * 128 * LP + r_ * LP + c_ * 16) = *(const u32x4*)(Wg + (size_t)(h) * 16384 + r_ * 128 + c_ * 8); } } while (0)
    SGU_STAGE_W(0, 0);
    u32x2 upre[4][4];
    { const int t_ = 16 * w + (lane & 15), row_ = row0 + t_;
#pragma unroll
        for (int h = 0; h < 4; ++h)
#pragma unroll
            for (int dt = 0; dt < 4; ++dt) upre[h][dt] = *(const u32x2*)(P + (size_t)row_ * INP + PC_U + h * 64 + dt * 16 + 4 * (lane >> 4)); }
    __syncthreads();
    f32x4 acc[4][4];
#pragma unroll
    for (int h = 0; h < 4; ++h)
#pragma unroll
        for (int dt = 0; dt < 4; ++dt) acc[h][dt] = (f32x4){0.f, 0.f, 0.f, 0.f};
    const int fr = lane & 15, fq = lane >> 4;
#pragma unroll
    for (int h = 0; h < 4; ++h) {
        if (h + 1 < 4) SGU_STAGE_W(h + 1, (h + 1) & 1);
        const LAS unsigned char* Wh = WB + (h & 1) * 128 * LP;
#pragma unroll
        for (int ks = 0; ks < 4; ++ks) {
            const bf16x8 bw = *(const LAS bf16x8*)(Wh + (16 * w + fr) * LP + (32 * ks + 8 * fq) * 2);
#pragma unroll
            for (int dt = 0; dt < 4; ++dt) { const bf16x8 av = *(const LAS bf16x8*)(VT + (h * 64 + dt * 16 + fr) * LP + (32 * ks + 8 * fq) * 2);
                acc[h][dt] = MFMA16(av, bw, acc[h][dt]); }
        }
        __syncthreads();
    }
#undef SGU_STAGE_W
    { const int t = 16 * w + fr, row = row0 + t;
#pragma unroll
        for (int h = 0; h < 4; ++h) { const float bsv = F.b_sgu[(l * 4 + h) * 128 + t];
#pragma unroll
            for (int dt = 0; dt < 4; ++dt) { const int c = h * 64 + dt * 16 + 4 * fq; const u32x2 r = upre[h][dt];
                const float o0 = gelu_tanh(bflo(r.x)) * (acc[h][dt][0] + bsv), o1 = gelu_tanh(bfhi(r.x)) * (acc[h][dt][1] + bsv), o2 = gelu_tanh(bflo(r.y)) * (acc[h][dt][2] + bsv), o3 = gelu_tanh(bfhi(r.y)) * (acc[h][dt][3] + bsv);
                u32x2 o; o.x = cvtpk(o0, o1); o.y = cvtpk(o2, o3); *(u32x2*)(CAT + (size_t)row * DM + c) = o; } } }
    __syncthreads();
}

__device__ __forceinline__ void ssd_local_unit(Frame& F, int l, int u) {
    int b, c, g, row0, seq0, seqlen; bool isc;
    if (u < 256) { b = u >> 5; c = (u >> 1) & 15; g = u & 1; row0 = b * SEQ + c * 128; seq0 = b * SEQ; seqlen = SEQ; isc = false; }
    else { const int uu = u - 256; b = uu >> 2; c = (uu >> 1) & 1; g = uu & 1; row0 = NLAT + b * CTXL + c * 128; seq0 = NLAT + b * CTXL; seqlen = CTXL; isc = true; }
    const bf16_t* P = WSP(bf16_t, WS_P);
    LAS unsigned char* R1 = F.lds;
    LAS unsigned char* R2 = F.lds + 128 * LP;
    LAS unsigned char* XT = F.lds + 256 * LP;
    LAS float* dtv = (LAS float*)(F.lds + 448 * LP);
    LAS float* acsv = dtv + 768;
    LAS float* wv = acsv + 768;
    const int w = F.wave, lane = F.lane, tid = F.tid, fr = lane & 15, fq = lane >> 4;
    const float* cw = F.conv_w + (size_t)l * 5 * 896; const float* cb = F.conv_b + l * 896;
    LAS float* wlb = (LAS float*)(F.lds + 448 * LP + 9216);
    if (tid < 56) { const int chx0 = tid < 24 ? g * 192 + 8 * tid : (tid < 40 ? 384 + g * 128 + 8 * (tid - 24) : 640 + g * 128 + 8 * (tid - 40));
#pragma unroll
        for (int k = 0; k < 5; ++k) { *(LAS f32x4*)(wlb + tid * 48 + 8 * k) = *(const f32x4*)(cw + k * 896 + chx0); *(LAS f32x4*)(wlb + tid * 48 + 8 * k + 4) = *(const f32x4*)(cw + k * 896 + chx0 + 4); }
        *(LAS f32x4*)(wlb + tid * 48 + 40) = *(const f32x4*)(cb + chx0); *(LAS f32x4*)(wlb + tid * 48 + 44) = *(const f32x4*)(cb + chx0 + 4); }
    __syncthreads();
    if (tid < 448) {
        const int cg = tid % 56, seg = tid / 56;
        int pcol, role, lch;
        if (cg < 24) { role = 0; lch = 8 * cg; pcol = PC_X + g * 192 + lch; }
        else if (cg < 40) { role = 1; lch = 8 * (cg - 24); pcol = PC_B + g * 128 + lch; }
        else { role = 2; lch = 8 * (cg - 40); pcol = PC_C + g * 128 + lch; }
        const LAS float* wl = wlb + cg * 48;
#pragma unroll 1
        for (int hb = 0; hb < 2; ++hb) {
            const int t0 = 16 * seg + 8 * hb;
            u32x4 rows[12];
#pragma unroll
            for (int i = 0; i < 12; ++i) { const int grow = row0 + t0 - 2 + i;
                if (i >= 2 && i < 10) rows[i] = *(const u32x4*)(P + (size_t)grow * INP + pcol);
                else { const bool ok = grow >= seq0 && grow < seq0 + seqlen; const int gcl = i < 2 ? (grow < seq0 ? seq0 : grow) : (grow >= seq0 + seqlen ? seq0 + seqlen - 1 : grow);
                    const u32x4 v_ = *(const u32x4*)(P + (size_t)gcl * INP + pcol); rows[i] = ok ? v_ : (u32x4){0u, 0u, 0u, 0u}; } }
            unsigned pk[8][4];
#pragma unroll
            for (int o2 = 0; o2 < 4; ++o2) {
                float y[2][8];
#pragma unroll
                for (int e = 0; e < 2; ++e) { const int o = 2 * o2 + e; f32x4 ya = *(const LAS f32x4*)(wl + 40), yb = *(const LAS f32x4*)(wl + 44);
#pragma unroll
                    for (int k = 0; k < 5; ++k) { const u32x4 r = rows[o + k]; const f32x4 xa = {bflo(r.x), bfhi(r.x), bflo(r.y), bfhi(r.y)}, xb = {bflo(r.z), bfhi(r.z), bflo(r.w), bfhi(r.w)};
                        ya += *(const LAS f32x4*)(wl + 8 * k) * xa; yb += *(const LAS f32x4*)(wl + 8 * k + 4) * xb; }
#pragma unroll
                    for (int c8 = 0; c8 < 4; ++c8) { y[e][c8] = silu_f(ya[c8]); y[e][4 + c8] = silu_f(yb[c8]); }
                    if (role != 0) { u32x4 st; st.x = cvtpk(y[e][0], y[e][1]); st.y = cvtpk(y[e][2], y[e][3]); st.z = cvtpk(y[e][4], y[e][5]); st.w = cvtpk(y[e][6], y[e][7]);
                        *(u32x4*)((role == 1 ? R2 : R1) + (t0 + o) * LP + lch * 2) = st;
                        if (role == 2) *(u32x4*)(WSP(bf16_t, WS_CC) + (size_t)(row0 + t0 + o) * 256 + g * 128 + lch) = st; }
                }
#pragma unroll
                for (int c8 = 0; c8 < 8; ++c8) pk[c8][o2] = cvtpk(y[0][c8], y[1][c8]);
            }
            if (role == 0) {
#pragma unroll
                for (int c8 = 0; c8 < 8; ++c8) *(LAS u32x4*)(XT + (lch + c8) * LP + t0 * 2) = (u32x4){pk[c8][0], pk[c8][1], pk[c8][2], pk[c8][3]}; }
        }
    }
    else {
        bf16_t draw[6][2];
#pragma unroll
        for (int q = 0; q < 6; ++q) { const int d = q / 3, h = g * 3 + q % 3; const int e0 = 2 * lane, t0 = d == 0 ? e0 : 127 - e0, t1 = d == 0 ? e0 + 1 : 126 - e0;
            draw[q][0] = P[(size_t)(row0 + t0) * INP + PC_DT + d * 6 + h]; draw[q][1] = P[(size_t)(row0 + t1) * INP + PC_DT + d * 6 + h]; }
        asm volatile("" ::: "memory");
#pragma unroll
        for (int q = 0; q < 6; ++q) { const int d = q / 3, j = q % 3, h = g * 3 + j;
            const float a = -__expf(F.a_log[l * 12 + d * 6 + h]), bias = F.dt_bias[l * 12 + d * 6 + h];
            const int e0 = 2 * lane, e1 = 2 * lane + 1, t0 = d == 0 ? e0 : 127 - e0, t1 = d == 0 ? e1 : 127 - e1;
            const float dt0 = softplus_f(bf1(draw[q][0]) + bias), dt1 = softplus_f(bf1(draw[q][1]) + bias);
            const float x0 = dt0 * a, x1 = dt1 * a; float s = x0 + x1;
#pragma unroll
            for (int off = 1; off < 64; off <<= 1) { const float t = __shfl_up(s, off); if (lane >= off) s += t; }
            const float a1v = s, a0v = s - x1, tot = __shfl(s, 63);
            dtv[q * 128 + t0] = dt0; dtv[q * 128 + t1] = dt1; acsv[q * 128 + t0] = a0v; acsv[q * 128 + t1] = a1v;
            wv[q * 128 + t0] = __expf(tot - a0v) * dt0; wv[q * 128 + t1] = __expf(tot - a1v) * dt1;
            float* ACS = WSP(float, WS_ACS); ACS[(size_t)(row0 + t0) * 12 + d * 6 + h] = a0v; ACS[(size_t)(row0 + t1) * 12 + d * 6 + h] = a1v;
            if (lane == 0) { const int pos = isc ? (d == 0 ? c : 1 - c) : (d == 0 ? 2 + c : 17 - c); WSP(float, WS_MISC + MISC_DEC)[((b * 2 + d) * NPOS + pos) * 6 + h] = __expf(tot); }
        }
    }
    __syncthreads();
    f32x4 G[8];
#pragma unroll
    for (int t = 0; t < 8; ++t) G[t] = (f32x4){0.f, 0.f, 0.f, 0.f};
#pragma unroll
    for (int ks = 0; ks < 4; ++ks) { const bf16x8 cf = *(const LAS bf16x8*)(R1 + (16 * w + fr) * LP + (32 * ks + 8 * fq) * 2);
#pragma unroll
        for (int t = 0; t < 8; ++t) { const bf16x8 bfm = *(const LAS bf16x8*)(R2 + (16 * t + fr) * LP + (32 * ks + 8 * fq) * 2); G[t] = MFMA16(bfm, cf, G[t]); } }
    __syncthreads();
    if (tid < 256) { const int sb = tid >> 4, nb = tid & 15; u32x4 r[8];
#pragma unroll
        for (int i = 0; i < 8; ++i) r[i] = *(const LAS u32x4*)(R2 + (8 * sb + i) * LP + nb * 16);
#pragma unroll
        for (int j = 0; j < 8; ++j) { u32x4 o;
            if ((j & 1) == 0) { o.x = (r[0][j >> 1] & 0xffffu) | (r[1][j >> 1] << 16); o.y = (r[2][j >> 1] & 0xffffu) | (r[3][j >> 1] << 16); o.z = (r[4][j >> 1] & 0xffffu) | (r[5][j >> 1] << 16); o.w = (r[6][j >> 1] & 0xffffu) | (r[7][j >> 1] << 16); }
            else { o.x = (r[0][j >> 1] >> 16) | (r[1][j >> 1] & 0xffff0000u); o.y = (r[2][j >> 1] >> 16) | (r[3][j >> 1] & 0xffff0000u); o.z = (r[4][j >> 1] >> 16) | (r[5][j >> 1] & 0xffff0000u); o.w = (r[6][j >> 1] >> 16) | (r[7][j >> 1] & 0xffff0000u); }
            *(LAS u32x4*)(R1 + (8 * nb + j) * LP + sb * 16) = o; } }
    __syncthreads();
    LAS unsigned char* Mw = R2 + w * 16 * LP;
    bf16_t* ST = WSP(bf16_t, WS_ST); float* YP = WSP(float, WS_YP);
    const bool needy = !(isc && l == DEPTH - 1);
    const int lrow = 16 * w + fr;
#pragma unroll 1
    for (int j = 0; j < 3; ++j) {
        const int h = g * 3 + j;
        f32x4 ay[4];
#pragma unroll
        for (int pt = 0; pt < 4; ++pt) ay[pt] = (f32x4){0.f, 0.f, 0.f, 0.f};
#pragma unroll 1
        for (int d = 0; d < 2; ++d) {
            const int q = d * 3 + j; const float al = acsv[q * 128 + lrow];
            if (needy) {
#pragma unroll
            for (int t = 0; t < 8; ++t) { const int s4 = 16 * t + 4 * fq; u32x2 o = {0u, 0u};
                if (d == 0 ? (t <= w) : (t >= w)) {
                    const f32x4 as = *(const LAS f32x4*)(acsv + q * 128 + s4), ds = *(const LAS f32x4*)(dtv + q * 128 + s4);
                    float mv[4];
#pragma unroll
                    for (int r = 0; r < 4; ++r) { const int s = s4 + r; const bool ok = (t != w) || (d == 0 ? (s <= lrow) : (s >= lrow)); mv[r] = ok ? G[t][r] * __expf(al - as[r]) * ds[r] : 0.f; }
                    o.x = cvtpk(mv[0], mv[1]); o.y = cvtpk(mv[2], mv[3]); }
                *(LAS u32x2*)(Mw + fr * LP + s4 * 2) = o; }
            LDS_WAIT();
#pragma unroll
            for (int ks = 0; ks < 4; ++ks) if (d == 0 ? (2 * ks <= w) : (2 * ks + 1 >= w)) { const bf16x8 mf = *(const LAS bf16x8*)(Mw + fr * LP + (32 * ks + 8 * fq) * 2);
#pragma unroll
                for (int pt = 0; pt < 4; ++pt) { const bf16x8 xf = *(const LAS bf16x8*)(XT + (j * 64 + 16 * pt + fr) * LP + (32 * ks + 8 * fq) * 2); ay[pt] = MFMA16(xf, mf, ay[pt]); } }
            }
            f32x4 as4[4];
#pragma unroll
            for (int pt = 0; pt < 4; ++pt) as4[pt] = (f32x4){0.f, 0.f, 0.f, 0.f};
#pragma unroll
            for (int ks = 0; ks < 4; ++ks) { const u32x4 raw = *(const LAS u32x4*)(R1 + (16 * w + fr) * LP + (32 * ks + 8 * fq) * 2);
                const f32x4 wa = *(const LAS f32x4*)(wv + q * 128 + 32 * ks + 8 * fq), wb = *(const LAS f32x4*)(wv + q * 128 + 32 * ks + 8 * fq + 4);
                u32x4 sc; sc.x = cvtpk(bflo(raw.x) * wa.x, bfhi(raw.x) * wa.y); sc.y = cvtpk(bflo(raw.y) * wa.z, bfhi(raw.y) * wa.w); sc.z = cvtpk(bflo(raw.z) * wb.x, bfhi(raw.z) * wb.y); sc.w = cvtpk(bflo(raw.w) * wb.z, bfhi(raw.w) * wb.w);
                const bf16x8 bsf = __builtin_bit_cast(bf16x8, sc);
#pragma unroll
                for (int pt = 0; pt < 4; ++pt) { const bf16x8 xf = *(const LAS bf16x8*)(XT + (j * 64 + 16 * pt + fr) * LP + (32 * ks + 8 * fq) * 2); as4[pt] = MFMA16(bsf, xf, as4[pt]); } }
            { const int pos = isc ? (d == 0 ? c : 1 - c) : (d == 0 ? 2 + c : 17 - c); bf16_t* sp = ST + ((size_t)((b * 2 + d) * NPOS + pos) * 6 + h) * 8192;
#pragma unroll
                for (int pt = 0; pt < 4; ++pt) { u32x2 o; o.x = cvtpk(as4[pt][0], as4[pt][1]); o.y = cvtpk(as4[pt][2], as4[pt][3]); *(u32x2*)(sp + (16 * pt + fr) * 128 + 16 * w + 4 * fq) = o; } }
        }
        if (needy) { const float skip = F.d_skip[l * 6 + h];
#pragma unroll
            for (int pt = 0; pt < 4; ++pt) { f32x4 o;
#pragma unroll
                for (int r = 0; r < 4; ++r) o[r] = ay[pt][r] + skip * bf1(*(const LAS bf16_t*)(XT + (j * 64 + 16 * pt + 4 * fq + r) * LP + lrow * 2));
                *(f32x4*)(YP + (size_t)(row0 + lrow) * 384 + h * 64 + 16 * pt + 4 * fq) = o; } }
    }
    __syncthreads();
}

__device__ __forceinline__ void ssd_scan(Frame& F) {
    bf16_t* ST = WSP(bf16_t, WS_ST); const float* DEC = WSP(float, WS_MISC + MISC_DEC);
    for (int gt = F.vcu * NTHR + F.tid; gt < 96 * 1024; gt += F.G * NTHR) {
        const int combo = gt >> 10, e8 = gt & 1023, bd = combo / 6, h = combo - bd * 6;
        u32x4 st[17]; float dec[17];
#pragma unroll
        for (int q = 0; q < 17; ++q) { const size_t sidx = (size_t)(bd * NPOS + q) * 6 + h; st[q] = *(const u32x4*)(ST + sidx * 8192 + e8 * 8); dec[q] = DEC[sidx]; }
        float hv[8];
#pragma unroll
        for (int i = 0; i < 8; ++i) hv[i] = 0.f;
#pragma unroll
        for (int q = 0; q < 17; ++q) { const size_t sidx = (size_t)(bd * NPOS + q) * 6 + h; const float dq = dec[q];
            hv[0] = dq * hv[0] + bflo(st[q].x); hv[1] = dq * hv[1] + bfhi(st[q].x); hv[2] = dq * hv[2] + bflo(st[q].y); hv[3] = dq * hv[3] + bfhi(st[q].y);
            hv[4] = dq * hv[4] + bflo(st[q].z); hv[5] = dq * hv[5] + bfhi(st[q].z); hv[6] = dq * hv[6] + bflo(st[q].w); hv[7] = dq * hv[7] + bfhi(st[q].w);
            u32x4 o; o.x = cvtpk(hv[0], hv[1]); o.y = cvtpk(hv[2], hv[3]); o.z = cvtpk(hv[4], hv[5]); o.w = cvtpk(hv[6], hv[7]);
            *(u32x4*)(ST + sidx * 8192 + e8 * 8) = o; }
    }
}

__device__ __forceinline__ void ssd_final_unit(Frame& F, int l, int u) {
    int row0; bool isc; chunk_rows(u, row0, isc);
    const int b = isc ? ((u - 128) >> 1) : (u >> 4), c = isc ? ((u - 128) & 1) : (u & 15);
    constexpr int CPITCH = 528;
    LAS unsigned char* Cs = F.lds;
    LAS unsigned char* Hs = F.lds + 128 * CPITCH;
    const int w = F.wave, lane = F.lane, tid = F.tid, fr = lane & 15, fq = lane >> 4;
    const bf16_t* CC = WSP(bf16_t, WS_CC); const bf16_t* ST = WSP(bf16_t, WS_ST); const float* ACS = WSP(float, WS_ACS);
#pragma unroll
    for (int i = 0; i < 8; ++i) { const int q = tid + NTHR * i, r = q >> 5, cc = q & 31; *(LAS u32x4*)(Cs + r * CPITCH + cc * 16) = *(const u32x4*)(CC + (size_t)(row0 + r) * 256 + cc * 8); }
    const int lrow = 16 * w + fr, row = row0 + lrow;
    const int hp = tid >> 3, hn0 = (tid & 7) * 16;
    const float* YP = WSP(float, WS_YP); const bf16_t* P = WSP(bf16_t, WS_P); bf16_t* CAT = WSP(bf16_t, WS_CAT);
    float ss = 0.f;
    const f32x4 ac0 = *(const f32x4*)(ACS + (size_t)row * 12), ac1 = *(const f32x4*)(ACS + (size_t)row * 12 + 4), ac2 = *(const f32x4*)(ACS + (size_t)row * 12 + 8);
    const float acv[12] = {ac0[0], ac0[1], ac0[2], ac0[3], ac1[0], ac1[1], ac1[2], ac1[3], ac2[0], ac2[1], ac2[2], ac2[3]};
    u32x4 hpre[2][2][2]; f32x4 ypre[2][4]; u32x2 zpre[2][4];
#define SSDF_LOAD(hh, S_) do { \
        _Pragma("unroll") for (int d = 0; d < 2; ++d) { const int pos = isc ? (d == 0 ? c : 1 - c) : (d == 0 ? 2 + c : 17 - c); hpre[S_][d][0] = (u32x4){0u, 0u, 0u, 0u}; hpre[S_][d][1] = hpre[S_][d][0]; \
            if (pos > 0) { const size_t sidx = (size_t)((b * 2 + d) * NPOS + pos - 1) * 6 + (hh); hpre[S_][d][0] = *(const u32x4*)(ST + sidx * 8192 + hp * 128 + hn0); hpre[S_][d][1] = *(const u32x4*)(ST + sidx * 8192 + hp * 128 + hn0 + 8); } } \
        _Pragma("unroll") for (int pt = 0; pt < 4; ++pt) { const int cidx = (hh) * 64 + 16 * pt + 4 * fq; ypre[S_][pt] = *(const f32x4*)(YP + (size_t)row * 384 + cidx); zpre[S_][pt] = *(const u32x2*)(P + (size_t)row * INP + PC_Z + cidx); } } while (0)
    SSDF_LOAD(0, 1);
#pragma unroll 1
    for (int h = 0; h < 6; ++h) {
        const int g = h / 3; constexpr int S = 0;
#pragma unroll
        for (int d = 0; d < 2; ++d) { hpre[0][d][0] = hpre[1][d][0]; hpre[0][d][1] = hpre[1][d][1]; }
#pragma unroll
        for (int pt = 0; pt < 4; ++pt) { ypre[0][pt] = ypre[1][pt]; zpre[0][pt] = zpre[1][pt]; }
        if (h + 1 < 6) SSDF_LOAD(h + 1, 1);
        LAS unsigned char* Hset = Hs + (h & 1) * 2 * 64 * LP;
#pragma unroll
        for (int d = 0; d < 2; ++d) { LAS unsigned char* Hb = Hset + d * 64 * LP;
            *(LAS u32x4*)(Hb + hp * LP + hn0 * 2) = hpre[S][d][0]; *(LAS u32x4*)(Hb + hp * LP + hn0 * 2 + 16) = hpre[S][d][1]; }
        LDS_BARRIER();
        f32x4 yh[4];
#pragma unroll
        for (int pt = 0; pt < 4; ++pt) yh[pt] = (f32x4){0.f, 0.f, 0.f, 0.f};
#pragma unroll
        for (int d = 0; d < 2; ++d) {
            const LAS unsigned char* Hb = Hset + d * 64 * LP;
            f32x4 tm[4];
#pragma unroll
            for (int pt = 0; pt < 4; ++pt) tm[pt] = (f32x4){0.f, 0.f, 0.f, 0.f};
#pragma unroll
            for (int ks = 0; ks < 4; ++ks) { const bf16x8 cf = *(const LAS bf16x8*)(Cs + lrow * CPITCH + (g * 128 + 32 * ks + 8 * fq) * 2);
#pragma unroll
                for (int pt = 0; pt < 4; ++pt) { const bf16x8 hf = *(const LAS bf16x8*)(Hb + (16 * pt + fr) * LP + (32 * ks + 8 * fq) * 2); tm[pt] = MFMA16(hf, cf, tm[pt]); } }
            const float e = __expf(d == 0 ? (h == 0 ? acv[0] : h == 1 ? acv[1] : h == 2 ? acv[2] : h == 3 ? acv[3] : h == 4 ? acv[4] : acv[5]) : (h == 0 ? acv[6] : h == 1 ? acv[7] : h == 2 ? acv[8] : h == 3 ? acv[9] : h == 4 ? acv[10] : acv[11]));
#pragma unroll
            for (int pt = 0; pt < 4; ++pt) yh[pt] += tm[pt] * e;
        }
#pragma unroll
        for (int pt = 0; pt < 4; ++pt) { const int cidx = h * 64 + 16 * pt + 4 * fq; const u32x2 z = zpre[S][pt];
            f32x4 v = yh[pt] + ypre[S][pt]; v[0] *= silu_f(bflo(z.x)); v[1] *= silu_f(bfhi(z.x)); v[2] *= silu_f(bflo(z.y)); v[3] *= silu_f(bfhi(z.y));
            u32x2 o; o.x = cvtpk(v[0], v[1]); o.y = cvtpk(v[2], v[3]); *(u32x2*)(CAT + (size_t)row * DM + 256 + cidx) = o; ss += (v[0] * v[0] + v[1] * v[1]) + (v[2] * v[2] + v[3] * v[3]); }
    }
#undef SSDF_LOAD
    ss += __shfl_xor(ss, 16); ss += __shfl_xor(ss, 32);
    const float rstd = rsqrtf(ss * (1.f / 384.f) + EPS);
    u32x2 st[6][4];
#pragma unroll
    for (int h = 0; h < 6; ++h)
#pragma unroll
        for (int pt = 0; pt < 4; ++pt) st[h][pt] = *(const u32x2*)(CAT + (size_t)row * DM + 256 + h * 64 + 16 * pt + 4 * fq);
    asm volatile("" ::: "memory");
#pragma unroll
    for (int h = 0; h < 6; ++h)
#pragma unroll
        for (int pt = 0; pt < 4; ++pt) { const int cidx = h * 64 + 16 * pt + 4 * fq; const f32x4 gg = *(const f32x4*)(F.g_ssd + l * 384 + cidx); const u32x2 t = st[h][pt]; f32x4 v = {bflo(t.x), bfhi(t.x), bflo(t.y), bfhi(t.y)}; v = v * rstd * gg;
            u32x2 o; o.x = cvtpk(v[0], v[1]); o.y = cvtpk(v[2], v[3]); *(u32x2*)(CAT + (size_t)row * DM + 256 + cidx) = o; }
    __syncthreads();
}

__device__ __forceinline__ void build_vt_item(Frame& F, int gt, int h) {
    const bf16_t* KV = WSP(bf16_t, WS_KV); bf16_t* VT = WSP(bf16_t, WS_VT);
    const int t7 = F.tid & 127, kq = t7 & 15, ch = t7 >> 4; u32x4 v[4];
#pragma unroll
    for (int r = 0; r < 4; ++r) v[r] = *(const u32x4*)(KV + (size_t)(gt * 64 + 4 * kq + r) * KVW + h * 128 + 64 + ch * 8);
    bf16_t* dst = VT + ((size_t)gt * 6 + h) * 4096 + 4 * kq;
#pragma unroll
    for (int j = 0; j < 4; ++j) { const unsigned a0 = v[0][j], a1 = v[1][j], a2 = v[2][j], a3 = v[3][j];
        u32x2 lo, hi; lo.x = (a0 & 0xffffu) | (a1 << 16); lo.y = (a2 & 0xffffu) | (a3 << 16); hi.x = (a0 >> 16) | (a1 & 0xffff0000u); hi.y = (a2 >> 16) | (a3 & 0xffff0000u);
        *(u32x2*)(dst + (8 * ch + 2 * j) * 64) = lo; *(u32x2*)(dst + (8 * ch + 2 * j + 1) * 64) = hi; }
}
template <class Sched> __device__ __forceinline__ void build_vt_own(Frame& F, const Sched& S) {
    asm volatile("s_waitcnt vmcnt(0)" ::: "memory"); __syncthreads();
    pg8::Unit u; const int sub = F.tid >> 7;
    for (int i = 0; S.next(i, u); ++i) {
#pragma unroll
        for (int k = 0; k < 2; ++k) { const int item = sub + 4 * k;
            build_vt_item(F, u.pm * 4 + (item & 3), u.pn * 2 + (item >> 2)); }
    }
}

__device__ __forceinline__ void attn_unit(Frame& F, int u) {
    int b, h, q0, nt; bool isc;
    if (u < 768) { b = u / 96; const int rem = u % 96; h = rem >> 4; q0 = b * SEQ + (rem & 15) * 128; nt = 36; isc = false; }
    else { const int uu = u - 768; b = uu / 12; const int rem = uu % 12; h = rem >> 1; q0 = NLAT + b * CTXL + (rem & 1) * 128; nt = 4; isc = true; }
    constexpr int KP = 208, VP = 136, TILEB = 64 * KP + 64 * VP;
    const bf16_t* Q = WSP(bf16_t, WS_Q); const bf16_t* KV = WSP(bf16_t, WS_KV); const bf16_t* KR = WSP(bf16_t, WS_KR); const bf16_t* VTg = WSP(bf16_t, WS_VT); bf16_t* CAT = WSP(bf16_t, WS_CAT);
    const int w = F.wave, lane = F.lane, tid = F.tid, qs = w & 3, par = w >> 2, r32 = lane & 31, hf = lane >> 5;
    bf16x8 qf[6];
    { const int qrow = q0 + 32 * qs + r32; const bf16_t* qp = Q + (size_t)qrow * QW + h * 96 + 8 * hf;
#pragma unroll
        for (int ks = 0; ks < 6; ++ks) qf[ks] = *(const bf16x8*)(qp + 16 * ks);
        if (!isc) { const int tok = qrow & (SEQ - 1); const f32x2* rt = WSP(f32x2, WS_MISC + MISC_ROPE);
#pragma unroll
            for (int ax = 0; ax < 2; ++ax) { const int pos = ax == 0 ? (tok >> 6) : (tok & 63); u32x4 own = __builtin_bit_cast(u32x4, qf[4 + ax]); u32x4 oth;
                oth.x = __shfl_xor(own.x, 32); oth.y = __shfl_xor(own.y, 32); oth.z = __shfl_xor(own.z, 32); oth.w = __shfl_xor(own.w, 32);
                float a[8], o[8], r[8];
                a[0] = bflo(own.x); a[1] = bfhi(own.x); a[2] = bflo(own.y); a[3] = bfhi(own.y); a[4] = bflo(own.z); a[5] = bfhi(own.z); a[6] = bflo(own.w); a[7] = bfhi(own.w);
                o[0] = bflo(oth.x); o[1] = bfhi(oth.x); o[2] = bflo(oth.y); o[3] = bfhi(oth.y); o[4] = bflo(oth.z); o[5] = bfhi(oth.z); o[6] = bflo(oth.w); o[7] = bfhi(oth.w);
#pragma unroll
                for (int f = 0; f < 8; ++f) { const f32x2 cs = rt[pos * 8 + f]; r[f] = hf == 0 ? (a[f] * cs.x - o[f] * cs.y) : (o[f] * cs.y + a[f] * cs.x); }
                u32x4 res; res.x = cvtpk(r[0], r[1]); res.y = cvtpk(r[2], r[3]); res.z = cvtpk(r[4], r[5]); res.w = cvtpk(r[6], r[7]); qf[4 + ax] = __builtin_bit_cast(bf16x8, res); } }
    }
    u32x4 knA[2], krA, vregA[2], knB[2], krB, vregB[2];
    const unsigned voffK = (unsigned)((tid >> 3) * KVW + (tid & 7) * 8) * 2u, voffR = (unsigned)tid * 16u, voffV = (unsigned)tid * 16u;
    const unsigned ldsK = (unsigned)((tid >> 3) * KP + (tid & 7) * 16), ldsR = (unsigned)((tid >> 8) * TILEB + ((tid >> 2) & 63) * KP + (8 + (tid & 3)) * 16), ldsV = (unsigned)(64 * KP + (tid >> 3) * VP + (tid & 7) * 16);
#define ATT_R(tp) ((isc || (tp) < 2) ? (NLAT + b * CTXL + (tp) * 128) : (b * SEQ + ((tp) - 2) * 128))
#define ATT_LOAD(kn, kr, vreg, tp) do { const int R_ = __builtin_amdgcn_readfirstlane(ATT_R(tp)); \
        const unsigned char* kb_ = (const unsigned char*)(KV + (size_t)R_ * KVW + h * 128); \
        kn[0] = *(const u32x4*)(kb_ + voffK); kn[1] = *(const u32x4*)(kb_ + 64 * KVW * 2 + voffK); \
        kr = *(const u32x4*)((const unsigned char*)(KR + (size_t)R_ * 32) + voffR); \
        const unsigned char* vb_ = (const unsigned char*)(VTg + ((size_t)(R_ >> 6) * 6 + h) * 4096); \
        vreg[0] = *(const u32x4*)(vb_ + voffV); vreg[1] = *(const u32x4*)(vb_ + 6 * 4096 * 2 + voffV); } while (0)
#define ATT_WRITE(kn, kr, vreg, buf) do { LAS unsigned char* base_ = F.lds + (buf) * 2 * TILEB; \
        *(LAS u32x4*)(base_ + ldsK) = kn[0]; *(LAS u32x4*)(base_ + TILEB + ldsK) = kn[1]; *(LAS u32x4*)(base_ + ldsR) = kr; \
        _Pragma("unroll") for (int i = 0; i < 2; ++i) { LAS unsigned char* vt = base_ + i * TILEB + ldsV; \
            *(LAS u32x2*)vt = (u32x2){vreg[i].x, vreg[i].y}; *(LAS u32x2*)(vt + 8) = (u32x2){vreg[i].z, vreg[i].w}; } } while (0)
    const int np = nt / 2;
    ATT_LOAD(knA, krA, vregA, 0); ATT_WRITE(knA, krA, vregA, 0);
    __syncthreads();
    ATT_LOAD(knB, krB, vregB, 1);
    f32x16 o0, o1;
#pragma unroll
    for (int r = 0; r < 16; ++r) { o0[r] = 0.f; o1[r] = 0.f; }
    float mrun = 0.f, lrun = 0.f;
    const unsigned kfo = (unsigned)(r32 * KP + 16 * hf), vfo = (unsigned)(64 * KP + r32 * VP + 8 * hf);
#define ATT_STEP(tp) do { \
        const LAS unsigned char* Kt = F.lds + ((((tp)) & 1) * 2 + par) * TILEB; \
        bf16x8 ka[6], kb[6]; \
        _Pragma("unroll") \
        for (int ks = 0; ks < 6; ++ks) ka[ks] = *(const LAS bf16x8*)(Kt + kfo + 32 * ks); \
        _Pragma("unroll") \
        for (int ks = 0; ks < 6; ++ks) kb[ks] = *(const LAS bf16x8*)(Kt + kfo + 32 * KP + 32 * ks); \
        f32x16 p0, p1; \
        _Pragma("unroll") \
        for (int r = 0; r < 16; ++r) { p0[r] = -mrun; p1[r] = -mrun; } \
        __builtin_amdgcn_sched_barrier(0); \
        _Pragma("unroll") \
        for (int ks = 0; ks < 6; ++ks) { p0 = MFMA32(ka[ks], qf[ks], p0); p1 = MFMA32(kb[ks], qf[ks], p1); } \
        u32x2 va[4][2], vc[4][2]; \
        _Pragma("unroll") \
        for (int s2 = 0; s2 < 4; ++s2) { \
            va[s2][0] = *(const LAS u32x2*)(Kt + vfo + 32 * s2); va[s2][1] = *(const LAS u32x2*)(Kt + vfo + 32 * s2 + 16); \
            vc[s2][0] = *(const LAS u32x2*)(Kt + vfo + 32 * VP + 32 * s2); vc[s2][1] = *(const LAS u32x2*)(Kt + vfo + 32 * VP + 32 * s2 + 16); } \
        __builtin_amdgcn_sched_barrier(0); \
        float mx = p0[0]; \
        _Pragma("unroll") \
        for (int r = 1; r < 16; ++r) mx = fmaxf(mx, p0[r]); \
        _Pragma("unroll") \
        for (int r = 0; r < 16; ++r) mx = fmaxf(mx, p1[r]); \
        mx = fmaxf(mx, __shfl_xor(mx, 32)); \
        if ((tp) == 0 || __any(mx > 8.f)) { const float dl = (tp) == 0 ? mx : fmaxf(mx, 0.f), alpha = __builtin_amdgcn_exp2f(-dl); lrun *= alpha; mrun += dl; \
        _Pragma("unroll") \
            for (int r = 0; r < 16; ++r) { o0[r] *= alpha; o1[r] *= alpha; p0[r] -= dl; p1[r] -= dl; } } \
        _Pragma("unroll") \
        for (int r = 0; r < 16; ++r) { p0[r] = __builtin_amdgcn_exp2f(p0[r]); p1[r] = __builtin_amdgcn_exp2f(p1[r]); } \
        float sa = p0[0], sb = p0[1], sc = p1[0], sd = p1[1]; \
        _Pragma("unroll") \
        for (int r = 2; r < 16; r += 2) { sa += p0[r]; sb += p0[r + 1]; sc += p1[r]; sd += p1[r + 1]; } \
        lrun += (sa + sb) + (sc + sd); \
        bf16x8 pf[4]; \
        _Pragma("unroll") \
        for (int s2 = 0; s2 < 4; ++s2) { u32x4 t; \
            if (s2 < 2) { t.x = cvtpk(p0[8 * s2], p0[8 * s2 + 1]); t.y = cvtpk(p0[8 * s2 + 2], p0[8 * s2 + 3]); t.z = cvtpk(p0[8 * s2 + 4], p0[8 * s2 + 5]); t.w = cvtpk(p0[8 * s2 + 6], p0[8 * s2 + 7]); } \
            else { const int s = s2 - 2; t.x = cvtpk(p1[8 * s], p1[8 * s + 1]); t.y = cvtpk(p1[8 * s + 2], p1[8 * s + 3]); t.z = cvtpk(p1[8 * s + 4], p1[8 * s + 5]); t.w = cvtpk(p1[8 * s + 6], p1[8 * s + 7]); } \
            pf[s2] = __builtin_bit_cast(bf16x8, t); } \
        _Pragma("unroll") \
        for (int s2 = 0; s2 < 4; ++s2) { \
            const u32x4 va4 = {va[s2][0].x, va[s2][0].y, va[s2][1].x, va[s2][1].y}, vc4 = {vc[s2][0].x, vc[s2][0].y, vc[s2][1].x, vc[s2][1].y}; \
            o0 = MFMA32(__builtin_bit_cast(bf16x8, va4), pf[s2], o0); o1 = MFMA32(__builtin_bit_cast(bf16x8, vc4), pf[s2], o1); } \
    } while (0)
    for (int tp = 0; tp < np; tp += 2) {
        ATT_LOAD(knA, krA, vregA, min(tp + 2, np - 1));
        ATT_STEP(tp);
        if (tp + 1 < np) ATT_WRITE(knB, krB, vregB, 1);
        LDS_BARRIER();
        if (tp + 1 < np) {
            ATT_LOAD(knB, krB, vregB, min(tp + 3, np - 1));
            ATT_STEP(tp + 1);
            if (tp + 2 < np) ATT_WRITE(knA, krA, vregA, 0);
            LDS_BARRIER();
        }
    }
#undef ATT_STEP
#undef ATT_R
#undef ATT_LOAD
#undef ATT_WRITE
    lrun += __shfl_xor(lrun, 32);
    LAS float* mg = (LAS float*)(F.lds + 4 * TILEB);
    if (par == 1) { LAS float* d = mg + ((qs * 64 + lane) * 36);
#pragma unroll
        for (int r = 0; r < 16; r += 4) { *(LAS f32x4*)(d + r) = (f32x4){o0[r], o0[r + 1], o0[r + 2], o0[r + 3]}; *(LAS f32x4*)(d + 16 + r) = (f32x4){o1[r], o1[r + 1], o1[r + 2], o1[r + 3]}; }
        d[32] = mrun; d[33] = lrun; }
    __syncthreads();
    if (par == 0) { const LAS float* d = mg + ((qs * 64 + lane) * 36);
        const float m2 = d[32], l2 = d[33], mm = fmaxf(mrun, m2), a1 = __builtin_amdgcn_exp2f(mrun - mm), a2 = __builtin_amdgcn_exp2f(m2 - mm), inv = 1.f / (lrun * a1 + l2 * a2);
        const int qrow = q0 + 32 * qs + r32; bf16_t* op = CAT + (size_t)qrow * DM + 640 + h * 64;
#pragma unroll
        for (int g4 = 0; g4 < 4; ++g4) { const f32x4 e0 = *(const LAS f32x4*)(d + 4 * g4), e1 = *(const LAS f32x4*)(d + 16 + 4 * g4);
            float r0[4], r1[4];
#pragma unroll
            for (int r = 0; r < 4; ++r) { r0[r] = (o0[4 * g4 + r] * a1 + e0[r] * a2) * inv; r1[r] = (o1[4 * g4 + r] * a1 + e1[r] * a2) * inv; }
            u32x2 w0, w1; w0.x = cvtpk(r0[0], r0[1]); w0.y = cvtpk(r0[2], r0[3]); w1.x = cvtpk(r1[0], r1[1]); w1.y = cvtpk(r1[2], r1[3]);
            *(u32x2*)(op + 8 * g4 + 4 * hf) = w0; *(u32x2*)(op + 32 + 8 * g4 + 4 * hf) = w1; } }
    __syncthreads();
}
#ifndef MK_PER_PHASE
#define MK_PER_PHASE 0
#endif
constexpr int N_PHASES = 20;
struct Args { const float* in[32]; float* out; unsigned char* ws; int ph_lo, ph_hi; };
typedef __attribute__((address_space(4))) const Args CArgs;
#define GPF(k) ((const float*)(GAS const float*)ap_->in[k])

__global__ void __launch_bounds__(NTHR, 2) fwd_megakernel(Args args) {
    extern __shared__ __attribute__((aligned(16))) unsigned char lds_raw[];
    Frame F;
    F.sm = lds_raw; F.lds = (LAS unsigned char*)lds_raw;
    F.G = gridDim.x; { const int bx = blockIdx.x; F.vcu = (F.G % 8 == 0) ? (bx % 8) * (F.G / 8) + bx / 8 : bx; }
#define PHASE_BEGIN() do { int t_ = threadIdx.x; asm volatile("" : "+v"(t_)); t_ &= 511; F.tid = t_; F.lane = t_ & 63; F.wave = __builtin_amdgcn_readfirstlane(t_ >> 6); \
    CArgs* ap_ = (CArgs*)__builtin_amdgcn_kernarg_segment_ptr(); asm volatile("" : "+s"(ap_)); \
    F.x = GPF(0); F.c = GPF(1); F.ctx = GPF(2); F.c_ctx = GPF(3); F.w_mod = GPF(4); F.b_mod = GPF(5); F.g_mix = GPF(6); F.w_in = GPF(7); \
    F.w_sgu = GPF(8); F.b_sgu = GPF(9); F.g_sgu = GPF(10); F.beta_sgu = GPF(11); F.conv_w = GPF(12); F.conv_b = GPF(13); F.dt_bias = GPF(14); F.a_log = GPF(15); \
    F.d_skip = GPF(16); F.g_ssd = GPF(17); F.g_q = GPF(18); F.w_uq = GPF(19); F.g_kv = GPF(20); F.w_ukv = GPF(21); F.w_out = GPF(22); F.g_ffn = GPF(23); \
    F.w_gate = GPF(24); F.w_up = GPF(25); F.w_down = GPF(26); F.w_router = GPF(27); F.w_gate_e = GPF(28); F.w_up_e = GPF(29); F.w_down_e = GPF(30); F.g_final = GPF(31); \
    F.out = (float*)(GAS float*)ap_->out; F.ws = (unsigned char*)(GAS unsigned char*)ap_->ws; } while (0)
    PHASE_BEGIN();
    volatile LAS unsigned* MISC = (volatile LAS unsigned*)(F.lds + MISC_OFF);
    for (int u = F.tid; u < (LDS_BYTES - LDSCTL_OFF) / 4; u += NTHR) ((LAS unsigned*)(F.lds + LDSCTL_OFF))[u] = 0u;
    __syncthreads();
    XcdBarrier bar = xcd_barrier_post(WSP(unsigned, WS_CTL) + CW_BAR, MISC + 8, threadIdx.x == 0);
    { long pc0_; int clen_; asm volatile("mk_code_beg:\n\ts_getpc_b64 %0\n\ts_mov_b32 %1, mk_code_end - mk_code_beg" : "=s"(pc0_), "=s"(clen_));
      if (threadIdx.x == 0) { volatile LAS unsigned* cw = (volatile LAS unsigned*)(F.lds + LDSCTL_OFF + 960); cw[0] = (unsigned)pc0_; cw[1] = (unsigned)((unsigned long)pc0_ >> 32); cw[2] = (unsigned)clen_; }
      const int ln_ = ((int)blockIdx.x >> 3) * NTHR + (int)threadIdx.x; if (ln_ * 128 < clen_) (void)*(volatile const unsigned*)((const char*)pc0_ + (size_t)ln_ * 128); }
#ifndef WARM_AT
#define WARM_AT(k) 0
#endif
#define CODE_WARM() do { const volatile LAS unsigned* cw_ = (const volatile LAS unsigned*)(F.lds + LDSCTL_OFF + 960); const int ln_ = ((int)blockIdx.x >> 3) * NTHR + (int)threadIdx.x; \
    if (ln_ * 128 < (int)cw_[2]) { const char* cb_ = (const char*)(((unsigned long)cw_[1] << 32) | (unsigned long)cw_[0]); (void)*(volatile const unsigned*)(cb_ + (size_t)ln_ * 128); } } while (0)
#if MK_PER_PHASE
    const int lo = args.ph_lo, hi = args.ph_hi;
#else
    constexpr int lo = 0, hi = N_PHASES;
#endif
#ifndef PH_MASK
#define PH_MASK 0xFFFFFFFFu
#endif
#define PE(b) ((PH_MASK >> (b)) & 1u)
#ifndef REP_MASK
#define REP_MASK 0u
#endif
#ifndef SSD_DRY_LIMIT
#define SSD_DRY_LIMIT 0
#endif
#define NREP(b) (1 + (int)((REP_MASK >> (b)) & 1u))
#define IN(k) (lo <= (k) && (k) < hi)
#define SEAM(k) do { if (IN(k) && IN((k) + 1)) { if (WARM_AT(k)) CODE_WARM(); for (int rep_ = 0; rep_ < NREP(20); ++rep_) xcd_barrier(bar, threadIdx.x == 0); } } while (0)
#define XC WSP(float, WS_XC)
#define SSQ WSP(float, WS_SSQP)
#define ctl WSP(unsigned, WS_CTL)

    if (IN(0) && PE(0)) { for (int rep = 0; rep < NREP(0); ++rep) { PHASE_BEGIN(); p_prologue(F); } }
    SEAM(0);
#pragma unroll 1
    for (int l = 0; l < DEPTH; ++l) {
        const int pb = 1 + 9 * l;
#define modl (WSP(float, WS_MOD) + (size_t)l * 9 * 6144)
#define srcL (l == 0 ? F.x : (const float*)F.out)
#define srcC (l == 0 ? F.ctx : (const float*)XC)
        if (IN(pb + 0) && PE(1)) for (int rep = 0; rep < NREP(1); ++rep) { PHASE_BEGIN(); p_norm<false>(F, l, 0, MT, srcL, srcC, l == 1 ? WSP(float, WS_SLAB) : nullptr, WSP(float, WS_MOD) + (size_t)8 * 6144 + 5 * DM); }
        SEAM(pb + 0);
        if (IN(pb + 1) && PE(2)) for (int rep = 0; rep < NREP(2); ++rep) {
            PHASE_BEGIN();
            pg8::Gemm g{WSP(bf16_t, WS_H), WSP(bf16_t, WS_WIN) + (size_t)l * INP * DM, DM, DM, 0};
            pg8::StaticOrder S; S.init(MT, INP, F.G, (int)blockIdx.x);
            pg8::EpiInProj E{WSP(bf16_t, WS_P), SSQ, rep < NREP(2) - 1};
            pg8::gemm_phase<pg8::EpiInProj, pg8::StaticOrder, true, false>(F.lds, F.tid, g, S, E);
        }
        SEAM(pb + 1);
        if (IN(pb + 2)) {
            if (PE(3)) for (int rep = 0; rep < NREP(3); ++rep) { PHASE_BEGIN(); pg8::Gemm g{WSP(bf16_t, WS_P) + PC_CQ, WSP(bf16_t, WS_WUQ) + (size_t)l * QWP * 384, INP, 384, 0};
              pg8::StaticOrder S;
              if (l == 0 && F.G == 256) { const int k_ = (int)blockIdx.x >> 3; S.init_plan(MT, QWP, (int)blockIdx.x & 7, k_ <= 10 ? k_ : (k_ == 15 ? 11 : (k_ == 19 ? 12 : (k_ == 20 ? 14 : k_ - 5))), (k_ >= 11 && k_ <= 18 && k_ != 15) ? 0 : ((k_ == 19 || k_ == 20) ? 2 : 1)); }
              else S.init(l == 0 ? MT : NLAT, QWP, F.G, l == 0 ? (int)blockIdx.x : (int)((blockIdx.x + 136u) % (unsigned)F.G));
              pg8::EpiScaleBf16 E{WSP(bf16_t, WS_Q), QW, QW, SSQ, 0, 1.f / 384.f, QSCALE};
              pg8::gemm_phase<pg8::EpiScaleBf16, pg8::StaticOrder, true, false>(F.lds, F.tid, g, S, E); }
            if (PE(4)) for (int rep = 0; rep < NREP(4); ++rep) { PHASE_BEGIN(); pg8::Gemm g{WSP(bf16_t, WS_P) + PC_CKV, WSP(bf16_t, WS_WUKV) + (size_t)l * KVW * 256, INP, 256, 0};
              pg8::StaticOrder S;
              if (l == 0 && F.G == 256) { const int k_ = (int)blockIdx.x >> 3; S.init_plan(MT, KVW, (int)blockIdx.x & 7, k_ <= 10 ? k_ : k_ - 5, (k_ >= 11 && k_ <= 15) ? 0 : 1); }
              else S.init(MT, KVW, F.G, (int)((blockIdx.x + 128u) % (unsigned)F.G));
              pg8::EpiScaleBf16 E{WSP(bf16_t, WS_KV), KVW, KVW, SSQ, 1, 1.f / 256.f, 1.f};
              pg8::gemm_phase<pg8::EpiScaleBf16, pg8::StaticOrder, true, false>(F.lds, F.tid, g, S, E);
              build_vt_own(F, S); }
            if (PE(5)) for (int rep = 0; rep < NREP(5); ++rep) { PHASE_BEGIN();
                for (int k = 0; k < 2; ++k) {
                    const int bx_ = (int)blockIdx.x; int u;
                    if (F.G == 256) u = k == 0 ? F.vcu : ((bx_ >= 88 && bx_ < 120) ? 256 + bx_ - 88 : -1); else u = F.vcu + k * F.G;
                    if (u >= 0 && u < 288) ssd_local_unit(F, l, u); } }
            if (PE(6)) { PHASE_BEGIN(); for (int u = F.vcu; u < 144; u += F.G) krope_unit(F, u); }
            if (PE(6) && !(l == 1 && F.G == 256)) for (int rep = 0; rep < NREP(6); ++rep) { PHASE_BEGIN();
                const int bx_ = (int)blockIdx.x;
                if (F.G == 256) { const int k_ = bx_ >> 3; if (k_ >= 15 && k_ <= 18) sgu_unit(F, l, 112 + (k_ - 15) * 8 + (bx_ & 7)); }
                else { for (int u = F.G - 1 - F.vcu; u < 144; u += F.G) sgu_unit(F, l, u); } }
        }
        SEAM(pb + 2);
        if (IN(pb + 3)) {
            if (PE(5)) { PHASE_BEGIN(); ssd_scan(F); }
        }
        SEAM(pb + 3);
        if (IN(pb + 4)) {
            const int nat = l == 0 ? 864 : 768, nsf = l == 0 ? 144 : 128;
            if (PE(7)) for (int rep = 0; rep < NREP(7); ++rep) { PHASE_BEGIN();
                const bool l1p = l == 1 && F.G == 256;
                const int nk = l1p ? 4 : (nat + F.G - 1) / F.G;
                for (int k = 0; k < nk; ++k) { const int u = (l1p && k >= 2) ? (F.vcu < 128 ? 512 + 128 * (k - 2) + F.vcu : nat) : F.vcu + F.G * k; if (u < nat) attn_unit(F, u); } }
            if (PE(8)) for (int rep = 0; rep < NREP(8); ++rep) { PHASE_BEGIN(); for (int u = F.G - 1 - F.vcu; u < nsf; u += F.G) ssd_final_unit(F, l, u); }
            if (PE(6) && F.G == 256) { PHASE_BEGIN();
                const int u = l == 1 ? (F.vcu >= 128 ? F.vcu - 128 : -1) : (F.vcu < 112 ? F.vcu : -1);
                if (u >= 0) sgu_unit(F, l, u); }
        }
        SEAM(pb + 4);
        if (IN(pb + 5) && PE(9)) {
         const int gst = l == 0 ? 0 : (int)((blockIdx.x >> 3) & 1u);
         for (int st = 0; st < (l == 0 ? 1 : 2); ++st) {
          if (st == gst) for (int rep = 0; rep < NREP(9); ++rep) {
            PHASE_BEGIN();
            pg8::Gemm g{WSP(bf16_t, WS_CAT), WSP(bf16_t, WS_WOUT) + (size_t)l * DM * DM, DM, DM, 0};
            pg8::StaticOrder S; S.init(l == 0 ? MT : NLAT, DM, F.G, (int)blockIdx.x);
            pg8::EpiResid E{srcL, srcC, F.out, XC, modl, 2, rep < NREP(9) - 1, nullptr};
            pg8::gemm_phase<pg8::EpiResid, pg8::StaticOrder, true, false>(F.lds, F.tid, g, S, E);
            if (l == 0 && rep == NREP(9) - 1) { PHASE_BEGIN(); int wi_, nw_; if (tail_worker(MT / 256 * (DM / 256), F.G, (int)blockIdx.x, wi_, nw_)) { for (int set_ = 2; set_ < 4; ++set_) convert_set(F, set_, wi_, nw_); mod_gemv(F, 1, wi_, nw_); } }
          }
          if (l == 1 && st != gst && PE(10)) for (int rep = 0; rep < NREP(10); ++rep) { PHASE_BEGIN(); p_moe_weights(F); }
         }
        }
        SEAM(pb + 5);
        if (IN(pb + 6) && PE(11)) { PHASE_BEGIN(); if (l == 0) { for (int rep = 0; rep < NREP(11); ++rep) p_norm<false>(F, l, 1, MT, F.out, XC); } else p_norm<true>(F, l, 1, NLAT, F.out, XC); }
        SEAM(pb + 6);
        if (IN(pb + 7)) {
            if (l == 0 && PE(12)) for (int rep = 0; rep < NREP(12); ++rep) {
                PHASE_BEGIN();
                pg8::Gemm g{WSP(bf16_t, WS_H), WSP(bf16_t, WS_WGU), DM, DM, 0};
                pg8::StaticOrder S; S.init(MT, 2 * DFF, F.G, (int)blockIdx.x);
                pg8::EpiSwiglu E{WSP(bf16_t, WS_ACT), DFF};
                pg8::gemm_phase<pg8::EpiSwiglu, pg8::StaticOrder, true, false>(F.lds, F.tid, g, S, E);
            } else if (l == 1 && PE(13)) for (int rep = 0; rep < NREP(13); ++rep) {
                PHASE_BEGIN();
                pg8::Gemm g{WSP(bf16_t, WS_H), WSP(bf16_t, WS_MOEW_GU), DM, DM, (size_t)2 * DFE * DM};
                pg8::MoeOrder S; S.init(ctl + CW_CNT, 11, F.G, (int)blockIdx.x, WSP(int, WS_LIST), true);
                pg8::EpiSwiglu E{WSP(bf16_t, WS_MACT), DFE};
                pg8::gemm_phase<pg8::EpiSwiglu, pg8::MoeOrder, true, true>(F.lds, F.tid, g, S, E);
            }
        }
        SEAM(pb + 7);
        if (IN(pb + 8)) {
            if (l == 0 && PE(14)) for (int rep = 0; rep < NREP(14); ++rep) {
                PHASE_BEGIN();
                pg8::Gemm g{WSP(bf16_t, WS_ACT), WSP(bf16_t, WS_WD), DFF, DFF, 0};
                pg8::DownSplitOrder S; S.init(F.G, (int)blockIdx.x);
                pg8::EpiResid E{F.out, XC, F.out, XC, modl, 5, rep < NREP(14) - 1, WSP(float, WS_SLAB)};
                pg8::gemm_phase<pg8::EpiResid, pg8::DownSplitOrder, true, false, true>(F.lds, F.tid, g, S, E);
            } else if (l == 1 && PE(15)) for (int rep = 0; rep < NREP(15); ++rep) {
                PHASE_BEGIN();
                pg8::Gemm g{WSP(bf16_t, WS_MACT), WSP(bf16_t, WS_MOEW_D), DFE, DFE, (size_t)DM * DFE};
                pg8::MoeOrder S; S.init(ctl + CW_CNT, 4, F.G, (int)blockIdx.x, WSP(int, WS_LIST), false);
                pg8::EpiMoeDown E{WSP(bf16_t, WS_Y), WSP(int, WS_LIST), WSP(float, WS_MISC + MISC_TOPW), S};
                pg8::gemm_phase<pg8::EpiMoeDown, pg8::MoeOrder, true, false>(F.lds, F.tid, g, S, E);
            }
        }
        SEAM(pb + 8);
    }
    if (IN(19) && PE(16)) { PHASE_BEGIN(); p_final(F); }
#undef IN
#undef SEAM
#undef XC
#undef SSQ
#undef ctl
#undef modl
#undef srcL
#undef srcC
#undef PHASE_BEGIN
    asm volatile("mk_code_end:");
}

extern "C" void kernel_launch(void* const* d_in, const int* in_sizes, int n_in, void* d_out, int out_size, void* d_ws, size_t ws_size, hipStream_t stream) {
    static int grid = 0;
    if (grid == 0) {
        if (n_in != 32 || out_size != NLAT * DM || ws_size < WS_END) { fprintf(stderr, "kernel_launch: unexpected shapes (n_in %d, out %d, ws %zu); nothing launched\n", n_in, out_size, ws_size); grid = -1; return; }
        int dev = 0, cus = 0, per_cu = 0;
        if (hipGetDevice(&dev) != hipSuccess || hipDeviceGetAttribute(&cus, hipDeviceAttributeMultiprocessorCount, dev) != hipSuccess) { grid = -1; return; }
        if (hipFuncSetAttribute((const void*)fwd_megakernel, hipFuncAttributeMaxDynamicSharedMemorySize, LDS_BYTES) != hipSuccess) { fprintf(stderr, "kernel_launch: hipFuncSetAttribute failed\n"); grid = -1; return; }
        if (hipOccupancyMaxActiveBlocksPerMultiprocessor(&per_cu, (const void*)fwd_megakernel, NTHR, LDS_BYTES) != hipSuccess || per_cu < 1) { fprintf(stderr, "kernel_launch: occupancy query says %d blocks/CU\n", per_cu); (void)hipGetLastError(); grid = -1; return; }
        grid = cus;
    }
    if (grid < 0) return;
    (void)hipMemsetAsync((char*)d_ws + WS_CTL, 0, CTL_BYTES, stream);
    Args a{};
    for (int i = 0; i < 32; ++i) a.in[i] = (const float*)d_in[i];
    a.out = (float*)d_out; a.ws = (unsigned char*)d_ws;
#if MK_PER_PHASE
    for (int k = 0; k < N_PHASES; ++k) { a.ph_lo = k; a.ph_hi = k + 1; hipLaunchKernelGGL(fwd_megakernel, dim3(grid), dim3(NTHR), LDS_BYTES, stream, a); }
#else
    a.ph_lo = 0; a.ph_hi = N_PHASES;
    void* kargs[] = {&a};
    hipError_t e = hipLaunchCooperativeKernel((const void*)fwd_megakernel, dim3(grid), dim3(NTHR), kargs, LDS_BYTES, stream);
    if (e != hipSuccess) fprintf(stderr, "kernel_launch: cooperative launch failed: %s (grid %d)\n", hipGetErrorString(e), grid);
#endif
}
```

```cpp
#include <hip/hip_runtime.h>
#include <cstdio>
#include <cstdint>

#define LAS __attribute__((address_space(3)))
#define GAS __attribute__((address_space(1)))
typedef unsigned short bf16_t;
typedef short bf16x8 __attribute__((ext_vector_type(8)));
typedef float f32x4 __attribute__((ext_vector_type(4)));
typedef float f32x16 __attribute__((ext_vector_type(16)));
typedef float f32x2 __attribute__((ext_vector_type(2)));
typedef unsigned u32x4 __attribute__((ext_vector_type(4)));
typedef unsigned u32x2 __attribute__((ext_vector_type(2)));
typedef __bf16 bf16x2_t __attribute__((ext_vector_type(2)));

constexpr int BATCH = 8, SEQ = 2048, DM = 1024, CTXL = 256, DEPTH = 2;
constexpr int NLAT = BATCH * SEQ, NCTX = BATCH * CTXL, MT = NLAT + NCTX;
constexpr int INW = 2476, INP = 2560;
constexpr int PC_U = 0, PC_V = 256, PC_Z = 512, PC_X = 896, PC_B = 1280, PC_C = 1536, PC_CQ = 1792, PC_CKV = 2176, PC_KR = 2432, PC_DT = 2464;
constexpr int DFF = 2816, NEXP = 8, DFE = 1408;
constexpr int QW = 576, QWP = 768, KVW = 768;
constexpr float EPS = 1e-6f;
constexpr float QSCALE = 0.10206207261596577f * 1.4426950408889634f;
constexpr int NPOS = 18;

constexpr size_t MiB = 1u << 20;
constexpr size_t WS_CTL = 0, CTL_BYTES = 64 * 1024;
constexpr size_t WS_MOD = 1 * MiB;
constexpr size_t WS_ACS = 2 * MiB;
constexpr size_t WS_MISC = 3 * MiB;
constexpr size_t WS_LIST = 4 * MiB;
constexpr size_t WS_WSGU = 5 * MiB;
constexpr size_t WS_WIN = 6 * MiB;
constexpr size_t WS_WUQ = 16 * MiB;
constexpr size_t WS_WUKV = 18 * MiB;
constexpr size_t WS_WOUT = 19 * MiB;
constexpr size_t WS_WGU = 23 * MiB;
constexpr size_t WS_WD = 34 * MiB;
constexpr size_t WS_XC = 40 * MiB;
constexpr size_t WS_H = 48 * MiB;
constexpr size_t WS_Q = 48 * MiB;
constexpr size_t WS_KR = 70 * MiB;
constexpr size_t WS_P = 84 * MiB;
constexpr size_t WS_CAT = 174 * MiB;
constexpr size_t WS_KV = 210 * MiB;
constexpr size_t WS_CC = 237 * MiB;
constexpr size_t WS_YP = 246 * MiB;
constexpr size_t WS_ST = 273 * MiB;
constexpr size_t WS_ACT = 84 * MiB;
constexpr size_t WS_MOEW_GU = 84 * MiB;
constexpr size_t WS_MOEW_D = 128 * MiB;
constexpr size_t WS_MACT = 150 * MiB;
constexpr size_t WS_Y = 244 * MiB;
constexpr size_t WS_SSQP = 300 * MiB;
constexpr size_t WS_VT = 302 * MiB;
constexpr size_t WS_SLAB = 200 * MiB;
constexpr size_t WS_END = 316 * MiB;
constexpr size_t MISC_SSQ = 0, MISC_DEC = 256 * 1024, MISC_ROPE = 320 * 1024, MISC_TOPW = 384 * 1024;
constexpr int CW_CNT = 64;
constexpr int CW_BAR = 4096;

__device__ __forceinline__ unsigned cvtpk(float lo, float hi) { f32x2 v = {lo, hi}; bf16x2_t b = __builtin_convertvector(v, bf16x2_t); return __builtin_bit_cast(unsigned, b); }
__device__ __forceinline__ float bflo(unsigned u) { return __uint_as_float(u << 16); }
__device__ __forceinline__ float bfhi(unsigned u) { return __uint_as_float(u & 0xffff0000u); }
__device__ __forceinline__ float bf1(bf16_t h) { return __uint_as_float((unsigned)h << 16); }
__device__ __forceinline__ bf16_t f2bf(float f) { return (bf16_t)(cvtpk(f, 0.f) & 0xffffu); }
__device__ __forceinline__ float wave_sum(float v) {
#pragma unroll
    for (int o = 1; o < 64; o <<= 1) v += __shfl_xor(v, o);
    return v;
}
__device__ __forceinline__ float silu_f(float x) { return x * __builtin_amdgcn_rcpf(1.f + __expf(-x)); }
__device__ __forceinline__ float gelu_tanh(float x) { const float u = 0.7978845608028654f * (x + 0.044715f * x * x * x); const float t = 1.f - 2.f * __builtin_amdgcn_rcpf(1.f + __expf(2.f * u)); return 0.5f * x * (1.f + t); }
__device__ __forceinline__ float softplus_f(float x) { return x > 20.f ? x : log1pf(__expf(x)); }
#define LDS_WAIT() asm volatile("s_waitcnt lgkmcnt(0)" ::: "memory")
#define LDS_BARRIER() asm volatile("s_waitcnt lgkmcnt(0)\n\ts_barrier" ::: "memory")
#define MFMA16(a, b, c) __builtin_amdgcn_mfma_f32_16x16x32_bf16((a), (b), (c), 0, 0, 0)
#define MFMA32(a, b, c) __builtin_amdgcn_mfma_f32_32x32x16_bf16((a), (b), (c), 0, 0, 0)

namespace pg8 {
constexpr int BM = 256, BK = 64, HALF = 128, HTB = HALF * BK * 2, STAGE_BYTES = 8 * HTB, NXCD = 8, WGM = 8;
__host__ __device__ __forceinline__ int lds_byte(int r, int c) { const int st = (r >> 4) * 2 + (c >> 5), rr = r & 15, cc = c & 31, ob = rr * 64 + cc * 2; return st * 1024 + (ob ^ (((ob >> 9) & 1) << 5)); }
__host__ __device__ __forceinline__ void stage_rc(int b, int& R, int& C) { const int st = b / 1024, sb = b % 1024, swz = sb ^ (((sb >> 9) & 1) << 5); R = (st >> 1) * 16 + swz / 64; C = (st & 1) * 32 + (swz % 64) / 2; }
__host__ __device__ __forceinline__ int perm32(int rho) { const int n = rho >> 4, i = rho & 15; return 8 * (i >> 2) + 4 * n + (i & 3); }

struct Unit { int pm, pn, e, kt0, nkt; };
struct Gemm { const bf16_t* A; const bf16_t* Bt; int lda; int K; size_t bstride_e; };

struct StaticOrder {
    int nM, nN, nwg, G, c, lim;
    __device__ void init(int M, int N, int G_, int c_) { nM = M / BM; nN = N / BM; nwg = nM * nN; G = G_; c = c_; lim = 0x7fffffff; }
    __device__ void init_plan(int M, int N, int r, int off0, int cnt) { nM = M / BM; nN = N / BM; nwg = nM * nN; G = NXCD; c = off0 * NXCD + r; lim = cnt; }
    __device__ bool next(int i, Unit& u) const {
        const long L = (long)i * G + c; if (i >= lim || L >= nwg) return false;
        int wgid = (int)L; { const int q = nwg / NXCD, r = nwg % NXCD, xcd = wgid % NXCD, off = wgid / NXCD; wgid = (xcd < r ? xcd * (q + 1) : r * (q + 1) + (xcd - r) * q) + off; }
        const int nig = WGM * nN, gid = wgid / nig, fm = gid * WGM, gsz = (nM - fm) < WGM ? (nM - fm) : WGM;
        u.pm = fm + ((wgid % nig) % gsz); u.pn = (wgid % nig) / gsz; u.e = 0; return true;
    }
    __device__ __forceinline__ int arow(const Unit& u, int r) const { return u.pm * BM + r; }
};

template <class Epi, class Sched, bool ALIGN_EPI, bool GATHER, bool KSPLIT = false>
__device__ __forceinline__ void gemm_phase(LAS unsigned char* lds, const int tid, const Gemm g, const Sched& S, const Epi& E) {
    const int wid = __builtin_amdgcn_readfirstlane(tid >> 6), lane = tid & 63, wr = wid >> 2, wc = wid & 3, fr = lane & 15, fq = lane >> 4;
    const int K = g.K; int nt = K / BK;
    int Rr[2], Cc[2]; unsigned voffA[2], voffB[2];
#pragma unroll
    for (int i = 0; i < 2; ++i) { int R, C; stage_rc(tid * 16 + i * 8192, R, C); Rr[i] = R; Cc[i] = C; const int Rb = Epi::PERM ? ((R & ~31) + perm32(R & 31)) : R;
        voffA[i] = (unsigned)(R * g.lda + C) * 2u; voffB[i] = (unsigned)(Rb * K + C) * 2u; }
    const size_t kstep = (size_t)(BK * 2);
    const size_t hstepB = (size_t)HALF * K * 2, tstepB = 2 * hstepB;
    const size_t hstepA = (size_t)HALF * g.lda * 2, tstepA = 2 * hstepA;
    const unsigned ldsw = (unsigned)wid * 1024u;
    const int aoff = lds_byte(wr * 64 + fr, fq * 8), boff = lds_byte(wc * 32 + fr, fq * 8);
    const char* const Abase = (const char*)g.A;
#define PG8_SA(b, h) (((b) * 2 + (h)) * HTB)
#define PG8_SB(b, h) ((4 + (b) * 2 + (h)) * HTB)
#define PG8_GL(gp, off) __builtin_amdgcn_global_load_lds((const unsigned*)(gp), (LAS unsigned*)(lds + (off)), 16, 0, 0)
#define PG8_STAGE_B(bufoff, gbase) do { PG8_GL((const char*)(gbase) + voffB[0], (bufoff) + ldsw); PG8_GL((const char*)(gbase) + voffB[1], (bufoff) + ldsw + 8192); } while (0)
#define PG8_STAGE_A_CUR(bufoff, kt, h) do { if constexpr (GATHER) { const char* _p = Abase + (size_t)(kt) * kstep; PG8_GL(_p + ((h) ? c10 : c00), (bufoff) + ldsw); PG8_GL(_p + ((h) ? c11 : c01), (bufoff) + ldsw + 8192); } \
        else { const char* _p = cA + (size_t)(kt) * kstep + (h) * hstepA; PG8_GL(_p + voffA[0], (bufoff) + ldsw); PG8_GL(_p + voffA[1], (bufoff) + ldsw + 8192); } } while (0)
#define PG8_STAGE_A_SEL(bufoff, kt, h) do { if constexpr (GATHER) { const char* _p = Abase + (size_t)(kt) * kstep; PG8_GL(_p + ((h) ? x10 : x00), (bufoff) + ldsw); PG8_GL(_p + ((h) ? x11 : x01), (bufoff) + ldsw + 8192); } \
        else { const char* _p = xA + (size_t)(kt) * kstep + (h) * hstepA; PG8_GL(_p + voffA[0], (bufoff) + ldsw); PG8_GL(_p + voffA[1], (bufoff) + ldsw + 8192); } } while (0)
#define PG8_LDA(dst, b, h) do { _Pragma("unroll") for (int m = 0; m < 4; ++m) _Pragma("unroll") for (int k = 0; k < 2; ++k) dst[m][k] = *(const LAS bf16x8*)(lds + PG8_SA(b, h) + aoff + m * 2048 + k * 1024); } while (0)
#define PG8_LDB(dst, b, h) do { _Pragma("unroll") for (int n = 0; n < 2; ++n) _Pragma("unroll") for (int k = 0; k < 2; ++k) dst[n][k] = *(const LAS bf16x8*)(lds + PG8_SB(b, h) + boff + n * 2048 + k * 1024); } while (0)
#define PG8_MMA(ai, bj, At, Bt) do { __builtin_amdgcn_s_setprio(1); _Pragma("unroll") for (int m = 0; m < 4; ++m) _Pragma("unroll") for (int n = 0; n < 2; ++n) _Pragma("unroll") for (int k = 0; k < 2; ++k) \
        acc[ai][bj][m][n] = __builtin_amdgcn_mfma_f32_16x16x32_bf16(Bt[n][k], At[m][k], acc[ai][bj][m][n], 0, 0, 0); __builtin_amdgcn_s_setprio(0); } while (0)
#define PG8_WAIT_V(n) asm volatile("s_waitcnt vmcnt(" #n ")" ::: "memory")
#define PG8_WAIT_L(n) asm volatile("s_waitcnt lgkmcnt(" #n ")" ::: "memory")
#define PG8_BAR __builtin_amdgcn_s_barrier()
#define PG8_SCHED __builtin_amdgcn_sched_barrier(0)
#define PG8_AOFFS(u, o00, o01, o10, o11) do { if constexpr (GATHER) { \
        o00 = (unsigned)(((size_t)S.arow(u, Rr[0]) * g.lda + Cc[0]) * 2); o01 = (unsigned)(((size_t)S.arow(u, Rr[1]) * g.lda + Cc[1]) * 2); \
        o10 = (unsigned)(((size_t)S.arow(u, HALF + Rr[0]) * g.lda + Cc[0]) * 2); o11 = (unsigned)(((size_t)S.arow(u, HALF + Rr[1]) * g.lda + Cc[1]) * 2); } } while (0)
    Unit cur, nxt; int ui = 0;
    if (!S.next(0, cur)) return;
    f32x4 acc[2][2][4][2];
#pragma unroll
    for (int a = 0; a < 2; ++a)
#pragma unroll
        for (int b = 0; b < 2; ++b)
#pragma unroll
            for (int m = 0; m < 4; ++m)
#pragma unroll
                for (int n = 0; n < 2; ++n) acc[a][b][m][n] = (f32x4){0.f, 0.f, 0.f, 0.f};
    bf16x8 At[4][2], B0[2][2], B1[2][2];
    unsigned c00 = 0, c01 = 0, c10 = 0, c11 = 0, n00 = 0, n01 = 0, n10 = 0, n11 = 0;
    PG8_AOFFS(cur, c00, c01, c10, c11);
    const char* cA = Abase + (size_t)cur.pm * tstepA;
    const char* cB = (const char*)g.Bt + ((size_t)cur.e * g.bstride_e) * 2 + (size_t)cur.pn * tstepB;
    if constexpr (KSPLIT) { cA += (size_t)cur.kt0 * kstep; cB += (size_t)cur.kt0 * kstep; nt = cur.nkt; }
    PG8_STAGE_B(PG8_SB(0, 0), cB); PG8_STAGE_B(PG8_SB(0, 1), cB + hstepB); PG8_STAGE_A_CUR(PG8_SA(0, 0), 0, 0); PG8_STAGE_A_CUR(PG8_SA(0, 1), 0, 1);
    if (wr == 1) PG8_BAR;
    PG8_WAIT_V(2); PG8_BAR;
    PG8_STAGE_B(PG8_SB(1, 0), cB + kstep); PG8_STAGE_A_CUR(PG8_SA(1, 0), 1, 0); PG8_STAGE_B(PG8_SB(1, 1), cB + hstepB + kstep);
    PG8_WAIT_V(6); PG8_BAR;
    for (;;) {
        const bool has_next = S.next(ui + 1, nxt);
        const char* nB = cB; const char* nA = cA;
        if (has_next) { PG8_AOFFS(nxt, n00, n01, n10, n11); nA = Abase + (size_t)nxt.pm * tstepA; nB = (const char*)g.Bt + ((size_t)nxt.e * g.bstride_e) * 2 + (size_t)nxt.pn * tstepB;
            if constexpr (KSPLIT) { nA += (size_t)nxt.kt0 * kstep; nB += (size_t)nxt.kt0 * kstep; } }
        else { n00 = c00; n01 = c01; n10 = c10; n11 = c11; }
#pragma unroll 1
        for (int t = 0; t < nt; t += 2) {
            const bool last = (t == nt - 2);
            const int kt2 = last ? 0 : t + 2, kt3 = kt2 + 1;
            const unsigned x00 = last ? n00 : c00, x01 = last ? n01 : c01, x10 = last ? n10 : c10, x11 = last ? n11 : c11;
            const char* xA = last ? nA : cA;
            const char* b2 = last ? nB : cB + (size_t)(t + 2) * kstep; const char* b3 = b2 + kstep;
            (void)x00; (void)x01; (void)x10; (void)x11; (void)xA;
            PG8_LDB(B0, 0, 0); PG8_LDB(B1, 0, 1); PG8_SCHED; PG8_LDA(At, 0, 0); PG8_STAGE_A_CUR(PG8_SA(1, 1), t + 1, 1);
            PG8_WAIT_V(8); PG8_WAIT_L(0); PG8_BAR; PG8_MMA(0, 0, At, B0); PG8_MMA(0, 1, At, B1); PG8_BAR; PG8_SCHED;
            PG8_LDA(At, 0, 1); PG8_STAGE_B(PG8_SB(0, 0), b2); PG8_STAGE_B(PG8_SB(0, 1), b2 + hstepB); PG8_STAGE_A_SEL(PG8_SA(0, 0), kt2, 0);
            PG8_WAIT_V(8); PG8_WAIT_L(0); PG8_BAR; PG8_MMA(1, 0, At, B0); PG8_MMA(1, 1, At, B1); PG8_BAR; PG8_SCHED;
            PG8_LDB(B0, 1, 0); PG8_LDB(B1, 1, 1); PG8_SCHED; PG8_LDA(At, 1, 0); PG8_STAGE_A_SEL(PG8_SA(0, 1), kt2, 1);
            PG8_WAIT_V(8); PG8_WAIT_L(0); PG8_BAR; PG8_MMA(0, 0, At, B0); PG8_MMA(0, 1, At, B1); PG8_BAR; PG8_SCHED;
            PG8_LDA(At, 1, 1); PG8_STAGE_B(PG8_SB(1, 0), b3); PG8_STAGE_B(PG8_SB(1, 1), b3 + hstepB); PG8_STAGE_A_SEL(PG8_SA(1, 0), kt3, 0);
            PG8_WAIT_V(8); PG8_WAIT_L(0); PG8_BAR; PG8_MMA(1, 0, At, B0); PG8_MMA(1, 1, At, B1); PG8_BAR; PG8_SCHED;
        }
        if constexpr (ALIGN_EPI) { if (wr == 0) PG8_BAR; }
        E(acc, cur, wr, wc, fr, fq);
        if (!has_next) break;
#pragma unroll
        for (int a = 0; a < 2; ++a)
#pragma unroll
            for (int b = 0; b < 2; ++b)
#pragma unroll
                for (int m = 0; m < 4; ++m)
#pragma unroll
                    for (int n = 0; n < 2; ++n) acc[a][b][m][n] = (f32x4){0.f, 0.f, 0.f, 0.f};
        cur = nxt; cA = nA; cB = nB; c00 = n00; c01 = n01; c10 = n10; c11 = n11; ++ui;
        if constexpr (KSPLIT) nt = cur.nkt;
        if constexpr (ALIGN_EPI) { if (wr == 1) PG8_BAR; }
    }
    PG8_WAIT_V(0);
    if constexpr (!ALIGN_EPI) { if (wr == 0) PG8_BAR; }
    PG8_BAR;
#undef PG8_SA
#undef PG8_SB
#undef PG8_GL
#undef PG8_STAGE_A_CUR
#undef PG8_STAGE_A_SEL
#undef PG8_STAGE_B
#undef PG8_LDA
#undef PG8_LDB
#undef PG8_MMA
#undef PG8_WAIT_V
#undef PG8_WAIT_L
#undef PG8_BAR
#undef PG8_SCHED
#undef PG8_AOFFS
}
}
namespace pg8 {
struct EpiInProj {
    static constexpr bool PERM = true;
    bf16_t* O; float* ssq; bool dry;
    __device__ __forceinline__ void operator()(const f32x4 (&acc)[2][2][4][2], const Unit& u, int wr, int wc, int fr, int fq) const {
        if (dry) return;
        const int row0 = u.pm * BM + wr * 64 + fr, col0 = u.pn * BM + wc * 32 + 8 * fq;
#pragma unroll
        for (int ai = 0; ai < 2; ++ai)
#pragma unroll
            for (int m = 0; m < 4; ++m) { const int row = row0 + ai * HALF + m * 16; bf16_t* rowp = O + (size_t)row * INP + col0;
                float sq = 0.f, sk = 0.f;
#pragma unroll
                for (int bj = 0; bj < 2; ++bj) { const f32x4 v0 = acc[ai][bj][m][0], v1 = acc[ai][bj][m][1];
                    u32x4 w; w.x = cvtpk(v0[0], v0[1]); w.y = cvtpk(v0[2], v0[3]); w.z = cvtpk(v1[0], v1[1]); w.w = cvtpk(v1[2], v1[3]);
                    *(u32x4*)(rowp + bj * HALF) = w;
                    const int hidx = 2 * u.pn + bj;
                    const float s = (v0[0] * v0[0] + v0[1] * v0[1]) + (v0[2] * v0[2] + v0[3] * v0[3]) + (v1[0] * v1[0] + v1[1] * v1[1]) + (v1[2] * v1[2] + v1[3] * v1[3]);
                    if (hidx >= 14 && hidx <= 16) sq += s;
                    if (hidx >= 17 && hidx <= 18) sk += s; }
                if (u.pn >= 7 && u.pn <= 9) {
                    sq += __shfl_xor(sq, 16); sq += __shfl_xor(sq, 32); sk += __shfl_xor(sk, 16); sk += __shfl_xor(sk, 32);
                    if (fq == 0) { float* sp = ssq + (size_t)row * 16;
                        if (u.pn == 7) sp[wc] = sq; if (u.pn == 8) { sp[4 + wc] = sq; sp[8 + wc] = sk; } if (u.pn == 9) sp[12 + wc] = sk; } } }
    }
};
struct EpiScaleBf16 {
    static constexpr bool PERM = true;
    bf16_t* O; int ldc, ncols; const float* ssq; int idx; float invn, mul;
    __device__ __forceinline__ void operator()(const f32x4 (&acc)[2][2][4][2], const Unit& u, int wr, int wc, int fr, int fq) const {
        const int row0 = u.pm * BM + wr * 64 + fr, col0 = u.pn * BM + wc * 32 + 8 * fq;
#pragma unroll
        for (int ai = 0; ai < 2; ++ai) {
            float scv[4];
#pragma unroll
            for (int m = 0; m < 4; ++m) { const int row = row0 + ai * HALF + m * 16;
                const f32x4 pa = *(const f32x4*)(ssq + (size_t)row * 16 + 8 * idx), pb = *(const f32x4*)(ssq + (size_t)row * 16 + 8 * idx + 4);
                scv[m] = rsqrtf((((pa[0] + pa[1]) + (pa[2] + pa[3])) + ((pb[0] + pb[1]) + (pb[2] + pb[3]))) * invn + EPS) * mul; }
            asm volatile("" ::: "memory");
#pragma unroll
            for (int m = 0; m < 4; ++m) { const int row = row0 + ai * HALF + m * 16; bf16_t* rowp = O + (size_t)row * ldc + col0;
                const float sc = scv[m];
#pragma unroll
                for (int bj = 0; bj < 2; ++bj) if (col0 + bj * HALF < ncols) { const f32x4 v0 = acc[ai][bj][m][0] * sc, v1 = acc[ai][bj][m][1] * sc;
                    u32x4 w; w.x = cvtpk(v0[0], v0[1]); w.y = cvtpk(v0[2], v0[3]); w.z = cvtpk(v1[0], v1[1]); w.w = cvtpk(v1[2], v1[3]);
                    *(u32x4*)(rowp + bj * HALF) = w; } } }
    }
};
struct EpiResid {
    static constexpr bool PERM = false;
    const float* oldL; const float* oldC; float* newL; float* newC; const float* mod; int gi; bool dry; float* slab;
    __device__ __forceinline__ void operator()(const f32x4 (&acc)[2][2][4][2], const Unit& u, int wr, int wc, int fr, int fq) const {
        if (dry) return;
        if (slab && u.e > 0) {
            float* sp = slab + ((size_t)(u.e - 1) * NCTX + (u.pm * BM - NLAT) + wr * 64 + fr) * DM + u.pn * BM + wc * 32 + 4 * fq;
#pragma unroll
            for (int ai = 0; ai < 2; ++ai)
#pragma unroll
                for (int m = 0; m < 4; ++m)
#pragma unroll
                    for (int bj = 0; bj < 2; ++bj)
#pragma unroll
                        for (int n = 0; n < 2; ++n) *(f32x4*)(sp + (size_t)(ai * HALF + m * 16) * DM + bj * HALF + n * 16) = acc[ai][bj][m][n];
            return; }
        const int rbase = u.pm * BM; const bool isc = rbase >= NLAT; const int b = isc ? 8 : (rbase >> 11);
        const float* xo = isc ? oldC - (size_t)NLAT * DM : oldL; float* xn = isc ? newC - (size_t)NLAT * DM : newL;
        const int row0 = rbase + wr * 64 + fr, col0 = u.pn * BM + wc * 32 + 4 * fq;
        const float* gp = mod + (size_t)b * 6144 + gi * DM + col0;
        f32x4 gv[2][2];
#pragma unroll
        for (int bj = 0; bj < 2; ++bj)
#pragma unroll
            for (int n = 0; n < 2; ++n) gv[bj][n] = *(const f32x4*)(gp + bj * HALF + n * 16);
#pragma unroll
        for (int am = 0; am < 4; ++am) { const int ai = am >> 1, m0 = (am & 1) * 2;
            f32x4 xv[2][2][2];
#pragma unroll
            for (int mm = 0; mm < 2; ++mm) { const size_t off = (size_t)(row0 + ai * HALF + (m0 + mm) * 16) * DM + col0;
#pragma unroll
                for (int bj = 0; bj < 2; ++bj)
#pragma unroll
                    for (int n = 0; n < 2; ++n) xv[mm][bj][n] = *(const f32x4*)(xo + off + bj * HALF + n * 16); }
            asm volatile("" ::: "memory");
#pragma unroll
            for (int mm = 0; mm < 2; ++mm) { const size_t off = (size_t)(row0 + ai * HALF + (m0 + mm) * 16) * DM + col0;
#pragma unroll
                for (int bj = 0; bj < 2; ++bj)
#pragma unroll
                    for (int n = 0; n < 2; ++n) *(f32x4*)(xn + off + bj * HALF + n * 16) = xv[mm][bj][n] + gv[bj][n] * acc[ai][bj][m0 + mm][n]; }
            asm volatile("" ::: "memory"); }
    }
};
struct EpiSwiglu {
    static constexpr bool PERM = true;
    bf16_t* O; int ldc;
    __device__ __forceinline__ void operator()(const f32x4 (&acc)[2][2][4][2], const Unit& u, int wr, int wc, int fr, int fq) const {
        const int row0 = u.pm * BM + wr * 64 + fr, col0 = u.pn * HALF + wc * 32 + 8 * fq;
#pragma unroll
        for (int ai = 0; ai < 2; ++ai)
#pragma unroll
            for (int m = 0; m < 4; ++m) { bf16_t* rowp = O + (size_t)(row0 + ai * HALF + m * 16) * ldc + col0;
                float r[8];
#pragma unroll
                for (int n = 0; n < 2; ++n)
#pragma unroll
                    for (int j = 0; j < 4; ++j) { const float gt = acc[ai][0][m][n][j], up = acc[ai][1][m][n][j]; r[4 * n + j] = silu_f(gt) * up; }
                u32x4 w; w.x = cvtpk(r[0], r[1]); w.y = cvtpk(r[2], r[3]); w.z = cvtpk(r[4], r[5]); w.w = cvtpk(r[6], r[7]);
                *(u32x4*)rowp = w; }
    }
};
struct DownSplitOrder {
    StaticOrder so; int G, c;
    __device__ void init(int G_, int c_) { so.init(NLAT, DM, G_, c_); G = G_; c = c_; }
    __device__ bool next(int i, Unit& u) const {
        if (so.next(i, u)) { u.kt0 = 0; u.nkt = DFF / BK; return true; }
        const int rounds = (so.nwg + G - 1) / G; const int j = (i - rounds) * G + c; if (i < rounds || j >= 128) return false;
        const int tile = j >> 2, part = j & 3; u.pm = NLAT / BM + (tile >> 2); u.pn = tile & 3; u.e = 1 + part;
        u.kt0 = part == 0 ? 0 : part == 1 ? 12 : part == 2 ? 24 : 34; u.nkt = part < 2 ? 12 : 10; return true;
    }
    __device__ __forceinline__ int arow(const Unit& u, int r) const { return u.pm * BM + r; }
};
struct MoeOrder {
    int c0, c1, c2, c3, c4, c5, c6, c7, t1, t2, t3, t4, t5, t6, t7, t8; int npn, G, c; const int* list; bool gather;
    __device__ void init(const unsigned* cw, int npn_, int G_, int c_, const int* list_, bool gather_) {
        #define RFL_(x) __builtin_amdgcn_readfirstlane((int)(x))
        c0 = RFL_(cw[0]); c1 = RFL_(cw[64]); c2 = RFL_(cw[128]); c3 = RFL_(cw[192]); c4 = RFL_(cw[256]); c5 = RFL_(cw[320]); c6 = RFL_(cw[384]); c7 = RFL_(cw[448]);
#undef RFL_
        t1 = (c0 + 255) >> 8; t2 = t1 + ((c1 + 255) >> 8); t3 = t2 + ((c2 + 255) >> 8); t4 = t3 + ((c3 + 255) >> 8); t5 = t4 + ((c4 + 255) >> 8); t6 = t5 + ((c5 + 255) >> 8); t7 = t6 + ((c6 + 255) >> 8); t8 = t7 + ((c7 + 255) >> 8);
        npn = npn_; G = G_; c = c_; list = list_; gather = gather_;
    }
    __device__ bool next(int i, Unit& u) const {
        const int L = i * G + c, nwg = t8 * npn; if (L >= nwg) return false;
        int wgid = L; { const int q = nwg / NXCD, r = nwg % NXCD, xcd = wgid % NXCD, off = wgid / NXCD; wgid = (xcd < r ? xcd * (q + 1) : r * (q + 1) + (xcd - r) * q) + off; }
        const int nig = WGM * npn, gid = wgid / nig, fm = gid * WGM, gsz = (t8 - fm) < WGM ? (t8 - fm) : WGM;
        const int ti = fm + ((wgid % nig) % gsz); u.pn = (wgid % nig) / gsz; u.pm = ti;
        u.e = (ti >= t1) + (ti >= t2) + (ti >= t3) + (ti >= t4) + (ti >= t5) + (ti >= t6) + (ti >= t7); return true;
    }
    __device__ __forceinline__ int ecnt(int e) const { return e == 0 ? c0 : e == 1 ? c1 : e == 2 ? c2 : e == 3 ? c3 : e == 4 ? c4 : e == 5 ? c5 : e == 6 ? c6 : c7; }
    __device__ __forceinline__ int etb(int e) const { return e == 0 ? 0 : e == 1 ? t1 : e == 2 ? t2 : e == 3 ? t3 : e == 4 ? t4 : e == 5 ? t5 : e == 6 ? t6 : t7; }
    __device__ __forceinline__ int arow(const Unit& u, int r) const {
        if (!gather) return u.pm * BM + r;
        const int pos = (u.pm - etb(u.e)) * BM + r;
        const int n_e = ecnt(u.e); const int v = list[u.e * NLAT + (pos < n_e ? pos : 0)] >> 1; return pos < n_e ? v : 0;
    }
};
struct EpiMoeDown {
    static constexpr bool PERM = true;
    bf16_t* Y; const int* list; const float* topw; MoeOrder mo;
    __device__ __forceinline__ void operator()(const f32x4 (&acc)[2][2][4][2], const Unit& u, int wr, int wc, int fr, int fq) const {
        const int pos0 = (u.pm - mo.etb(u.e)) * BM + wr * 64 + fr, n_e = mo.ecnt(u.e), col0 = u.pn * BM + wc * 32 + 8 * fq;
        int tkv[8]; float wgv[8];
#pragma unroll
        for (int i = 0; i < 8; ++i) { const int pos = pos0 + (i >> 2) * HALF + (i & 3) * 16; tkv[i] = list[u.e * NLAT + (pos < n_e ? pos : 0)]; }
#pragma unroll
        for (int i = 0; i < 8; ++i) wgv[i] = topw[tkv[i]];
#pragma unroll
        for (int ai = 0; ai < 2; ++ai)
#pragma unroll
            for (int m = 0; m < 4; ++m) { const int pos = pos0 + ai * HALF + m * 16;
                if (pos < n_e) { const int tk = tkv[ai * 4 + m]; const float wgt = wgv[ai * 4 + m]; bf16_t* rowp = Y + (size_t)tk * DM + col0;
#pragma unroll
                    for (int bj = 0; bj < 2; ++bj) { const f32x4 v0 = acc[ai][bj][m][0] * wgt, v1 = acc[ai][bj][m][1] * wgt;
                        u32x4 w; w.x = cvtpk(v0[0], v0[1]); w.y = cvtpk(v0[2], v0[3]); w.z = cvtpk(v1[0], v1[1]); w.w = cvtpk(v1[2], v1[3]);
                        *(u32x4*)(rowp + bj * HALF) = w; } } }
    }
};
}
constexpr int NWAVES = 8, NTHR = 512;
constexpr int RING_BYTES = 147456;
constexpr int LDSCTL_OFF = RING_BYTES, MISC_OFF = LDSCTL_OFF + 320;
constexpr int LDS_BYTES = RING_BYTES + 1024;
typedef GAS unsigned gu32;
#define RLX_AGENT __ATOMIC_RELAXED, __HIP_MEMORY_SCOPE_AGENT

#define XB_TMO      128
#define XB_XCNT(j)  (256  + 64 * (j))
#define XB_XSUB(j)  (1280 + 64 * (j))
#define XB_XGEN(j)  (2304 + 64 * (j))
#define XB_TOP      3328
#define XB_TOPGEN   3392
#define XCD_BAR_WORDS 3456
#define XB_SPIN_CAP (1u << 18)
__device__ __forceinline__ unsigned xb_ld(unsigned* p)              { return __hip_atomic_load(p, __ATOMIC_RELAXED, __HIP_MEMORY_SCOPE_AGENT); }
__device__ __forceinline__ unsigned xb_add(unsigned* p, unsigned v) { return __hip_atomic_fetch_add(p, v, __ATOMIC_RELAXED, __HIP_MEMORY_SCOPE_AGENT); }
__device__ __forceinline__ unsigned xb_xcc_id() { return (unsigned)__builtin_amdgcn_s_getreg((3 << 11) | 20) & 0xFu; }
#define XB_SPIN(cond, bar) do { unsigned _sp = 0; while (cond) { __builtin_amdgcn_s_sleep(1); \
    if ((++_sp & 255u) == 0u) { if (xb_ld(&(bar)[XB_TMO])) break; if (_sp > XB_SPIN_CAP) { atomicAdd(&(bar)[XB_TMO], 1u); break; } } } } while (0)
struct XcdBarrier { unsigned* bar; unsigned x; volatile LAS unsigned* st; };
__device__ __forceinline__ XcdBarrier xcd_barrier_post(unsigned* bar, volatile LAS unsigned* st, bool leader) {
    XcdBarrier b; b.bar = bar; b.x = xb_xcc_id(); b.st = st;
    if (leader) (void)xb_add(&bar[XB_XCNT(b.x)], 1u);
    return b;
}
__device__ __forceinline__ void xcd_barrier_complete(unsigned* bar, unsigned x, unsigned& nloc, unsigned& nx) {
    const unsigned G = gridDim.x * gridDim.y * gridDim.z;
    unsigned sum, cnt, mine, sp = 0u;
    for (;;) {
        sum = 0u; cnt = 0u; mine = 0u;
#pragma unroll
        for (unsigned j = 0; j < 16; ++j) { const unsigned c = xb_ld(&bar[XB_XCNT(j)]); sum += c; cnt += (c > 0u) ? 1u : 0u; mine = (j == x) ? c : mine; }
        if (sum == G) break;
        __builtin_amdgcn_s_sleep(1);
        if ((++sp & 255u) == 0u) { if (xb_ld(&bar[XB_TMO])) break; if (sp > XB_SPIN_CAP) { atomicAdd(&bar[XB_TMO], 1u); break; } }
    }
    nloc = mine > 0u ? mine : 1u; nx = cnt > 0u ? cnt : 1u;
}
__device__ __forceinline__ void xcd_barrier(const XcdBarrier& b, bool leader) {
    asm volatile("s_waitcnt vmcnt(0)" ::: "memory");
    __syncthreads();
    if (leader) {
        unsigned* bar = b.bar;
        __builtin_amdgcn_s_waitcnt(0);
        unsigned nloc = b.st[0], nx = b.st[1];
        if (nloc == 0u) { xcd_barrier_complete(bar, b.x, nloc, nx); b.st[0] = nloc; b.st[1] = nx; }
        const unsigned old = xb_add(&bar[XB_XSUB(b.x)], 1u);
        const unsigned gen = old / nloc;
        if (old + 1u == (gen + 1u) * nloc) {
            __builtin_amdgcn_fence(__ATOMIC_RELEASE, "agent");
            asm volatile("s_waitcnt vmcnt(0)" ::: "memory");
            const unsigned og = xb_add(&bar[XB_TOP], 1u);
            const unsigned tg = og / nx;
            if (og + 1u == (tg + 1u) * nx) xb_add(&bar[XB_TOPGEN], 1u);
            else XB_SPIN(xb_ld(&bar[XB_TOPGEN]) == tg, bar);
            __builtin_amdgcn_fence(__ATOMIC_ACQUIRE, "agent");
            xb_add(&bar[XB_XGEN(b.x)], 1u);
            asm volatile("s_waitcnt vmcnt(0)" ::: "memory");
        } else {
            XB_SPIN(xb_ld(&bar[XB_XGEN(b.x)]) == gen, bar);
            __builtin_amdgcn_fence(__ATOMIC_ACQUIRE, "agent");
            asm volatile("s_waitcnt vmcnt(0)" ::: "memory");
        }
    }
    __syncthreads();
}

struct Frame {
    unsigned char* sm;
    LAS unsigned char* lds;
    int tid, lane, wave, G, vcu;
    const float *x, *c, *ctx, *c_ctx, *w_mod, *b_mod, *g_mix, *w_in, *w_sgu, *b_sgu, *g_sgu, *beta_sgu, *conv_w, *conv_b, *dt_bias, *a_log, *d_skip, *g_ssd, *g_q, *w_uq, *g_kv, *w_ukv,
                *w_out, *g_ffn, *w_gate, *w_up, *w_down, *w_router, *w_gate_e, *w_up_e, *w_down_e, *g_final;
    float* out; unsigned char* ws;
};
#define WSP(T, off) ((T*)(F.ws + (off)))

__device__ __forceinline__ int rowmap(int mode, int n) {
    if (mode == 1) { if (n < 1792) return n; if (n < 1804) return n + 672; return n - 12; }
    if (mode == 2) return ((n >> 7) << 8) + (n & 127);
    if (mode == 3) return ((n >> 7) << 8) + 128 + (n & 127);
    return n;
}
__device__ __forceinline__ void transpose_item(const float* W, int K, int N, bf16_t* WT, const float* ks, int mode, LAS float* scr, int item, int lane) {
    const int nblk = (N + 31) / 32, kb = item / nblk, nb = item % nblk, k0 = 64 * kb, n0 = 32 * nb;
    const int nn = n0 + (lane & 31); const bool nok = nn < N;
#pragma unroll 16
    for (int i = 0; i < 32; ++i) { const int kk = 2 * i + (lane >> 5); float v = W[(size_t)(k0 + kk) * N + (nok ? nn : N - 1)]; v = nok ? v : 0.f; if (ks) v *= ks[k0 + kk]; scr[kk * 33 + (lane & 31)] = v; }
    LDS_WAIT(); asm volatile("" ::: "memory");
    const int cch = lane & 7;
#pragma unroll
    for (int j = 0; j < 4; ++j) { const int n = (lane >> 3) + 8 * j; const LAS float* s = scr + (8 * cch) * 33 + n;
        u32x4 o; o.x = cvtpk(s[0 * 33], s[1 * 33]); o.y = cvtpk(s[2 * 33], s[3 * 33]); o.z = cvtpk(s[4 * 33], s[5 * 33]); o.w = cvtpk(s[6 * 33], s[7 * 33]);
        if (n0 + n < N) *(u32x4*)(WT + (size_t)rowmap(mode, n0 + n) * K + k0 + 8 * cch) = o; }
    LDS_WAIT(); asm volatile("" ::: "memory");
}
__device__ __forceinline__ void transpose_item64(const float* W, int K, int N, bf16_t* WT, const float* ks, int mode, LAS float* scr, int item, int lane) {
    const int nblk = (N + 63) / 64, kb = item / nblk, nb = item % nblk, k0 = 64 * kb, n0 = 64 * nb;
    const int lr = lane >> 4, lc = (lane & 15) * 4; const bool nok = n0 + lc < N; const int ncol = nok ? n0 + lc : N - 4;
#pragma unroll
    for (int i = 0; i < 16; ++i) { const int kk = 4 * i + lr; f32x4 v = __builtin_nontemporal_load((const f32x4*)(W + (size_t)(k0 + kk) * N + ncol)); if (ks) v = v * ks[k0 + kk];
        scr[kk * 65 + lc] = v[0]; scr[kk * 65 + lc + 1] = v[1]; scr[kk * 65 + lc + 2] = v[2]; scr[kk * 65 + lc + 3] = v[3]; }
    LDS_WAIT(); asm volatile("" ::: "memory");
    const int cch = lane & 7;
#pragma unroll
    for (int j = 0; j < 8; ++j) { const int n = (lane >> 3) + 8 * j; const LAS float* s = scr + (8 * cch) * 65 + n;
        u32x4 o; o.x = cvtpk(s[0 * 65], s[1 * 65]); o.y = cvtpk(s[2 * 65], s[3 * 65]); o.z = cvtpk(s[4 * 65], s[5 * 65]); o.w = cvtpk(s[6 * 65], s[7 * 65]);
        if (n0 + n < N) *(u32x4*)(WT + (size_t)rowmap(mode, n0 + n) * K + k0 + 8 * cch) = o; }
    LDS_WAIT(); asm volatile("" ::: "memory");
}
__device__ __forceinline__ void zero_fill16(Frame& F, void* p, size_t bytes) {
    const size_t n = bytes / 16; const u32x4 z = {0u, 0u, 0u, 0u};
    for (size_t i = (size_t)F.vcu * NTHR + F.tid; i < n; i += (size_t)F.G * NTHR) ((u32x4*)p)[i] = z;
}
__device__ __forceinline__ void mod_gemv(Frame& F, int l, int wi, int nw) {
    LAS float* cond = (LAS float*)F.lds;
    LAS float* red = (LAS float*)(F.lds + 36864);
    __syncthreads();
    for (int i = F.tid; i < 9 * DM; i += NTHR) { const float v = i < 8 * DM ? F.c[i] : F.c_ctx[i - 8 * DM]; cond[i] = silu_f(v); }
    __syncthreads();
    for (int ch = wi; ch < 192; ch += nw) {
        const int cl = F.lane & 31, kh = F.lane >> 5, col = ch * 32 + cl, kg = F.wave;
        const float* wp = F.w_mod + (size_t)l * DM * 6144 + (size_t)(kg * 128 + kh) * 6144 + col;
        float a[9];
#pragma unroll
        for (int r = 0; r < 9; ++r) a[r] = 0.f;
#pragma unroll 8
        for (int k4 = 0; k4 < 16; ++k4) { const float w0 = wp[(size_t)(8 * k4) * 6144], w1 = wp[(size_t)(8 * k4 + 2) * 6144], w2 = wp[(size_t)(8 * k4 + 4) * 6144], w3 = wp[(size_t)(8 * k4 + 6) * 6144];
#pragma unroll
            for (int r = 0; r < 9; ++r) { const LAS float* cp = cond + r * DM + kg * 128 + 8 * k4 + kh; a[r] += (cp[0] * w0 + cp[2] * w1) + (cp[4] * w2 + cp[6] * w3); } }
#pragma unroll
        for (int r = 0; r < 9; ++r) { a[r] += __shfl_xor(a[r], 32); if (kh == 0) red[(kg * 9 + r) * 32 + cl] = a[r]; }
        __syncthreads();
        for (int idx = F.tid; idx < 9 * 32; idx += NTHR) { const int r = idx >> 5, cc = idx & 31; float s = 0.f;
#pragma unroll
            for (int g = 0; g < 8; ++g) s += red[(g * 9 + r) * 32 + cc];
            WSP(float, WS_MOD)[((size_t)l * 9 + r) * 6144 + ch * 32 + cc] = s + F.b_mod[l * 6144 + ch * 32 + cc]; }
        __syncthreads();
    }
}
__device__ __forceinline__ void convert_set(Frame& F, int set, int wi, int nw) {
    __syncthreads();
    LAS float* scr = (LAS float*)(F.lds + F.wave * 16640);
    const int gw = wi * NWAVES + F.wave, NGW = nw * NWAVES;
    constexpr int I_IN = 16 * 39, I_UQ = 6 * 9, I_UKV = 4 * 12, I_OUT = 16 * 16, I_G = 16 * 44, I_D = 44 * 16;
    if (set == 0 || set == 3) { const int l = set == 0 ? 0 : 1; const int n = I_IN + I_UQ + I_UKV + (l == 1 ? I_OUT : 0);
        for (int it = gw; it < n; it += NGW) { int r = it;
            if (r < I_IN) { transpose_item64(F.w_in + (size_t)l * DM * INW, DM, INW, WSP(bf16_t, WS_WIN) + (size_t)l * INP * DM, nullptr, 1, scr, r, F.lane); continue; } r -= I_IN;
            if (r < I_UQ) { transpose_item64(F.w_uq + (size_t)l * 384 * QW, 384, QW, WSP(bf16_t, WS_WUQ) + (size_t)l * QWP * 384, F.g_q + l * 384, 0, scr, r, F.lane); continue; } r -= I_UQ;
            if (r < I_UKV) { transpose_item64(F.w_ukv + (size_t)l * 256 * KVW, 256, KVW, WSP(bf16_t, WS_WUKV) + (size_t)l * KVW * 256, F.g_kv + l * 256, 0, scr, r, F.lane); continue; } r -= I_UKV;
            transpose_item64(F.w_out + (size_t)l * DM * DM, DM, DM, WSP(bf16_t, WS_WOUT) + (size_t)l * DM * DM, nullptr, 0, scr, r, F.lane); }
        const u32x4 z = {0u, 0u, 0u, 0u};
        { u32x4* p0 = (u32x4*)(WSP(bf16_t, WS_WIN) + ((size_t)l * INP + INW) * DM); const size_t n0 = (size_t)(INP - INW) * DM * 2 / 16; for (size_t i = (size_t)wi * NTHR + F.tid; i < n0; i += (size_t)nw * NTHR) p0[i] = z;
          u32x4* p1 = (u32x4*)(WSP(bf16_t, WS_WUQ) + ((size_t)l * QWP + QW) * 384); const size_t n1 = (size_t)(QWP - QW) * 384 * 2 / 16; for (size_t i = (size_t)wi * NTHR + F.tid; i < n1; i += (size_t)nw * NTHR) p1[i] = z; }
    } else if (set == 1) {
        for (int it = gw; it < I_OUT; it += NGW) transpose_item64(F.w_out, DM, DM, WSP(bf16_t, WS_WOUT), nullptr, 0, scr, it, F.lane);
    } else {
        for (int it = gw; it < 2 * I_G + I_D; it += NGW) { int r = it;
            if (r < I_G) { transpose_item64(F.w_gate, DM, DFF, WSP(bf16_t, WS_WGU), nullptr, 2, scr, r, F.lane); continue; } r -= I_G;
            if (r < I_G) { transpose_item64(F.w_up, DM, DFF, WSP(bf16_t, WS_WGU), nullptr, 3, scr, r, F.lane); continue; } r -= I_G;
            transpose_item64(F.w_down, DFF, DM, WSP(bf16_t, WS_WD), nullptr, 0, scr, r, F.lane); }
    }
    __syncthreads();
}
__device__ __forceinline__ void p_prologue(Frame& F) {
    const bool two = F.G == 256;
    if (!two || F.vcu < 192) mod_gemv(F, 0, F.vcu, two ? 192 : F.G);
    if (!two || F.vcu >= 192) for (int set_ = 0; set_ < 2; ++set_) convert_set(F, set_, two ? F.vcu - 192 : F.vcu, two ? 64 : F.G);
    if (F.vcu == 0) { for (int i = F.tid; i < 64 * 8; i += NTHR) { const int pos = i >> 3, f = i & 7; const float inv = powf(10000.f, -(float)f / 8.f); const float ang = (float)pos * inv;
            WSP(f32x2, WS_MISC + MISC_ROPE)[i] = (f32x2){cosf(ang), sinf(ang)}; } }
    for (int i = F.vcu * NTHR + F.tid; i < 2 * 4 * 128 * 128 / 2; i += F.G * NTHR) { const f32x2 v = ((const f32x2*)F.w_sgu)[i]; WSP(unsigned, WS_WSGU)[i] = cvtpk(v.x, v.y); }
}
__device__ __forceinline__ bool tail_worker(int nwg, int G, int c, int& wi, int& nw) {
    const int rounds = (nwg + G - 1) / G, first = nwg - (rounds - 1) * G;
    if (first >= G) { wi = c; nw = G; return true; }
    if (c < first) return false;
    wi = c - first; nw = G - first; return true;
}
__device__ __forceinline__ void p_moe_weights(Frame& F) {
    __syncthreads();
    LAS float* scr = (LAS float*)(F.lds + F.wave * 16640);
    const int gw = F.vcu * NWAVES + F.wave, NGW = F.G * NWAVES;
    constexpr int I_G = 16 * 22, I_D = 22 * 16, PER_E = 2 * I_G + I_D;
    for (int it = gw; it < 8 * PER_E; it += NGW) {
        const int e = it / PER_E; int r = it - e * PER_E;
        bf16_t* gu = WSP(bf16_t, WS_MOEW_GU) + (size_t)e * 2 * DFE * DM;
        if (r < I_G) { transpose_item64(F.w_gate_e + (size_t)e * DM * DFE, DM, DFE, gu, nullptr, 2, scr, r, F.lane); continue; } r -= I_G;
        if (r < I_G) { transpose_item64(F.w_up_e + (size_t)e * DM * DFE, DM, DFE, gu, nullptr, 3, scr, r, F.lane); continue; } r -= I_G;
        transpose_item64(F.w_down_e + (size_t)e * DFE * DM, DFE, DM, WSP(bf16_t, WS_MOEW_D) + (size_t)e * DM * DFE, nullptr, 0, scr, r, F.lane);
    }
    __syncthreads();
}

template <bool ROUTE>
__device__ __forceinline__ void p_norm(Frame& F, int l, int which, int nrows, const float* srcL, const float* srcC, const float* slab = nullptr, const float* slabgate = nullptr) {
    const float* mod = WSP(float, WS_MOD) + (size_t)l * 9 * 6144;
    const float* g = (which == 0 ? F.g_mix : F.g_ffn) + l * DM;
    bf16_t* H = WSP(bf16_t, WS_H);
    LAS int* lcnt = (LAS int*)(F.lds + 32768);
    LAS int* rec = (LAS int*)(F.lds + 32768 + 64);
    int nrec = 0;
    if (ROUTE) { LAS float* wr = (LAS float*)F.lds; for (int i = F.tid; i < DM * 8; i += NTHR) wr[i] = F.w_router[i]; if (F.tid < 16) lcnt[F.tid] = 0; __syncthreads(); }
    const int gw = F.vcu * NWAVES + F.wave, NGW = F.G * NWAVES;
    for (int row = gw; row < nrows; row += NGW) {
        const bool isc = row >= NLAT; const int b = isc ? 8 : (row >> 11);
        const float* xr = isc ? srcC + (size_t)(row - NLAT) * DM : srcL + (size_t)row * DM;
        f32x4 v[4]; float s = 0.f;
#pragma unroll
        for (int j = 0; j < 4; ++j) v[j] = *(const f32x4*)(xr + 256 * j + 4 * F.lane);
        if (slab && isc) {
#pragma unroll
            for (int j = 0; j < 4; ++j) { const size_t o_ = (size_t)(row - NLAT) * DM + 256 * j + 4 * F.lane; const f32x4 gt = *(const f32x4*)(slabgate + 256 * j + 4 * F.lane);
                const f32x4 p0 = *(const f32x4*)(slab + o_), p1 = *(const f32x4*)(slab + (size_t)NCTX * DM + o_), p2 = *(const f32x4*)(slab + (size_t)2 * NCTX * DM + o_), p3 = *(const f32x4*)(slab + (size_t)3 * NCTX * DM + o_);
                v[j] = v[j] + gt * ((p0 + p1) + (p2 + p3)); } }
#pragma unroll
        for (int j = 0; j < 4; ++j) s += (v[j].x * v[j].x + v[j].y * v[j].y) + (v[j].z * v[j].z + v[j].w * v[j].w);
        const float rstd = rsqrtf(wave_sum(s) * (1.f / DM) + EPS);
        const float* sh = mod + (size_t)b * 6144 + (which * 3) * DM; const float* sc = sh + DM;
        float lg[8];
        if (ROUTE) {
#pragma unroll
            for (int e = 0; e < 8; ++e) lg[e] = 0.f; }
#pragma unroll
        for (int j = 0; j < 4; ++j) { const int k = 256 * j + 4 * F.lane;
            const f32x4 gg = *(const f32x4*)(g + k), s1 = *(const f32x4*)(sc + k), s0 = *(const f32x4*)(sh + k);
            f32x4 h = (v[j] * rstd) * gg * (s1 + 1.f) + s0;
            u32x2 w; w.x = cvtpk(h.x, h.y); w.y = cvtpk(h.z, h.w);
            *(u32x2*)(H + (size_t)row * DM + k) = w;
            if (ROUTE) { const LAS float* wr = (const LAS float*)F.lds + k * 8;
#pragma unroll
                for (int i = 0; i < 4; ++i) { const f32x4 w0 = *(const LAS f32x4*)(wr + 8 * i), w1 = *(const LAS f32x4*)(wr + 8 * i + 4); const float hv = h[i];
                    lg[0] += hv * w0.x; lg[1] += hv * w0.y; lg[2] += hv * w0.z; lg[3] += hv * w0.w; lg[4] += hv * w1.x; lg[5] += hv * w1.y; lg[6] += hv * w1.z; lg[7] += hv * w1.w; }
                asm volatile("" ::: "memory"); }
        }
        if (ROUTE) {
#pragma unroll
            for (int e = 0; e < 8; ++e) lg[e] = wave_sum(lg[e]);
            int i0 = 0; float m0 = lg[0];
#pragma unroll
            for (int e = 1; e < 8; ++e) if (lg[e] > m0) { m0 = lg[e]; i0 = e; }
            int i1 = -1; float m1 = -3.0e38f;
#pragma unroll
            for (int e = 0; e < 8; ++e) if (e != i0 && lg[e] > m1) { m1 = lg[e]; i1 = e; }
            const float w1 = 1.f / (1.f + __expf(m0 - m1)), w0 = 1.f - w1;
            if (F.lane == 0) { float* tw = WSP(float, WS_MISC + MISC_TOPW);
                const int p0 = __hip_atomic_fetch_add(lcnt + i0, 1, __ATOMIC_RELAXED, __HIP_MEMORY_SCOPE_WORKGROUP), p1 = __hip_atomic_fetch_add(lcnt + i1, 1, __ATOMIC_RELAXED, __HIP_MEMORY_SCOPE_WORKGROUP);
                LAS int* r = rec + (F.wave * 16 + nrec) * 4; r[0] = row; r[1] = i0 | (i1 << 8); r[2] = p0; r[3] = p1; tw[row * 2] = w0; tw[row * 2 + 1] = w1; }
            ++nrec;
        }
    }
    if (ROUTE) {
        __syncthreads();
        if (F.tid < 8) lcnt[8 + F.tid] = (int)atomicAdd(WSP(unsigned, WS_CTL) + CW_CNT + 64 * F.tid, (unsigned)lcnt[F.tid]);
        __syncthreads();
        int* list = WSP(int, WS_LIST);
        if (F.lane < nrec) { const LAS int* r = rec + (F.wave * 16 + F.lane) * 4; const int row = r[0], i0 = r[1] & 255, i1 = r[1] >> 8;
            list[i0 * NLAT + lcnt[8 + i0] + r[2]] = row * 2; list[i1 * NLAT + lcnt[8 + i1] + r[3]] = row * 2 + 1; }
        __syncthreads();
    }
}
__device__ __forceinline__ void p_final(Frame& F) {
    const float* mod = WSP(float, WS_MOD) + (size_t)1 * 9 * 6144; const bf16_t* Y = WSP(bf16_t, WS_Y);
    const int gw = F.vcu * NWAVES + F.wave, NGW = F.G * NWAVES;
    for (int row = gw; row < NLAT; row += NGW) {
        const int b = row >> 11; float* xr = F.out + (size_t)row * DM; const float* gt = mod + (size_t)b * 6144 + 5 * DM;
        f32x4 v[4]; float s = 0.f;
#pragma unroll
        for (int j = 0; j < 4; ++j) { const int k = 256 * j + 4 * F.lane; const f32x4 xv = *(const f32x4*)(xr + k), gv = *(const f32x4*)(gt + k);
            const u32x2 a = *(const u32x2*)(Y + (size_t)(2 * row) * DM + k), c = *(const u32x2*)(Y + (size_t)(2 * row + 1) * DM + k);
            f32x4 y; y.x = bflo(a.x) + bflo(c.x); y.y = bfhi(a.x) + bfhi(c.x); y.z = bflo(a.y) + bflo(c.y); y.w = bfhi(a.y) + bfhi(c.y);
            v[j] = xv + gv * y; s += (v[j].x * v[j].x + v[j].y * v[j].y) + (v[j].z * v[j].z + v[j].w * v[j].w); }
        const float rstd = rsqrtf(wave_sum(s) * (1.f / DM) + EPS);
#pragma unroll
        for (int j = 0; j < 4; ++j) { const int k = 256 * j + 4 * F.lane; *(f32x4*)(xr + k) = (v[j] * rstd) * *(const f32x4*)(F.g_final + k); }
    }
}
constexpr int LP = 272;
__device__ __forceinline__ void chunk_rows(int u, int& row0, bool& isc) {
    if (u < 128) { row0 = (u >> 4) * SEQ + (u & 15) * 128; isc = false; } else { const int uu = u - 128; row0 = NLAT + (uu >> 1) * CTXL + (uu & 1) * 128; isc = true; }
}
__device__ __forceinline__ void krope_unit(Frame& F, int u) {
    int row0; bool isc; chunk_rows(u, row0, isc);
    const bf16_t* P = WSP(bf16_t, WS_P);
    if (F.tid < 128) {
        const int row = row0 + F.tid; const u32x4* src = (const u32x4*)(P + (size_t)row * INP + PC_KR);
        u32x4 q[4];
#pragma unroll
        for (int i = 0; i < 4; ++i) q[i] = src[i];
        if (!isc) {
            const int tok = row & (SEQ - 1); const f32x2* rt = WSP(f32x2, WS_MISC + MISC_ROPE);
            float v[32];
#pragma unroll
            for (int i = 0; i < 4; ++i) { v[8 * i] = bflo(q[i].x); v[8 * i + 1] = bfhi(q[i].x); v[8 * i + 2] = bflo(q[i].y); v[8 * i + 3] = bfhi(q[i].y); v[8 * i + 4] = bflo(q[i].z); v[8 * i + 5] = bfhi(q[i].z); v[8 * i + 6] = bflo(q[i].w); v[8 * i + 7] = bfhi(q[i].w); }
#pragma unroll
            for (int ax = 0; ax < 2; ++ax) { const int pos = ax == 0 ? (tok >> 6) : (tok & 63);
#pragma unroll
                for (int f = 0; f < 8; ++f) { const f32x2 cs = rt[pos * 8 + f]; const float t1 = v[16 * ax + f], t2 = v[16 * ax + 8 + f];
                    v[16 * ax + f] = t1 * cs.x - t2 * cs.y; v[16 * ax + 8 + f] = t1 * cs.y + t2 * cs.x; } }
#pragma unroll
            for (int i = 0; i < 4; ++i) { q[i].x = cvtpk(v[8 * i], v[8 * i + 1]); q[i].y = cvtpk(v[8 * i + 2], v[8 * i + 3]); q[i].z = cvtpk(v[8 * i + 4], v[8 * i + 5]); q[i].w = cvtpk(v[8 * i + 6], v[8 * i + 7]); }
        }
        u32x4* dst = (u32x4*)(WSP(bf16_t, WS_KR) + (size_t)row * 32);
#pragma unroll
        for (int i = 0; i < 4; ++i) dst[i] = q[i];
    }
}
__device__ __forceinline__ void sgu_unit(Frame& F, int l, int u) {
    int row0; bool isc; chunk_rows(u, row0, isc);
    const bf16_t* P = WSP(bf16_t, WS_P); bf16_t* CAT = WSP(bf16_t, WS_CAT);
    LAS unsigned char* VT = F.lds;
    LAS unsigned char* WB = F.lds + 256 * LP;
    const int w = F.wave, lane = F.lane;
    {
        const f32x4 gs = *(const f32x4*)(F.g_sgu + l * 256 + 4 * lane), bs = *(const f32x4*)(F.beta_sgu + l * 256 + 4 * lane);
#pragma unroll
        for (int grp = 0; grp < 2; ++grp) {
            const int s0 = 16 * w + 8 * grp;
            float v[8][4];
#pragma unroll
            for (int tt = 0; tt < 8; ++tt) { const u32x2 r = *(const u32x2*)(P + (size_t)(row0 + s0 + tt) * INP + PC_V + 4 * lane);
                v[tt][0] = gelu_tanh(bflo(r.x)); v[tt][1] = gelu_tanh(bfhi(r.x)); v[tt][2] = gelu_tanh(bflo(r.y)); v[tt][3] = gelu_tanh(bfhi(r.y)); }
#pragma unroll
            for (int tt = 0; tt < 8; ++tt) {
                const float mu = wave_sum((v[tt][0] + v[tt][1]) + (v[tt][2] + v[tt][3])) * (1.f / 256.f);
                float d0 = v[tt][0] - mu, d1 = v[tt][1] - mu, d2 = v[tt][2] - mu, d3 = v[tt][3] - mu;
                const float rstd = rsqrtf(wave_sum((d0 * d0 + d1 * d1) + (d2 * d2 + d3 * d3)) * (1.f / 256.f) + EPS);
                v[tt][0] = d0 * rstd * gs.x + bs.x; v[tt][1] = d1 * rstd * gs.y + bs.y; v[tt][2] = d2 * rstd * gs.z + bs.z; v[tt][3] = d3 * rstd * gs.w + bs.w; }
#pragma unroll
            for (int i = 0; i < 4; ++i) { u32x4 o; o.x = cvtpk(v[0][i], v[1][i]); o.y = cvtpk(v[2][i], v[3][i]); o.z = cvtpk(v[4][i], v[5][i]); o.w = cvtpk(v[6][i], v[7][i]);
                *(LAS u32x4*)(VT + (4 * lane + i) * LP + s0 * 2) = o; }
        }
    }
    const bf16_t* Wg = WSP(bf16_t, WS_WSGU) + (size_t)l * 4 * 128 * 128;
#define SGU_STAGE_W(h, buf) do { _Pragma("unroll") for (int _i = 0; _i < 4; ++_i) { const int q_ = F.tid + NTHR * _i, r_ = q_ >> 4, c_ = q_ & 15; \
        *(LAS u32x4*)(WB + (buf) * 128 * LP + r_ * LP + c_ * 16) = *(const u32x4*)(Wg + (size_t)(h) * 16384 + r_ * 128 + c_ * 8); } } while (0)
    SGU_STAGE_W(0, 0);
    u32x2 upre[4][4];
    { const int t_ = 16 * w + (lane & 15), row_ = row0 + t_;
#pragma unroll
        for (int h = 0; h < 4; ++h)
#pragma unroll
            for (int dt = 0; dt < 4; ++dt) upre[h][dt] = *(const u32x2*)(P + (size_t)row_ * INP + PC_U + h * 64 + dt * 16 + 4 * (lane >> 4)); }
    __syncthreads();
    f32x4 acc[4][4];
#pragma unroll
    for (int h = 0; h < 4; ++h)
#pragma unroll
        for (int dt = 0; dt < 4; ++dt) acc[h][dt] = (f32x4){0.f, 0.f, 0.f, 0.f};
    const int fr = lane & 15, fq = lane >> 4;
#pragma unroll
    for (int h = 0; h < 4; ++h) {
        if (h + 1 < 4) SGU_STAGE_W(h + 1, (h + 1) & 1);
        const LAS unsigned char* Wh = WB + (h & 1) * 128 * LP;
#pragma unroll
        for (int ks = 0; ks < 4; ++ks) {
            const bf16x8 bw = *(const LAS bf16x8*)(Wh + (16 * w + fr) * LP + (32 * ks + 8 * fq) * 2);
#pragma unroll
            for (int dt = 0; dt < 4; ++dt) { const bf16x8 av = *(const LAS bf16x8*)(VT + (h * 64 + dt * 16 + fr) * LP + (32 * ks + 8 * fq) * 2);
                acc[h][dt] = MFMA16(av, bw, acc[h][dt]); }
        }
        __syncthreads();
    }
#undef SGU_STAGE_W
    { const int t = 16 * w + fr, row = row0 + t;
#pragma unroll
        for (int h = 0; h < 4; ++h) { const float bsv = F.b_sgu[(l * 4 + h) * 128 + t];
#pragma unroll
            for (int dt = 0; dt < 4; ++dt) { const int c = h * 64 + dt * 16 + 4 * fq; const u32x2 r = upre[h][dt];
                const float o0 = gelu_tanh(bflo(r.x)) * (acc[h][dt][0] + bsv), o1 = gelu_tanh(bfhi(r.x)) * (acc[h][dt][1] + bsv), o2 = gelu_tanh(bflo(r.y)) * (acc[h][dt][2] + bsv), o3 = gelu_tanh(bfhi(r.y)) * (acc[h][dt][3] + bsv);
                u32x2 o; o.x = cvtpk(o0, o1); o.y = cvtpk(o2, o3); *(u32x2*)(CAT + (size_t)row * DM + c) = o; } } }
    __syncthreads();
}

__device__ __forceinline__ void ssd_local_unit(Frame& F, int l, int u) {
    int b, c, g, row0, seq0, seqlen; bool isc;
    if (u < 256) { b = u >> 5; c = (u >> 1) & 15; g = u & 1; row0 = b * SEQ + c * 128; seq0 = b * SEQ; seqlen = SEQ; isc = false; }
    else { const int uu = u - 256; b = uu >> 2; c = (uu >> 1) & 1; g = uu & 1; row0 = NLAT + b * CTXL + c * 128; seq0 = NLAT + b * CTXL; seqlen = CTXL; isc = true; }
    const bf16_t* P = WSP(bf16_t, WS_P);
    LAS unsigned char* R1 = F.lds;
    LAS unsigned char* R2 = F.lds + 128 * LP;
    LAS unsigned char* XT = F.lds + 256 * LP;
    LAS float* dtv = (LAS float*)(F.lds + 448 * LP);
    LAS float* acsv = dtv + 768;
    LAS float* wv = acsv + 768;
    const int w = F.wave, lane = F.lane, tid = F.tid, fr = lane & 15, fq = lane >> 4;
    const float* cw = F.conv_w + (size_t)l * 5 * 896; const float* cb = F.conv_b + l * 896;
    LAS float* wlb = (LAS float*)(F.lds + 448 * LP + 9216);
    if (tid < 56) { const int chx0 = tid < 24 ? g * 192 + 8 * tid : (tid < 40 ? 384 + g * 128 + 8 * (tid - 24) : 640 + g * 128 + 8 * (tid - 40));
#pragma unroll
        for (int k = 0; k < 5; ++k) { *(LAS f32x4*)(wlb + tid * 48 + 8 * k) = *(const f32x4*)(cw + k * 896 + chx0); *(LAS f32x4*)(wlb + tid * 48 + 8 * k + 4) = *(const f32x4*)(cw + k * 896 + chx0 + 4); }
        *(LAS f32x4*)(wlb + tid * 48 + 40) = *(const f32x4*)(cb + chx0); *(LAS f32x4*)(wlb + tid * 48 + 44) = *(const f32x4*)(cb + chx0 + 4); }
    __syncthreads();
    if (tid < 448) {
        const int cg = tid % 56, seg = tid / 56;
        int pcol, role, lch;
        if (cg < 24) { role = 0; lch = 8 * cg; pcol = PC_X + g * 192 + lch; }
        else if (cg < 40) { role = 1; lch = 8 * (cg - 24); pcol = PC_B + g * 128 + lch; }
        else { role = 2; lch = 8 * (cg - 40); pcol = PC_C + g * 128 + lch; }
        const LAS float* wl = wlb + cg * 48;
#pragma unroll 1
        for (int hb = 0; hb < 2; ++hb) {
            const int t0 = 16 * seg + 8 * hb;
            u32x4 rows[12];
#pragma unroll
            for (int i = 0; i < 12; ++i) { const int grow = row0 + t0 - 2 + i;
                if (i >= 2 && i < 10) rows[i] = *(const u32x4*)(P + (size_t)grow * INP + pcol);
                else { const bool ok = grow >= seq0 && grow < seq0 + seqlen; const int gcl = i < 2 ? (grow < seq0 ? seq0 : grow) : (grow >= seq0 + seqlen ? seq0 + seqlen - 1 : grow);
                    const u32x4 v_ = *(const u32x4*)(P + (size_t)gcl * INP + pcol); rows[i] = ok ? v_ : (u32x4){0u, 0u, 0u, 0u}; } }
            unsigned pk[8][4];
#pragma unroll
            for (int o2 = 0; o2 < 4; ++o2) {
                float y[2][8];
#pragma unroll
                for (int e = 0; e < 2; ++e) { const int o = 2 * o2 + e; f32x4 ya = *(const LAS f32x4*)(wl + 40), yb = *(const LAS f32x4*)(wl + 44);
#pragma unroll
                    for (int k = 0; k < 5; ++k) { const u32x4 r = rows[o + k]; const f32x4 xa = {bflo(r.x), bfhi(r.x), bflo(r.y), bfhi(r.y)}, xb = {bflo(r.z), bfhi(r.z), bflo(r.w), bfhi(r.w)};
                        ya += *(const LAS f32x4*)(wl + 8 * k) * xa; yb += *(const LAS f32x4*)(wl + 8 * k + 4) * xb; }
#pragma unroll
                    for (int c8 = 0; c8 < 4; ++c8) { y[e][c8] = silu_f(ya[c8]); y[e][4 + c8] = silu_f(yb[c8]); }
                    if (role != 0) { u32x4 st; st.x = cvtpk(y[e][0], y[e][1]); st.y = cvtpk(y[e][2], y[e][3]); st.z = cvtpk(y[e][4], y[e][5]); st.w = cvtpk(y[e][6], y[e][7]);
                        *(u32x4*)((role == 1 ? R2 : R1) + (t0 + o) * LP + lch * 2) = st;
                        if (role == 2) *(u32x4*)(WSP(bf16_t, WS_CC) + (size_t)(row0 + t0 + o) * 256 + g * 128 + lch) = st; }
                }
#pragma unroll
                for (int c8 = 0; c8 < 8; ++c8) pk[c8][o2] = cvtpk(y[0][c8], y[1][c8]);
            }
            if (role == 0) {
#pragma unroll
                for (int c8 = 0; c8 < 8; ++c8) *(LAS u32x4*)(XT + (lch + c8) * LP + t0 * 2) = (u32x4){pk[c8][0], pk[c8][1], pk[c8][2], pk[c8][3]}; }
        }
    }
    else {
        bf16_t draw[6][2];
#pragma unroll
        for (int q = 0; q < 6; ++q) { const int d = q / 3, h = g * 3 + q % 3; const int e0 = 2 * lane, t0 = d == 0 ? e0 : 127 - e0, t1 = d == 0 ? e0 + 1 : 126 - e0;
            draw[q][0] = P[(size_t)(row0 + t0) * INP + PC_DT + d * 6 + h]; draw[q][1] = P[(size_t)(row0 + t1) * INP + PC_DT + d * 6 + h]; }
        asm volatile("" ::: "memory");
#pragma unroll
        for (int q = 0; q < 6; ++q) { const int d = q / 3, j = q % 3, h = g * 3 + j;
            const float a = -__expf(F.a_log[l * 12 + d * 6 + h]), bias = F.dt_bias[l * 12 + d * 6 + h];
            const int e0 = 2 * lane, e1 = 2 * lane + 1, t0 = d == 0 ? e0 : 127 - e0, t1 = d == 0 ? e1 : 127 - e1;
            const float dt0 = softplus_f(bf1(draw[q][0]) + bias), dt1 = softplus_f(bf1(draw[q][1]) + bias);
            const float x0 = dt0 * a, x1 = dt1 * a; float s = x0 + x1;
#pragma unroll
            for (int off = 1; off < 64; off <<= 1) { const float t = __shfl_up(s, off); if (lane >= off) s += t; }
            const float a1v = s, a0v = s - x1, tot = __shfl(s, 63);
            dtv[q * 128 + t0] = dt0; dtv[q * 128 + t1] = dt1; acsv[q * 128 + t0] = a0v; acsv[q * 128 + t1] = a1v;
            wv[q * 128 + t0] = __expf(tot - a0v) * dt0; wv[q * 128 + t1] = __expf(tot - a1v) * dt1;
            float* ACS = WSP(float, WS_ACS); ACS[(size_t)(row0 + t0) * 12 + d * 6 + h] = a0v; ACS[(size_t)(row0 + t1) * 12 + d * 6 + h] = a1v;
            if (lane == 0) { const int pos = isc ? (d == 0 ? c : 1 - c) : (d == 0 ? 2 + c : 17 - c); WSP(float, WS_MISC + MISC_DEC)[((b * 2 + d) * NPOS + pos) * 6 + h] = __expf(tot); }
        }
    }
    __syncthreads();
    f32x4 G[8];
#pragma unroll
    for (int t = 0; t < 8; ++t) G[t] = (f32x4){0.f, 0.f, 0.f, 0.f};
#pragma unroll
    for (int ks = 0; ks < 4; ++ks) { const bf16x8 cf = *(const LAS bf16x8*)(R1 + (16 * w + fr) * LP + (32 * ks + 8 * fq) * 2);
#pragma unroll
        for (int t = 0; t < 8; ++t) { const bf16x8 bfm = *(const LAS bf16x8*)(R2 + (16 * t + fr) * LP + (32 * ks + 8 * fq) * 2); G[t] = MFMA16(bfm, cf, G[t]); } }
    __syncthreads();
    if (tid < 256) { const int sb = tid >> 4, nb = tid & 15; u32x4 r[8];
#pragma unroll
        for (int i = 0; i < 8; ++i) r[i] = *(const LAS u32x4*)(R2 + (8 * sb + i) * LP + nb * 16);
#pragma unroll
        for (int j = 0; j < 8; ++j) { u32x4 o;
            if ((j & 1) == 0) { o.x = (r[0][j >> 1] & 0xffffu) | (r[1][j >> 1] << 16); o.y = (r[2][j >> 1] & 0xffffu) | (r[3][j >> 1] << 16); o.z = (r[4][j >> 1] & 0xffffu) | (r[5][j >> 1] << 16); o.w = (r[6][j >> 1] & 0xffffu) | (r[7][j >> 1] << 16); }
            else { o.x = (r[0][j >> 1] >> 16) | (r[1][j >> 1] & 0xffff0000u); o.y = (r[2][j >> 1] >> 16) | (r[3][j >> 1] & 0xffff0000u); o.z = (r[4][j >> 1] >> 16) | (r[5][j >> 1] & 0xffff0000u); o.w = (r[6][j >> 1] >> 16) | (r[7][j >> 1] & 0xffff0000u); }
            *(LAS u32x4*)(R1 + (8 * nb + j) * LP + sb * 16) = o; } }
    __syncthreads();
    LAS unsigned char* Mw = R2 + w * 16 * LP;
    bf16_t* ST = WSP(bf16_t, WS_ST); float* YP = WSP(float, WS_YP);
    const bool needy = !(isc && l == DEPTH - 1);
    const int lrow = 16 * w + fr;
#pragma unroll 1
    for (int j = 0; j < 3; ++j) {
        const int h = g * 3 + j;
        f32x4 ay[4];
#pragma unroll
        for (int pt = 0; pt < 4; ++pt) ay[pt] = (f32x4){0.f, 0.f, 0.f, 0.f};
#pragma unroll 1
        for (int d = 0; d < 2; ++d) {
            const int q = d * 3 + j; const float al = acsv[q * 128 + lrow];
            if (needy) {
#pragma unroll
            for (int t = 0; t < 8; ++t) { const int s4 = 16 * t + 4 * fq; u32x2 o = {0u, 0u};
                if (d == 0 ? (t <= w) : (t >= w)) {
                    const f32x4 as = *(const LAS f32x4*)(acsv + q * 128 + s4), ds = *(const LAS f32x4*)(dtv + q * 128 + s4);
                    float mv[4];
#pragma unroll
                    for (int r = 0; r < 4; ++r) { const int s = s4 + r; const bool ok = (t != w) || (d == 0 ? (s <= lrow) : (s >= lrow)); mv[r] = ok ? G[t][r] * __expf(al - as[r]) * ds[r] : 0.f; }
                    o.x = cvtpk(mv[0], mv[1]); o.y = cvtpk(mv[2], mv[3]); }
                *(LAS u32x2*)(Mw + fr * LP + s4 * 2) = o; }
            LDS_WAIT();
#pragma unroll
            for (int ks = 0; ks < 4; ++ks) if (d == 0 ? (2 * ks <= w) : (2 * ks + 1 >= w)) { const bf16x8 mf = *(const LAS bf16x8*)(Mw + fr * LP + (32 * ks + 8 * fq) * 2);
#pragma unroll
                for (int pt = 0; pt < 4; ++pt) { const bf16x8 xf = *(const LAS bf16x8*)(XT + (j * 64 + 16 * pt + fr) * LP + (32 * ks + 8 * fq) * 2); ay[pt] = MFMA16(xf, mf, ay[pt]); } }
            }
            f32x4 as4[4];
#pragma unroll
            for (int pt = 0; pt < 4; ++pt) as4[pt] = (f32x4){0.f, 0.f, 0.f, 0.f};
#pragma unroll
            for (int ks = 0; ks < 4; ++ks) { const u32x4 raw = *(const LAS u32x4*)(R1 + (16 * w + fr) * LP + (32 * ks + 8 * fq) * 2);
                const f32x4 wa = *(const LAS f32x4*)(wv + q * 128 + 32 * ks + 8 * fq), wb = *(const LAS f32x4*)(wv + q * 128 + 32 * ks + 8 * fq + 4);
                u32x4 sc; sc.x = cvtpk(bflo(raw.x) * wa.x, bfhi(raw.x) * wa.y); sc.y = cvtpk(bflo(raw.y) * wa.z, bfhi(raw.y) * wa.w); sc.z = cvtpk(bflo(raw.z) * wb.x, bfhi(raw.z) * wb.y); sc.w = cvtpk(bflo(raw.w) * wb.z, bfhi(raw.w) * wb.w);
                const bf16x8 bsf = __builtin_bit_cast(bf16x8, sc);
#pragma unroll
                for (int pt = 0; pt < 4; ++pt) { const bf16x8 xf = *(const LAS bf16x8*)(XT + (j * 64 + 16 * pt + fr) * LP + (32 * ks + 8 * fq) * 2); as4[pt] = MFMA16(bsf, xf, as4[pt]); } }
            { const int pos = isc ? (d == 0 ? c : 1 - c) : (d == 0 ? 2 + c : 17 - c); bf16_t* sp = ST + ((size_t)((b * 2 + d) * NPOS + pos) * 6 + h) * 8192;
#pragma unroll
                for (int pt = 0; pt < 4; ++pt) { u32x2 o; o.x = cvtpk(as4[pt][0], as4[pt][1]); o.y = cvtpk(as4[pt][2], as4[pt][3]); *(u32x2*)(sp + (16 * pt + fr) * 128 + 16 * w + 4 * fq) = o; } }
        }
        if (needy) { const float skip = F.d_skip[l * 6 + h];
#pragma unroll
            for (int pt = 0; pt < 4; ++pt) { f32x4 o;
#pragma unroll
                for (int r = 0; r < 4; ++r) o[r] = ay[pt][r] + skip * bf1(*(const LAS bf16_t*)(XT + (j * 64 + 16 * pt + 4 * fq + r) * LP + lrow * 2));
                *(f32x4*)(YP + (size_t)(row0 + lrow) * 384 + h * 64 + 16 * pt + 4 * fq) = o; } }
    }
    __syncthreads();
}

__device__ __forceinline__ void ssd_scan(Frame& F) {
    bf16_t* ST = WSP(bf16_t, WS_ST); const float* DEC = WSP(float, WS_MISC + MISC_DEC);
    for (int gt = F.vcu * NTHR + F.tid; gt < 96 * 1024; gt += F.G * NTHR) {
        const int combo = gt >> 10, e8 = gt & 1023, bd = combo / 6, h = combo - bd * 6;
        u32x4 st[17]; float dec[17];
#pragma unroll
        for (int q = 0; q < 17; ++q) { const size_t sidx = (size_t)(bd * NPOS + q) * 6 + h; st[q] = *(const u32x4*)(ST + sidx * 8192 + e8 * 8); dec[q] = DEC[sidx]; }
        float hv[8];
#pragma unroll
        for (int i = 0; i < 8; ++i) hv[i] = 0.f;
#pragma unroll
        for (int q = 0; q < 17; ++q) { const size_t sidx = (size_t)(bd * NPOS + q) * 6 + h; const float dq = dec[q];
            hv[0] = dq * hv[0] + bflo(st[q].x); hv[1] = dq * hv[1] + bfhi(st[q].x); hv[2] = dq * hv[2] + bflo(st[q].y); hv[3] = dq * hv[3] + bfhi(st[q].y);
            hv[4] = dq * hv[4] + bflo(st[q].z); hv[5] = dq * hv[5] + bfhi(st[q].z); hv[6] = dq * hv[6] + bflo(st[q].w); hv[7] = dq * hv[7] + bfhi(st[q].w);
            u32x4 o; o.x = cvtpk(hv[0], hv[1]); o.y = cvtpk(hv[2], hv[3]); o.z = cvtpk(hv[4], hv[5]); o.w = cvtpk(hv[6], hv[7]);
            *(u32x4*)(ST + sidx * 8192 + e8 * 8) = o; }
    }
}

__device__ __forceinline__ void ssd_final_unit(Frame& F, int l, int u) {
    int row0; bool isc; chunk_rows(u, row0, isc);
    const int b = isc ? ((u - 128) >> 1) : (u >> 4), c = isc ? ((u - 128) & 1) : (u & 15);
    constexpr int CPITCH = 528;
    LAS unsigned char* Cs = F.lds;
    LAS unsigned char* Hs = F.lds + 128 * CPITCH;
    const int w = F.wave, lane = F.lane, tid = F.tid, fr = lane & 15, fq = lane >> 4;
    const bf16_t* CC = WSP(bf16_t, WS_CC); const bf16_t* ST = WSP(bf16_t, WS_ST); const float* ACS = WSP(float, WS_ACS);
#pragma unroll
    for (int i = 0; i < 8; ++i) { const int q = tid + NTHR * i, r = q >> 5, cc = q & 31; *(LAS u32x4*)(Cs + r * CPITCH + cc * 16) = *(const u32x4*)(CC + (size_t)(row0 + r) * 256 + cc * 8); }
    const int lrow = 16 * w + fr, row = row0 + lrow;
    const int hp = tid >> 3, hn0 = (tid & 7) * 16;
    const float* YP = WSP(float, WS_YP); const bf16_t* P = WSP(bf16_t, WS_P); bf16_t* CAT = WSP(bf16_t, WS_CAT);
    float ss = 0.f;
    const f32x4 ac0 = *(const f32x4*)(ACS + (size_t)row * 12), ac1 = *(const f32x4*)(ACS + (size_t)row * 12 + 4), ac2 = *(const f32x4*)(ACS + (size_t)row * 12 + 8);
    const float acv[12] = {ac0[0], ac0[1], ac0[2], ac0[3], ac1[0], ac1[1], ac1[2], ac1[3], ac2[0], ac2[1], ac2[2], ac2[3]};
    u32x4 hpre[2][2][2]; f32x4 ypre[2][4]; u32x2 zpre[2][4];
#define SSDF_LOAD(hh, S_) do { \
        _Pragma("unroll") for (int d = 0; d < 2; ++d) { const int pos = isc ? (d == 0 ? c : 1 - c) : (d == 0 ? 2 + c : 17 - c); hpre[S_][d][0] = (u32x4){0u, 0u, 0u, 0u}; hpre[S_][d][1] = hpre[S_][d][0]; \
            if (pos > 0) { const size_t sidx = (size_t)((b * 2 + d) * NPOS + pos - 1) * 6 + (hh); hpre[S_][d][0] = *(const u32x4*)(ST + sidx * 8192 + hp * 128 + hn0); hpre[S_][d][1] = *(const u32x4*)(ST + sidx * 8192 + hp * 128 + hn0 + 8); } } \
        _Pragma("unroll") for (int pt = 0; pt < 4; ++pt) { const int cidx = (hh) * 64 + 16 * pt + 4 * fq; ypre[S_][pt] = *(const f32x4*)(YP + (size_t)row * 384 + cidx); zpre[S_][pt] = *(const u32x2*)(P + (size_t)row * INP + PC_Z + cidx); } } while (0)
    SSDF_LOAD(0, 1);
#pragma unroll 1
    for (int h = 0; h < 6; ++h) {
        const int g = h / 3; constexpr int S = 0;
#pragma unroll
        for (int d = 0; d < 2; ++d) { hpre[0][d][0] = hpre[1][d][0]; hpre[0][d][1] = hpre[1][d][1]; }
#pragma unroll
        for (int pt = 0; pt < 4; ++pt) { ypre[0][pt] = ypre[1][pt]; zpre[0][pt] = zpre[1][pt]; }
        if (h + 1 < 6) SSDF_LOAD(h + 1, 1);
        LAS unsigned char* Hset = Hs + (h & 1) * 2 * 64 * LP;
#pragma unroll
        for (int d = 0; d < 2; ++d) { LAS unsigned char* Hb = Hset + d * 64 * LP;
            *(LAS u32x4*)(Hb + hp * LP + hn0 * 2) = hpre[S][d][0]; *(LAS u32x4*)(Hb + hp * LP + hn0 * 2 + 16) = hpre[S][d][1]; }
        LDS_BARRIER();
        f32x4 yh[4];
#pragma unroll
        for (int pt = 0; pt < 4; ++pt) yh[pt] = (f32x4){0.f, 0.f, 0.f, 0.f};
#pragma unroll
        for (int d = 0; d < 2; ++d) {
            const LAS unsigned char* Hb = Hset + d * 64 * LP;
            f32x4 tm[4];
#pragma unroll
            for (int pt = 0; pt < 4; ++pt) tm[pt] = (f32x4){0.f, 0.f, 0.f, 0.f};
#pragma unroll
            for (int ks = 0; ks < 4; ++ks) { const bf16x8 cf = *(const LAS bf16x8*)(Cs + lrow * CPITCH + (g * 128 + 32 * ks + 8 * fq) * 2);
#pragma unroll
                for (int pt = 0; pt < 4; ++pt) { const bf16x8 hf = *(const LAS bf16x8*)(Hb + (16 * pt + fr) * LP + (32 * ks + 8 * fq) * 2); tm[pt] = MFMA16(hf, cf, tm[pt]); } }
            const float e = __expf(d == 0 ? (h == 0 ? acv[0] : h == 1 ? acv[1] : h == 2 ? acv[2] : h == 3 ? acv[3] : h == 4 ? acv[4] : acv[5]) : (h == 0 ? acv[6] : h == 1 ? acv[7] : h == 2 ? acv[8] : h == 3 ? acv[9] : h == 4 ? acv[10] : acv[11]));
#pragma unroll
            for (int pt = 0; pt < 4; ++pt) yh[pt] += tm[pt] * e;
        }
#pragma unroll
        for (int pt = 0; pt < 4; ++pt) { const int cidx = h * 64 + 16 * pt + 4 * fq; const u32x2 z = zpre[S][pt];
            f32x4 v = yh[pt] + ypre[S][pt]; v[0] *= silu_f(bflo(z.x)); v[1] *= silu_f(bfhi(z.x)); v[2] *= silu_f(bflo(z.y)); v[3] *= silu_f(bfhi(z.y));
            u32x2 o; o.x = cvtpk(v[0], v[1]); o.y = cvtpk(v[2], v[3]); *(u32x2*)(CAT + (size_t)row * DM + 256 + cidx) = o; ss += (v[0] * v[0] + v[1] * v[1]) + (v[2] * v[2] + v[3] * v[3]); }
    }
#undef SSDF_LOAD
    ss += __shfl_xor(ss, 16); ss += __shfl_xor(ss, 32);
    const float rstd = rsqrtf(ss * (1.f / 384.f) + EPS);
    u32x2 st[6][4];
#pragma unroll
    for (int h = 0; h < 6; ++h)
#pragma unroll
        for (int pt = 0; pt < 4; ++pt) st[h][pt] = *(const u32x2*)(CAT + (size_t)row * DM + 256 + h * 64 + 16 * pt + 4 * fq);
    asm volatile("" ::: "memory");
#pragma unroll
    for (int h = 0; h < 6; ++h)
#pragma unroll
        for (int pt = 0; pt < 4; ++pt) { const int cidx = h * 64 + 16 * pt + 4 * fq; const f32x4 gg = *(const f32x4*)(F.g_ssd + l * 384 + cidx); const u32x2 t = st[h][pt]; f32x4 v = {bflo(t.x), bfhi(t.x), bflo(t.y), bfhi(t.y)}; v = v * rstd * gg;
            u32x2 o; o.x = cvtpk(v[0], v[1]); o.y = cvtpk(v[2], v[3]); *(u32x2*)(CAT + (size_t)row * DM + 256 + cidx) = o; }
    __syncthreads();
}

__device__ __forceinline__ void build_vt_item(Frame& F, int gt, int h) {
    const bf16_t* KV = WSP(bf16_t, WS_KV); bf16_t* VT = WSP(bf16_t, WS_VT);
    const int t7 = F.tid & 127, kq = t7 & 15, ch = t7 >> 4; u32x4 v[4];
#pragma unroll
    for (int r = 0; r < 4; ++r) v[r] = *(const u32x4*)(KV + (size_t)(gt * 64 + 4 * kq + r) * KVW + h * 128 + 64 + ch * 8);
    bf16_t* dst = VT + ((size_t)gt * 6 + h) * 4096 + 4 * kq;
#pragma unroll
    for (int j = 0; j < 4; ++j) { const unsigned a0 = v[0][j], a1 = v[1][j], a2 = v[2][j], a3 = v[3][j];
        u32x2 lo, hi; lo.x = (a0 & 0xffffu) | (a1 << 16); lo.y = (a2 & 0xffffu) | (a3 << 16); hi.x = (a0 >> 16) | (a1 & 0xffff0000u); hi.y = (a2 >> 16) | (a3 & 0xffff0000u);
        *(u32x2*)(dst + (8 * ch + 2 * j) * 64) = lo; *(u32x2*)(dst + (8 * ch + 2 * j + 1) * 64) = hi; }
}
template <class Sched> __device__ __forceinline__ void build_vt_own(Frame& F, const Sched& S) {
    asm volatile("s_waitcnt vmcnt(0)" ::: "memory"); __syncthreads();
    pg8::Unit u; const int sub = F.tid >> 7;
    for (int i = 0; S.next(i, u); ++i) {
#pragma unroll
        for (int k = 0; k < 2; ++k) { const int item = sub + 4 * k;
            build_vt_item(F, u.pm * 4 + (item & 3), u.pn * 2 + (item >> 2)); }
    }
}

__device__ __forceinline__ void attn_unit(Frame& F, int u) {
    int b, h, q0, nt; bool isc;
    if (u < 768) { b = u / 96; const int rem = u % 96; h = rem >> 4; q0 = b * SEQ + (rem & 15) * 128; nt = 36; isc = false; }
    else { const int uu = u - 768; b = uu / 12; const int rem = uu % 12; h = rem >> 1; q0 = NLAT + b * CTXL + (rem & 1) * 128; nt = 4; isc = true; }
    constexpr int KP = 208, VP = 136, TILEB = 64 * KP + 64 * VP;
    const bf16_t* Q = WSP(bf16_t, WS_Q); const bf16_t* KV = WSP(bf16_t, WS_KV); const bf16_t* KR = WSP(bf16_t, WS_KR); const bf16_t* VTg = WSP(bf16_t, WS_VT); bf16_t* CAT = WSP(bf16_t, WS_CAT);
    const int w = F.wave, lane = F.lane, tid = F.tid, qs = w & 3, par = w >> 2, r32 = lane & 31, hf = lane >> 5;
    bf16x8 qf[6];
    { const int qrow = q0 + 32 * qs + r32; const bf16_t* qp = Q + (size_t)qrow * QW + h * 96 + 8 * hf;
#pragma unroll
        for (int ks = 0; ks < 6; ++ks) qf[ks] = *(const bf16x8*)(qp + 16 * ks);
        if (!isc) { const int tok = qrow & (SEQ - 1); const f32x2* rt = WSP(f32x2, WS_MISC + MISC_ROPE);
#pragma unroll
            for (int ax = 0; ax < 2; ++ax) { const int pos = ax == 0 ? (tok >> 6) : (tok & 63); u32x4 own = __builtin_bit_cast(u32x4, qf[4 + ax]); u32x4 oth;
                oth.x = __shfl_xor(own.x, 32); oth.y = __shfl_xor(own.y, 32); oth.z = __shfl_xor(own.z, 32); oth.w = __shfl_xor(own.w, 32);
                float a[8], o[8], r[8];
                a[0] = bflo(own.x); a[1] = bfhi(own.x); a[2] = bflo(own.y); a[3] = bfhi(own.y); a[4] = bflo(own.z); a[5] = bfhi(own.z); a[6] = bflo(own.w); a[7] = bfhi(own.w);
                o[0] = bflo(oth.x); o[1] = bfhi(oth.x); o[2] = bflo(oth.y); o[3] = bfhi(oth.y); o[4] = bflo(oth.z); o[5] = bfhi(oth.z); o[6] = bflo(oth.w); o[7] = bfhi(oth.w);
#pragma unroll
                for (int f = 0; f < 8; ++f) { const f32x2 cs = rt[pos * 8 + f]; r[f] = hf == 0 ? (a[f] * cs.x - o[f] * cs.y) : (o[f] * cs.y + a[f] * cs.x); }
                u32x4 res; res.x = cvtpk(r[0], r[1]); res.y = cvtpk(r[2], r[3]); res.z = cvtpk(r[4], r[5]); res.w = cvtpk(r[6], r[7]); qf[4 + ax] = __builtin_bit_cast(bf16x8, res); } }
    }
    u32x4 knA[2], krA, vregA[2], knB[2], krB, vregB[2];
    const unsigned voffK = (unsigned)((tid >> 3) * KVW + (tid & 7) * 8) * 2u, voffR = (unsigned)tid * 16u, voffV = (unsigned)tid * 16u;
    const unsigned ldsK = (unsigned)((tid >> 3) * KP + (tid & 7) * 16), ldsR = (unsigned)((tid >> 8) * TILEB + ((tid >> 2) & 63) * KP + (8 + (tid & 3)) * 16), ldsV = (unsigned)(64 * KP + (tid >> 3) * VP + (tid & 7) * 16);
#define ATT_R(tp) ((isc || (tp) < 2) ? (NLAT + b * CTXL + (tp) * 128) : (b * SEQ + ((tp) - 2) * 128))
#define ATT_LOAD(kn, kr, vreg, tp) do { const int R_ = __builtin_amdgcn_readfirstlane(ATT_R(tp)); \
        const unsigned char* kb_ = (const unsigned char*)(KV + (size_t)R_ * KVW + h * 128); \
        kn[0] = *(const u32x4*)(kb_ + voffK); kn[1] = *(const u32x4*)(kb_ + 64 * KVW * 2 + voffK); \
        kr = *(const u32x4*)((const unsigned char*)(KR + (size_t)R_ * 32) + voffR); \
        const unsigned char* vb_ = (const unsigned char*)(VTg + ((size_t)(R_ >> 6) * 6 + h) * 4096); \
        vreg[0] = *(const u32x4*)(vb_ + voffV); vreg[1] = *(const u32x4*)(vb_ + 6 * 4096 * 2 + voffV); } while (0)
#define ATT_WRITE(kn, kr, vreg, buf) do { LAS unsigned char* base_ = F.lds + (buf) * 2 * TILEB; \
        *(LAS u32x4*)(base_ + ldsK) = kn[0]; *(LAS u32x4*)(base_ + TILEB + ldsK) = kn[1]; *(LAS u32x4*)(base_ + ldsR) = kr; \
        _Pragma("unroll") for (int i = 0; i < 2; ++i) { LAS unsigned char* vt = base_ + i * TILEB + ldsV; \
            *(LAS u32x2*)vt = (u32x2){vreg[i].x, vreg[i].y}; *(LAS u32x2*)(vt + 8) = (u32x2){vreg[i].z, vreg[i].w}; } } while (0)
    const int np = nt / 2;
    ATT_LOAD(knA, krA, vregA, 0); ATT_WRITE(knA, krA, vregA, 0);
    __syncthreads();
    ATT_LOAD(knB, krB, vregB, 1);
    f32x16 o0, o1;
#pragma unroll
    for (int r = 0; r < 16; ++r) { o0[r] = 0.f; o1[r] = 0.f; }
    float mrun = 0.f, lrun = 0.f;
    const unsigned kfo = (unsigned)(r32 * KP + 16 * hf), vfo = (unsigned)(64 * KP + r32 * VP + 8 * hf);
#define ATT_STEP(tp) do { \
        const LAS unsigned char* Kt = F.lds + ((((tp)) & 1) * 2 + par) * TILEB; \
        bf16x8 ka[6], kb[6]; \
        _Pragma("unroll") \
        for (int ks = 0; ks < 6; ++ks) ka[ks] = *(const LAS bf16x8*)(Kt + kfo + 32 * ks); \
        _Pragma("unroll") \
        for (int ks = 0; ks < 6; ++ks) kb[ks] = *(const LAS bf16x8*)(Kt + kfo + 32 * KP + 32 * ks); \
        f32x16 p0, p1; \
        _Pragma("unroll") \
        for (int r = 0; r < 16; ++r) { p0[r] = -mrun; p1[r] = -mrun; } \
        __builtin_amdgcn_sched_barrier(0); \
        _Pragma("unroll") \
        for (int ks = 0; ks < 6; ++ks) { p0 = MFMA32(ka[ks], qf[ks], p0); p1 = MFMA32(kb[ks], qf[ks], p1); } \
        u32x2 va[4][2], vc[4][2]; \
        _Pragma("unroll") \
        for (int s2 = 0; s2 < 4; ++s2) { \
            va[s2][0] = *(const LAS u32x2*)(Kt + vfo + 32 * s2); va[s2][1] = *(const LAS u32x2*)(Kt + vfo + 32 * s2 + 16); \
            vc[s2][0] = *(const LAS u32x2*)(Kt + vfo + 32 * VP + 32 * s2); vc[s2][1] = *(const LAS u32x2*)(Kt + vfo + 32 * VP + 32 * s2 + 16); } \
        __builtin_amdgcn_sched_barrier(0); \
        float mx = p0[0]; \
        _Pragma("unroll") \
        for (int r = 1; r < 16; ++r) mx = fmaxf(mx, p0[r]); \
        _Pragma("unroll") \
        for (int r = 0; r < 16; ++r) mx = fmaxf(mx, p1[r]); \
        mx = fmaxf(mx, __shfl_xor(mx, 32)); \
        if ((tp) == 0 || __any(mx > 8.f)) { const float dl = (tp) == 0 ? mx : fmaxf(mx, 0.f), alpha = __builtin_amdgcn_exp2f(-dl); lrun *= alpha; mrun += dl; \
        _Pragma("unroll") \
            for (int r = 0; r < 16; ++r) { o0[r] *= alpha; o1[r] *= alpha; p0[r] -= dl; p1[r] -= dl; } } \
        _Pragma("unroll") \
        for (int r = 0; r < 16; ++r) { p0[r] = __builtin_amdgcn_exp2f(p0[r]); p1[r] = __builtin_amdgcn_exp2f(p1[r]); } \
        float sa = p0[0], sb = p0[1], sc = p1[0], sd = p1[1]; \
        _Pragma("unroll") \
        for (int r = 2; r < 16; r += 2) { sa += p0[r]; sb += p0[r + 1]; sc += p1[r]; sd += p1[r + 1]; } \
        lrun += (sa + sb) + (sc + sd); \
        bf16x8 pf[4]; \
        _Pragma("unroll") \
        for (int s2 = 0; s2 < 4; ++s2) { u32x4 t; \
            if (s2 < 2) { t.x = cvtpk(p0[8 * s2], p0[8 * s2 + 1]); t.y = cvtpk(p0[8 * s2 + 2], p0[8 * s2 + 3]); t.z = cvtpk(p0[8 * s2 + 4], p0[8 * s2 + 5]); t.w = cvtpk(p0[8 * s2 + 6], p0[8 * s2 + 7]); } \
            else { const int s = s2 - 2; t.x = cvtpk(p1[8 * s], p1[8 * s + 1]); t.y = cvtpk(p1[8 * s + 2], p1[8 * s + 3]); t.z = cvtpk(p1[8 * s + 4], p1[8 * s + 5]); t.w = cvtpk(p1[8 * s + 6], p1[8 * s + 7]); } \
            pf[s2] = __builtin_bit_cast(bf16x8, t); } \
        _Pragma("unroll") \
        for (int s2 = 0; s2 < 4; ++s2) { \
            const u32x4 va4 = {va[s2][0].x, va[s2][0].y, va[s2][1].x, va[s2][1].y}, vc4 = {vc[s2][0].x, vc[s2][0].y, vc[s2][1].x, vc[s2][1].y}; \
            o0 = MFMA32(__builtin_bit_cast(bf16x8, va4), pf[s2], o0); o1 = MFMA32(__builtin_bit_cast(bf16x8, vc4), pf[s2], o1); } \
    } while (0)
    for (int tp = 0; tp < np; tp += 2) {
        ATT_LOAD(knA, krA, vregA, min(tp + 2, np - 1));
        ATT_STEP(tp);
        if (tp + 1 < np) ATT_WRITE(knB, krB, vregB, 1);
        LDS_BARRIER();
        if (tp + 1 < np) {
            ATT_LOAD(knB, krB, vregB, min(tp + 3, np - 1));
            ATT_STEP(tp + 1);
            if (tp + 2 < np) ATT_WRITE(knA, krA, vregA, 0);
            LDS_BARRIER();
        }
    }
#undef ATT_STEP
#undef ATT_R
#undef ATT_LOAD
#undef ATT_WRITE
    lrun += __shfl_xor(lrun, 32);
    LAS float* mg = (LAS float*)(F.lds + 4 * TILEB);
    if (par == 1) { LAS float* d = mg + ((qs * 64 + lane) * 36);
#pragma unroll
        for (int r = 0; r < 16; r += 4) { *(LAS f32x4*)(d + r) = (f32x4){o0[r], o0[r + 1], o0[r + 2], o0[r + 3]}; *(LAS f32x4*)(d + 16 + r) = (f32x4){o1[r], o1[r + 1], o1[r + 2], o1[r + 3]}; }
        d[32] = mrun; d[33] = lrun; }
    __syncthreads();
    if (par == 0) { const LAS float* d = mg + ((qs * 64 + lane) * 36);
        const float m2 = d[32], l2 = d[33], mm = fmaxf(mrun, m2), a1 = __builtin_amdgcn_exp2f(mrun - mm), a2 = __builtin_amdgcn_exp2f(m2 - mm), inv = 1.f / (lrun * a1 + l2 * a2);
        const int qrow = q0 + 32 * qs + r32; bf16_t* op = CAT + (size_t)qrow * DM + 640 + h * 64;
#pragma unroll
        for (int g4 = 0; g4 < 4; ++g4) { const f32x4 e0 = *(const LAS f32x4*)(d + 4 * g4), e1 = *(const LAS f32x4*)(d + 16 + 4 * g4);
            float r0[4], r1[4];
#pragma unroll
            for (int r = 0; r < 4; ++r) { r0[r] = (o0[4 * g4 + r] * a1 + e0[r] * a2) * inv; r1[r] = (o1[4 * g4 + r] * a1 + e1[r] * a2) * inv; }
            u32x2 w0, w1; w0.x = cvtpk(r0[0], r0[1]); w0.y = cvtpk(r0[2], r0[3]); w1.x = cvtpk(r1[0], r1[1]); w1.y = cvtpk(r1[2], r1[3]);
            *(u32x2*)(op + 8 * g4 + 4 * hf) = w0; *(u32x2*)(op + 32 + 8 * g4 + 4 * hf) = w1; } }
    __syncthreads();
}
#ifndef MK_PER_PHASE
#define MK_PER_PHASE 0
#endif
constexpr int N_PHASES = 20;
struct Args { const float* in[32]; float* out; unsigned char* ws; int ph_lo, ph_hi; };
typedef __attribute__((address_space(4))) const Args CArgs;
#define GPF(k) ((const float*)(GAS const float*)ap_->in[k])

__global__ void __launch_bounds__(NTHR, 2) fwd_megakernel(Args args) {
    extern __shared__ __attribute__((aligned(16))) unsigned char lds_raw[];
    Frame F;
    F.sm = lds_raw; F.lds = (LAS unsigned char*)lds_raw;
    F.G = gridDim.x; { const int bx = blockIdx.x; F.vcu = (F.G % 8 == 0) ? (bx % 8) * (F.G / 8) + bx / 8 : bx; }
#define PHASE_BEGIN() do { int t_ = threadIdx.x; asm volatile("" : "+v"(t_)); t_ &= 511; F.tid = t_; F.lane = t_ & 63; F.wave = __builtin_amdgcn_readfirstlane(t_ >> 6); \
    CArgs* ap_ = (CArgs*)__builtin_amdgcn_kernarg_segment_ptr(); asm volatile("" : "+s"(ap_)); \
    F.x = GPF(0); F.c = GPF(1); F.ctx = GPF(2); F.c_ctx = GPF(3); F.w_mod = GPF(4); F.b_mod = GPF(5); F.g_mix = GPF(6); F.w_in = GPF(7); \
    F.w_sgu = GPF(8); F.b_sgu = GPF(9); F.g_sgu = GPF(10); F.beta_sgu = GPF(11); F.conv_w = GPF(12); F.conv_b = GPF(13); F.dt_bias = GPF(14); F.a_log = GPF(15); \
    F.d_skip = GPF(16); F.g_ssd = GPF(17); F.g_q = GPF(18); F.w_uq = GPF(19); F.g_kv = GPF(20); F.w_ukv = GPF(21); F.w_out = GPF(22); F.g_ffn = GPF(23); \
    F.w_gate = GPF(24); F.w_up = GPF(25); F.w_down = GPF(26); F.w_router = GPF(27); F.w_gate_e = GPF(28); F.w_up_e = GPF(29); F.w_down_e = GPF(30); F.g_final = GPF(31); \
    F.out = (float*)(GAS float*)ap_->out; F.ws = (unsigned char*)(GAS unsigned char*)ap_->ws; } while (0)
    PHASE_BEGIN();
    volatile LAS unsigned* MISC = (volatile LAS unsigned*)(F.lds + MISC_OFF);
    for (int u = F.tid; u < (LDS_BYTES - LDSCTL_OFF) / 4; u += NTHR) ((LAS unsigned*)(F.lds + LDSCTL_OFF))[u] = 0u;
    __syncthreads();
    XcdBarrier bar = xcd_barrier_post(WSP(unsigned, WS_CTL) + CW_BAR, MISC + 8, threadIdx.x == 0);
    { long pc0_; int clen_; asm volatile("mk_code_beg:\n\ts_getpc_b64 %0\n\ts_mov_b32 %1, mk_code_end - mk_code_beg" : "=s"(pc0_), "=s"(clen_));
      if (threadIdx.x == 0) { volatile LAS unsigned* cw = (volatile LAS unsigned*)(F.lds + LDSCTL_OFF + 960); cw[0] = (unsigned)pc0_; cw[1] = (unsigned)((unsigned long)pc0_ >> 32); cw[2] = (unsigned)clen_; }
      const int ln_ = ((int)blockIdx.x >> 3) * NTHR + (int)threadIdx.x; if (ln_ * 128 < clen_) (void)*(volatile const unsigned*)((const char*)pc0_ + (size_t)ln_ * 128); }
#ifndef WARM_AT
#define WARM_AT(k) 0
#endif
#define CODE_WARM() do { const volatile LAS unsigned* cw_ = (const volatile LAS unsigned*)(F.lds + LDSCTL_OFF + 960); const int ln_ = ((int)blockIdx.x >> 3) * NTHR + (int)threadIdx.x; \
    if (ln_ * 128 < (int)cw_[2]) { const char* cb_ = (const char*)(((unsigned long)cw_[1] << 32) | (unsigned long)cw_[0]); (void)*(volatile const unsigned*)(cb_ + (size_t)ln_ * 128); } } while (0)
#if MK_PER_PHASE
    const int lo = args.ph_lo, hi = args.ph_hi;
#else
    constexpr int lo = 0, hi = N_PHASES;
#endif
#ifndef PH_MASK
#define PH_MASK 0xFFFFFFFFu
#endif
#define PE(b) ((PH_MASK >> (b)) & 1u)
#ifndef REP_MASK
#define REP_MASK 0u
#endif
#ifndef SSD_DRY_LIMIT
#define SSD_DRY_LIMIT 0
#endif
#define NREP(b) (1 + (int)((REP_MASK >> (b)) & 1u))
#define IN(k) (lo <= (k) && (k) < hi)
#define SEAM(k) do { if (IN(k) && IN((k) + 1)) { if (WARM_AT(k)) CODE_WARM(); for (int rep_ = 0; rep_ < NREP(20); ++rep_) xcd_barrier(bar, threadIdx.x == 0); } } while (0)
#define XC WSP(float, WS_XC)
#define SSQ WSP(float, WS_SSQP)
#define ctl WSP(unsigned, WS_CTL)

    if (IN(0) && PE(0)) { for (int rep = 0; rep < NREP(0); ++rep) { PHASE_BEGIN(); p_prologue(F); } }
    SEAM(0);
#pragma unroll 1
    for (int l = 0; l < DEPTH; ++l) {
        const int pb = 1 + 9 * l;
#define modl (WSP(float, WS_MOD) + (size_t)l * 9 * 6144)
#define srcL (l == 0 ? F.x : (const float*)F.out)
#define srcC (l == 0 ? F.ctx : (const float*)XC)
        if (IN(pb + 0) && PE(1)) for (int rep = 0; rep < NREP(1); ++rep) { PHASE_BEGIN(); p_norm<false>(F, l, 0, MT, srcL, srcC, l == 1 ? WSP(float, WS_SLAB) : nullptr, WSP(float, WS_MOD) + (size_t)8 * 6144 + 5 * DM); }
        SEAM(pb + 0);
        if (IN(pb + 1) && PE(2)) for (int rep = 0; rep < NREP(2); ++rep) {
            PHASE_BEGIN();
            pg8::Gemm g{WSP(bf16_t, WS_H), WSP(bf16_t, WS_WIN) + (size_t)l * INP * DM, DM, DM, 0};
            pg8::StaticOrder S; S.init(MT, INP, F.G, (int)blockIdx.x);
            pg8::EpiInProj E{WSP(bf16_t, WS_P), SSQ, rep < NREP(2) - 1};
            pg8::gemm_phase<pg8::EpiInProj, pg8::StaticOrder, true, false>(F.lds, F.tid, g, S, E);
        }
        SEAM(pb + 1);
        if (IN(pb + 2)) {
            if (PE(3)) for (int rep = 0; rep < NREP(3); ++rep) { PHASE_BEGIN(); pg8::Gemm g{WSP(bf16_t, WS_P) + PC_CQ, WSP(bf16_t, WS_WUQ) + (size_t)l * QWP * 384, INP, 384, 0};
              pg8::StaticOrder S;
              if (l == 0 && F.G == 256) { const int k_ = (int)blockIdx.x >> 3; S.init_plan(MT, QWP, (int)blockIdx.x & 7, k_ <= 10 ? k_ : (k_ == 15 ? 11 : (k_ == 19 ? 12 : (k_ == 20 ? 14 : k_ - 5))), (k_ >= 11 && k_ <= 18 && k_ != 15) ? 0 : ((k_ == 19 || k_ == 20) ? 2 : 1)); }
              else S.init(l == 0 ? MT : NLAT, QWP, F.G, l == 0 ? (int)blockIdx.x : (int)((blockIdx.x + 136u) % (unsigned)F.G));
              pg8::EpiScaleBf16 E{WSP(bf16_t, WS_Q), QW, QW, SSQ, 0, 1.f / 384.f, QSCALE};
              pg8::gemm_phase<pg8::EpiScaleBf16, pg8::StaticOrder, true, false>(F.lds, F.tid, g, S, E); }
            if (PE(4)) for (int rep = 0; rep < NREP(4); ++rep) { PHASE_BEGIN(); pg8::Gemm g{WSP(bf16_t, WS_P) + PC_CKV, WSP(bf16_t, WS_WUKV) + (size_t)l * KVW * 256, INP, 256, 0};
              pg8::StaticOrder S;
              if (l == 0 && F.G == 256) { const int k_ = (int)blockIdx.x >> 3; S.init_plan(MT, KVW, (int)blockIdx.x & 7, k_ <= 10 ? k_ : k_ - 5, (k_ >= 11 && k_ <= 15) ? 0 : 1); }
              else S.init(MT, KVW, F.G, (int)((blockIdx.x + 128u) % (unsigned)F.G));
              pg8::EpiScaleBf16 E{WSP(bf16_t, WS_KV), KVW, KVW, SSQ, 1, 1.f / 256.f, 1.f};
              pg8::gemm_phase<pg8::EpiScaleBf16, pg8::StaticOrder, true, false>(F.lds, F.tid, g, S, E);
              build_vt_own(F, S); }
            if (PE(5)) for (int rep = 0; rep < NREP(5); ++rep) { PHASE_BEGIN();
                for (int k = 0; k < 2; ++k) {
                    const int bx_ = (int)blockIdx.x; int u;
                    if (F.G == 256) u = k == 0 ? F.vcu : ((bx_ >= 88 && bx_ < 120) ? 256 + bx_ - 88 : -1); else u = F.vcu + k * F.G;
                    if (u >= 0 && u < 288) ssd_local_unit(F, l, u); } }
            if (PE(6)) { PHASE_BEGIN(); for (int u = F.vcu; u < 144; u += F.G) krope_unit(F, u); }
            if (PE(6) && !(l == 1 && F.G == 256)) for (int rep = 0; rep < NREP(6); ++rep) { PHASE_BEGIN();
                const int bx_ = (int)blockIdx.x;
                if (F.G == 256) { const int k_ = bx_ >> 3; if (k_ >= 15 && k_ <= 18) sgu_unit(F, l, 112 + (k_ - 15) * 8 + (bx_ & 7)); }
                else { for (int u = F.G - 1 - F.vcu; u < 144; u += F.G) sgu_unit(F, l, u); } }
        }
        SEAM(pb + 2);
        if (IN(pb + 3)) {
            if (PE(5)) { PHASE_BEGIN(); ssd_scan(F); }
        }
        SEAM(pb + 3);
        if (IN(pb + 4)) {
            const int nat = l == 0 ? 864 : 768, nsf = l == 0 ? 144 : 128;
            if (PE(7)) for (int rep = 0; rep < NREP(7); ++rep) { PHASE_BEGIN();
                const bool l1p = l == 1 && F.G == 256;
                const int nk = l1p ? 4 : (nat + F.G - 1) / F.G;
                for (int k = 0; k < nk; ++k) { const int u = (l1p && k >= 2) ? (F.vcu < 128 ? 512 + 128 * (k - 2) + F.vcu : nat) : F.vcu + F.G * k; if (u < nat) attn_unit(F, u); } }
            if (PE(8)) for (int rep = 0; rep < NREP(8); ++rep) { PHASE_BEGIN(); for (int u = F.G - 1 - F.vcu; u < nsf; u += F.G) ssd_final_unit(F, l, u); }
            if (PE(6) && F.G == 256) { PHASE_BEGIN();
                const int u = l == 1 ? (F.vcu >= 128 ? F.vcu - 128 : -1) : (F.vcu < 112 ? F.vcu : -1);
                if (u >= 0) sgu_unit(F, l, u); }
        }
        SEAM(pb + 4);
        if (IN(pb + 5) && PE(9)) {
         const int gst = l == 0 ? 0 : (int)((blockIdx.x >> 3) & 1u);
         for (int st = 0; st < (l == 0 ? 1 : 2); ++st) {
          if (st == gst) for (int rep = 0; rep < NREP(9); ++rep) {
            PHASE_BEGIN();
            pg8::Gemm g{WSP(bf16_t, WS_CAT), WSP(bf16_t, WS_WOUT) + (size_t)l * DM * DM, DM, DM, 0};
            pg8::StaticOrder S; S.init(l == 0 ? MT : NLAT, DM, F.G, (int)blockIdx.x);
            pg8::EpiResid E{srcL, srcC, F.out, XC, modl, 2, rep < NREP(9) - 1, nullptr};
            pg8::gemm_phase<pg8::EpiResid, pg8::StaticOrder, true, false>(F.lds, F.tid, g, S, E);
            if (l == 0 && rep == NREP(9) - 1) { PHASE_BEGIN(); int wi_, nw_; if (tail_worker(MT / 256 * (DM / 256), F.G, (int)blockIdx.x, wi_, nw_)) { for (int set_ = 2; set_ < 4; ++set_) convert_set(F, set_, wi_, nw_); mod_gemv(F, 1, wi_, nw_); } }
          }
          if (l == 1 && st != gst && PE(10)) for (int rep = 0; rep < NREP(10); ++rep) { PHASE_BEGIN(); p_moe_weights(F); }
         }
        }
        SEAM(pb + 5);
        if (IN(pb + 6) && PE(11)) { PHASE_BEGIN(); if (l == 0) { for (int rep = 0; rep < NREP(11); ++rep) p_norm<false>(F, l, 1, MT, F.out, XC); } else p_norm<true>(F, l, 1, NLAT, F.out, XC); }
        SEAM(pb + 6);
        if (IN(pb + 7)) {
            if (l == 0 && PE(12)) for (int rep = 0; rep < NREP(12); ++rep) {
                PHASE_BEGIN();
                pg8::Gemm g{WSP(bf16_t, WS_H), WSP(bf16_t, WS_WGU), DM, DM, 0};
                pg8::StaticOrder S; S.init(MT, 2 * DFF, F.G, (int)blockIdx.x);
                pg8::EpiSwiglu E{WSP(bf16_t, WS_ACT), DFF};
                pg8::gemm_phase<pg8::EpiSwiglu, pg8::StaticOrder, true, false>(F.lds, F.tid, g, S, E);
            } else if (l == 1 && PE(13)) for (int rep = 0; rep < NREP(13); ++rep) {
                PHASE_BEGIN();
                pg8::Gemm g{WSP(bf16_t, WS_H), WSP(bf16_t, WS_MOEW_GU), DM, DM, (size_t)2 * DFE * DM};
                pg8::MoeOrder S; S.init(ctl + CW_CNT, 11, F.G, (int)blockIdx.x, WSP(int, WS_LIST), true);
                pg8::EpiSwiglu E{WSP(bf16_t, WS_MACT), DFE};
                pg8::gemm_phase<pg8::EpiSwiglu, pg8::MoeOrder, true, true>(F.lds, F.tid, g, S, E);
            }
        }
        SEAM(pb + 7);
        if (IN(pb + 8)) {
            if (l == 0 && PE(14)) for (int rep = 0; rep < NREP(14); ++rep) {
                PHASE_BEGIN();
                pg8::Gemm g{WSP(bf16_t, WS_ACT), WSP(bf16_t, WS_WD), DFF, DFF, 0};
                pg8::DownSplitOrder S; S.init(F.G, (int)blockIdx.x);
                pg8::EpiResid E{F.out, XC, F.out, XC, modl, 5, rep < NREP(14) - 1, WSP(float, WS_SLAB)};
                pg8::gemm_phase<pg8::EpiResid, pg8::DownSplitOrder, true, false, true>(F.lds, F.tid, g, S, E);
            } else if (l == 1 && PE(15)) for (int rep = 0; rep < NREP(15); ++rep) {
                PHASE_BEGIN();
                pg8::Gemm g{WSP(bf16_t, WS_MACT), WSP(bf16_t, WS_MOEW_D), DFE, DFE, (size_t)DM * DFE};
                pg8::MoeOrder S; S.init(ctl + CW_CNT, 4, F.G, (int)blockIdx.x, WSP(int, WS_LIST), false);
                pg8::EpiMoeDown E{WSP(bf16_t, WS_Y), WSP(int, WS_LIST), WSP(float, WS_MISC + MISC_TOPW), S};
                pg8::gemm_phase<pg8::EpiMoeDown, pg8::MoeOrder, true, false>(F.lds, F.tid, g, S, E);
            }
        }
        SEAM(pb + 8);
    }
    if (IN(19) && PE(16)) { PHASE_BEGIN(); p_final(F); }
#undef IN
#undef SEAM
#undef XC
#undef SSQ
#undef ctl
#undef modl
#undef srcL
#undef srcC
#undef PHASE_BEGIN
    asm volatile("mk_code_end:");
}

extern "C" void kernel_launch(void* const* d_in, const int* in_sizes, int n_in, void* d_out, int out_size, void* d_ws, size_t ws_size, hipStream_t stream) {
    static int grid = 0;
    if (grid == 0) {
        if (n_in != 32 || out_size != NLAT * DM || ws_size < WS_END) { fprintf(stderr, "kernel_launch: unexpected shapes (n_in %d, out %d, ws %zu); nothing launched\n", n_in, out_size, ws_size); grid = -1; return; }
        int dev = 0, cus = 0, per_cu = 0;
        if (hipGetDevice(&dev) != hipSuccess || hipDeviceGetAttribute(&cus, hipDeviceAttributeMultiprocessorCount, dev) != hipSuccess) { grid = -1; return; }
        if (hipFuncSetAttribute((const void*)fwd_megakernel, hipFuncAttributeMaxDynamicSharedMemorySize, LDS_BYTES) != hipSuccess) { fprintf(stderr, "kernel_launch: hipFuncSetAttribute failed\n"); grid = -1; return; }
        if (hipOccupancyMaxActiveBlocksPerMultiprocessor(&per_cu, (const void*)fwd_megakernel, NTHR, LDS_BYTES) != hipSuccess || per_cu < 1) { fprintf(stderr, "kernel_launch: occupancy query says %d blocks/CU\n", per_cu); (void)hipGetLastError(); grid = -1; return; }
        grid = cus;
    }
    if (grid < 0) return;
    (void)hipMemsetAsync((char*)d_ws + WS_CTL, 0, CTL_BYTES, stream);
    Args a{};
    for (int i = 0; i < 32; ++i) a.in[i] = (const float*)d_in[i];
    a.out = (float*)d_out; a.ws = (unsigned char*)d_ws;
#if MK_PER_PHASE
    for (int k = 0; k < N_PHASES; ++k) { a.ph_lo = k; a.ph_hi = k + 1; hipLaunchKernelGGL(fwd_megakernel, dim3(grid), dim3(NTHR), LDS_BYTES, stream, a); }
#else
    a.ph_lo = 0; a.ph_hi = N_PHASES;
    void* kargs[] = {&a};
    hipError_t e = hipLaunchCooperativeKernel((const void*)fwd_megakernel, dim3(grid), dim3(NTHR), kargs, LDS_BYTES, stream);
    if (e != hipSuccess) fprintf(stderr, "kernel_launch: cooperative launch failed: %s (grid %d)\n", hipGetErrorString(e), grid);
#endif
}
```
